# Optimizing an MI355X kernel written in HIP

```python
import math
import jax, jax.numpy as jnp
from jax import lax
import numpy as np

D_MODEL = 1024
BATCH = 16
SEQ = 4096
DEPTH = 2
DEC_BATCH = 4
DEC_SEQ = 4096
PAST_LEN = 128

N_META = 16
MLA_HEADS = 16
MLA_Q_LORA = 768
MLA_KV_LORA = 256
MLA_D_NOPE = 64
MLA_D_ROPE = 32
MLA_D_V = 64
MLA_SCALE = (MLA_D_NOPE + MLA_D_ROPE) ** -0.5
ROPE_BASE = 10000.0
Q_BLOCK = 128
HG_HEADS = 8
HG_D_K = 128
HG_D_V = D_MODEL // HG_HEADS
HG_HK = HG_HEADS * HG_D_K
HG_HV = HG_HEADS * HG_D_V
HG_CHUNK = 64
D_FF = 2816
CONV_WIDTH = 3
ALPHA = (2 * DEPTH) ** 0.25
BETA = (8 * DEPTH) ** -0.25
EPS = 1e-6
N_MLA_LAYERS = (DEPTH + 1) // 2
N_HGRN_LAYERS = DEPTH // 2

kernel_name = "hybrid_mla_hgrn2_convffn_encoder"


def rms_norm(x, gain):
    x32 = x.astype(jnp.float32)
    y = x32 * lax.rsqrt(jnp.mean(x32 * x32, axis=-1, keepdims=True) + EPS) * gain.astype(jnp.float32)
    return y.astype(x.dtype)


def layer_norm(x, gain, bias):
    x32 = x.astype(jnp.float32)
    mu = jnp.mean(x32, axis=-1, keepdims=True)
    xc = x32 - mu
    var = jnp.mean(xc * xc, axis=-1, keepdims=True)
    y = xc * lax.rsqrt(var + EPS) * gain.astype(jnp.float32) + bias.astype(jnp.float32)
    return y.astype(x.dtype)


def rope_tables(length):
    inv = 1.0 / (ROPE_BASE ** (jnp.arange(0, MLA_D_ROPE, 2, dtype=jnp.float32) / MLA_D_ROPE))
    ang = jnp.arange(length, dtype=jnp.float32)[:, None] * inv[None, :]
    return jnp.cos(ang), jnp.sin(ang)


def apply_rope(x, cos, sin):
    x32 = x.astype(jnp.float32)
    x1, x2 = jnp.split(x32, 2, axis=-1)
    return jnp.concatenate([x1 * cos - x2 * sin, x1 * sin + x2 * cos], axis=-1).astype(x.dtype)


def mla_attend(q_nope, q_rope, k_nope, k_rope, v):
    B, L, H, _ = q_nope.shape
    nb = -(-L // Q_BLOCK)
    pad = nb * Q_BLOCK - L
    def blocks(t):
        t = jnp.pad(t, ((0, 0), (0, pad), (0, 0), (0, 0)))
        return t.reshape(B, nb, Q_BLOCK, H, t.shape[-1]).transpose(1, 0, 2, 3, 4)
    def one_block(args):
        qn, qr = args
        s = jnp.einsum('bqhd,bkhd->bhqk', qn, k_nope) + jnp.einsum('bqhd,bkd->bhqk', qr, k_rope)
        p = jax.nn.softmax(s.astype(jnp.float32) * MLA_SCALE, axis=-1)
        return jnp.einsum('bhqk,bkhd->bqhd', p.astype(v.dtype), v)
    o = lax.map(one_block, (blocks(q_nope), blocks(q_rope)))
    return o.transpose(1, 0, 2, 3, 4).reshape(B, nb * Q_BLOCK, H, MLA_D_V)[:, :L]


def mla_mixer(h, w_in, q_norm, kv_norm, w_uq, w_ukv, w_o, cos, sin):
    B, L, _ = h.shape
    proj = h @ w_in
    c_q, c_kv, k_rope = jnp.split(proj, [MLA_Q_LORA, MLA_Q_LORA + MLA_KV_LORA], axis=-1)
    c_q = rms_norm(c_q, q_norm)
    c_kv = rms_norm(c_kv, kv_norm)
    q = (c_q @ w_uq).reshape(B, L, MLA_HEADS, MLA_D_NOPE + MLA_D_ROPE)
    kv = (c_kv @ w_ukv).reshape(B, L, MLA_HEADS, MLA_D_NOPE + MLA_D_V)
    q_nope, q_rope = jnp.split(q, [MLA_D_NOPE], axis=-1)
    k_nope, v = jnp.split(kv, [MLA_D_NOPE], axis=-1)
    q_rope = apply_rope(q_rope, cos[:, None, :], sin[:, None, :])
    k_rope = apply_rope(k_rope, cos, sin)
    o = mla_attend(q_nope, q_rope, k_nope, k_rope, v)
    return o.reshape(B, L, MLA_HEADS * MLA_D_V) @ w_o


def gla_chunked(q, k, v, logf):
    B, Lp, H, K = q.shape
    V = v.shape[-1]
    C = HG_CHUNK
    N = Lp // C
    ch = lambda t: t.reshape(B, N, C, H, t.shape[-1])
    q, k, v, logf = ch(q), ch(k), ch(v), ch(logf)
    b = jnp.cumsum(logf, axis=2)
    ref = b[:, :, C // 2:C // 2 + 1]
    a = jnp.einsum('bnthk,bnshk->bnhts', q * jnp.exp(b - ref), k * jnp.exp(ref - b))
    a = jnp.where(jnp.tril(jnp.ones((C, C), dtype=bool)), a, 0.0)
    o_intra = jnp.einsum('bnhts,bnshv->bnthv', a, v)
    b_last = b[:, :, -1]
    u = jnp.einsum('bnshk,bnshv->bnhkv', k * jnp.exp(b_last[:, :, None] - b), v)
    q_dec = q * jnp.exp(b)
    def step(s, xs):
        dec_n, u_n, q_n = xs
        o_n = jnp.einsum('bthk,bhkv->bthv', q_n, s)
        return jnp.exp(dec_n)[..., None] * s + u_n, o_n
    s0 = jnp.zeros((B, H, K, V), jnp.float32)
    _, o_inter = lax.scan(step, s0, (b_last.transpose(1, 0, 2, 3), u.transpose(1, 0, 2, 3, 4), q_dec.transpose(1, 0, 2, 3, 4)))
    o = o_intra + o_inter.transpose(1, 0, 2, 3, 4)
    return o.reshape(B, Lp, H, V)


def hgrn2_mixer(h, w_in, lb_param, o_norm, w_o, layer_idx):
    B, L, _ = h.shape
    pad = HG_CHUNK - N_META
    hp = jnp.pad(h, ((0, 0), (pad, 0), (0, 0)))
    Lp = L + pad
    proj = hp @ w_in
    q, i, f_fw, f_bw, g = jnp.split(proj, [HG_HK, HG_HK + HG_HV, 2 * HG_HK + HG_HV, 3 * HG_HK + HG_HV], axis=-1)
    p = jax.nn.softmax(lb_param.astype(jnp.float32), axis=1)
    lb = (jnp.cumsum(p, axis=1) - p[:, :1])[:, layer_idx]
    valid = (jnp.arange(Lp) >= pad)[None, :, None]
    def forget(f_logit, lb_d):
        f = lb_d + (1.0 - lb_d) * jax.nn.sigmoid(f_logit.astype(jnp.float32))
        return jnp.where(valid, f, 1.0)
    heads = lambda t: t.reshape(B, Lp, HG_HEADS, -1).astype(jnp.float32)
    qh, vh = heads(q), heads(i)
    ff = heads(forget(f_fw, lb[0]))
    fb = heads(forget(f_bw, lb[1]))
    rev = lambda t: jnp.flip(t, axis=1)
    o_fw = gla_chunked(qh, 1.0 - ff, vh, jnp.log(ff))
    o_bw = rev(gla_chunked(rev(qh), rev(1.0 - fb), rev(vh), rev(jnp.log(fb))))
    o = (o_fw + o_bw)[:, pad:]
    o = o * lax.rsqrt(jnp.mean(o * o, axis=-1, keepdims=True) + EPS) * o_norm.astype(jnp.float32).reshape(HG_HEADS, HG_D_V)
    o = o.reshape(B, L, HG_HV) * jax.nn.silu(g[:, pad:].astype(jnp.float32))
    return o.astype(h.dtype) @ w_o


def conv_ffn(h, w_up, conv_w, conv_b, w_down):
    L = h.shape[1]
    u = h @ w_up
    half = CONV_WIDTH // 2
    up = jnp.pad(u, ((0, 0), (half, half), (0, 0)))
    u = sum(up[:, j:j + L] * conv_w[j] for j in range(CONV_WIDTH)) + conv_b
    val, gate = jnp.split(u, 2, axis=-1)
    return (jax.nn.silu(gate) * val) @ w_down


def trunk(x, meta_tokens, mla_w_in, mla_q_norm, mla_kv_norm, mla_w_uq, mla_w_ukv, mla_w_o,
          hgrn_w_in, hgrn_lower_bound, hgrn_o_norm, hgrn_w_o,
          ffn_w_up, ffn_conv_w, ffn_conv_b, ffn_w_down, ln_gain, ln_bias):
    B = x.shape[0]
    meta = jnp.broadcast_to(meta_tokens[None].astype(x.dtype), (B, N_META, D_MODEL))
    h = jnp.concatenate([meta, x], axis=1)
    cos, sin = rope_tables(h.shape[1])
    for layer in range(DEPTH):
        j = layer // 2
        if layer % 2 == 0:
            mix = mla_mixer(h, mla_w_in[j], mla_q_norm[j], mla_kv_norm[j], mla_w_uq[j], mla_w_ukv[j], mla_w_o[j], cos, sin)
        else:
            mix = hgrn2_mixer(h, hgrn_w_in[j], hgrn_lower_bound, hgrn_o_norm[j], hgrn_w_o[j], layer)
        h = layer_norm(ALPHA * h + mix, ln_gain[layer, 0], ln_bias[layer, 0])
        h = layer_norm(ALPHA * h + conv_ffn(h, ffn_w_up[layer], ffn_conv_w[layer], ffn_conv_b[layer], ffn_w_down[layer]),
                       ln_gain[layer, 1], ln_bias[layer, 1])
    return h[:, N_META:]


def setup_inputs(seed: int = 0) -> dict:
    key = jax.random.key(seed)
    ks = jax.random.split(key, 24)
    f32 = jnp.float32
    def nrm(k, shape, fan_in, scale=1.0):
        return jax.random.normal(k, shape, f32) * (scale * fan_in ** -0.5)
    def gain(k, shape):
        return 1.0 + 0.02 * jax.random.normal(k, shape, f32)
    NA, NB = N_MLA_LAYERS, N_HGRN_LAYERS
    return {
        "x_prompt": jax.random.normal(ks[0], (BATCH, SEQ, D_MODEL), f32),
        "x_sample": jax.random.normal(ks[1], (DEC_BATCH, DEC_SEQ, D_MODEL), f32),
        "meta_tokens": jax.random.normal(ks[2], (N_META, D_MODEL), f32),
        "mla_w_in": nrm(ks[3], (NA, D_MODEL, MLA_Q_LORA + MLA_KV_LORA + MLA_D_ROPE), D_MODEL),
        "mla_q_norm": gain(ks[4], (NA, MLA_Q_LORA)),
        "mla_kv_norm": gain(ks[5], (NA, MLA_KV_LORA)),
        "mla_w_uq": nrm(ks[6], (NA, MLA_Q_LORA, MLA_HEADS * (MLA_D_NOPE + MLA_D_ROPE)), MLA_Q_LORA),
        "mla_w_ukv": nrm(ks[7], (NA, MLA_KV_LORA, MLA_HEADS * (MLA_D_NOPE + MLA_D_V)), MLA_KV_LORA),
        "mla_w_o": nrm(ks[8], (NA, MLA_HEADS * MLA_D_V, D_MODEL), MLA_HEADS * MLA_D_V, BETA),
        "hgrn_w_in": nrm(ks[9], (NB, D_MODEL, 3 * HG_HK + 2 * HG_HV), D_MODEL),
        "hgrn_lower_bound": 0.1 * jax.random.normal(ks[10], (2, DEPTH, HG_HK), f32),
        "hgrn_o_norm": gain(ks[11], (NB, HG_HV)),
        "hgrn_w_o": nrm(ks[12], (NB, HG_HV, D_MODEL), HG_HV, BETA),
        "ffn_w_up": nrm(ks[13], (DEPTH, D_MODEL, 2 * D_FF), D_MODEL),
        "ffn_conv_w": nrm(ks[14], (DEPTH, CONV_WIDTH, 2 * D_FF), CONV_WIDTH),
        "ffn_conv_b": 0.02 * jax.random.normal(ks[15], (DEPTH, 2 * D_FF), f32),
        "ffn_w_down": nrm(ks[16], (DEPTH, D_FF, D_MODEL), D_FF, BETA),
        "ln_gain": gain(ks[17], (DEPTH, 2, D_MODEL)),
        "ln_bias": 0.02 * jax.random.normal(ks[18], (DEPTH, 2, D_MODEL), f32),
    }


def reference(x_prompt, x_sample, meta_tokens, mla_w_in, mla_q_norm, mla_kv_norm, mla_w_uq, mla_w_ukv, mla_w_o,
              hgrn_w_in, hgrn_lower_bound, hgrn_o_norm, hgrn_w_o,
              ffn_w_up, ffn_conv_w, ffn_conv_b, ffn_w_down, ln_gain, ln_bias):
    y_prompt = trunk(x_prompt, meta_tokens, mla_w_in, mla_q_norm, mla_kv_norm, mla_w_uq, mla_w_ukv, mla_w_o,
                     hgrn_w_in, hgrn_lower_bound, hgrn_o_norm, hgrn_w_o,
                     ffn_w_up, ffn_conv_w, ffn_conv_b, ffn_w_down, ln_gain, ln_bias)
    y_sample = trunk(x_sample, meta_tokens, mla_w_in, mla_q_norm, mla_kv_norm, mla_w_uq, mla_w_ukv, mla_w_o,
                     hgrn_w_in, hgrn_lower_bound, hgrn_o_norm, hgrn_w_o,
                     ffn_w_up, ffn_conv_w, ffn_conv_b, ffn_w_down, ln_gain, ln_bias)
    return (y_prompt, y_sample)
```

```cpp
#include <hip/hip_runtime.h>
#include <cstdio>
constexpr int NB = 20;
constexpr int LP = 4160;
constexpr int PADR = 48, LTOK = 4112, SEQ = 4096, DM = 1024;
constexpr int M = NB * LP;
constexpr int MT = M / 256;
constexpr int DFF = 2816, NUP = 2 * DFF;
constexpr int NBLK62 = (M + 61) / 62;
constexpr int MT_UP = (NBLK62 + 3) / 4;
constexpr float EPS = 1e-6f, ALPHA = 1.4142135623730951f;
constexpr float SM_C = 0.10206207261596575f * 1.4426950408889634f;
#include <cstdint>
namespace pg8 {
#define PG8_LAS __attribute__((address_space(3)))
typedef unsigned short bf16_t;
typedef short bf16x8 __attribute__((ext_vector_type(8)));
typedef float f32x4 __attribute__((ext_vector_type(4)));
typedef unsigned u32x4 __attribute__((ext_vector_type(4)));
typedef unsigned u32x2 __attribute__((ext_vector_type(2)));
constexpr int BM = 256, BK = 64, HALF = 128, HTB = HALF * BK * 2  , STAGE_BYTES = 8 * HTB, NXCD = 8, WGM = 8;

__host__ __device__ __forceinline__ int lds_byte(int r, int c) { const int st = (r >> 4) * 2 + (c >> 5), rr = r & 15, cc = c & 31, ob = rr * 64 + cc * 2; return st * 1024 + (ob ^ (((ob >> 9) & 1) << 5)); }
__host__ __device__ __forceinline__ void stage_rc(int b, int& R, int& C) { const int st = b / 1024, sb = b % 1024, swz = sb ^ (((sb >> 9) & 1) << 5); R = (st >> 1) * 16 + swz / 64; C = (st & 1) * 32 + (swz % 64) / 2; }
__host__ __device__ __forceinline__ int perm32(int rho) { const int n = rho >> 4, i = rho & 15; return 8 * (i >> 2) + 4 * n + (i & 3); }

struct Unit { int pm, pn; };
struct Gemm { const bf16_t* A; const bf16_t* Bt; int K, lda, ldb; };

struct StaticOrder {
    int nM, nN, nwg, G, c;
    __host__ __device__ void init(int nM_, int nN_, int G_, int c_) { nM = nM_; nN = nN_; nwg = nM * nN; G = G_; c = c_; }
    __host__ __device__ bool next(int i, Unit& u) const {
        const long L = (long)i * G + c; if (L >= nwg) return false;
        int wgid = (int)L; { const int q = nwg / NXCD, r = nwg % NXCD, xcd = wgid % NXCD, off = wgid / NXCD; wgid = (xcd < r ? xcd * (q + 1) : r * (q + 1) + (xcd - r) * q) + off; }
        const int nig = WGM * nN, gid = wgid / nig, fm = gid * WGM, gsz = (nM - fm) < WGM ? (nM - fm) : WGM;
        u.pm = fm + ((wgid % nig) % gsz); u.pn = (wgid % nig) / gsz; return true;
    }
    __device__ __forceinline__ void a_ready(const Unit&) const {}
    __device__ __forceinline__ void done(const Unit&) const {}
};
__device__ __forceinline__ unsigned cvt_pk_bf16(float lo, float hi) { unsigned r; asm volatile("v_cvt_pk_bf16_f32 %0, %1, %2" : "=v"(r) : "v"(lo), "v"(hi)); return r; }
__device__ __forceinline__ float bf_lo(unsigned w) { return __uint_as_float(w << 16); }
__device__ __forceinline__ float bf_hi(unsigned w) { return __uint_as_float(w & 0xffff0000u); }
typedef float f32x2 __attribute__((ext_vector_type(2)));
__device__ __forceinline__ u32x4 pack8(const f32x4 v0, const f32x4 v1) { u32x4 w; w.x = cvt_pk_bf16(v0[0], v0[1]); w.y = cvt_pk_bf16(v0[2], v0[3]); w.z = cvt_pk_bf16(v1[0], v1[1]); w.w = cvt_pk_bf16(v1[2], v1[3]); return w; }
__device__ __forceinline__ void rope8(f32x4& v0, f32x4& v1, const f32x2* tab, int pos, int i0) {
    const f32x2* t = tab + pos * 16 + i0;
    const f32x2 c0 = t[0], c1 = t[1], c2 = t[2], c3 = t[3];
    f32x4 a, b;
    a[0] = v0[0] * c0.x - v0[1] * c0.y; a[1] = v0[0] * c0.y + v0[1] * c0.x;
    a[2] = v0[2] * c1.x - v0[3] * c1.y; a[3] = v0[2] * c1.y + v0[3] * c1.x;
    b[0] = v1[0] * c2.x - v1[1] * c2.y; b[1] = v1[0] * c2.y + v1[1] * c2.x;
    b[2] = v1[2] * c3.x - v1[3] * c3.y; b[3] = v1[2] * c3.y + v1[3] * c3.x;
    v0 = a; v1 = b;
}
struct EpiProj {
    static constexpr bool PERM = true, AFTER_DRAIN = false;
    bf16_t* cqkv; float* ssq; bf16_t* krope; const f32x2* rope;
    __device__ __forceinline__ void operator()(const f32x4 (&acc)[2][2][4][2], const Unit& u, int wr, int wc, int fr, int fq) const {
        const int row0 = u.pm * BM + wr * 64 + fr;
        if (u.pn < 4) {
            const int col0 = u.pn * BM + wc * 32 + 8 * fq;
#pragma unroll
            for (int ai = 0; ai < 2; ++ai)
#pragma unroll
                for (int m = 0; m < 4; ++m) { const int row = row0 + ai * HALF + m * 16; float s = 0.f;
#pragma unroll
                    for (int bj = 0; bj < 2; ++bj) { const f32x4 v0 = acc[ai][bj][m][0], v1 = acc[ai][bj][m][1];
                        s += (v0[0] * v0[0] + v0[1] * v0[1]) + (v0[2] * v0[2] + v0[3] * v0[3]) + (v1[0] * v1[0] + v1[1] * v1[1]) + (v1[2] * v1[2] + v1[3] * v1[3]);
                        *(u32x4*)(cqkv + (size_t)row * 1024 + col0 + bj * HALF) = pack8(v0, v1); }
                    s += __shfl_xor(s, 16); s += __shfl_xor(s, 32);
                    if (fq == 0) ssq[(size_t)row * 16 + u.pn * 4 + wc] = s; }
        } else if (wc == 0) {
#pragma unroll
            for (int ai = 0; ai < 2; ++ai)
#pragma unroll
                for (int m = 0; m < 4; ++m) { const int row = row0 + ai * HALF + m * 16; int pos = row % LP - PADR; pos = pos < 0 ? 0 : pos;
                    f32x4 v0 = acc[ai][0][m][0], v1 = acc[ai][0][m][1]; rope8(v0, v1, rope, pos, 4 * fq);
                    *(u32x4*)(krope + (size_t)row * 32 + 8 * fq) = pack8(v0, v1); }
        }
    }
};
struct EpiQ {
    static constexpr bool PERM = true, AFTER_DRAIN = false;
    bf16_t* Q; const float* ssq; const f32x2* rope;
    __device__ __forceinline__ void operator()(const f32x4 (&acc)[2][2][4][2], const Unit& u, int wr, int wc, int fr, int fq) const {
        const int row0 = u.pm * BM + wr * 64 + fr, col0 = u.pn * BM + wc * 32 + 8 * fq;
#pragma unroll
        for (int ai = 0; ai < 2; ++ai)
#pragma unroll
            for (int m = 0; m < 4; ++m) { const int row = row0 + ai * HALF + m * 16; int pos = row % LP - PADR; pos = pos < 0 ? 0 : pos;
                const f32x4* sp = (const f32x4*)(ssq + (size_t)row * 16); const f32x4 s0 = sp[0], s1 = sp[1], s2 = sp[2];
                const float ss = ((s0[0] + s0[1]) + (s0[2] + s0[3])) + ((s1[0] + s1[1]) + (s1[2] + s1[3])) + ((s2[0] + s2[1]) + (s2[2] + s2[3]));
                const float rstd = 1.0f / sqrtf(ss * (1.0f / 768.0f) + EPS);
#pragma unroll
                for (int bj = 0; bj < 2; ++bj) { const int c = col0 + bj * HALF, d = c % 96; f32x4 v0 = acc[ai][bj][m][0] * rstd, v1 = acc[ai][bj][m][1] * rstd;
                    if (d >= 64) rope8(v0, v1, rope, pos, (d - 64) >> 1);
                    *(u32x4*)(Q + (size_t)row * 1536 + c) = pack8(v0, v1); } }
    }
};
struct EpiKV {
    static constexpr bool PERM = true, AFTER_DRAIN = false;
    bf16_t* KV; const float* ssq;
    __device__ __forceinline__ void operator()(const f32x4 (&acc)[2][2][4][2], const Unit& u, int wr, int wc, int fr, int fq) const {
        const int row0 = u.pm * BM + wr * 64 + fr, col0 = u.pn * BM + wc * 32 + 8 * fq;
#pragma unroll
        for (int ai = 0; ai < 2; ++ai)
#pragma unroll
            for (int m = 0; m < 4; ++m) { const int row = row0 + ai * HALF + m * 16;
                const f32x4 s3 = *(const f32x4*)(ssq + (size_t)row * 16 + 12);
                const float rstd = 1.0f / sqrtf(((s3[0] + s3[1]) + (s3[2] + s3[3])) * (1.0f / 256.0f) + EPS);
#pragma unroll
                for (int bj = 0; bj < 2; ++bj) *(u32x4*)(KV + (size_t)row * 2048 + col0 + bj * HALF) = pack8(acc[ai][bj][m][0] * rstd, acc[ai][bj][m][1] * rstd); }
    }
};
struct EpiResid {
    static constexpr bool PERM = false, AFTER_DRAIN = false;
    const bf16_t* h; float* X;
    __device__ __forceinline__ void operator()(const f32x4 (&acc)[2][2][4][2], const Unit& u, int wr, int wc, int fr, int fq) const {
        const int row0 = u.pm * BM + wr * 64 + fr, col0 = u.pn * BM + wc * 32 + 4 * fq;
#pragma unroll
        for (int ai = 0; ai < 2; ++ai)
#pragma unroll
            for (int m = 0; m < 4; ++m) { const size_t off = (size_t)(row0 + ai * HALF + m * 16) * 1024 + col0;
#pragma unroll
                for (int bj = 0; bj < 2; ++bj)
#pragma unroll
                    for (int n = 0; n < 2; ++n) { const u32x2 hw = *(const u32x2*)(h + off + bj * HALF + n * 16);
                        f32x4 hv; hv[0] = bf_lo(hw.x); hv[1] = bf_hi(hw.x); hv[2] = bf_lo(hw.y); hv[3] = bf_hi(hw.y);
                        *(f32x4*)(X + off + bj * HALF + n * 16) = hv * ALPHA + acc[ai][bj][m][n]; } }
    }
};
struct EpiHgIn {
    static constexpr bool PERM = true, AFTER_DRAIN = false;
    bf16_t* q; bf16_t* v; bf16_t* kf; bf16_t* kb; bf16_t* sg; const float* lb;
    __device__ __forceinline__ void operator()(const f32x4 (&acc)[2][2][4][2], const Unit& u, int wr, int wc, int fr, int fq) const {
        const int row0 = u.pm * BM + wr * 64 + fr, t = u.pn >> 2, col0 = (u.pn & 3) * BM + wc * 32 + 8 * fq;
        bf16_t* dst = t == 0 ? q : t == 1 ? v : t == 2 ? kf : t == 3 ? kb : sg;
#pragma unroll
        for (int bj = 0; bj < 2; ++bj) { const int c = col0 + bj * HALF;
            f32x4 om0 = {1.f, 1.f, 1.f, 1.f}, om1 = om0;
            if (t == 2 || t == 3) { const f32x4* lp = (const f32x4*)(lb + (t - 2) * 1024 + c); om0 = 1.0f - lp[0]; om1 = 1.0f - lp[1]; }
#pragma unroll
            for (int ai = 0; ai < 2; ++ai)
#pragma unroll
                for (int m = 0; m < 4; ++m) { const int row = row0 + ai * HALF + m * 16; const bool pad = (row % LP) < PADR;
                    f32x4 v0 = acc[ai][bj][m][0], v1 = acc[ai][bj][m][1];
                    if (t == 2 || t == 3) {
#pragma unroll
                        for (int j = 0; j < 4; ++j) { v0[j] = pad ? 0.f : om0[j] * __builtin_amdgcn_rcpf(1.0f + __builtin_amdgcn_exp2f(v0[j] * 1.4426950408889634f));
                                                      v1[j] = pad ? 0.f : om1[j] * __builtin_amdgcn_rcpf(1.0f + __builtin_amdgcn_exp2f(v1[j] * 1.4426950408889634f)); }
                    } else if (t == 4) {
#pragma unroll
                        for (int j = 0; j < 4; ++j) { v0[j] = v0[j] * __builtin_amdgcn_rcpf(1.0f + __builtin_amdgcn_exp2f(v0[j] * -1.4426950408889634f));
                                                      v1[j] = v1[j] * __builtin_amdgcn_rcpf(1.0f + __builtin_amdgcn_exp2f(v1[j] * -1.4426950408889634f)); }
                    }
                    *(u32x4*)(dst + (size_t)row * 1024 + c) = pack8(v0, v1); } }
    }
};
struct EpiConvGate {
    static constexpr bool PERM = true, AFTER_DRAIN = false;
    bf16_t* act; const float* cw; const float* cb;
    __device__ __forceinline__ void operator()(const f32x4 (&acc)[2][2][4][2], const Unit& u, int wr, int wc, int fr, int fq) const {
        const int lane = fq * 16 + fr, lprev = fq * 16 + ((fr + 15) & 15), lnext = fq * 16 + ((fr + 1) & 15);
        const int cv0 = 128 * u.pn + 32 * wc + 8 * fq;
#pragma unroll
        for (int n = 0; n < 2; ++n)
#pragma unroll
          for (int jp = 0; jp < 2; ++jp) { const int cv = cv0 + 4 * n + 2 * jp;
            const f32x2 wv0 = *(const f32x2*)(cw + cv), wv1 = *(const f32x2*)(cw + NUP + cv), wv2 = *(const f32x2*)(cw + 2 * NUP + cv), bv = *(const f32x2*)(cb + cv);
            const f32x2 wg0 = *(const f32x2*)(cw + DFF + cv), wg1 = *(const f32x2*)(cw + NUP + DFF + cv), wg2 = *(const f32x2*)(cw + 2 * NUP + DFF + cv), bg = *(const f32x2*)(cb + DFF + cv);
#pragma unroll
            for (int ai = 0; ai < 2; ++ai) { const int J = 4 * u.pm + 2 * ai + wr;
                float o[4][2];
#pragma unroll
                for (int jj = 0; jj < 2; ++jj) { const int j = 2 * jp + jj;
                    float rv[4], lv[4], rg[4], lg[4];
#pragma unroll
                    for (int m = 0; m < 4; ++m) { rv[m] = __shfl(acc[ai][0][m][n][j], lprev); lv[m] = __shfl(acc[ai][0][m][n][j], lnext);
                                                  rg[m] = __shfl(acc[ai][1][m][n][j], lprev); lg[m] = __shfl(acc[ai][1][m][n][j], lnext); }
#pragma unroll
                    for (int m = 0; m < 4; ++m) {
                        const float pv = fr == 0 ? rv[m == 0 ? 0 : m - 1] : rv[m], nv = fr == 15 ? lv[m == 3 ? 3 : m + 1] : lv[m];
                        const float pg = fr == 0 ? rg[m == 0 ? 0 : m - 1] : rg[m], ng = fr == 15 ? lg[m == 3 ? 3 : m + 1] : lg[m];
                        const float val = wv0[jj] * pv + wv1[jj] * acc[ai][0][m][n][j] + wv2[jj] * nv + bv[jj];
                        const float gat = wg0[jj] * pg + wg1[jj] * acc[ai][1][m][n][j] + wg2[jj] * ng + bg[jj];
                        o[m][jj] = val * gat * __builtin_amdgcn_rcpf(1.0f + __builtin_amdgcn_exp2f(gat * -1.4426950408889634f)); } }
#pragma unroll
                for (int m = 0; m < 4; ++m) { const int R64 = 16 * m + fr; const int rowo = 62 * J - 1 + R64;
                    if (R64 >= 1 && R64 <= 62 && rowo < M) *(unsigned*)(act + (size_t)rowo * DFF + cv) = cvt_pk_bf16(o[m][0], o[m][1]); }
                asm volatile("" ::: "memory"); } }
        (void)lane;
    }
};
template <class Epi, class Sched, bool ALIGN_EPI = false, bool SP2 = false, bool SHIFT = false>
__device__ __forceinline__ void gemm_phase(PG8_LAS unsigned char* lds, const Gemm g, const Sched& S, const Epi& E) {
    const int tid = threadIdx.x, wid = __builtin_amdgcn_readfirstlane(tid >> 6), lane = tid & 63, wr = wid >> 2, wc = wid & 3, fr = lane & 15, fq = lane >> 4;
    const int K = g.K, nt = K / BK;
    unsigned voffA[2], voffB[2];
#pragma unroll
    for (int i = 0; i < 2; ++i) { int R, C; stage_rc(tid * 16 + i * 8192, R, C); const int Rb = Epi::PERM ? ((R & ~31) + perm32(R & 31)) : R;
        const int Ra = SHIFT ? (R - 2 * (R >> 6)) : R; voffA[i] = (unsigned)(Ra * g.lda + C) * 2u; voffB[i] = (unsigned)(Rb * g.ldb + C) * 2u; }
    const size_t kstep = (size_t)(BK * 2);
    const size_t hstepA = (size_t)(SHIFT ? 124 : HALF) * g.lda * 2, hstepB = (size_t)HALF * g.ldb * 2;
    const size_t tstepA = 2 * hstepA, tstepB = 2 * hstepB;
    const unsigned ldsw = (unsigned)wid * 1024u;
    const int aoff = lds_byte(wr * 64 + fr, fq * 8), boff = lds_byte(wc * 32 + fr, fq * 8);
#define PG8_SA(b, h) (((b) * 2 + (h)) * HTB)
#define PG8_SB(b, h) ((4 + (b) * 2 + (h)) * HTB)
#define PG8_STAGE(bufoff, gbase, voff) do { _Pragma("unroll") for (int _i = 0; _i < 2; ++_i) \
        __builtin_amdgcn_global_load_lds((const unsigned*)((const char*)(gbase) + (voff)[_i]), (PG8_LAS unsigned*)(lds + (bufoff) + ldsw + _i * 8192), 16, 0, 0); } while (0)
#define PG8_LDA(dst, b, h) do { _Pragma("unroll") for (int m = 0; m < 4; ++m) _Pragma("unroll") for (int k = 0; k < 2; ++k) dst[m][k] = *(const PG8_LAS bf16x8*)(lds + PG8_SA(b, h) + aoff + m * 2048 + k * 1024); } while (0)
#define PG8_LDB(dst, b, h) do { _Pragma("unroll") for (int n = 0; n < 2; ++n) _Pragma("unroll") for (int k = 0; k < 2; ++k) dst[n][k] = *(const PG8_LAS bf16x8*)(lds + PG8_SB(b, h) + boff + n * 2048 + k * 1024); } while (0)
#define PG8_MMA(ai, bj, At, Bt) do { __builtin_amdgcn_s_setprio(1); _Pragma("unroll") for (int m = 0; m < 4; ++m) _Pragma("unroll") for (int n = 0; n < 2; ++n) _Pragma("unroll") for (int k = 0; k < 2; ++k) \
        acc[ai][bj][m][n] = __builtin_amdgcn_mfma_f32_16x16x32_bf16(Bt[n][k], At[m][k], acc[ai][bj][m][n], 0, 0, 0); __builtin_amdgcn_s_setprio(0); } while (0)
#define PG8_WAIT_V(n) asm volatile("s_waitcnt vmcnt(" #n ")" ::: "memory")
#define PG8_WAIT_L(n) asm volatile("s_waitcnt lgkmcnt(" #n ")" ::: "memory")
#define PG8_BAR __builtin_amdgcn_s_barrier()
#define PG8_SCHED __builtin_amdgcn_sched_barrier(0)
    Unit cur, nxt; int ui = 0;
    if (!S.next(0, cur)) return;
    f32x4 acc[2][2][4][2];
#pragma unroll
    for (int a = 0; a < 2; ++a)
#pragma unroll
        for (int b = 0; b < 2; ++b)
#pragma unroll
            for (int m = 0; m < 4; ++m)
#pragma unroll
                for (int n = 0; n < 2; ++n) acc[a][b][m][n] = (f32x4){0.f, 0.f, 0.f, 0.f};
    bf16x8 At[4][2], B0[2][2], B1[2][2];
    const char* cA = (const char*)g.A + (size_t)cur.pm * tstepA; const char* cB = (const char*)g.Bt + (size_t)cur.pn * tstepB;
    S.a_ready(cur);
    if constexpr (SP2) {
        PG8_STAGE(PG8_SB(0, 0), cB, voffB); PG8_STAGE(PG8_SB(0, 1), cB + hstepB, voffB); PG8_STAGE(PG8_SA(0, 0), cA, voffA); PG8_STAGE(PG8_SA(0, 1), cA + hstepA, voffA);
        if (wr == 1) PG8_BAR;
        PG8_WAIT_V(2); PG8_BAR;
        PG8_STAGE(PG8_SB(1, 0), cB + kstep, voffB); PG8_STAGE(PG8_SA(1, 0), cA + kstep, voffA); PG8_STAGE(PG8_SB(1, 1), cB + hstepB + kstep, voffB);
        PG8_WAIT_V(6); PG8_BAR;
    } else {
        PG8_STAGE(PG8_SB(0, 0), cB, voffB); PG8_STAGE(PG8_SA(0, 0), cA, voffA); PG8_STAGE(PG8_SB(0, 1), cB + hstepB, voffB); PG8_STAGE(PG8_SA(0, 1), cA + hstepA, voffA);
        if (wr == 1) PG8_BAR;
        PG8_WAIT_V(4); PG8_BAR;
        PG8_STAGE(PG8_SB(1, 0), cB + kstep, voffB); PG8_STAGE(PG8_SA(1, 0), cA + kstep, voffA); PG8_STAGE(PG8_SB(1, 1), cB + hstepB + kstep, voffB);
        PG8_WAIT_V(6); PG8_BAR;
    }
    for (;;) {
        const bool has_next = S.next(ui + 1, nxt);
        const char* nA = has_next ? (const char*)g.A + (size_t)nxt.pm * tstepA : cA; const char* nB = has_next ? (const char*)g.Bt + (size_t)nxt.pn * tstepB : cB;
        for (int t = 0; t < nt; t += 2) {
            const bool last = (t == nt - 2);
            const char* a1 = cA + (size_t)(t + 1) * kstep;
            const char* a2 = last ? nA : cA + (size_t)(t + 2) * kstep; const char* b2 = last ? nB : cB + (size_t)(t + 2) * kstep;
            const char* a3 = a2 + kstep; const char* b3 = b2 + kstep;
            if (last && has_next) S.a_ready(nxt);
            if constexpr (SP2) {
            PG8_LDB(B0, 0, 0); PG8_LDB(B1, 0, 1); PG8_SCHED; PG8_LDA(At, 0, 0); PG8_STAGE(PG8_SA(1, 1), a1 + hstepA, voffA);
            PG8_WAIT_V(8); PG8_WAIT_L(0); PG8_BAR; PG8_MMA(0, 0, At, B0); PG8_MMA(0, 1, At, B1); PG8_BAR; PG8_SCHED;
            PG8_LDA(At, 0, 1); PG8_STAGE(PG8_SB(0, 0), b2, voffB); PG8_STAGE(PG8_SB(0, 1), b2 + hstepB, voffB); PG8_STAGE(PG8_SA(0, 0), a2, voffA);
            PG8_WAIT_V(8); PG8_WAIT_L(0); PG8_BAR; PG8_MMA(1, 0, At, B0); PG8_MMA(1, 1, At, B1); PG8_BAR; PG8_SCHED;
            PG8_LDB(B0, 1, 0); PG8_LDB(B1, 1, 1); PG8_SCHED; PG8_LDA(At, 1, 0); PG8_STAGE(PG8_SA(0, 1), a2 + hstepA, voffA);
            PG8_WAIT_V(8); PG8_WAIT_L(0); PG8_BAR; PG8_MMA(0, 0, At, B0); PG8_MMA(0, 1, At, B1); PG8_BAR; PG8_SCHED;
            PG8_LDA(At, 1, 1); PG8_STAGE(PG8_SB(1, 0), b3, voffB); PG8_STAGE(PG8_SB(1, 1), b3 + hstepB, voffB); PG8_STAGE(PG8_SA(1, 0), a3, voffA);
            PG8_WAIT_V(8); PG8_WAIT_L(0); PG8_BAR; PG8_MMA(1, 0, At, B0); PG8_MMA(1, 1, At, B1); PG8_BAR; PG8_SCHED;
            } else {
            PG8_LDB(B0, 0, 0); PG8_SCHED; PG8_LDA(At, 0, 0); PG8_STAGE(PG8_SA(1, 1), a1 + hstepA, voffA);
            PG8_WAIT_L(8); PG8_BAR; PG8_WAIT_L(0); PG8_MMA(0, 0, At, B0); PG8_BAR; PG8_SCHED;
            PG8_LDB(B1, 0, 1); PG8_STAGE(PG8_SB(0, 0), b2, voffB);
            PG8_BAR; PG8_WAIT_L(0); PG8_MMA(0, 1, At, B1); PG8_BAR;
            PG8_LDA(At, 0, 1); PG8_STAGE(PG8_SA(0, 0), a2, voffA);
            PG8_BAR; PG8_WAIT_L(0); PG8_MMA(1, 0, At, B0); PG8_BAR; PG8_SCHED;
            PG8_STAGE(PG8_SB(0, 1), b2 + hstepB, voffB);
            PG8_WAIT_V(6); PG8_BAR; PG8_MMA(1, 1, At, B1); PG8_BAR;
            PG8_LDB(B0, 1, 0); PG8_SCHED; PG8_LDA(At, 1, 0); PG8_STAGE(PG8_SA(0, 1), a2 + hstepA, voffA);
            PG8_WAIT_L(8); PG8_BAR; PG8_WAIT_L(0); PG8_MMA(0, 0, At, B0); PG8_BAR; PG8_SCHED;
            PG8_LDB(B1, 1, 1); PG8_STAGE(PG8_SB(1, 0), b3, voffB);
            PG8_BAR; PG8_WAIT_L(0); PG8_MMA(0, 1, At, B1); PG8_BAR;
            PG8_LDA(At, 1, 1); PG8_STAGE(PG8_SA(1, 0), a3, voffA);
            PG8_BAR; PG8_WAIT_L(0); PG8_MMA(1, 0, At, B0); PG8_BAR; PG8_SCHED;
            PG8_STAGE(PG8_SB(1, 1), b3 + hstepB, voffB);
            PG8_WAIT_V(6); PG8_BAR; PG8_MMA(1, 1, At, B1); PG8_BAR;
            }
        }
        if constexpr (ALIGN_EPI) { if (wr == 0) PG8_BAR; }
        if constexpr (!Epi::AFTER_DRAIN) { E(acc, cur, wr, wc, fr, fq); S.done(cur); }
        if (!has_next) break;
#pragma unroll
        for (int a = 0; a < 2; ++a)
#pragma unroll
            for (int b = 0; b < 2; ++b)
#pragma unroll
                for (int m = 0; m < 4; ++m)
#pragma unroll
                    for (int n = 0; n < 2; ++n) acc[a][b][m][n] = (f32x4){0.f, 0.f, 0.f, 0.f};
        cur = nxt; cA = nA; cB = nB; ++ui;
        if constexpr (ALIGN_EPI) { if (wr == 1) PG8_BAR; }
    }
    PG8_WAIT_V(0);
    if constexpr (!ALIGN_EPI) { if (wr == 0) PG8_BAR; }
    PG8_BAR;
    if constexpr (Epi::AFTER_DRAIN) { E.fused(acc, cur, wr, wc, fr, fq, lds, wid, lane); S.done(cur); }
#undef PG8_SA
#undef PG8_SB
#undef PG8_STAGE
#undef PG8_LDA
#undef PG8_LDB
#undef PG8_MMA
#undef PG8_WAIT_V
#undef PG8_WAIT_L
#undef PG8_BAR
#undef PG8_SCHED
}
}
#define GAS __attribute__((address_space(1)))
#define LAS __attribute__((address_space(3)))
typedef unsigned short bf16;
typedef unsigned v4u __attribute__((ext_vector_type(4)));
typedef unsigned v2u __attribute__((ext_vector_type(2)));
typedef float f32x4 __attribute__((ext_vector_type(4)));
typedef float f32x2 __attribute__((ext_vector_type(2)));
typedef GAS unsigned gu32;
using pg8::cvt_pk_bf16; using pg8::bf_lo; using pg8::bf_hi;

constexpr size_t MiB = 1u << 20;
constexpr size_t WS_CTL = 0, CTL_ZERO_BYTES = 64 * 1024;
constexpr size_t WS_ROPE = 1 * MiB;
constexpr size_t WS_LB = WS_ROPE + 640 * 1024;
constexpr size_t WS_W = 2 * MiB;
constexpr size_t W_IN = WS_W, W_UQ = W_IN + 1280ull * 1024 * 2, W_UKV = W_UQ + 1536ull * 768 * 2, W_O = W_UKV + 2048ull * 256 * 2, W_HIN = W_O + 1024ull * 1024 * 2,
                 W_HO = W_HIN + 5120ull * 1024 * 2, W_UP0 = W_HO + 1024ull * 1024 * 2, W_UP1 = W_UP0 + 5632ull * 1024 * 2, W_DN0 = W_UP1 + 5632ull * 1024 * 2, W_DN1 = W_DN0 + 1024ull * 2816 * 2,
                 W_END = W_DN1 + 1024ull * 2816 * 2;
static_assert(W_END <= 55 * MiB, "weights");
constexpr int SLACK = 256;
constexpr size_t ROWB = 2048;
constexpr size_t WS_B0 = 55 * MiB, B0_BYTES = (size_t)(M + 2 * SLACK) * ROWB;
static_assert(B0_BYTES <= 164 * MiB, "B0");
constexpr size_t WS_R = 219 * MiB;
constexpr size_t R_CQKV = WS_R;
constexpr size_t R_Q = R_CQKV + 164 * MiB;
constexpr size_t R_KV = R_Q + 245 * MiB;
constexpr size_t R_KROPE = R_KV + 326 * MiB;
constexpr size_t R_SSQ = R_KROPE + 6 * MiB;
constexpr size_t R_X_L0 = R_Q;
constexpr size_t R_ACT = WS_R;
constexpr size_t R_X_FFN = WS_R + 448 * MiB;
constexpr size_t R_HV = WS_R, R_HKF = WS_R + 163 * MiB, R_HKB = WS_R + 326 * MiB, R_HSG = WS_R + 489 * MiB;
constexpr size_t R_X_HG = WS_R;
constexpr size_t WS_END = 1024 * MiB;
static_assert(R_SSQ + (size_t)M * 16 * 4 <= WS_END && R_X_FFN + (size_t)M * 4096 <= WS_END && R_HSG + (size_t)M * ROWB <= WS_END, "d_ws map");
static_assert((size_t)M * 1536 * 2 + 64 * 3072 <= 245 * MiB && (size_t)M * 4096 + 64 * 4096 <= 326 * MiB && (size_t)M * DFF * 2 <= 448 * MiB && (size_t)M * ROWB <= 163 * MiB, "d_ws map 2");

constexpr int RING_OFF = 0, RING_BYTES = 131072;
constexpr int LDSCTL_OFF = RING_BYTES, MISC_OFF = LDSCTL_OFF + 320;
constexpr int LDS_BYTES = 147456;
constexpr int NWAVES = 8;

#define RLX_AGENT __ATOMIC_RELAXED, __HIP_MEMORY_SCOPE_AGENT
#define XB_TMO      128
#define XB_XCNT(j)  (256  + 64 * (j))
#define XB_XSUB(j)  (1280 + 64 * (j))
#define XB_XGEN(j)  (2304 + 64 * (j))
#define XB_TOP      3328
#define XB_TOPGEN   3392
#define XCD_BAR_WORDS 3456
#define XB_SPIN_CAP (1u << 18)

__device__ __forceinline__ unsigned xb_ld(unsigned* p)              { return __hip_atomic_load(p, __ATOMIC_RELAXED, __HIP_MEMORY_SCOPE_AGENT); }
__device__ __forceinline__ unsigned xb_add(unsigned* p, unsigned v) { return __hip_atomic_fetch_add(p, v, __ATOMIC_RELAXED, __HIP_MEMORY_SCOPE_AGENT); }
__device__ __forceinline__ unsigned xb_xcc_id() { return (unsigned)__builtin_amdgcn_s_getreg((3 << 11) | 20) & 0xFu; }
#define XB_SPIN(cond, bar) do { unsigned _sp = 0; while (cond) { __builtin_amdgcn_s_sleep(1); \
    if ((++_sp & 255u) == 0u) { if (xb_ld(&(bar)[XB_TMO])) break; if (_sp > XB_SPIN_CAP) { atomicAdd(&(bar)[XB_TMO], 1u); break; } } } } while (0)

struct XcdBarrier {
    unsigned* bar; unsigned x;
    volatile LAS unsigned* st;
};

__device__ __forceinline__ XcdBarrier xcd_barrier_post(unsigned* bar, volatile LAS unsigned* st) {
    XcdBarrier b; b.bar = bar; b.x = xb_xcc_id(); b.st = st;
    if (threadIdx.x == 0) (void)xb_add(&bar[XB_XCNT(b.x)], 1u);
    return b;
}
__device__ __forceinline__ void xcd_barrier_complete(unsigned* bar, unsigned x, unsigned& nloc, unsigned& nx) {
    const unsigned G = gridDim.x * gridDim.y * gridDim.z;
    unsigned sum, cnt, mine, sp = 0u;
    for (;;) {
        sum = 0u; cnt = 0u; mine = 0u;
#pragma unroll
        for (unsigned j = 0; j < 16; ++j) { const unsigned c = xb_ld(&bar[XB_XCNT(j)]); sum += c; cnt += (c > 0u) ? 1u : 0u; mine = (j == x) ? c : mine; }
        if (sum == G) break;
        __builtin_amdgcn_s_sleep(1);
        if ((++sp & 255u) == 0u) { if (xb_ld(&bar[XB_TMO])) break; if (sp > XB_SPIN_CAP) { atomicAdd(&bar[XB_TMO], 1u); break; } }
    }
    nloc = mine > 0u ? mine : 1u; nx = cnt > 0u ? cnt : 1u;
}

__device__ __forceinline__ void xcd_barrier(const XcdBarrier& b) {
    asm volatile("s_waitcnt vmcnt(0)" ::: "memory");
    __syncthreads();
    if (threadIdx.x == 0) {
        unsigned* bar = b.bar;
        __builtin_amdgcn_s_waitcnt(0);
        unsigned nloc = b.st[0], nx = b.st[1];
        if (nloc == 0u) { xcd_barrier_complete(bar, b.x, nloc, nx); b.st[0] = nloc; b.st[1] = nx; }
        const unsigned old = xb_add(&bar[XB_XSUB(b.x)], 1u);
        const unsigned gen = old / nloc;
        if (old + 1u == (gen + 1u) * nloc) {
            __builtin_amdgcn_fence(__ATOMIC_RELEASE, "agent");
            asm volatile("s_waitcnt vmcnt(0)" ::: "memory");
            const unsigned og = xb_add(&bar[XB_TOP], 1u);
            const unsigned tg = og / nx;
            if (og + 1u == (tg + 1u) * nx) xb_add(&bar[XB_TOPGEN], 1u);
            else XB_SPIN(xb_ld(&bar[XB_TOPGEN]) == tg, bar);
            __builtin_amdgcn_fence(__ATOMIC_ACQUIRE, "agent");
            xb_add(&bar[XB_XGEN(b.x)], 1u);
            asm volatile("s_waitcnt vmcnt(0)" ::: "memory");
        } else {
            XB_SPIN(xb_ld(&bar[XB_XGEN(b.x)]) == gen, bar);
            __builtin_amdgcn_fence(__ATOMIC_ACQUIRE, "agent");
            asm volatile("s_waitcnt vmcnt(0)" ::: "memory");
        }
    }
    __syncthreads();
}

struct Frame {
    LAS unsigned char* lds;
    volatile LAS unsigned* MISC;
    int tid, lane, wave;
    int vcu, G;
};
__device__ __forceinline__ float wave_sum(float v) {
#pragma unroll
    for (int o = 1; o < 64; o <<= 1) v += __shfl_xor(v, o);
    return v;
}
__device__ __forceinline__ unsigned f2bf(float f) { unsigned u = __builtin_bit_cast(unsigned, f); return (u + 0x7fffu + ((u >> 16) & 1u)) >> 16; }
__device__ __forceinline__ unsigned pk2(float lo, float hi) { return f2bf(lo) | (f2bf(hi) << 16); }

__device__ __forceinline__ int src_col(int kind, int n) {
    if (kind == 1) { if (n < 1024) return n; if (n >= 1056) return -1; const int e = n - 1024; return 1024 + ((e & 1) ? 16 + (e >> 1) : (e >> 1)); }
    if (kind == 2) { const int hd = n / 96, d = n % 96; if (d < 64) return n; const int e = d - 64; return hd * 96 + 64 + ((e & 1) ? 16 + (e >> 1) : (e >> 1)); }
    if (kind == 3) { const int pn = n >> 8, r = n & 255; return r < 128 ? 128 * pn + r : DFF + 128 * pn + (r - 128); }
    return n;
}
__device__ __forceinline__ void p0_transpose_item(const float* W, int K, int N, bf16* WT, int kind, const float* gain, LAS float* scr, int item, int lane, int NP) {
    const int nblk = NP / 32, kb = item / nblk, nb = item % nblk, k0 = 64 * kb, n0 = 32 * nb;
    const int sc = src_col(kind, n0 + (lane & 31));
#pragma unroll 8
    for (int i = 0; i < 32; ++i) { const int kk = 2 * i + (lane >> 5); float v = sc >= 0 ? W[(size_t)(k0 + kk) * N + sc] : 0.f; if (gain) v *= gain[k0 + kk]; scr[kk * 33 + (lane & 31)] = v; }
    asm volatile("s_waitcnt lgkmcnt(0)" ::: "memory");
    const int c = lane & 7;
#pragma unroll
    for (int j = 0; j < 4; ++j) { const int n = (lane >> 3) + 8 * j; const LAS float* s = scr + (8 * c) * 33 + n;
        v4u o; o.x = pk2(s[0 * 33], s[1 * 33]); o.y = pk2(s[2 * 33], s[3 * 33]); o.z = pk2(s[4 * 33], s[5 * 33]); o.w = pk2(s[6 * 33], s[7 * 33]);
        *(GAS v4u*)(WT + (size_t)(n0 + n) * K + k0 + 8 * c) = o; }
    asm volatile("s_waitcnt lgkmcnt(0)" ::: "memory");
}
struct WJob { const float* W; bf16* WT; const float* gain; int K, N, NP, kind; };
__device__ __forceinline__ void p0_prologue(Frame& F, const float* const* in, unsigned char* ws, bf16* h0) {
    LAS float* scr = (LAS float*)(F.lds + RING_OFF + F.wave * 16384);
    const int gw = F.vcu * NWAVES + F.wave, NGW = F.G * NWAVES;
#define WJOB(SRC, DST, GAIN, K_, N_, NP_, KIND) { const int nitems = ((K_) / 64) * ((NP_) / 32); for (int it = gw; it < nitems; it += NGW) p0_transpose_item(SRC, K_, N_, (bf16*)(ws + (DST)), KIND, GAIN, scr, it, F.lane, NP_); }
    WJOB(in[3], W_IN, nullptr, 1024, 1056, 1280, 1)
    WJOB(in[6], W_UQ, in[4], 768, 1536, 1536, 2)
    WJOB(in[7], W_UKV, in[5], 256, 2048, 2048, 0)
    WJOB(in[8], W_O, nullptr, 1024, 1024, 1024, 0)
    WJOB(in[9], W_HIN, nullptr, 1024, 5120, 5120, 0)
    WJOB(in[12], W_HO, nullptr, 1024, 1024, 1024, 0)
    WJOB(in[13], W_UP0, nullptr, 1024, NUP, NUP, 3)
    WJOB(in[13] + (size_t)1024 * NUP, W_UP1, nullptr, 1024, NUP, NUP, 3)
    WJOB(in[16], W_DN0, nullptr, DFF, 1024, 1024, 0)
    WJOB(in[16] + (size_t)DFF * 1024, W_DN1, nullptr, DFF, 1024, 1024, 0)
#undef WJOB
    for (int row = gw; row < M; row += NGW) {
        const int b = row / LP, s = row % LP;
        GAS unsigned long long* o8 = (GAS unsigned long long*)(h0 + (size_t)row * 1024) + F.lane;
        if (s < PADR) {
#pragma unroll
            for (int j = 0; j < 4; ++j) o8[64 * j] = 0ull;
        } else {
            const float* src = s < PADR + 16 ? in[2] + (size_t)(s - PADR) * 1024 : (b < 16 ? in[0] + ((size_t)b * SEQ + (s - 64)) * 1024 : in[1] + ((size_t)(b - 16) * SEQ + (s - 64)) * 1024);
            const GAS f32x4* xr = (const GAS f32x4*)src + F.lane;
#pragma unroll
            for (int j = 0; j < 4; ++j) { const f32x4 v = xr[64 * j]; o8[64 * j] = (unsigned long long)pk2(v.x, v.y) | ((unsigned long long)pk2(v.z, v.w) << 32); }
        }
    }
    { const int gt = gw * 64 + F.lane, NGT = NGW * 64; GAS v4u* z0 = (GAS v4u*)(ws + WS_B0); GAS v4u* z1 = (GAS v4u*)(ws + WS_B0 + (size_t)(SLACK + M) * ROWB);
      const int n16 = SLACK * (int)ROWB / 16;
      for (int i = gt; i < n16; i += NGT) { z0[i] = (v4u){0u, 0u, 0u, 0u}; z1[i] = (v4u){0u, 0u, 0u, 0u}; } }
    { const int gt = gw * 64 + F.lane, NGT = NGW * 64; f32x2* tab = (f32x2*)(ws + WS_ROPE);
      for (int i = gt; i < LTOK * 16; i += NGT) { const int pos = i >> 4, k = i & 15;
          const float inv = 1.0f / powf(10000.0f, (float)(2 * k) / 32.0f); const float ang = (float)pos * inv;
          f32x2 cs; cs.x = (float)cos((double)ang); cs.y = (float)sin((double)ang); tab[i] = cs; } }
    { const int gt = gw * 64 + F.lane; float* lb = (float*)(ws + WS_LB);
      if (gt < 2048) { const int d = gt >> 10, k = gt & 1023; const float x0 = in[10][(size_t)(d * 2 + 0) * 1024 + k], x1 = in[10][(size_t)(d * 2 + 1) * 1024 + k];
          lb[gt] = 1.0f / (1.0f + expf(x0 - x1)); } }
}

template <bool FINAL> __device__ __forceinline__ void ln_pass(Frame& F, const float* X, const float* gain, const float* bias, bf16* hout, float* out) {
    const int gw = F.vcu * NWAVES + F.wave, NGW = F.G * NWAVES;
    f32x4 g[4], bb[4];
#pragma unroll
    for (int j = 0; j < 4; ++j) { g[j] = ((const f32x4*)gain)[64 * j + F.lane]; bb[j] = ((const f32x4*)bias)[64 * j + F.lane]; }
    for (int row = gw; row < M; row += NGW) {
        const int b = row / LP, s = row % LP;
        if (FINAL) { if (s < 64) continue; }
        else if (s < PADR) { GAS unsigned long long* o8 = (GAS unsigned long long*)(hout + (size_t)row * 1024) + F.lane;
#pragma unroll
            for (int j = 0; j < 4; ++j) o8[64 * j] = 0ull;
            continue; }
        const GAS f32x4* xr = (const GAS f32x4*)(X + (size_t)row * 1024) + F.lane;
        f32x4 v[4]; float sm = 0.f;
#pragma unroll
        for (int j = 0; j < 4; ++j) { v[j] = xr[64 * j]; sm += (v[j].x + v[j].y) + (v[j].z + v[j].w); }
        const float mean = wave_sum(sm) * (1.f / 1024.f); float s2 = 0.f;
#pragma unroll
        for (int j = 0; j < 4; ++j) { v[j] = v[j] - mean; s2 += (v[j].x * v[j].x + v[j].y * v[j].y) + (v[j].z * v[j].z + v[j].w * v[j].w); }
        const float rstd = 1.f / sqrtf(wave_sum(s2) * (1.f / 1024.f) + EPS);
        if (FINAL) { GAS f32x4* o = (GAS f32x4*)(out + ((size_t)b * SEQ + (s - 64)) * 1024) + F.lane;
#pragma unroll
            for (int j = 0; j < 4; ++j) o[64 * j] = v[j] * rstd * g[j] + bb[j];
        } else { GAS unsigned long long* o8 = (GAS unsigned long long*)(hout + (size_t)row * 1024) + F.lane;
#pragma unroll
            for (int j = 0; j < 4; ++j) { const f32x4 y = v[j] * rstd * g[j] + bb[j]; o8[64 * j] = (unsigned long long)cvt_pk_bf16(y.x, y.y) | ((unsigned long long)cvt_pk_bf16(y.z, y.w) << 32); } }
    }
}
__device__ __forceinline__ void attn_simple(Frame& F, const bf16* Q, const bf16* KV, const bf16* KR, bf16* O) {
    LAS float* Ks = (LAS float*)(F.lds);
    LAS float* Vs = (LAS float*)(F.lds + 64 * 96 * 4);
    constexpr int NQC = 17;
    const int hf = F.tid & 1;
    for (int u = F.vcu; u < NB * 16 * NQC; u += F.G) {
        const int bh = u / NQC, qc = u % NQC, b = bh >> 4, h = bh & 15;
        const int sq = qc * 256 + (F.tid >> 1); const bool vq = sq < LP; const size_t rowq = (size_t)b * LP + (vq ? sq : LP - 1);
        float q[48];
#pragma unroll
        for (int c = 0; c < 6; ++c) { const v4u w = *(const GAS v4u*)(Q + rowq * 1536 + h * 96 + hf * 48 + c * 8);
            q[c * 8 + 0] = bf_lo(w.x); q[c * 8 + 1] = bf_hi(w.x); q[c * 8 + 2] = bf_lo(w.y); q[c * 8 + 3] = bf_hi(w.y);
            q[c * 8 + 4] = bf_lo(w.z); q[c * 8 + 5] = bf_hi(w.z); q[c * 8 + 6] = bf_lo(w.w); q[c * 8 + 7] = bf_hi(w.w); }
        float o[32];
#pragma unroll
        for (int d = 0; d < 32; ++d) o[d] = 0.f;
        float mx = -1e30f, l = 0.f;
        for (int kt = 0; kt < 65; ++kt) {
            __syncthreads();
            for (int idx = F.tid; idx < 64 * 12; idx += 512) { const int j = idx / 12, c = idx % 12; int sk = PADR + kt * 64 + j; sk = sk < LP ? sk : LP - 1; const size_t rk = (size_t)b * LP + sk;
                const v4u w = c < 8 ? *(const GAS v4u*)(KV + rk * 2048 + h * 128 + c * 8) : *(const GAS v4u*)(KR + rk * 32 + (c - 8) * 8);
                LAS float* d = Ks + j * 96 + c * 8; d[0] = bf_lo(w.x); d[1] = bf_hi(w.x); d[2] = bf_lo(w.y); d[3] = bf_hi(w.y); d[4] = bf_lo(w.z); d[5] = bf_hi(w.z); d[6] = bf_lo(w.w); d[7] = bf_hi(w.w); }
            { const int j = F.tid >> 3, c = F.tid & 7; int sk = PADR + kt * 64 + j; sk = sk < LP ? sk : LP - 1; const size_t rk = (size_t)b * LP + sk;
                const v4u w = *(const GAS v4u*)(KV + rk * 2048 + h * 128 + 64 + c * 8);
                LAS float* d = Vs + j * 64 + c * 8; d[0] = bf_lo(w.x); d[1] = bf_hi(w.x); d[2] = bf_lo(w.y); d[3] = bf_hi(w.y); d[4] = bf_lo(w.z); d[5] = bf_hi(w.z); d[6] = bf_lo(w.w); d[7] = bf_hi(w.w); }
            __syncthreads();
            const int nk = (LTOK - kt * 64) < 64 ? (LTOK - kt * 64) : 64;
#pragma unroll 1
            for (int jj = 0; jj < nk; ++jj) {
                const LAS f32x4* kr = (const LAS f32x4*)(Ks + jj * 96 + hf * 48); float a0 = 0.f, a1 = 0.f;
#pragma unroll
                for (int c = 0; c < 12; c += 2) { const f32x4 k0 = kr[c], k1 = kr[c + 1];
                    a0 += q[4 * c] * k0.x + q[4 * c + 1] * k0.y + q[4 * c + 2] * k0.z + q[4 * c + 3] * k0.w;
                    a1 += q[4 * c + 4] * k1.x + q[4 * c + 5] * k1.y + q[4 * c + 6] * k1.z + q[4 * c + 7] * k1.w; }
                float sc = a0 + a1; sc += __shfl_xor(sc, 1); sc *= SM_C;
                const float mn = fmaxf(mx, sc);
                const float al = __builtin_amdgcn_exp2f(mx - mn), p = __builtin_amdgcn_exp2f(sc - mn); mx = mn; l = l * al + p;
                const LAS f32x4* vr = (const LAS f32x4*)(Vs + jj * 64 + hf * 32);
#pragma unroll
                for (int c = 0; c < 8; ++c) { const f32x4 vv = vr[c]; o[4 * c] = fmaf(p, vv.x, o[4 * c] * al); o[4 * c + 1] = fmaf(p, vv.y, o[4 * c + 1] * al); o[4 * c + 2] = fmaf(p, vv.z, o[4 * c + 2] * al); o[4 * c + 3] = fmaf(p, vv.w, o[4 * c + 3] * al); }
            }
        }
        if (vq) { const float il = 1.0f / l;
#pragma unroll
            for (int c = 0; c < 4; ++c) { v4u w; w.x = cvt_pk_bf16(o[8 * c] * il, o[8 * c + 1] * il); w.y = cvt_pk_bf16(o[8 * c + 2] * il, o[8 * c + 3] * il); w.z = cvt_pk_bf16(o[8 * c + 4] * il, o[8 * c + 5] * il); w.w = cvt_pk_bf16(o[8 * c + 6] * il, o[8 * c + 7] * il);
                *(GAS v4u*)(O + rowq * 1024 + h * 64 + hf * 32 + c * 8) = w; } }
    }
    __syncthreads();
}

__device__ __forceinline__ void gla_simple(Frame& F, bf16* Qb, const bf16* Vb, bf16* KFb, const bf16* KBb, const bf16* SGb, const float* onorm) {
    LAS float* tq = (LAS float*)(F.lds);
    LAS float* tk = (LAS float*)(F.lds + 16384);
    LAS float* tv = (LAS float*)(F.lds + 32768);
    LAS float* pr = (LAS float*)(F.lds + 49152);
    const int j = F.tid & 127, kq = F.tid >> 7;
    for (int it = F.vcu; it < NB * 8; it += F.G) {
        const int b = it >> 3, h = it & 7; const size_t cbase = (size_t)h * 128;
        for (int dir = 0; dir < 2; ++dir) {
            float S[32];
#pragma unroll
            for (int k = 0; k < 32; ++k) S[k] = 0.f;
            const bf16* Kg = dir == 0 ? KFb : KBb;
            for (int tile = 0; tile < (LTOK + 31) / 32; ++tile) {
                __syncthreads();
                { const int i = F.tid >> 4, c8 = (F.tid & 15) * 8; const int tt = tile * 32 + i; const bool vt = tt < LTOK; const int tok = dir == 0 ? tt : LTOK - 1 - tt;
                  const size_t off = ((size_t)b * LP + PADR + (vt ? tok : 0)) * 1024 + cbase + c8;
                  v4u wq = *(const GAS v4u*)(Qb + off), wk = *(const GAS v4u*)(Kg + off), wv = *(const GAS v4u*)(Vb + off);
                  if (!vt) { wq = (v4u){0u, 0u, 0u, 0u}; wk = wq; wv = wq; }
                  LAS float* dq = tq + i * 128 + c8; LAS float* dk = tk + i * 128 + c8; LAS float* dv = tv + i * 128 + c8;
                  dq[0] = bf_lo(wq.x); dq[1] = bf_hi(wq.x); dq[2] = bf_lo(wq.y); dq[3] = bf_hi(wq.y); dq[4] = bf_lo(wq.z); dq[5] = bf_hi(wq.z); dq[6] = bf_lo(wq.w); dq[7] = bf_hi(wq.w);
                  dk[0] = bf_lo(wk.x); dk[1] = bf_hi(wk.x); dk[2] = bf_lo(wk.y); dk[3] = bf_hi(wk.y); dk[4] = bf_lo(wk.z); dk[5] = bf_hi(wk.z); dk[6] = bf_lo(wk.w); dk[7] = bf_hi(wk.w);
                  dv[0] = bf_lo(wv.x); dv[1] = bf_hi(wv.x); dv[2] = bf_lo(wv.y); dv[3] = bf_hi(wv.y); dv[4] = bf_lo(wv.z); dv[5] = bf_hi(wv.z); dv[6] = bf_lo(wv.w); dv[7] = bf_hi(wv.w); }
                __syncthreads();
                for (int i = 0; i < 32; ++i) {
                    const float vj = tv[i * 128 + j]; float part = 0.f;
                    const LAS f32x4* kr = (const LAS f32x4*)(tk + i * 128 + kq * 32); const LAS f32x4* qr = (const LAS f32x4*)(tq + i * 128 + kq * 32);
#pragma unroll
                    for (int c = 0; c < 8; ++c) { const f32x4 kk = kr[c], qq = qr[c];
                        S[4 * c] = fmaf(kk.x, vj - S[4 * c], S[4 * c]); part = fmaf(S[4 * c], qq.x, part);
                        S[4 * c + 1] = fmaf(kk.y, vj - S[4 * c + 1], S[4 * c + 1]); part = fmaf(S[4 * c + 1], qq.y, part);
                        S[4 * c + 2] = fmaf(kk.z, vj - S[4 * c + 2], S[4 * c + 2]); part = fmaf(S[4 * c + 2], qq.z, part);
                        S[4 * c + 3] = fmaf(kk.w, vj - S[4 * c + 3], S[4 * c + 3]); part = fmaf(S[4 * c + 3], qq.w, part); }
                    pr[(i * 4 + kq) * 128 + j] = part;
                }
                __syncthreads();
#pragma unroll
                for (int ii = 0; ii < 4; ++ii) { const int i = F.wave * 4 + ii; const int tt = tile * 32 + i; const bool vt = tt < LTOK; const int tok = dir == 0 ? tt : LTOK - 1 - tt;
                    const int c = 2 * F.lane;
                    float o0 = pr[(i * 4 + 0) * 128 + c] + pr[(i * 4 + 1) * 128 + c] + pr[(i * 4 + 2) * 128 + c] + pr[(i * 4 + 3) * 128 + c];
                    float o1 = pr[(i * 4 + 0) * 128 + c + 1] + pr[(i * 4 + 1) * 128 + c + 1] + pr[(i * 4 + 2) * 128 + c + 1] + pr[(i * 4 + 3) * 128 + c + 1];
                    const size_t off = ((size_t)b * LP + PADR + (vt ? tok : 0)) * 1024 + cbase + c;
                    if (dir == 0) { if (vt) *(GAS unsigned*)(KFb + off) = cvt_pk_bf16(o0, o1); }
                    else { const unsigned wf = *(const GAS unsigned*)(KFb + off); o0 += bf_lo(wf); o1 += bf_hi(wf);
                        const float ss = wave_sum(o0 * o0 + o1 * o1); const float rstd = 1.0f / sqrtf(ss * (1.0f / 128.0f) + EPS);
                        const unsigned wg = *(const GAS unsigned*)(SGb + off); const f32x2 gn = *(const f32x2*)(onorm + cbase + c);
                        if (vt) *(GAS unsigned*)(Qb + off) = cvt_pk_bf16(o0 * rstd * gn.x * bf_lo(wg), o1 * rstd * gn.y * bf_hi(wg)); } }
            }
            __syncthreads();
        }
    }
    __syncthreads();
}
constexpr int NPHASE = 16;
#ifndef MK_ONE_LAUNCH
#define MK_ONE_LAUNCH 0
#endif
struct Args { const float* in[19]; float* out; unsigned char* ws; int ph_lo, ph_hi; };
__global__ void __launch_bounds__(NWAVES * 64, 2) fwd(Args args) {
    extern __shared__ __attribute__((aligned(16))) unsigned char lds[];
    Frame F;
    F.lds = (LAS unsigned char*)lds;
    F.MISC = (volatile LAS unsigned*)(F.lds + MISC_OFF);
    F.tid = threadIdx.x; F.lane = F.tid & 63; F.wave = __builtin_amdgcn_readfirstlane(F.tid >> 6);
    F.G = gridDim.x; { const int bx = blockIdx.x; F.vcu = (F.G % 8 == 0) ? (bx % 8) * (F.G / 8) + bx / 8 : bx; }
    unsigned char* ws = args.ws;
    for (int u = F.tid; u < (LDS_BYTES - LDSCTL_OFF) / 4; u += NWAVES * 64) ((LAS unsigned*)(F.lds + LDSCTL_OFF))[u] = 0u;
    __syncthreads();
    const int lo = args.ph_lo, hi = args.ph_hi;
    XcdBarrier bar; bar.bar = (unsigned*)(ws + WS_CTL); bar.x = 0; bar.st = nullptr;
    if (hi - lo > 1) bar = xcd_barrier_post((unsigned*)(ws + WS_CTL), F.MISC + 8);
#ifndef ONLY_PHASE
#define ONLY_PHASE -1
#endif
#define IN(k) (lo <= (k) && (k) < hi && (ONLY_PHASE < 0 || ONLY_PHASE == (k)))
#define SEAM(k) do { if (IN(k) && IN((k) + 1)) xcd_barrier(bar); } while (0)
    const float* const* in = args.in;
    bf16* hD = (bf16*)args.out;
    bf16* hB = (bf16*)(ws + WS_B0 + (size_t)SLACK * ROWB);
    const pg8::f32x2* rope = (const pg8::f32x2*)(ws + WS_ROPE);
    using pg8::Gemm; using pg8::StaticOrder;
    const int cid = (int)blockIdx.x;

    if (IN(0)) { p0_prologue(F, in, ws, hD); } SEAM(0);
    if (IN(1)) { Gemm g{hD, (const bf16*)(ws + W_IN), 1024, 1024, 1024}; StaticOrder S; S.init(MT, 5, F.G, cid);
        pg8::EpiProj E{(bf16*)(ws + R_CQKV), (float*)(ws + R_SSQ), (bf16*)(ws + R_KROPE), rope};
        pg8::gemm_phase<pg8::EpiProj, StaticOrder, true, true>(F.lds + RING_OFF, g, S, E); } SEAM(1);
    if (IN(2)) {
        { Gemm g{(const bf16*)(ws + R_CQKV), (const bf16*)(ws + W_UQ), 768, 1024, 768}; StaticOrder S; S.init(MT, 6, F.G, cid);
          pg8::EpiQ E{(bf16*)(ws + R_Q), (const float*)(ws + R_SSQ), rope};
          pg8::gemm_phase<pg8::EpiQ, StaticOrder, true, true>(F.lds + RING_OFF, g, S, E); }
        { Gemm g{(const bf16*)(ws + R_CQKV) + 768, (const bf16*)(ws + W_UKV), 256, 1024, 256}; StaticOrder S; S.init(MT, 8, F.G, cid);
          pg8::EpiKV E{(bf16*)(ws + R_KV), (const float*)(ws + R_SSQ)};
          pg8::gemm_phase<pg8::EpiKV, StaticOrder, true, true>(F.lds + RING_OFF, g, S, E); }
    } SEAM(2);
    if (IN(3)) { attn_simple(F, (const bf16*)(ws + R_Q), (const bf16*)(ws + R_KV), (const bf16*)(ws + R_KROPE), (bf16*)(ws + R_CQKV)); } SEAM(3);
    if (IN(4)) { Gemm g{(const bf16*)(ws + R_CQKV), (const bf16*)(ws + W_O), 1024, 1024, 1024}; StaticOrder S; S.init(MT, 4, F.G, cid);
        pg8::EpiResid E{hD, (float*)(ws + R_X_L0)};
        pg8::gemm_phase<pg8::EpiResid, StaticOrder, true, true>(F.lds + RING_OFF, g, S, E); } SEAM(4);
    if (IN(5)) { ln_pass<false>(F, (const float*)(ws + R_X_L0), in[17] + 0 * 1024, in[18] + 0 * 1024, hB, nullptr); } SEAM(5);
    if (IN(6)) { Gemm g{hB - 1024, (const bf16*)(ws + W_UP0), 1024, 1024, 1024}; StaticOrder S; S.init(MT_UP, 22, F.G, cid);
        pg8::EpiConvGate E{(bf16*)(ws + R_ACT), in[14], in[15]};
        pg8::gemm_phase<pg8::EpiConvGate, StaticOrder, true, true, true>(F.lds + RING_OFF, g, S, E); } SEAM(6);
    if (IN(7)) { Gemm g{(const bf16*)(ws + R_ACT), (const bf16*)(ws + W_DN0), DFF, DFF, DFF}; StaticOrder S; S.init(MT, 4, F.G, cid);
        pg8::EpiResid E{hB, (float*)(ws + R_X_FFN)};
        pg8::gemm_phase<pg8::EpiResid, StaticOrder, true, true>(F.lds + RING_OFF, g, S, E); } SEAM(7);
    if (IN(8)) { ln_pass<false>(F, (const float*)(ws + R_X_FFN), in[17] + 1 * 1024, in[18] + 1 * 1024, hD, nullptr); } SEAM(8);
    if (IN(9)) { Gemm g{hD, (const bf16*)(ws + W_HIN), 1024, 1024, 1024}; StaticOrder S; S.init(MT, 20, F.G, cid);
        pg8::EpiHgIn E{hB, (bf16*)(ws + R_HV), (bf16*)(ws + R_HKF), (bf16*)(ws + R_HKB), (bf16*)(ws + R_HSG), (const float*)(ws + WS_LB)};
        pg8::gemm_phase<pg8::EpiHgIn, StaticOrder, true, true>(F.lds + RING_OFF, g, S, E); } SEAM(9);
    if (IN(10)) { gla_simple(F, hB, (const bf16*)(ws + R_HV), (bf16*)(ws + R_HKF), (const bf16*)(ws + R_HKB), (const bf16*)(ws + R_HSG), in[11]); } SEAM(10);
    if (IN(11)) { Gemm g{hB, (const bf16*)(ws + W_HO), 1024, 1024, 1024}; StaticOrder S; S.init(MT, 4, F.G, cid);
        pg8::EpiResid E{hD, (float*)(ws + R_X_HG)};
        pg8::gemm_phase<pg8::EpiResid, StaticOrder, true, true>(F.lds + RING_OFF, g, S, E); } SEAM(11);
    if (IN(12)) { ln_pass<false>(F, (const float*)(ws + R_X_HG), in[17] + 2 * 1024, in[18] + 2 * 1024, hB, nullptr); } SEAM(12);
    if (IN(13)) { Gemm g{hB - 1024, (const bf16*)(ws + W_UP1), 1024, 1024, 1024}; StaticOrder S; S.init(MT_UP, 22, F.G, cid);
        pg8::EpiConvGate E{(bf16*)(ws + R_ACT), in[14] + 3 * NUP, in[15] + NUP};
        pg8::gemm_phase<pg8::EpiConvGate, StaticOrder, true, true, true>(F.lds + RING_OFF, g, S, E); } SEAM(13);
    if (IN(14)) { Gemm g{(const bf16*)(ws + R_ACT), (const bf16*)(ws + W_DN1), DFF, DFF, DFF}; StaticOrder S; S.init(MT, 4, F.G, cid);
        pg8::EpiResid E{hB, (float*)(ws + R_X_FFN)};
        pg8::gemm_phase<pg8::EpiResid, StaticOrder, true, true>(F.lds + RING_OFF, g, S, E); } SEAM(14);
    if (IN(15)) { ln_pass<true>(F, (const float*)(ws + R_X_FFN), in[17] + 3 * 1024, in[18] + 3 * 1024, nullptr, args.out); }
#undef IN
#undef SEAM
}

__global__ void nan_fill(float* o, long n) { const float q = __builtin_nanf(""); for (long i = blockIdx.x * 256L + threadIdx.x; i < n; i += gridDim.x * 256L) o[i] = q; }
extern "C" void kernel_launch(void* const* d_in, const int* in_sizes, int n_in, void* d_out, int out_size, void* d_ws, size_t ws_size, hipStream_t stream) {
    static int grid = 0;
    if (grid == 0) {
        bool ok = (n_in == 19) && in_sizes[0] == 16 * SEQ * 1024 && in_sizes[1] == 4 * SEQ * 1024 && out_size == NB * SEQ * 1024 && ws_size >= WS_END;
        int dev = 0, cus = 0;
        if (ok) ok = hipGetDevice(&dev) == hipSuccess && hipDeviceGetAttribute(&cus, hipDeviceAttributeMultiprocessorCount, dev) == hipSuccess;
        if (ok) ok = hipFuncSetAttribute((const void*)fwd, hipFuncAttributeMaxDynamicSharedMemorySize, LDS_BYTES) == hipSuccess;
        if (!ok) { fprintf(stderr, "kernel_launch: unexpected shapes / workspace (%zu) / device\n", ws_size); grid = -1; }
        else grid = cus;
        (void)hipGetLastError();
    }
    if (grid < 0) { hipLaunchKernelGGL(nan_fill, dim3(1024), dim3(256), 0, stream, (float*)d_out, (long)out_size); return; }
    (void)hipMemsetAsync((char*)d_ws + WS_CTL, 0, CTL_ZERO_BYTES, stream);
    Args a{};
    for (int i = 0; i < 19; ++i) a.in[i] = (const float*)d_in[i];
    a.out = (float*)d_out; a.ws = (unsigned char*)d_ws;
#if MK_ONE_LAUNCH
    a.ph_lo = 0; a.ph_hi = NPHASE;
    hipLaunchKernelGGL(fwd, dim3(grid), dim3(NWAVES * 64), LDS_BYTES, stream, a);
#else
    for (int p = 0; p < NPHASE; ++p) { a.ph_lo = p; a.ph_hi = p + 1; hipLaunchKernelGGL(fwd, dim3(grid), dim3(NWAVES * 64), LDS_BYTES, stream, a); }
#endif
}
```

```cpp
#include <hip/hip_runtime.h>
#include <cstdio>
constexpr int NB = 20;
constexpr int LP = 4160;
constexpr int PADR = 48, LTOK = 4112, SEQ = 4096, DM = 1024;
constexpr int M = NB * LP;
constexpr int MT = M / 256;
constexpr int DFF = 2816, NUP = 2 * DFF;
constexpr int NBLK62 = (M + 61) / 62;
constexpr int MT_UP = (NBLK62 + 3) / 4;
constexpr float EPS = 1e-6f, ALPHA = 1.4142135623730951f;
constexpr float SM_C = 0.10206207261596575f * 1.4426950408889634f;
#include <cstdint>
namespace pg8 {
#define PG8_LAS __attribute__((address_space(3)))
typedef unsigned short bf16_t;
typedef short bf16x8 __attribute__((ext_vector_type(8)));
typedef float f32x4 __attribute__((ext_vector_type(4)));
typedef unsigned u32x4 __attribute__((ext_vector_type(4)));
typedef unsigned u32x2 __attribute__((ext_vector_type(2)));
constexpr int BM = 256, BK = 64, HALF = 128, HTB = HALF * BK * 2  , STAGE_BYTES = 8 * HTB, NXCD = 8, WGM = 8;

__host__ __device__ __forceinline__ int lds_byte(int r, int c) { const int st = (r >> 4) * 2 + (c >> 5), rr = r & 15, cc = c & 31, ob = rr * 64 + cc * 2; return st * 1024 + (ob ^ (((ob >> 9) & 1) << 5)); }
__host__ __device__ __forceinline__ void stage_rc(int b, int& R, int& C) { const int st = b / 1024, sb = b % 1024, swz = sb ^ (((sb >> 9) & 1) << 5); R = (st >> 1) * 16 + swz / 64; C = (st & 1) * 32 + (swz % 64) / 2; }
__host__ __device__ __forceinline__ int perm32(int rho) { const int n = rho >> 4, i = rho & 15; return 8 * (i >> 2) + 4 * n + (i & 3); }

struct Unit { int pm, pn; };
struct Gemm { const bf16_t* A; const bf16_t* Bt; int K, lda, ldb; };

struct StaticOrder {
    int nM, nN, nwg, G, c;
    __host__ __device__ void init(int nM_, int nN_, int G_, int c_) { nM = nM_; nN = nN_; nwg = nM * nN; G = G_; c = c_; }
    __host__ __device__ bool next(int i, Unit& u) const {
        const long L = (long)i * G + c; if (L >= nwg) return false;
        int wgid = (int)L; { const int q = nwg / NXCD, r = nwg % NXCD, xcd = wgid % NXCD, off = wgid / NXCD; wgid = (xcd < r ? xcd * (q + 1) : r * (q + 1) + (xcd - r) * q) + off; }
        const int nig = WGM * nN, gid = wgid / nig, fm = gid * WGM, gsz = (nM - fm) < WGM ? (nM - fm) : WGM;
        u.pm = fm + ((wgid % nig) % gsz); u.pn = (wgid % nig) / gsz; return true;
    }
    __device__ __forceinline__ void a_ready(const Unit&) const {}
    __device__ __forceinline__ void done(const Unit&) const {}
};
__device__ __forceinline__ unsigned cvt_pk_bf16(float lo, float hi) { unsigned r; asm volatile("v_cvt_pk_bf16_f32 %0, %1, %2" : "=v"(r) : "v"(lo), "v"(hi)); return r; }
__device__ __forceinline__ float bf_lo(unsigned w) { return __uint_as_float(w << 16); }
__device__ __forceinline__ float bf_hi(unsigned w) { return __uint_as_float(w & 0xffff0000u); }
typedef float f32x2 __attribute__((ext_vector_type(2)));
__device__ __forceinline__ u32x4 pack8(const f32x4 v0, const f32x4 v1) { u32x4 w; w.x = cvt_pk_bf16(v0[0], v0[1]); w.y = cvt_pk_bf16(v0[2], v0[3]); w.z = cvt_pk_bf16(v1[0], v1[1]); w.w = cvt_pk_bf16(v1[2], v1[3]); return w; }
__device__ __forceinline__ void rope8(f32x4& v0, f32x4& v1, const f32x2* tab, int pos, int i0) {
    const f32x2* t = tab + pos * 16 + i0;
    const f32x2 c0 = t[0], c1 = t[1], c2 = t[2], c3 = t[3];
    f32x4 a, b;
    a[0] = v0[0] * c0.x - v0[1] * c0.y; a[1] = v0[0] * c0.y + v0[1] * c0.x;
    a[2] = v0[2] * c1.x - v0[3] * c1.y; a[3] = v0[2] * c1.y + v0[3] * c1.x;
    b[0] = v1[0] * c2.x - v1[1] * c2.y; b[1] = v1[0] * c2.y + v1[1] * c2.x;
    b[2] = v1[2] * c3.x - v1[3] * c3.y; b[3] = v1[2] * c3.y + v1[3] * c3.x;
    v0 = a; v1 = b;
}
struct EpiProj {
    static constexpr bool PERM = true, AFTER_DRAIN = false;
    bf16_t* cqkv; float* ssq; bf16_t* krope; const f32x2* rope;
    __device__ __forceinline__ void operator()(const f32x4 (&acc)[2][2][4][2], const Unit& u, int wr, int wc, int fr, int fq) const {
        const int row0 = u.pm * BM + wr * 64 + fr;
        if (u.pn < 4) {
            const int col0 = u.pn * BM + wc * 32 + 8 * fq;
#pragma unroll
            for (int ai = 0; ai < 2; ++ai)
#pragma unroll
                for (int m = 0; m < 4; ++m) { const int row = row0 + ai * HALF + m * 16; float s = 0.f;
#pragma unroll
                    for (int bj = 0; bj < 2; ++bj) { const f32x4 v0 = acc[ai][bj][m][0], v1 = acc[ai][bj][m][1];
                        s += (v0[0] * v0[0] + v0[1] * v0[1]) + (v0[2] * v0[2] + v0[3] * v0[3]) + (v1[0] * v1[0] + v1[1] * v1[1]) + (v1[2] * v1[2] + v1[3] * v1[3]);
                        *(u32x4*)(cqkv + (size_t)row * 1024 + col0 + bj * HALF) = pack8(v0, v1); }
                    s += __shfl_xor(s, 16); s += __shfl_xor(s, 32);
                    if (fq == 0) ssq[(size_t)row * 16 + u.pn * 4 + wc] = s; }
        } else if (wc == 0) {
#pragma unroll
            for (int ai = 0; ai < 2; ++ai)
#pragma unroll
                for (int m = 0; m < 4; ++m) { const int row = row0 + ai * HALF + m * 16; int pos = row % LP - PADR; pos = pos < 0 ? 0 : pos;
                    f32x4 v0 = acc[ai][0][m][0], v1 = acc[ai][0][m][1]; rope8(v0, v1, rope, pos, 4 * fq);
                    *(u32x4*)(krope + (size_t)row * 32 + 8 * fq) = pack8(v0, v1); }
        }
    }
};
struct EpiQ {
    static constexpr bool PERM = true, AFTER_DRAIN = false;
    bf16_t* Q; const float* ssq; const f32x2* rope;
    __device__ __forceinline__ void operator()(const f32x4 (&acc)[2][2][4][2], const Unit& u, int wr, int wc, int fr, int fq) const {
        const int row0 = u.pm * BM + wr * 64 + fr, col0 = u.pn * BM + wc * 32 + 8 * fq;
#pragma unroll
        for (int ai = 0; ai < 2; ++ai)
#pragma unroll
            for (int m = 0; m < 4; ++m) { const int row = row0 + ai * HALF + m * 16; int pos = row % LP - PADR; pos = pos < 0 ? 0 : pos;
                const f32x4* sp = (const f32x4*)(ssq + (size_t)row * 16); const f32x4 s0 = sp[0], s1 = sp[1], s2 = sp[2];
                const float ss = ((s0[0] + s0[1]) + (s0[2] + s0[3])) + ((s1[0] + s1[1]) + (s1[2] + s1[3])) + ((s2[0] + s2[1]) + (s2[2] + s2[3]));
                const float rstd = 1.0f / sqrtf(ss * (1.0f / 768.0f) + EPS);
#pragma unroll
                for (int bj = 0; bj < 2; ++bj) { const int c = col0 + bj * HALF, d = c % 96; f32x4 v0 = acc[ai][bj][m][0] * rstd, v1 = acc[ai][bj][m][1] * rstd;
                    if (d >= 64) rope8(v0, v1, rope, pos, (d - 64) >> 1);
                    *(u32x4*)(Q + (size_t)row * 1536 + c) = pack8(v0, v1); } }
    }
};
struct EpiKV {
    static constexpr bool PERM = true, AFTER_DRAIN = false;
    bf16_t* KV; const float* ssq;
    __device__ __forceinline__ void operator()(const f32x4 (&acc)[2][2][4][2], const Unit& u, int wr, int wc, int fr, int fq) const {
        const int row0 = u.pm * BM + wr * 64 + fr, col0 = u.pn * BM + wc * 32 + 8 * fq;
#pragma unroll
        for (int ai = 0; ai < 2; ++ai)
#pragma unroll
            for (int m = 0; m < 4; ++m) { const int row = row0 + ai * HALF + m * 16;
                const f32x4 s3 = *(const f32x4*)(ssq + (size_t)row * 16 + 12);
                const float rstd = 1.0f / sqrtf(((s3[0] + s3[1]) + (s3[2] + s3[3])) * (1.0f / 256.0f) + EPS);
#pragma unroll
                for (int bj = 0; bj < 2; ++bj) *(u32x4*)(KV + (size_t)row * 2048 + col0 + bj * HALF) = pack8(acc[ai][bj][m][0] * rstd, acc[ai][bj][m][1] * rstd); }
    }
};
struct EpiResid {
    static constexpr bool PERM = false, AFTER_DRAIN = false;
    const bf16_t* h; float* X;
    __device__ __forceinline__ void operator()(const f32x4 (&acc)[2][2][4][2], const Unit& u, int wr, int wc, int fr, int fq) const {
        const int row0 = u.pm * BM + wr * 64 + fr, col0 = u.pn * BM + wc * 32 + 4 * fq;
#pragma unroll
        for (int ai = 0; ai < 2; ++ai)
#pragma unroll
            for (int m = 0; m < 4; ++m) { const size_t off = (size_t)(row0 + ai * HALF + m * 16) * 1024 + col0;
#pragma unroll
                for (int bj = 0; bj < 2; ++bj)
#pragma unroll
                    for (int n = 0; n < 2; ++n) { const u32x2 hw = *(const u32x2*)(h + off + bj * HALF + n * 16);
                        f32x4 hv; hv[0] = bf_lo(hw.x); hv[1] = bf_hi(hw.x); hv[2] = bf_lo(hw.y); hv[3] = bf_hi(hw.y);
                        *(f32x4*)(X + off + bj * HALF + n * 16) = hv * ALPHA + acc[ai][bj][m][n]; } }
    }
};
struct EpiHgIn {
    static constexpr bool PERM = true, AFTER_DRAIN = false;
    bf16_t* q; bf16_t* v; bf16_t* kf; bf16_t* kb; bf16_t* sg; const float* lb;
    __device__ __forceinline__ void operator()(const f32x4 (&acc)[2][2][4][2], const Unit& u, int wr, int wc, int fr, int fq) const {
        const int row0 = u.pm * BM + wr * 64 + fr, t = u.pn >> 2, col0 = (u.pn & 3) * BM + wc * 32 + 8 * fq;
        bf16_t* dst = t == 0 ? q : t == 1 ? v : t == 2 ? kf : t == 3 ? kb : sg;
#pragma unroll
        for (int bj = 0; bj < 2; ++bj) { const int c = col0 + bj * HALF;
            f32x4 om0 = {1.f, 1.f, 1.f, 1.f}, om1 = om0;
            if (t == 2 || t == 3) { const f32x4* lp = (const f32x4*)(lb + (t - 2) * 1024 + c); om0 = 1.0f - lp[0]; om1 = 1.0f - lp[1]; }
#pragma unroll
            for (int ai = 0; ai < 2; ++ai)
#pragma unroll
                for (int m = 0; m < 4; ++m) { const int row = row0 + ai * HALF + m * 16; const bool pad = (row % LP) < PADR;
                    f32x4 v0 = acc[ai][bj][m][0], v1 = acc[ai][bj][m][1];
                    if (t == 2 || t == 3) {
#pragma unroll
                        for (int j = 0; j < 4; ++j) { v0[j] = pad ? 0.f : om0[j] * __builtin_amdgcn_rcpf(1.0f + __builtin_amdgcn_exp2f(v0[j] * 1.4426950408889634f));
                                                      v1[j] = pad ? 0.f : om1[j] * __builtin_amdgcn_rcpf(1.0f + __builtin_amdgcn_exp2f(v1[j] * 1.4426950408889634f)); }
                    } else if (t == 4) {
#pragma unroll
                        for (int j = 0; j < 4; ++j) { v0[j] = v0[j] * __builtin_amdgcn_rcpf(1.0f + __builtin_amdgcn_exp2f(v0[j] * -1.4426950408889634f));
                                                      v1[j] = v1[j] * __builtin_amdgcn_rcpf(1.0f + __builtin_amdgcn_exp2f(v1[j] * -1.4426950408889634f)); }
                    }
                    *(u32x4*)(dst + (size_t)row * 1024 + c) = pack8(v0, v1); } }
    }
};
struct EpiConvGate {
    static constexpr bool PERM = true, AFTER_DRAIN = false;
    bf16_t* act; const float* cw; const float* cb;
    __device__ __forceinline__ void operator()(const f32x4 (&acc)[2][2][4][2], const Unit& u, int wr, int wc, int fr, int fq) const {
        const int lane = fq * 16 + fr, lprev = fq * 16 + ((fr + 15) & 15), lnext = fq * 16 + ((fr + 1) & 15);
        const int cv0 = 128 * u.pn + 32 * wc + 8 * fq;
#pragma unroll
        for (int n = 0; n < 2; ++n)
#pragma unroll
          for (int jp = 0; jp < 2; ++jp) { const int cv = cv0 + 4 * n + 2 * jp;
            const f32x2 wv0 = *(const f32x2*)(cw + cv), wv1 = *(const f32x2*)(cw + NUP + cv), wv2 = *(const f32x2*)(cw + 2 * NUP + cv), bv = *(const f32x2*)(cb + cv);
            const f32x2 wg0 = *(const f32x2*)(cw + DFF + cv), wg1 = *(const f32x2*)(cw + NUP + DFF + cv), wg2 = *(const f32x2*)(cw + 2 * NUP + DFF + cv), bg = *(const f32x2*)(cb + DFF + cv);
#pragma unroll
            for (int ai = 0; ai < 2; ++ai) { const int J = 4 * u.pm + 2 * ai + wr;
                float o[4][2];
#pragma unroll
                for (int jj = 0; jj < 2; ++jj) { const int j = 2 * jp + jj;
                    float rv[4], lv[4], rg[4], lg[4];
#pragma unroll
                    for (int m = 0; m < 4; ++m) { rv[m] = __shfl(acc[ai][0][m][n][j], lprev); lv[m] = __shfl(acc[ai][0][m][n][j], lnext);
                                                  rg[m] = __shfl(acc[ai][1][m][n][j], lprev); lg[m] = __shfl(acc[ai][1][m][n][j], lnext); }
#pragma unroll
                    for (int m = 0; m < 4; ++m) {
                        const float pv = fr == 0 ? rv[m == 0 ? 0 : m - 1] : rv[m], nv = fr == 15 ? lv[m == 3 ? 3 : m + 1] : lv[m];
                        const float pg = fr == 0 ? rg[m == 0 ? 0 : m - 1] : rg[m], ng = fr == 15 ? lg[m == 3 ? 3 : m + 1] : lg[m];
                        const float val = wv0[jj] * pv + wv1[jj] * acc[ai][0][m][n][j] + wv2[jj] * nv + bv[jj];
                        const float gat = wg0[jj] * pg + wg1[jj] * acc[ai][1][m][n][j] + wg2[jj] * ng + bg[jj];
                        o[m][jj] = val * gat * __builtin_amdgcn_rcpf(1.0f + __builtin_amdgcn_exp2f(gat * -1.4426950408889634f)); } }
#pragma unroll
                for (int m = 0; m < 4; ++m) { const int R64 = 16 * m + fr; const int rowo = 62 * J - 1 + R64;
                    if (R64 >= 1 && R64 <= 62 && rowo < M) *(unsigned*)(act + (size_t)rowo * DFF + cv) = cvt_pk_bf16(o[m][0], o[m][1]); }
                asm volatile("" ::: "memory"); } }
        (void)lane;
    }
};
template <class Epi, class Sched, bool ALIGN_EPI = false, bool SP2 = false, bool SHIFT = false>
__device__ __forceinline__ void gemm_phase(PG8_LAS unsigned char* lds, const Gemm g, const Sched& S, const Epi& E) {
    const int tid = threadIdx.x, wid = __builtin_amdgcn_readfirstlane(tid >> 6), lane = tid & 63, wr = wid >> 2, wc = wid & 3, fr = lane & 15, fq = lane >> 4;
    const int K = g.K, nt = K / BK;
    unsigned voffA[2], voffB[2];
#pragma unroll
    for (int i = 0; i < 2; ++i) { int R, C; stage_rc(tid * 16 + i * 8192, R, C); const int Rb = Epi::PERM ? ((R & ~31) + perm32(R & 31)) : R;
        const int Ra = SHIFT ? (R - 2 * (R >> 6)) : R; voffA[i] = (unsigned)(Ra * g.lda + C) * 2u; voffB[i] = (unsigned)(Rb * g.ldb + C) * 2u; }
    const size_t kstep = (size_t)(BK * 2);
    const size_t hstepA = (size_t)(SHIFT ? 124 : HALF) * g.lda * 2, hstepB = (size_t)HALF * g.ldb * 2;
    const size_t tstepA = 2 * hstepA, tstepB = 2 * hstepB;
    const unsigned ldsw = (unsigned)wid * 1024u;
    const int aoff = lds_byte(wr * 64 + fr, fq * 8), boff = lds_byte(wc * 32 + fr, fq * 8);
#define PG8_SA(b, h) (((b) * 2 + (h)) * HTB)
#define PG8_SB(b, h) ((4 + (b) * 2 + (h)) * HTB)
#define PG8_STAGE(bufoff, gbase, voff) do { _Pragma("unroll") for (int _i = 0; _i < 2; ++_i) \
        __builtin_amdgcn_global_load_lds((const unsigned*)((const char*)(gbase) + (voff)[_i]), (PG8_LAS unsigned*)(lds + (bufoff) + ldsw + _i * 8192), 16, 0, 0); } while (0)
#define PG8_LDA(dst, b, h) do { _Pragma("unroll") for (int m = 0; m < 4; ++m) _Pragma("unroll") for (int k = 0; k < 2; ++k) dst[m][k] = *(const PG8_LAS bf16x8*)(lds + PG8_SA(b, h) + aoff + m * 2048 + k * 1024); } while (0)
#define PG8_LDB(dst, b, h) do { _Pragma("unroll") for (int n = 0; n < 2; ++n) _Pragma("unroll") for (int k = 0; k < 2; ++k) dst[n][k] = *(const PG8_LAS bf16x8*)(lds + PG8_SB(b, h) + boff + n * 2048 + k * 1024); } while (0)
#define PG8_MMA(ai, bj, At, Bt) do { __builtin_amdgcn_s_setprio(1); _Pragma("unroll") for (int m = 0; m < 4; ++m) _Pragma("unroll") for (int n = 0; n < 2; ++n) _Pragma("unroll") for (int k = 0; k < 2; ++k) \
        acc[ai][bj][m][n] = __builtin_amdgcn_mfma_f32_16x16x32_bf16(Bt[n][k], At[m][k], acc[ai][bj][m][n], 0, 0, 0); __builtin_amdgcn_s_setprio(0); } while (0)
#define PG8_WAIT_V(n) asm volatile("s_waitcnt vmcnt(" #n ")" ::: "memory")
#define PG8_WAIT_L(n) asm volatile("s_waitcnt lgkmcnt(" #n ")" ::: "memory")
#define PG8_BAR __builtin_amdgcn_s_barrier()
#define PG8_SCHED __builtin_amdgcn_sched_barrier(0)
    Unit cur, nxt; int ui = 0;
    if (!S.next(0, cur)) return;
    f32x4 acc[2][2][4][2];
#pragma unroll
    for (int a = 0; a < 2; ++a)
#pragma unroll
        for (int b = 0; b < 2; ++b)
#pragma unroll
            for (int m = 0; m < 4; ++m)
#pragma unroll
                for (int n = 0; n < 2; ++n) acc[a][b][m][n] = (f32x4){0.f, 0.f, 0.f, 0.f};
    bf16x8 At[4][2], B0[2][2], B1[2][2];
    const char* cA = (const char*)g.A + (size_t)cur.pm * tstepA; const char* cB = (const char*)g.Bt + (size_t)cur.pn * tstepB;
    S.a_ready(cur);
    if constexpr (SP2) {
        PG8_STAGE(PG8_SB(0, 0), cB, voffB); PG8_STAGE(PG8_SB(0, 1), cB + hstepB, voffB); PG8_STAGE(PG8_SA(0, 0), cA, voffA); PG8_STAGE(PG8_SA(0, 1), cA + hstepA, voffA);
        if (wr == 1) PG8_BAR;
        PG8_WAIT_V(2); PG8_BAR;
        PG8_STAGE(PG8_SB(1, 0), cB + kstep, voffB); PG8_STAGE(PG8_SA(1, 0), cA + kstep, voffA); PG8_STAGE(PG8_SB(1, 1), cB + hstepB + kstep, voffB);
        PG8_WAIT_V(6); PG8_BAR;
    } else {
        PG8_STAGE(PG8_SB(0, 0), cB, voffB); PG8_STAGE(PG8_SA(0, 0), cA, voffA); PG8_STAGE(PG8_SB(0, 1), cB + hstepB, voffB); PG8_STAGE(PG8_SA(0, 1), cA + hstepA, voffA);
        if (wr == 1) PG8_BAR;
        PG8_WAIT_V(4); PG8_BAR;
        PG8_STAGE(PG8_SB(1, 0), cB + kstep, voffB); PG8_STAGE(PG8_SA(1, 0), cA + kstep, voffA); PG8_STAGE(PG8_SB(1, 1), cB + hstepB + kstep, voffB);
        PG8_WAIT_V(6); PG8_BAR;
    }
    for (;;) {
        const bool has_next = S.next(ui + 1, nxt);
        const char* nA = has_next ? (const char*)g.A + (size_t)nxt.pm * tstepA : cA; const char* nB = has_next ? (const char*)g.Bt + (size_t)nxt.pn * tstepB : cB;
        for (int t = 0; t < nt; t += 2) {
            const bool last = (t == nt - 2);
            const char* a1 = cA + (size_t)(t + 1) * kstep;
            const char* a2 = last ? nA : cA + (size_t)(t + 2) * kstep; const char* b2 = last ? nB : cB + (size_t)(t + 2) * kstep;
            const char* a3 = a2 + kstep; const char* b3 = b2 + kstep;
            if (last && has_next) S.a_ready(nxt);
            if constexpr (SP2) {
            PG8_LDB(B0, 0, 0); PG8_LDB(B1, 0, 1); PG8_SCHED; PG8_LDA(At, 0, 0); PG8_STAGE(PG8_SA(1, 1), a1 + hstepA, voffA);
            PG8_WAIT_V(8); PG8_WAIT_L(0); PG8_BAR; PG8_MMA(0, 0, At, B0); PG8_MMA(0, 1, At, B1); PG8_BAR; PG8_SCHED;
            PG8_LDA(At, 0, 1); PG8_STAGE(PG8_SB(0, 0), b2, voffB); PG8_STAGE(PG8_SB(0, 1), b2 + hstepB, voffB); PG8_STAGE(PG8_SA(0, 0), a2, voffA);
            PG8_WAIT_V(8); PG8_WAIT_L(0); PG8_BAR; PG8_MMA(1, 0, At, B0); PG8_MMA(1, 1, At, B1); PG8_BAR; PG8_SCHED;
            PG8_LDB(B0, 1, 0); PG8_LDB(B1, 1, 1); PG8_SCHED; PG8_LDA(At, 1, 0); PG8_STAGE(PG8_SA(0, 1), a2 + hstepA, voffA);
            PG8_WAIT_V(8); PG8_WAIT_L(0); PG8_BAR; PG8_MMA(0, 0, At, B0); PG8_MMA(0, 1, At, B1); PG8_BAR; PG8_SCHED;
            PG8_LDA(At, 1, 1); PG8_STAGE(PG8_SB(1, 0), b3, voffB); PG8_STAGE(PG8_SB(1, 1), b3 + hstepB, voffB); PG8_STAGE(PG8_SA(1, 0), a3, voffA);
            PG8_WAIT_V(8); PG8_WAIT_L(0); PG8_BAR; PG8_MMA(1, 0, At, B0); PG8_MMA(1, 1, At, B1); PG8_BAR; PG8_SCHED;
            } else {
            PG8_LDB(B0, 0, 0); PG8_SCHED; PG8_LDA(At, 0, 0); PG8_STAGE(PG8_SA(1, 1), a1 + hstepA, voffA);
            PG8_WAIT_L(8); PG8_BAR; PG8_WAIT_L(0); PG8_MMA(0, 0, At, B0); PG8_BAR; PG8_SCHED;
            PG8_LDB(B1, 0, 1); PG8_STAGE(PG8_SB(0, 0), b2, voffB);
            PG8_BAR; PG8_WAIT_L(0); PG8_MMA(0, 1, At, B1); PG8_BAR;
            PG8_LDA(At, 0, 1); PG8_STAGE(PG8_SA(0, 0), a2, voffA);
            PG8_BAR; PG8_WAIT_L(0); PG8_MMA(1, 0, At, B0); PG8_BAR; PG8_SCHED;
            PG8_STAGE(PG8_SB(0, 1), b2 + hstepB, voffB);
            PG8_WAIT_V(6); PG8_BAR; PG8_MMA(1, 1, At, B1); PG8_BAR;
            PG8_LDB(B0, 1, 0); PG8_SCHED; PG8_LDA(At, 1, 0); PG8_STAGE(PG8_SA(0, 1), a2 + hstepA, voffA);
            PG8_WAIT_L(8); PG8_BAR; PG8_WAIT_L(0); PG8_MMA(0, 0, At, B0); PG8_BAR; PG8_SCHED;
            PG8_LDB(B1, 1, 1); PG8_STAGE(PG8_SB(1, 0), b3, voffB);
            PG8_BAR; PG8_WAIT_L(0); PG8_MMA(0, 1, At, B1); PG8_BAR;
            PG8_LDA(At, 1, 1); PG8_STAGE(PG8_SA(1, 0), a3, voffA);
            PG8_BAR; PG8_WAIT_L(0); PG8_MMA(1, 0, At, B0); PG8_BAR; PG8_SCHED;
            PG8_STAGE(PG8_SB(1, 1), b3 + hstepB, voffB);
            PG8_WAIT_V(6); PG8_BAR; PG8_MMA(1, 1, At, B1); PG8_BAR;
            }
        }
        if constexpr (ALIGN_EPI) { if (wr == 0) PG8_BAR; }
        if constexpr (!Epi::AFTER_DRAIN) { E(acc, cur, wr, wc, fr, fq); S.done(cur); }
        if (!has_next) break;
#pragma unroll
        for (int a = 0; a < 2; ++a)
#pragma unroll
            for (int b = 0; b < 2; ++b)
#pragma unroll
                for (int m = 0; m < 4; ++m)
#pragma unroll
                    for (int n = 0; n < 2; ++n) acc[a][b][m][n] = (f32x4){0.f, 0.f, 0.f, 0.f};
        cur = nxt; cA = nA; cB = nB; ++ui;
        if constexpr (ALIGN_EPI) { if (wr == 1) PG8_BAR; }
    }
    PG8_WAIT_V(0);
    if constexpr (!ALIGN_EPI) { if (wr == 0) PG8_BAR; }
    PG8_BAR;
    if constexpr (Epi::AFTER_DRAIN) { E.fused(acc, cur, wr, wc, fr, fq, lds, wid, lane); S.done(cur); }
#undef PG8_SA
#undef PG8_SB
#undef PG8_STAGE
#undef PG8_LDA
#undef PG8_LDB
#undef PG8_MMA
#undef PG8_WAIT_V
#undef PG8_WAIT_L
#undef PG8_BAR
#undef PG8_SCHED
}
}
#define GAS __attribute__((address_space(1)))
#define LAS __attribute__((address_space(3)))
typedef unsigned short bf16;
typedef unsigned v4u __attribute__((ext_vector_type(4)));
typedef unsigned v2u __attribute__((ext_vector_type(2)));
typedef float f32x4 __attribute__((ext_vector_type(4)));
typedef float f32x2 __attribute__((ext_vector_type(2)));
typedef GAS unsigned gu32;
using pg8::cvt_pk_bf16; using pg8::bf_lo; using pg8::bf_hi;

constexpr size_t MiB = 1u << 20;
constexpr size_t WS_CTL = 0, CTL_ZERO_BYTES = 64 * 1024;
constexpr size_t WS_ROPE = 1 * MiB;
constexpr size_t WS_LB = WS_ROPE + 640 * 1024;
constexpr size_t WS_W = 2 * MiB;
constexpr size_t W_IN = WS_W, W_UQ = W_IN + 1280ull * 1024 * 2, W_UKV = W_UQ + 1536ull * 768 * 2, W_O = W_UKV + 2048ull * 256 * 2, W_HIN = W_O + 1024ull * 1024 * 2,
                 W_HO = W_HIN + 5120ull * 1024 * 2, W_UP0 = W_HO + 1024ull * 1024 * 2, W_UP1 = W_UP0 + 5632ull * 1024 * 2, W_DN0 = W_UP1 + 5632ull * 1024 * 2, W_DN1 = W_DN0 + 1024ull * 2816 * 2,
                 W_END = W_DN1 + 1024ull * 2816 * 2;
static_assert(W_END <= 55 * MiB, "weights");
constexpr int SLACK = 256;
constexpr size_t ROWB = 2048;
constexpr size_t WS_B0 = 55 * MiB, B0_BYTES = (size_t)(M + 2 * SLACK) * ROWB;
static_assert(B0_BYTES <= 164 * MiB, "B0");
constexpr size_t WS_R = 219 * MiB;
constexpr size_t R_CQKV = WS_R;
constexpr size_t R_Q = R_CQKV + 164 * MiB;
constexpr size_t R_KV = R_Q + 245 * MiB;
constexpr size_t R_KROPE = R_KV + 326 * MiB;
constexpr size_t R_SSQ = R_KROPE + 6 * MiB;
constexpr size_t R_X_L0 = R_Q;
constexpr size_t R_ACT = WS_R;
constexpr size_t R_X_FFN = WS_R + 448 * MiB;
constexpr size_t R_HV = WS_R, R_HKF = WS_R + 163 * MiB, R_HKB = WS_R + 326 * MiB, R_HSG = WS_R + 489 * MiB;
constexpr size_t R_X_HG = WS_R;
constexpr size_t WS_END = 1024 * MiB;
static_assert(R_SSQ + (size_t)M * 16 * 4 <= WS_END && R_X_FFN + (size_t)M * 4096 <= WS_END && R_HSG + (size_t)M * ROWB <= WS_END, "d_ws map");
static_assert((size_t)M * 1536 * 2 + 64 * 3072 <= 245 * MiB && (size_t)M * 4096 + 64 * 4096 <= 326 * MiB && (size_t)M * DFF * 2 <= 448 * MiB && (size_t)M * ROWB <= 163 * MiB, "d_ws map 2");

constexpr int RING_OFF = 0, RING_BYTES = 131072;
constexpr int LDSCTL_OFF = RING_BYTES, MISC_OFF = LDSCTL_OFF + 320;
constexpr int LDS_BYTES = 147456;
constexpr int NWAVES = 8;

#define RLX_AGENT __ATOMIC_RELAXED, __HIP_MEMORY_SCOPE_AGENT
#define XB_TMO      128
#define XB_XCNT(j)  (256  + 64 * (j))
#define XB_XSUB(j)  (1280 + 64 * (j))
#define XB_XGEN(j)  (2304 + 64 * (j))
#define XB_TOP      3328
#define XB_TOPGEN   3392
#define XCD_BAR_WORDS 3456
#define XB_SPIN_CAP (1u << 18)

__device__ __forceinline__ unsigned xb_ld(unsigned* p)              { return __hip_atomic_load(p, __ATOMIC_RELAXED, __HIP_MEMORY_SCOPE_AGENT); }
__device__ __forceinline__ unsigned xb_add(unsigned* p, unsigned v) { return __hip_atomic_fetch_add(p, v, __ATOMIC_RELAXED, __HIP_MEMORY_SCOPE_AGENT); }
__device__ __forceinline__ unsigned xb_xcc_id() { return (unsigned)__builtin_amdgcn_s_getreg((3 << 11) | 20) & 0xFu; }
#define XB_SPIN(cond, bar) do { unsigned _sp = 0; while (cond) { __builtin_amdgcn_s_sleep(1); \
    if ((++_sp & 255u) == 0u) { if (xb_ld(&(bar)[XB_TMO])) break; if (_sp > XB_SPIN_CAP) { atomicAdd(&(bar)[XB_TMO], 1u); break; } } } } while (0)

struct XcdBarrier {
    unsigned* bar; unsigned x;
    volatile LAS unsigned* st;
};

__device__ __forceinline__ XcdBarrier xcd_barrier_post(unsigned* bar, volatile LAS unsigned* st) {
    XcdBarrier b; b.bar = bar; b.x = xb_xcc_id(); b.st = st;
    if (threadIdx.x == 0) (void)xb_add(&bar[XB_XCNT(b.x)], 1u);
    return b;
}
__device__ __forceinline__ void xcd_barrier_complete(unsigned* bar, unsigned x, unsigned& nloc, unsigned& nx) {
    const unsigned G = gridDim.x * gridDim.y * gridDim.z;
    unsigned sum, cnt, mine, sp = 0u;
    for (;;) {
        sum = 0u; cnt = 0u; mine = 0u;
#pragma unroll
        for (unsigned j = 0; j < 16; ++j) { const unsigned c = xb_ld(&bar[XB_XCNT(j)]); sum += c; cnt += (c > 0u) ? 1u : 0u; mine = (j == x) ? c : mine; }
        if (sum == G) break;
        __builtin_amdgcn_s_sleep(1);
        if ((++sp & 255u) == 0u) { if (xb_ld(&bar[XB_TMO])) break; if (sp > XB_SPIN_CAP) { atomicAdd(&bar[XB_TMO], 1u); break; } }
    }
    nloc = mine > 0u ? mine : 1u; nx = cnt > 0u ? cnt : 1u;
}

__device__ __forceinline__ void xcd_barrier(const XcdBarrier& b) {
    asm volatile("s_waitcnt vmcnt(0)" ::: "memory");
    __syncthreads();
    if (threadIdx.x == 0) {
        unsigned* bar = b.bar;
        __builtin_amdgcn_s_waitcnt(0);
        unsigned nloc = b.st[0], nx = b.st[1];
        if (nloc == 0u) { xcd_barrier_complete(bar, b.x, nloc, nx); b.st[0] = nloc; b.st[1] = nx; }
        const unsigned old = xb_add(&bar[XB_XSUB(b.x)], 1u);
        const unsigned gen = old / nloc;
        if (old + 1u == (gen + 1u) * nloc) {
            __builtin_amdgcn_fence(__ATOMIC_RELEASE, "agent");
            asm volatile("s_waitcnt vmcnt(0)" ::: "memory");
            const unsigned og = xb_add(&bar[XB_TOP], 1u);
            const unsigned tg = og / nx;
            if (og + 1u == (tg + 1u) * nx) xb_add(&bar[XB_TOPGEN], 1u);
            else XB_SPIN(xb_ld(&bar[XB_TOPGEN]) == tg, bar);
            __builtin_amdgcn_fence(__ATOMIC_ACQUIRE, "agent");
            xb_add(&bar[XB_XGEN(b.x)], 1u);
            asm volatile("s_waitcnt vmcnt(0)" ::: "memory");
        } else {
            XB_SPIN(xb_ld(&bar[XB_XGEN(b.x)]) == gen, bar);
            __builtin_amdgcn_fence(__ATOMIC_ACQUIRE, "agent");
            asm volatile("s_waitcnt vmcnt(0)" ::: "memory");
        }
    }
    __syncthreads();
}

struct Frame {
    LAS unsigned char* lds;
    volatile LAS unsigned* MISC;
    int tid, lane, wave;
    int vcu, G;
};
__device__ __forceinline__ float wave_sum(float v) {
#pragma unroll
    for (int o = 1; o < 64; o <<= 1) v += __shfl_xor(v, o);
    return v;
}
__device__ __forceinline__ unsigned f2bf(float f) { unsigned u = __builtin_bit_cast(unsigned, f); return (u + 0x7fffu + ((u >> 16) & 1u)) >> 16; }
__device__ __forceinline__ unsigned pk2(float lo, float hi) { return f2bf(lo) | (f2bf(hi) << 16); }

__device__ __forceinline__ int src_col(int kind, int n) {
    if (kind == 1) { if (n < 1024) return n; if (n >= 1056) return -1; const int e = n - 1024; return 1024 + ((e & 1) ? 16 + (e >> 1) : (e >> 1)); }
    if (kind == 2) { const int hd = n / 96, d = n % 96; if (d < 64) return n; const int e = d - 64; return hd * 96 + 64 + ((e & 1) ? 16 + (e >> 1) : (e >> 1)); }
    if (kind == 3) { const int pn = n >> 8, r = n & 255; return r < 128 ? 128 * pn + r : DFF + 128 * pn + (r - 128); }
    return n;
}
__device__ __forceinline__ void p0_transpose_item(const float* W, int K, int N, bf16* WT, int kind, const float* gain, LAS float* scr, int item, int lane, int NP) {
    const int nblk = NP / 32, kb = item / nblk, nb = item % nblk, k0 = 64 * kb, n0 = 32 * nb;
    const int sc = src_col(kind, n0 + (lane & 31));
#pragma unroll 8
    for (int i = 0; i < 32; ++i) { const int kk = 2 * i + (lane >> 5); float v = sc >= 0 ? W[(size_t)(k0 + kk) * N + sc] : 0.f; if (gain) v *= gain[k0 + kk]; scr[kk * 33 + (lane & 31)] = v; }
    asm volatile("s_waitcnt lgkmcnt(0)" ::: "memory");
    const int c = lane & 7;
#pragma unroll
    for (int j = 0; j < 4; ++j) { const int n = (lane >> 3) + 8 * j; const LAS float* s = scr + (8 * c) * 33 + n;
        v4u o; o.x = pk2(s[0 * 33], s[1 * 33]); o.y = pk2(s[2 * 33], s[3 * 33]); o.z = pk2(s[4 * 33], s[5 * 33]); o.w = pk2(s[6 * 33], s[7 * 33]);
        *(GAS v4u*)(WT + (size_t)(n0 + n) * K + k0 + 8 * c) = o; }
    asm volatile("s_waitcnt lgkmcnt(0)" ::: "memory");
}
struct WJob { const float* W; bf16* WT; const float* gain; int K, N, NP, kind; };
__device__ __forceinline__ void p0_prologue(Frame& F, const float* const* in, unsigned char* ws, bf16* h0) {
    LAS float* scr = (LAS float*)(F.lds + RING_OFF + F.wave * 16384);
    const int gw = F.vcu * NWAVES + F.wave, NGW = F.G * NWAVES;
#define WJOB(SRC, DST, GAIN, K_, N_, NP_, KIND) { const int nitems = ((K_) / 64) * ((NP_) / 32); for (int it = gw; it < nitems; it += NGW) p0_transpose_item(SRC, K_, N_, (bf16*)(ws + (DST)), KIND, GAIN, scr, it, F.lane, NP_); }
    WJOB(in[3], W_IN, nullptr, 1024, 1056, 1280, 1)
    WJOB(in[6], W_UQ, in[4], 768, 1536, 1536, 2)
    WJOB(in[7], W_UKV, in[5], 256, 2048, 2048, 0)
    WJOB(in[8], W_O, nullptr, 1024, 1024, 1024, 0)
    WJOB(in[9], W_HIN, nullptr, 1024, 5120, 5120, 0)
    WJOB(in[12], W_HO, nullptr, 1024, 1024, 1024, 0)
    WJOB(in[13], W_UP0, nullptr, 1024, NUP, NUP, 3)
    WJOB(in[13] + (size_t)1024 * NUP, W_UP1, nullptr, 1024, NUP, NUP, 3)
    WJOB(in[16], W_DN0, nullptr, DFF, 1024, 1024, 0)
    WJOB(in[16] + (size_t)DFF * 1024, W_DN1, nullptr, DFF, 1024, 1024, 0)
#undef WJOB
    for (int row = gw; row < M; row += NGW) {
        const int b = row / LP, s = row % LP;
        GAS unsigned long long* o8 = (GAS unsigned long long*)(h0 + (size_t)row * 1024) + F.lane;
        if (s < PADR) {
#pragma unroll
            for (int j = 0; j < 4; ++j) o8[64 * j] = 0ull;
        } else {
            const float* src = s < PADR + 16 ? in[2] + (size_t)(s - PADR) * 1024 : (b < 16 ? in[0] + ((size_t)b * SEQ + (s - 64)) * 1024 : in[1] + ((size_t)(b - 16) * SEQ + (s - 64)) * 1024);
            const GAS f32x4* xr = (const GAS f32x4*)src + F.lane;
#pragma unroll
            for (int j = 0; j < 4; ++j) { const f32x4 v = xr[64 * j]; o8[64 * j] = (unsigned long long)pk2(v.x, v.y) | ((unsigned long long)pk2(v.z, v.w) << 32); }
        }
    }
    { const int gt = gw * 64 + F.lane, NGT = NGW * 64; GAS v4u* z0 = (GAS v4u*)(ws + WS_B0); GAS v4u* z1 = (GAS v4u*)(ws + WS_B0 + (size_t)(SLACK + M) * ROWB);
      const int n16 = SLACK * (int)ROWB / 16;
      for (int i = gt; i < n16; i += NGT) { z0[i] = (v4u){0u, 0u, 0u, 0u}; z1[i] = (v4u){0u, 0u, 0u, 0u}; } }
    { const int gt = gw * 64 + F.lane, NGT = NGW * 64; f32x2* tab = (f32x2*)(ws + WS_ROPE);
      for (int i = gt; i < LTOK * 16; i += NGT) { const int pos = i >> 4, k = i & 15;
          const float inv = 1.0f / powf(10000.0f, (float)(2 * k) / 32.0f); const float ang = (float)pos * inv;
          f32x2 cs; cs.x = (float)cos((double)ang); cs.y = (float)sin((double)ang); tab[i] = cs; } }
    { const int gt = gw * 64 + F.lane; float* lb = (float*)(ws + WS_LB);
      if (gt < 2048) { const int d = gt >> 10, k = gt & 1023; const float x0 = in[10][(size_t)(d * 2 + 0) * 1024 + k], x1 = in[10][(size_t)(d * 2 + 1) * 1024 + k];
          lb[gt] = 1.0f / (1.0f + expf(x0 - x1)); } }
}

template <bool FINAL> __device__ __forceinline__ void ln_pass(Frame& F, const float* X, const float* gain, const float* bias, bf16* hout, float* out) {
    const int gw = F.vcu * NWAVES + F.wave, NGW = F.G * NWAVES;
    f32x4 g[4], bb[4];
#pragma unroll
    for (int j = 0; j < 4; ++j) { g[j] = ((const f32x4*)gain)[64 * j + F.lane]; bb[j] = ((const f32x4*)bias)[64 * j + F.lane]; }
    for (int row = gw; row < M; row += NGW) {
        const int b = row / LP, s = row % LP;
        if (FINAL) { if (s < 64) continue; }
        else if (s < PADR) { GAS unsigned long long* o8 = (GAS unsigned long long*)(hout + (size_t)row * 1024) + F.lane;
#pragma unroll
            for (int j = 0; j < 4; ++j) o8[64 * j] = 0ull;
            continue; }
        const GAS f32x4* xr = (const GAS f32x4*)(X + (size_t)row * 1024) + F.lane;
        f32x4 v[4]; float sm = 0.f;
#pragma unroll
        for (int j = 0; j < 4; ++j) { v[j] = xr[64 * j]; sm += (v[j].x + v[j].y) + (v[j].z + v[j].w); }
        const float mean = wave_sum(sm) * (1.f / 1024.f); float s2 = 0.f;
#pragma unroll
        for (int j = 0; j < 4; ++j) { v[j] = v[j] - mean; s2 += (v[j].x * v[j].x + v[j].y * v[j].y) + (v[j].z * v[j].z + v[j].w * v[j].w); }
        const float rstd = 1.f / sqrtf(wave_sum(s2) * (1.f / 1024.f) + EPS);
        if (FINAL) { GAS f32x4* o = (GAS f32x4*)(out + ((size_t)b * SEQ + (s - 64)) * 1024) + F.lane;
#pragma unroll
            for (int j = 0; j < 4; ++j) o[64 * j] = v[j] * rstd * g[j] + bb[j];
        } else { GAS unsigned long long* o8 = (GAS unsigned long long*)(hout + (size_t)row * 1024) + F.lane;
#pragma unroll
            for (int j = 0; j < 4; ++j) { const f32x4 y = v[j] * rstd * g[j] + bb[j]; o8[64 * j] = (unsigned long long)cvt_pk_bf16(y.x, y.y) | ((unsigned long long)cvt_pk_bf16(y.z, y.w) << 32); } }
    }
}
__device__ __forceinline__ void attn_simple(Frame& F, const bf16* Q, const bf16* KV, const bf16* KR, bf16* O) {
    LAS float* Ks = (LAS float*)(F.lds);
    LAS float* Vs = (LAS float*)(F.lds + 64 * 96 * 4);
    constexpr int NQC = 17;
    const int hf = F.tid & 1;
    for (int u = F.vcu; u < NB * 16 * NQC; u += F.G) {
        const int bh = u / NQC, qc = u % NQC, b = bh >> 4, h = bh & 15;
        const int sq = qc * 256 + (F.tid >> 1); const bool vq = sq < LP; const size_t rowq = (size_t)b * LP + (vq ? sq : LP - 1);
        float q[48];
#pragma unroll
        for (int c = 0; c < 6; ++c) { const v4u w = *(const GAS v4u*)(Q + rowq * 1536 + h * 96 + hf * 48 + c * 8);
            q[c * 8 + 0] = bf_lo(w.x); q[c * 8 + 1] = bf_hi(w.x); q[c * 8 + 2] = bf_lo(w.y); q[c * 8 + 3] = bf_hi(w.y);
            q[c * 8 + 4] = bf_lo(w.z); q[c * 8 + 5] = bf_hi(w.z); q[c * 8 + 6] = bf_lo(w.w); q[c * 8 + 7] = bf_hi(w.w); }
        float o[32];
#pragma unroll
        for (int d = 0; d < 32; ++d) o[d] = 0.f;
        float mx = -1e30f, l = 0.f;
        for (int kt = 0; kt < 65; ++kt) {
            __syncthreads();
            for (int idx = F.tid; idx < 64 * 12; idx += 512) { const int j = idx / 12, c = idx % 12; int sk = PADR + kt * 64 + j; sk = sk < LP ? sk : LP - 1; const size_t rk = (size_t)b * LP + sk;
                const v4u w = c < 8 ? *(const GAS v4u*)(KV + rk * 2048 + h * 128 + c * 8) : *(const GAS v4u*)(KR + rk * 32 + (c - 8) * 8);
                LAS float* d = Ks + j * 96 + c * 8; d[0] = bf_lo(w.x); d[1] = bf_hi(w.x); d[2] = bf_lo(w.y); d[3] = bf_hi(w.y); d[4] = bf_lo(w.z); d[5] = bf_hi(w.z); d[6] = bf_lo(w.w); d[7] = bf_hi(w.w); }
            { const int j = F.tid >> 3, c = F.tid & 7; int sk = PADR + kt * 64 + j; sk = sk < LP ? sk : LP - 1; const size_t rk = (size_t)b * LP + sk;
                const v4u w = *(const GAS v4u*)(KV + rk * 2048 + h * 128 + 64 + c * 8);
                LAS float* d = Vs + j * 64 + c * 8; d[0] = bf_lo(w.x); d[1] = bf_hi(w.x); d[2] = bf_lo(w.y); d[3] = bf_hi(w.y); d[4] = bf_lo(w.z); d[5] = bf_hi(w.z); d[6] = bf_lo(w.w); d[7] = bf_hi(w.w); }
            __syncthreads();
            const int nk = (LTOK - kt * 64) < 64 ? (LTOK - kt * 64) : 64;
#pragma unroll 1
            for (int jj = 0; jj < nk; ++jj) {
                const LAS f32x4* kr = (const LAS f32x4*)(Ks + jj * 96 + hf * 48); float a0 = 0.f, a1 = 0.f;
#pragma unroll
                for (int c = 0; c < 12; c += 2) { const f32x4 k0 = kr[c], k1 = kr[c + 1];
                    a0 += q[4 * c] * k0.x + q[4 * c + 1] * k0.y + q[4 * c + 2] * k0.z + q[4 * c + 3] * k0.w;
                    a1 += q[4 * c + 4] * k1.x + q[4 * c + 5] * k1.y + q[4 * c + 6] * k1.z + q[4 * c + 7] * k1.w; }
                float sc = a0 + a1; sc += __shfl_xor(sc, 1); sc *= SM_C;
                const float mn = fmaxf(mx, sc);
                const float al = __builtin_amdgcn_exp2f(mx - mn), p = __builtin_amdgcn_exp2f(sc - mn); mx = mn; l = l * al + p;
                const LAS f32x4* vr = (const LAS f32x4*)(Vs + jj * 64 + hf * 32);
#pragma unroll
                for (int c = 0; c < 8; ++c) { const f32x4 vv = vr[c]; o[4 * c] = fmaf(p, vv.x, o[4 * c] * al); o[4 * c + 1] = fmaf(p, vv.y, o[4 * c + 1] * al); o[4 * c + 2] = fmaf(p, vv.z, o[4 * c + 2] * al); o[4 * c + 3] = fmaf(p, vv.w, o[4 * c + 3] * al); }
            }
        }
        if (vq) { const float il = 1.0f / l;
#pragma unroll
            for (int c = 0; c < 4; ++c) { v4u w; w.x = cvt_pk_bf16(o[8 * c] * il, o[8 * c + 1] * il); w.y = cvt_pk_bf16(o[8 * c + 2] * il, o[8 * c + 3] * il); w.z = cvt_pk_bf16(o[8 * c + 4] * il, o[8 * c + 5] * il); w.w = cvt_pk_bf16(o[8 * c + 6] * il, o[8 * c + 7] * il);
                *(GAS v4u*)(O + rowq * 1024 + h * 64 + hf * 32 + c * 8) = w; } }
    }
    __syncthreads();
}

__device__ __forceinline__ void gla_simple(Frame& F, bf16* Qb, const bf16* Vb, bf16* KFb, const bf16* KBb, const bf16* SGb, const float* onorm) {
    LAS float* tq = (LAS float*)(F.lds);
    LAS float* tk = (LAS float*)(F.lds + 16384);
    LAS float* tv = (LAS float*)(F.lds + 32768);
    LAS float* pr = (LAS float*)(F.lds + 49152);
    const int j = F.tid & 127, kq = F.tid >> 7;
    for (int it = F.vcu; it < NB * 8; it += F.G) {
        const int b = it >> 3, h = it & 7; const size_t cbase = (size_t)h * 128;
        for (int dir = 0; dir < 2; ++dir) {
            float S[32];
#pragma unroll
            for (int k = 0; k < 32; ++k) S[k] = 0.f;
            const bf16* Kg = dir == 0 ? KFb : KBb;
            for (int tile = 0; tile < (LTOK + 31) / 32; ++tile) {
                __syncthreads();
                { const int i = F.tid >> 4, c8 = (F.tid & 15) * 8; const int tt = tile * 32 + i; const bool vt = tt < LTOK; const int tok = dir == 0 ? tt : LTOK - 1 - tt;
                  const size_t off = ((size_t)b * LP + PADR + (vt ? tok : 0)) * 1024 + cbase + c8;
                  v4u wq = *(const GAS v4u*)(Qb + off), wk = *(const GAS v4u*)(Kg + off), wv = *(const GAS v4u*)(Vb + off);
                  if (!vt) { wq = (v4u){0u, 0u, 0u, 0u}; wk = wq; wv = wq; }
                  LAS float* dq = tq + i * 128 + c8; LAS float* dk = tk + i * 128 + c8; LAS float* dv = tv + i * 128 + c8;
                  dq[0] = bf_lo(wq.x); dq[1] = bf_hi(wq.x); dq[2] = bf_lo(wq.y); dq[3] = bf_hi(wq.y); dq[4] = bf_lo(wq.z); dq[5] = bf_hi(wq.z); dq[6] = bf_lo(wq.w); dq[7] = bf_hi(wq.w);
                  dk[0] = bf_lo(wk.x); dk[1] = bf_hi(wk.x); dk[2] = bf_lo(wk.y); dk[3] = bf_hi(wk.y); dk[4] = bf_lo(wk.z); dk[5] = bf_hi(wk.z); dk[6] = bf_lo(wk.w); dk[7] = bf_hi(wk.w);
                  dv[0] = bf_lo(wv.x); dv[1] = bf_hi(wv.x); dv[2] = bf_lo(wv.y); dv[3] = bf_hi(wv.y); dv[4] = bf_lo(wv.z); dv[5] = bf_hi(wv.z); dv[6] = bf_lo(wv.w); dv[7] = bf_hi(wv.w); }
                __syncthreads();
                for (int i = 0; i < 32; ++i) {
                    const float vj = tv[i * 128 + j]; float part = 0.f;
                    const LAS f32x4* kr = (const LAS f32x4*)(tk + i * 128 + kq * 32); const LAS f32x4* qr = (const LAS f32x4*)(tq + i * 128 + kq * 32);
#pragma unroll
                    for (int c = 0; c < 8; ++c) { const f32x4 kk = kr[c], qq = qr[c];
                        S[4 * c] = fmaf(kk.x, vj - S[4 * c], S[4 * c]); part = fmaf(S[4 * c], qq.x, part);
                        S[4 * c + 1] = fmaf(kk.y, vj - S[4 * c + 1], S[4 * c + 1]); part = fmaf(S[4 * c + 1], qq.y, part);
                        S[4 * c + 2] = fmaf(kk.z, vj - S[4 * c + 2], S[4 * c + 2]); part = fmaf(S[4 * c + 2], qq.z, part);
                        S[4 * c + 3] = fmaf(kk.w, vj - S[4 * c + 3], S[4 * c + 3]); part = fmaf(S[4 * c + 3], qq.w, part); }
                    pr[(i * 4 + kq) * 128 + j] = part;
                }
                __syncthreads();
#pragma unroll
                for (int ii = 0; ii < 4; ++ii) { const int i = F.wave * 4 + ii; const int tt = tile * 32 + i; const bool vt = tt < LTOK; const int tok = dir == 0 ? tt : LTOK - 1 - tt;
                    const int c = 2 * F.lane;
                    float o0 = pr[(i * 4 + 0) * 128 + c] + pr[(i * 4 + 1) * 128 + c] + pr[(i * 4 + 2) * 128 + c] + pr[(i * 4 + 3) * 128 + c];
                    float o1 = pr[(i * 4 + 0) * 128 + c + 1] + pr[(i * 4 + 1) * 128 + c + 1] + pr[(i * 4 + 2) * 128 + c + 1] + pr[(i * 4 + 3) * 128 + c + 1];
                    const size_t off = ((size_t)b * LP + PADR + (vt ? tok : 0)) * 1024 + cbase + c;
                    if (dir == 0) { if (vt) *(GAS unsigned*)(KFb + off) = cvt_pk_bf16(o0, o1); }
                    else { const unsigned wf = *(const GAS unsigned*)(KFb + off); o0 += bf_lo(wf); o1 += bf_hi(wf);
                        const float ss = wave_sum(o0 * o0 + o1 * o1); const float rstd = 1.0f / sqrtf(ss * (1.0f / 128.0f) + EPS);
                        const unsigned wg = *(const GAS unsigned*)(SGb + off); const f32x2 gn = *(const f32x2*)(onorm + cbase + c);
                        if (vt) *(GAS unsigned*)(Qb + off) = cvt_pk_bf16(o0 * rstd * gn.x * bf_lo(wg), o1 * rstd * gn.y * bf_hi(wg)); } }
            }
            __syncthreads();
        }
    }
    __syncthreads();
}
constexpr int NPHASE = 16;
#ifndef MK_ONE_LAUNCH
#define MK_ONE_LAUNCH 1
#endif
struct Args { const float* in[19]; float* out; unsigned char* ws; int ph_lo, ph_hi; };
__global__ void __launch_bounds__(NWAVES * 64, 2) fwd(Args args) {
    extern __shared__ __attribute__((aligned(16))) unsigned char lds[];
    Frame F;
    F.lds = (LAS unsigned char*)lds;
    F.MISC = (volatile LAS unsigned*)(F.lds + MISC_OFF);
    F.tid = threadIdx.x; F.lane = F.tid & 63; F.wave = __builtin_amdgcn_readfirstlane(F.tid >> 6);
    F.G = gridDim.x; { const int bx = blockIdx.x; F.vcu = (F.G % 8 == 0) ? (bx % 8) * (F.G / 8) + bx / 8 : bx; }
    unsigned char* ws = args.ws;
    for (int u = F.tid; u < (LDS_BYTES - LDSCTL_OFF) / 4; u += NWAVES * 64) ((LAS unsigned*)(F.lds + LDSCTL_OFF))[u] = 0u;
    __syncthreads();
    const int lo = args.ph_lo, hi = args.ph_hi;
    XcdBarrier bar; bar.bar = (unsigned*)(ws + WS_CTL); bar.x = 0; bar.st = nullptr;
    if (hi - lo > 1) bar = xcd_barrier_post((unsigned*)(ws + WS_CTL), F.MISC + 8);
#ifndef ONLY_PHASE
#define ONLY_PHASE -1
#endif
#define IN(k) (lo <= (k) && (k) < hi && (ONLY_PHASE < 0 || ONLY_PHASE == (k)))
#define SEAM(k) do { if (IN(k) && IN((k) + 1)) xcd_barrier(bar); } while (0)
    const float* const* in = args.in;
    bf16* hD = (bf16*)args.out;
    bf16* hB = (bf16*)(ws + WS_B0 + (size_t)SLACK * ROWB);
    const pg8::f32x2* rope = (const pg8::f32x2*)(ws + WS_ROPE);
    using pg8::Gemm; using pg8::StaticOrder;
    const int cid = (int)blockIdx.x;

    if (IN(0)) { p0_prologue(F, in, ws, hD); } SEAM(0);
    if (IN(1)) { Gemm g{hD, (const bf16*)(ws + W_IN), 1024, 1024, 1024}; StaticOrder S; S.init(MT, 5, F.G, cid);
        pg8::EpiProj E{(bf16*)(ws + R_CQKV), (float*)(ws + R_SSQ), (bf16*)(ws + R_KROPE), rope};
        pg8::gemm_phase<pg8::EpiProj, StaticOrder, true, true>(F.lds + RING_OFF, g, S, E); } SEAM(1);
    if (IN(2)) {
        { Gemm g{(const bf16*)(ws + R_CQKV), (const bf16*)(ws + W_UQ), 768, 1024, 768}; StaticOrder S; S.init(MT, 6, F.G, cid);
          pg8::EpiQ E{(bf16*)(ws + R_Q), (const float*)(ws + R_SSQ), rope};
          pg8::gemm_phase<pg8::EpiQ, StaticOrder, true, true>(F.lds + RING_OFF, g, S, E); }
        { Gemm g{(const bf16*)(ws + R_CQKV) + 768, (const bf16*)(ws + W_UKV), 256, 1024, 256}; StaticOrder S; S.init(MT, 8, F.G, cid);
          pg8::EpiKV E{(bf16*)(ws + R_KV), (const float*)(ws + R_SSQ)};
          pg8::gemm_phase<pg8::EpiKV, StaticOrder, true, true>(F.lds + RING_OFF, g, S, E); }
    } SEAM(2);
    if (IN(3)) { attn_simple(F, (const bf16*)(ws + R_Q), (const bf16*)(ws + R_KV), (const bf16*)(ws + R_KROPE), (bf16*)(ws + R_CQKV)); } SEAM(3);
    if (IN(4)) { Gemm g{(const bf16*)(ws + R_CQKV), (const bf16*)(ws + W_O), 1024, 1024, 1024}; StaticOrder S; S.init(MT, 4, F.G, cid);
        pg8::EpiResid E{hD, (float*)(ws + R_X_L0)};
        pg8::gemm_phase<pg8::EpiResid, StaticOrder, true, true>(F.lds + RING_OFF, g, S, E); } SEAM(4);
    if (IN(5)) { ln_pass<false>(F, (const float*)(ws + R_X_L0), in[17] + 0 * 1024, in[18] + 0 * 1024, hB, nullptr); } SEAM(5);
    if (IN(6)) { Gemm g{hB - 1024, (const bf16*)(ws + W_UP0), 1024, 1024, 1024}; StaticOrder S; S.init(MT_UP, 22, F.G, cid);
        pg8::EpiConvGate E{(bf16*)(ws + R_ACT), in[14], in[15]};
        pg8::gemm_phase<pg8::EpiConvGate, StaticOrder, true, true, true>(F.lds + RING_OFF, g, S, E); } SEAM(6);
    if (IN(7)) { Gemm g{(const bf16*)(ws + R_ACT), (const bf16*)(ws + W_DN0), DFF, DFF, DFF}; StaticOrder S; S.init(MT, 4, F.G, cid);
        pg8::EpiResid E{hB, (float*)(ws + R_X_FFN)};
        pg8::gemm_phase<pg8::EpiResid, StaticOrder, true, true>(F.lds + RING_OFF, g, S, E); } SEAM(7);
    if (IN(8)) { ln_pass<false>(F, (const float*)(ws + R_X_FFN), in[17] + 1 * 1024, in[18] + 1 * 1024, hD, nullptr); } SEAM(8);
    if (IN(9)) { Gemm g{hD, (const bf16*)(ws + W_HIN), 1024, 1024, 1024}; StaticOrder S; S.init(MT, 20, F.G, cid);
        pg8::EpiHgIn E{hB, (bf16*)(ws + R_HV), (bf16*)(ws + R_HKF), (bf16*)(ws + R_HKB), (bf16*)(ws + R_HSG), (const float*)(ws + WS_LB)};
        pg8::gemm_phase<pg8::EpiHgIn, StaticOrder, true, true>(F.lds + RING_OFF, g, S, E); } SEAM(9);
    if (IN(10)) { gla_simple(F, hB, (const bf16*)(ws + R_HV), (bf16*)(ws + R_HKF), (const bf16*)(ws + R_HKB), (const bf16*)(ws + R_HSG), in[11]); } SEAM(10);
    if (IN(11)) { Gemm g{hB, (const bf16*)(ws + W_HO), 1024, 1024, 1024}; StaticOrder S; S.init(MT, 4, F.G, cid);
        pg8::EpiResid E{hD, (float*)(ws + R_X_HG)};
        pg8::gemm_phase<pg8::EpiResid, StaticOrder, true, true>(F.lds + RING_OFF, g, S, E); } SEAM(11);
    if (IN(12)) { ln_pass<false>(F, (const float*)(ws + R_X_HG), in[17] + 2 * 1024, in[18] + 2 * 1024, hB, nullptr); } SEAM(12);
    if (IN(13)) { Gemm g{hB - 1024, (const bf16*)(ws + W_UP1), 1024, 1024, 1024}; StaticOrder S; S.init(MT_UP, 22, F.G, cid);
        pg8::EpiConvGate E{(bf16*)(ws + R_ACT), in[14] + 3 * NUP, in[15] + NUP};
        pg8::gemm_phase<pg8::EpiConvGate, StaticOrder, true, true, true>(F.lds + RING_OFF, g, S, E); } SEAM(13);
    if (IN(14)) { Gemm g{(const bf16*)(ws + R_ACT), (const bf16*)(ws + W_DN1), DFF, DFF, DFF}; StaticOrder S; S.init(MT, 4, F.G, cid);
        pg8::EpiResid E{hB, (float*)(ws + R_X_FFN)};
        pg8::gemm_phase<pg8::EpiResid, StaticOrder, true, true>(F.lds + RING_OFF, g, S, E); } SEAM(14);
    if (IN(15)) { ln_pass<true>(F, (const float*)(ws + R_X_FFN), in[17] + 3 * 1024, in[18] + 3 * 1024, nullptr, args.out); }
#undef IN
#undef SEAM
}

__global__ void nan_fill(float* o, long n) { const float q = __builtin_nanf(""); for (long i = blockIdx.x * 256L + threadIdx.x; i < n; i += gridDim.x * 256L) o[i] = q; }
extern "C" void kernel_launch(void* const* d_in, const int* in_sizes, int n_in, void* d_out, int out_size, void* d_ws, size_t ws_size, hipStream_t stream) {
    static int grid = 0;
    if (grid == 0) {
        bool ok = (n_in == 19) && in_sizes[0] == 16 * SEQ * 1024 && in_sizes[1] == 4 * SEQ * 1024 && out_size == NB * SEQ * 1024 && ws_size >= WS_END;
        int dev = 0, cus = 0;
        if (ok) ok = hipGetDevice(&dev) == hipSuccess && hipDeviceGetAttribute(&cus, hipDeviceAttributeMultiprocessorCount, dev) == hipSuccess;
        if (ok) ok = hipFuncSetAttribute((const void*)fwd, hipFuncAttributeMaxDynamicSharedMemorySize, LDS_BYTES) == hipSuccess;
        if (!ok) { fprintf(stderr, "kernel_launch: unexpected shapes / workspace (%zu) / device\n", ws_size); grid = -1; }
        else grid = cus;
        (void)hipGetLastError();
    }
    if (grid < 0) { hipLaunchKernelGGL(nan_fill, dim3(1024), dim3(256), 0, stream, (float*)d_out, (long)out_size); return; }
    (void)hipMemsetAsync((char*)d_ws + WS_CTL, 0, CTL_ZERO_BYTES, stream);
    Args a{};
    for (int i = 0; i < 19; ++i) a.in[i] = (const float*)d_in[i];
    a.out = (float*)d_out; a.ws = (unsigned char*)d_ws;
#if MK_ONE_LAUNCH
    a.ph_lo = 0; a.ph_hi = NPHASE;
    hipLaunchKernelGGL(fwd, dim3(grid), dim3(NWAVES * 64), LDS_BYTES, stream, a);
#else
    for (int p = 0; p < NPHASE; ++p) { a.ph_lo = p; a.ph_hi = p + 1; hipLaunchKernelGGL(fwd, dim3(grid), dim3(NWAVES * 64), LDS_BYTES, stream, a); }
#endif
}
```

```cpp
#include <hip/hip_runtime.h>
#include <cstdio>
constexpr int NB = 20;
constexpr int LP = 4160;
constexpr int PADR = 48, LTOK = 4112, SEQ = 4096, DM = 1024;
constexpr int M = NB * LP;
constexpr int MT = M / 256;
constexpr int DFF = 2816, NUP = 2 * DFF;
constexpr int NBLK62 = (M + 61) / 62;
constexpr int MT_UP = (NBLK62 + 3) / 4;
constexpr float EPS = 1e-6f, ALPHA = 1.4142135623730951f;
constexpr float SM_C = 0.10206207261596575f * 1.4426950408889634f;
#include <cstdint>
namespace pg8 {
#define PG8_LAS __attribute__((address_space(3)))
typedef unsigned short bf16_t;
typedef short bf16x8 __attribute__((ext_vector_type(8)));
typedef float f32x4 __attribute__((ext_vector_type(4)));
typedef unsigned u32x4 __attribute__((ext_vector_type(4)));
typedef unsigned u32x2 __attribute__((ext_vector_type(2)));
constexpr int BM = 256, BK = 64, HALF = 128, HTB = HALF * BK * 2  , STAGE_BYTES = 8 * HTB, NXCD = 8, WGM = 8;

__host__ __device__ __forceinline__ int lds_byte(int r, int c) { const int st = (r >> 4) * 2 + (c >> 5), rr = r & 15, cc = c & 31, ob = rr * 64 + cc * 2; return st * 1024 + (ob ^ (((ob >> 9) & 1) << 5)); }
__host__ __device__ __forceinline__ void stage_rc(int b, int& R, int& C) { const int st = b / 1024, sb = b % 1024, swz = sb ^ (((sb >> 9) & 1) << 5); R = (st >> 1) * 16 + swz / 64; C = (st & 1) * 32 + (swz % 64) / 2; }
__host__ __device__ __forceinline__ int perm32(int rho) { const int n = rho >> 4, i = rho & 15; return 8 * (i >> 2) + 4 * n + (i & 3); }

struct Unit { int pm, pn; };
struct Gemm { const bf16_t* A; const bf16_t* Bt; int K, lda, ldb; };

struct StaticOrder {
    int nM, nN, nwg, G, c;
    __host__ __device__ void init(int nM_, int nN_, int G_, int c_) { nM = nM_; nN = nN_; nwg = nM * nN; G = G_; c = c_; }
    __host__ __device__ bool next(int i, Unit& u) const {
        const long L = (long)i * G + c; if (L >= nwg) return false;
        int wgid = (int)L; { const int q = nwg / NXCD, r = nwg % NXCD, xcd = wgid % NXCD, off = wgid / NXCD; wgid = (xcd < r ? xcd * (q + 1) : r * (q + 1) + (xcd - r) * q) + off; }
        const int nig = WGM * nN, gid = wgid / nig, fm = gid * WGM, gsz = (nM - fm) < WGM ? (nM - fm) : WGM;
        u.pm = fm + ((wgid % nig) % gsz); u.pn = (wgid % nig) / gsz; return true;
    }
    __device__ __forceinline__ void a_ready(const Unit&) const {}
    __device__ __forceinline__ void done(const Unit&) const {}
};
__device__ __forceinline__ unsigned cvt_pk_bf16(float lo, float hi) { unsigned r; asm volatile("v_cvt_pk_bf16_f32 %0, %1, %2" : "=v"(r) : "v"(lo), "v"(hi)); return r; }
__device__ __forceinline__ float bf_lo(unsigned w) { return __uint_as_float(w << 16); }
__device__ __forceinline__ float bf_hi(unsigned w) { return __uint_as_float(w & 0xffff0000u); }
typedef float f32x2 __attribute__((ext_vector_type(2)));
__device__ __forceinline__ u32x4 pack8(const f32x4 v0, const f32x4 v1) { u32x4 w; w.x = cvt_pk_bf16(v0[0], v0[1]); w.y = cvt_pk_bf16(v0[2], v0[3]); w.z = cvt_pk_bf16(v1[0], v1[1]); w.w = cvt_pk_bf16(v1[2], v1[3]); return w; }
__device__ __forceinline__ void rope8(f32x4& v0, f32x4& v1, const f32x2* tab, int pos, int i0) {
    const f32x2* t = tab + pos * 16 + i0;
    const f32x2 c0 = t[0], c1 = t[1], c2 = t[2], c3 = t[3];
    f32x4 a, b;
    a[0] = v0[0] * c0.x - v0[1] * c0.y; a[1] = v0[0] * c0.y + v0[1] * c0.x;
    a[2] = v0[2] * c1.x - v0[3] * c1.y; a[3] = v0[2] * c1.y + v0[3] * c1.x;
    b[0] = v1[0] * c2.x - v1[1] * c2.y; b[1] = v1[0] * c2.y + v1[1] * c2.x;
    b[2] = v1[2] * c3.x - v1[3] * c3.y; b[3] = v1[2] * c3.y + v1[3] * c3.x;
    v0 = a; v1 = b;
}
struct EpiProj {
    static constexpr bool PERM = true, AFTER_DRAIN = false;
    bf16_t* cqkv; float* ssq; bf16_t* krope; const f32x2* rope;
    __device__ __forceinline__ void operator()(const f32x4 (&acc)[2][2][4][2], const Unit& u, int wr, int wc, int fr, int fq) const {
        const int row0 = u.pm * BM + wr * 64 + fr;
        if (u.pn < 4) {
            const int col0 = u.pn * BM + wc * 32 + 8 * fq;
#pragma unroll
            for (int ai = 0; ai < 2; ++ai)
#pragma unroll
                for (int m = 0; m < 4; ++m) { const int row = row0 + ai * HALF + m * 16; float s = 0.f;
#pragma unroll
                    for (int bj = 0; bj < 2; ++bj) { const f32x4 v0 = acc[ai][bj][m][0], v1 = acc[ai][bj][m][1];
                        s += (v0[0] * v0[0] + v0[1] * v0[1]) + (v0[2] * v0[2] + v0[3] * v0[3]) + (v1[0] * v1[0] + v1[1] * v1[1]) + (v1[2] * v1[2] + v1[3] * v1[3]);
                        *(u32x4*)(cqkv + (size_t)row * 1024 + col0 + bj * HALF) = pack8(v0, v1); }
                    s += __shfl_xor(s, 16); s += __shfl_xor(s, 32);
                    if (fq == 0) ssq[(size_t)row * 16 + u.pn * 4 + wc] = s; }
        } else if (wc == 0) {
#pragma unroll
            for (int ai = 0; ai < 2; ++ai)
#pragma unroll
                for (int m = 0; m < 4; ++m) { const int row = row0 + ai * HALF + m * 16; int pos = row % LP - PADR; pos = pos < 0 ? 0 : pos;
                    f32x4 v0 = acc[ai][0][m][0], v1 = acc[ai][0][m][1]; rope8(v0, v1, rope, pos, 4 * fq);
                    *(u32x4*)(krope + (size_t)row * 32 + 8 * fq) = pack8(v0, v1); }
        }
    }
};
struct EpiQ {
    static constexpr bool PERM = true, AFTER_DRAIN = false;
    bf16_t* Q; const float* ssq; const f32x2* rope;
    __device__ __forceinline__ void operator()(const f32x4 (&acc)[2][2][4][2], const Unit& u, int wr, int wc, int fr, int fq) const {
        const int row0 = u.pm * BM + wr * 64 + fr, col0 = u.pn * BM + wc * 32 + 8 * fq;
#pragma unroll
        for (int ai = 0; ai < 2; ++ai)
#pragma unroll
            for (int m = 0; m < 4; ++m) { const int row = row0 + ai * HALF + m * 16; int pos = row % LP - PADR; pos = pos < 0 ? 0 : pos;
                const f32x4* sp = (const f32x4*)(ssq + (size_t)row * 16); const f32x4 s0 = sp[0], s1 = sp[1], s2 = sp[2];
                const float ss = ((s0[0] + s0[1]) + (s0[2] + s0[3])) + ((s1[0] + s1[1]) + (s1[2] + s1[3])) + ((s2[0] + s2[1]) + (s2[2] + s2[3]));
                const float rstd = 1.0f / sqrtf(ss * (1.0f / 768.0f) + EPS);
#pragma unroll
                for (int bj = 0; bj < 2; ++bj) { const int c = col0 + bj * HALF, d = c % 96; f32x4 v0 = acc[ai][bj][m][0] * rstd, v1 = acc[ai][bj][m][1] * rstd;
                    if (d >= 64) rope8(v0, v1, rope, pos, (d - 64) >> 1);
                    *(u32x4*)(Q + (size_t)row * 1536 + c) = pack8(v0, v1); } }
    }
};
struct EpiKV {
    static constexpr bool PERM = true, AFTER_DRAIN = false;
    bf16_t* KV; const float* ssq;
    __device__ __forceinline__ void operator()(const f32x4 (&acc)[2][2][4][2], const Unit& u, int wr, int wc, int fr, int fq) const {
        const int row0 = u.pm * BM + wr * 64 + fr, col0 = u.pn * BM + wc * 32 + 8 * fq;
#pragma unroll
        for (int ai = 0; ai < 2; ++ai)
#pragma unroll
            for (int m = 0; m < 4; ++m) { const int row = row0 + ai * HALF + m * 16;
                const f32x4 s3 = *(const f32x4*)(ssq + (size_t)row * 16 + 12);
                const float rstd = 1.0f / sqrtf(((s3[0] + s3[1]) + (s3[2] + s3[3])) * (1.0f / 256.0f) + EPS);
#pragma unroll
                for (int bj = 0; bj < 2; ++bj) *(u32x4*)(KV + (size_t)row * 2048 + col0 + bj * HALF) = pack8(acc[ai][bj][m][0] * rstd, acc[ai][bj][m][1] * rstd); }
    }
};
struct EpiResid {
    static constexpr bool PERM = false, AFTER_DRAIN = false;
    const bf16_t* h; float* X;
    __device__ __forceinline__ void operator()(const f32x4 (&acc)[2][2][4][2], const Unit& u, int wr, int wc, int fr, int fq) const {
        const int row0 = u.pm * BM + wr * 64 + fr, col0 = u.pn * BM + wc * 32 + 4 * fq;
#pragma unroll
        for (int ai = 0; ai < 2; ++ai)
#pragma unroll
            for (int m = 0; m < 4; ++m) { const size_t off = (size_t)(row0 + ai * HALF + m * 16) * 1024 + col0;
#pragma unroll
                for (int bj = 0; bj < 2; ++bj)
#pragma unroll
                    for (int n = 0; n < 2; ++n) { const u32x2 hw = *(const u32x2*)(h + off + bj * HALF + n * 16);
                        f32x4 hv; hv[0] = bf_lo(hw.x); hv[1] = bf_hi(hw.x); hv[2] = bf_lo(hw.y); hv[3] = bf_hi(hw.y);
                        *(f32x4*)(X + off + bj * HALF + n * 16) = hv * ALPHA + acc[ai][bj][m][n]; } }
    }
};
struct EpiHgIn {
    static constexpr bool PERM = true, AFTER_DRAIN = false;
    bf16_t* q; bf16_t* v; bf16_t* kf; bf16_t* kb; bf16_t* sg; const float* lb;
    __device__ __forceinline__ void operator()(const f32x4 (&acc)[2][2][4][2], const Unit& u, int wr, int wc, int fr, int fq) const {
        const int row0 = u.pm * BM + wr * 64 + fr, t = u.pn >> 2, col0 = (u.pn & 3) * BM + wc * 32 + 8 * fq;
        bf16_t* dst = t == 0 ? q : t == 1 ? v : t == 2 ? kf : t == 3 ? kb : sg;
#pragma unroll
        for (int bj = 0; bj < 2; ++bj) { const int c = col0 + bj * HALF;
            f32x4 om0 = {1.f, 1.f, 1.f, 1.f}, om1 = om0;
            if (t == 2 || t == 3) { const f32x4* lp = (const f32x4*)(lb + (t - 2) * 1024 + c); om0 = 1.0f - lp[0]; om1 = 1.0f - lp[1]; }
#pragma unroll
            for (int ai = 0; ai < 2; ++ai)
#pragma unroll
                for (int m = 0; m < 4; ++m) { const int row = row0 + ai * HALF + m * 16; const bool pad = (row % LP) < PADR;
                    f32x4 v0 = acc[ai][bj][m][0], v1 = acc[ai][bj][m][1];
                    if (t == 2 || t == 3) {
#pragma unroll
                        for (int j = 0; j < 4; ++j) { v0[j] = pad ? 0.f : om0[j] * __builtin_amdgcn_rcpf(1.0f + __builtin_amdgcn_exp2f(v0[j] * 1.4426950408889634f));
                                                      v1[j] = pad ? 0.f : om1[j] * __builtin_amdgcn_rcpf(1.0f + __builtin_amdgcn_exp2f(v1[j] * 1.4426950408889634f)); }
                    } else if (t == 4) {
#pragma unroll
                        for (int j = 0; j < 4; ++j) { v0[j] = v0[j] * __builtin_amdgcn_rcpf(1.0f + __builtin_amdgcn_exp2f(v0[j] * -1.4426950408889634f));
                                                      v1[j] = v1[j] * __builtin_amdgcn_rcpf(1.0f + __builtin_amdgcn_exp2f(v1[j] * -1.4426950408889634f)); }
                    }
                    *(u32x4*)(dst + (size_t)row * 1024 + c) = pack8(v0, v1); } }
    }
};
struct EpiConvGate {
    static constexpr bool PERM = true, AFTER_DRAIN = false;
    bf16_t* act; const float* cw; const float* cb;
    __device__ __forceinline__ void operator()(const f32x4 (&acc)[2][2][4][2], const Unit& u, int wr, int wc, int fr, int fq) const {
        const int lane = fq * 16 + fr, lprev = fq * 16 + ((fr + 15) & 15), lnext = fq * 16 + ((fr + 1) & 15);
        const int cv0 = 128 * u.pn + 32 * wc + 8 * fq;
#pragma unroll
        for (int n = 0; n < 2; ++n)
#pragma unroll
          for (int jp = 0; jp < 2; ++jp) { const int cv = cv0 + 4 * n + 2 * jp;
            const f32x2 wv0 = *(const f32x2*)(cw + cv), wv1 = *(const f32x2*)(cw + NUP + cv), wv2 = *(const f32x2*)(cw + 2 * NUP + cv), bv = *(const f32x2*)(cb + cv);
            const f32x2 wg0 = *(const f32x2*)(cw + DFF + cv), wg1 = *(const f32x2*)(cw + NUP + DFF + cv), wg2 = *(const f32x2*)(cw + 2 * NUP + DFF + cv), bg = *(const f32x2*)(cb + DFF + cv);
#pragma unroll
            for (int ai = 0; ai < 2; ++ai) { const int J = 4 * u.pm + 2 * ai + wr;
                float o[4][2];
#pragma unroll
                for (int jj = 0; jj < 2; ++jj) { const int j = 2 * jp + jj;
                    float rv[4], lv[4], rg[4], lg[4];
#pragma unroll
                    for (int m = 0; m < 4; ++m) { rv[m] = __shfl(acc[ai][0][m][n][j], lprev); lv[m] = __shfl(acc[ai][0][m][n][j], lnext);
                                                  rg[m] = __shfl(acc[ai][1][m][n][j], lprev); lg[m] = __shfl(acc[ai][1][m][n][j], lnext); }
#pragma unroll
                    for (int m = 0; m < 4; ++m) {
                        const float pv = fr == 0 ? rv[m == 0 ? 0 : m - 1] : rv[m], nv = fr == 15 ? lv[m == 3 ? 3 : m + 1] : lv[m];
                        const float pg = fr == 0 ? rg[m == 0 ? 0 : m - 1] : rg[m], ng = fr == 15 ? lg[m == 3 ? 3 : m + 1] : lg[m];
                        const float val = wv0[jj] * pv + wv1[jj] * acc[ai][0][m][n][j] + wv2[jj] * nv + bv[jj];
                        const float gat = wg0[jj] * pg + wg1[jj] * acc[ai][1][m][n][j] + wg2[jj] * ng + bg[jj];
                        o[m][jj] = val * gat * __builtin_amdgcn_rcpf(1.0f + __builtin_amdgcn_exp2f(gat * -1.4426950408889634f)); } }
#pragma unroll
                for (int m = 0; m < 4; ++m) { const int R64 = 16 * m + fr; const int rowo = 62 * J - 1 + R64;
                    if (R64 >= 1 && R64 <= 62 && rowo < M) *(unsigned*)(act + (size_t)rowo * DFF + cv) = cvt_pk_bf16(o[m][0], o[m][1]); }
                asm volatile("" ::: "memory"); } }
        (void)lane;
    }
};
template <class Epi, class Sched, bool ALIGN_EPI = false, bool SP2 = false, bool SHIFT = false>
__device__ __forceinline__ void gemm_phase(PG8_LAS unsigned char* lds, const Gemm g, const Sched& S, const Epi& E) {
    const int tid = threadIdx.x, wid = __builtin_amdgcn_readfirstlane(tid >> 6), lane = tid & 63, wr = wid >> 2, wc = wid & 3, fr = lane & 15, fq = lane >> 4;
    const int K = g.K, nt = K / BK;
    unsigned voffA[2], voffB[2];
#pragma unroll
    for (int i = 0; i < 2; ++i) { int R, C; stage_rc(tid * 16 + i * 8192, R, C); const int Rb = Epi::PERM ? ((R & ~31) + perm32(R & 31)) : R;
        const int Ra = SHIFT ? (R - 2 * (R >> 6)) : R; voffA[i] = (unsigned)(Ra * g.lda + C) * 2u; voffB[i] = (unsigned)(Rb * g.ldb + C) * 2u; }
    const size_t kstep = (size_t)(BK * 2);
    const size_t hstepA = (size_t)(SHIFT ? 124 : HALF) * g.lda * 2, hstepB = (size_t)HALF * g.ldb * 2;
    const size_t tstepA = 2 * hstepA, tstepB = 2 * hstepB;
    const unsigned ldsw = (unsigned)wid * 1024u;
    const int aoff = lds_byte(wr * 64 + fr, fq * 8), boff = lds_byte(wc * 32 + fr, fq * 8);
#define PG8_SA(b, h) (((b) * 2 + (h)) * HTB)
#define PG8_SB(b, h) ((4 + (b) * 2 + (h)) * HTB)
#define PG8_STAGE(bufoff, gbase, voff) do { _Pragma("unroll") for (int _i = 0; _i < 2; ++_i) \
        __builtin_amdgcn_global_load_lds((const unsigned*)((const char*)(gbase) + (voff)[_i]), (PG8_LAS unsigned*)(lds + (bufoff) + ldsw + _i * 8192), 16, 0, 0); } while (0)
#define PG8_LDA(dst, b, h) do { _Pragma("unroll") for (int m = 0; m < 4; ++m) _Pragma("unroll") for (int k = 0; k < 2; ++k) dst[m][k] = *(const PG8_LAS bf16x8*)(lds + PG8_SA(b, h) + aoff + m * 2048 + k * 1024); } while (0)
#define PG8_LDB(dst, b, h) do { _Pragma("unroll") for (int n = 0; n < 2; ++n) _Pragma("unroll") for (int k = 0; k < 2; ++k) dst[n][k] = *(const PG8_LAS bf16x8*)(lds + PG8_SB(b, h) + boff + n * 2048 + k * 1024); } while (0)
#define PG8_MMA(ai, bj, At, Bt) do { __builtin_amdgcn_s_setprio(1); _Pragma("unroll") for (int m = 0; m < 4; ++m) _Pragma("unroll") for (int n = 0; n < 2; ++n) _Pragma("unroll") for (int k = 0; k < 2; ++k) \
        acc[ai][bj][m][n] = __builtin_amdgcn_mfma_f32_16x16x32_bf16(Bt[n][k], At[m][k], acc[ai][bj][m][n], 0, 0, 0); __builtin_amdgcn_s_setprio(0); } while (0)
#define PG8_WAIT_V(n) asm volatile("s_waitcnt vmcnt(" #n ")" ::: "memory")
#define PG8_WAIT_L(n) asm volatile("s_waitcnt lgkmcnt(" #n ")" ::: "memory")
#define PG8_BAR __builtin_amdgcn_s_barrier()
#define PG8_SCHED __builtin_amdgcn_sched_barrier(0)
    Unit cur, nxt; int ui = 0;
    if (!S.next(0, cur)) return;
    f32x4 acc[2][2][4][2];
#pragma unroll
    for (int a = 0; a < 2; ++a)
#pragma unroll
        for (int b = 0; b < 2; ++b)
#pragma unroll
            for (int m = 0; m < 4; ++m)
#pragma unroll
                for (int n = 0; n < 2; ++n) acc[a][b][m][n] = (f32x4){0.f, 0.f, 0.f, 0.f};
    bf16x8 At[4][2], B0[2][2], B1[2][2];
    const char* cA = (const char*)g.A + (size_t)cur.pm * tstepA; const char* cB = (const char*)g.Bt + (size_t)cur.pn * tstepB;
    S.a_ready(cur);
    if constexpr (SP2) {
        PG8_STAGE(PG8_SB(0, 0), cB, voffB); PG8_STAGE(PG8_SB(0, 1), cB + hstepB, voffB); PG8_STAGE(PG8_SA(0, 0), cA, voffA); PG8_STAGE(PG8_SA(0, 1), cA + hstepA, voffA);
        if (wr == 1) PG8_BAR;
        PG8_WAIT_V(2); PG8_BAR;
        PG8_STAGE(PG8_SB(1, 0), cB + kstep, voffB); PG8_STAGE(PG8_SA(1, 0), cA + kstep, voffA); PG8_STAGE(PG8_SB(1, 1), cB + hstepB + kstep, voffB);
        PG8_WAIT_V(6); PG8_BAR;
    } else {
        PG8_STAGE(PG8_SB(0, 0), cB, voffB); PG8_STAGE(PG8_SA(0, 0), cA, voffA); PG8_STAGE(PG8_SB(0, 1), cB + hstepB, voffB); PG8_STAGE(PG8_SA(0, 1), cA + hstepA, voffA);
        if (wr == 1) PG8_BAR;
        PG8_WAIT_V(4); PG8_BAR;
        PG8_STAGE(PG8_SB(1, 0), cB + kstep, voffB); PG8_STAGE(PG8_SA(1, 0), cA + kstep, voffA); PG8_STAGE(PG8_SB(1, 1), cB + hstepB + kstep, voffB);
        PG8_WAIT_V(6); PG8_BAR;
    }
    for (;;) {
        const bool has_next = S.next(ui + 1, nxt);
        const char* nA = has_next ? (const char*)g.A + (size_t)nxt.pm * tstepA : cA; const char* nB = has_next ? (const char*)g.Bt + (size_t)nxt.pn * tstepB : cB;
        for (int t = 0; t < nt; t += 2) {
            const bool last = (t == nt - 2);
            const char* a1 = cA + (size_t)(t + 1) * kstep;
            const char* a2 = last ? nA : cA + (size_t)(t + 2) * kstep; const char* b2 = last ? nB : cB + (size_t)(t + 2) * kstep;
            const char* a3 = a2 + kstep; const char* b3 = b2 + kstep;
            if (last && has_next) S.a_ready(nxt);
            if constexpr (SP2) {
            PG8_LDB(B0, 0, 0); PG8_LDB(B1, 0, 1); PG8_SCHED; PG8_LDA(At, 0, 0); PG8_STAGE(PG8_SA(1, 1), a1 + hstepA, voffA);
            PG8_WAIT_V(8); PG8_WAIT_L(0); PG8_BAR; PG8_MMA(0, 0, At, B0); PG8_MMA(0, 1, At, B1); PG8_BAR; PG8_SCHED;
            PG8_LDA(At, 0, 1); PG8_STAGE(PG8_SB(0, 0), b2, voffB); PG8_STAGE(PG8_SB(0, 1), b2 + hstepB, voffB); PG8_STAGE(PG8_SA(0, 0), a2, voffA);
            PG8_WAIT_V(8); PG8_WAIT_L(0); PG8_BAR; PG8_MMA(1, 0, At, B0); PG8_MMA(1, 1, At, B1); PG8_BAR; PG8_SCHED;
            PG8_LDB(B0, 1, 0); PG8_LDB(B1, 1, 1); PG8_SCHED; PG8_LDA(At, 1, 0); PG8_STAGE(PG8_SA(0, 1), a2 + hstepA, voffA);
            PG8_WAIT_V(8); PG8_WAIT_L(0); PG8_BAR; PG8_MMA(0, 0, At, B0); PG8_MMA(0, 1, At, B1); PG8_BAR; PG8_SCHED;
            PG8_LDA(At, 1, 1); PG8_STAGE(PG8_SB(1, 0), b3, voffB); PG8_STAGE(PG8_SB(1, 1), b3 + hstepB, voffB); PG8_STAGE(PG8_SA(1, 0), a3, voffA);
            PG8_WAIT_V(8); PG8_WAIT_L(0); PG8_BAR; PG8_MMA(1, 0, At, B0); PG8_MMA(1, 1, At, B1); PG8_BAR; PG8_SCHED;
            } else {
            PG8_LDB(B0, 0, 0); PG8_SCHED; PG8_LDA(At, 0, 0); PG8_STAGE(PG8_SA(1, 1), a1 + hstepA, voffA);
            PG8_WAIT_L(8); PG8_BAR; PG8_WAIT_L(0); PG8_MMA(0, 0, At, B0); PG8_BAR; PG8_SCHED;
            PG8_LDB(B1, 0, 1); PG8_STAGE(PG8_SB(0, 0), b2, voffB);
            PG8_BAR; PG8_WAIT_L(0); PG8_MMA(0, 1, At, B1); PG8_BAR;
            PG8_LDA(At, 0, 1); PG8_STAGE(PG8_SA(0, 0), a2, voffA);
            PG8_BAR; PG8_WAIT_L(0); PG8_MMA(1, 0, At, B0); PG8_BAR; PG8_SCHED;
            PG8_STAGE(PG8_SB(0, 1), b2 + hstepB, voffB);
            PG8_WAIT_V(6); PG8_BAR; PG8_MMA(1, 1, At, B1); PG8_BAR;
            PG8_LDB(B0, 1, 0); PG8_SCHED; PG8_LDA(At, 1, 0); PG8_STAGE(PG8_SA(0, 1), a2 + hstepA, voffA);
            PG8_WAIT_L(8); PG8_BAR; PG8_WAIT_L(0); PG8_MMA(0, 0, At, B0); PG8_BAR; PG8_SCHED;
            PG8_LDB(B1, 1, 1); PG8_STAGE(PG8_SB(1, 0), b3, voffB);
            PG8_BAR; PG8_WAIT_L(0); PG8_MMA(0, 1, At, B1); PG8_BAR;
            PG8_LDA(At, 1, 1); PG8_STAGE(PG8_SA(1, 0), a3, voffA);
            PG8_BAR; PG8_WAIT_L(0); PG8_MMA(1, 0, At, B0); PG8_BAR; PG8_SCHED;
            PG8_STAGE(PG8_SB(1, 1), b3 + hstepB, voffB);
            PG8_WAIT_V(6); PG8_BAR; PG8_MMA(1, 1, At, B1); PG8_BAR;
            }
        }
        if constexpr (ALIGN_EPI) { if (wr == 0) PG8_BAR; }
        if constexpr (!Epi::AFTER_DRAIN) { E(acc, cur, wr, wc, fr, fq); S.done(cur); }
        if (!has_next) break;
#pragma unroll
        for (int a = 0; a < 2; ++a)
#pragma unroll
            for (int b = 0; b < 2; ++b)
#pragma unroll
                for (int m = 0; m < 4; ++m)
#pragma unroll
                    for (int n = 0; n < 2; ++n) acc[a][b][m][n] = (f32x4){0.f, 0.f, 0.f, 0.f};
        cur = nxt; cA = nA; cB = nB; ++ui;
        if constexpr (ALIGN_EPI) { if (wr == 1) PG8_BAR; }
    }
    PG8_WAIT_V(0);
    if constexpr (!ALIGN_EPI) { if (wr == 0) PG8_BAR; }
    PG8_BAR;
    if constexpr (Epi::AFTER_DRAIN) { E.fused(acc, cur, wr, wc, fr, fq, lds, wid, lane); S.done(cur); }
#undef PG8_SA
#undef PG8_SB
#undef PG8_STAGE
#undef PG8_LDA
#undef PG8_LDB
#undef PG8_MMA
#undef PG8_WAIT_V
#undef PG8_WAIT_L
#undef PG8_BAR
#undef PG8_SCHED
}
}
#define GAS __attribute__((address_space(1)))
#define LAS __attribute__((address_space(3)))
typedef unsigned short bf16;
typedef unsigned v4u __attribute__((ext_vector_type(4)));
typedef unsigned v2u __attribute__((ext_vector_type(2)));
typedef float f32x4 __attribute__((ext_vector_type(4)));
typedef float f32x2 __attribute__((ext_vector_type(2)));
typedef GAS unsigned gu32;
using pg8::cvt_pk_bf16; using pg8::bf_lo; using pg8::bf_hi;

constexpr size_t MiB = 1u << 20;
constexpr size_t WS_CTL = 0, CTL_ZERO_BYTES = 64 * 1024;
constexpr size_t WS_ROPE = 1 * MiB;
constexpr size_t WS_LB = WS_ROPE + 640 * 1024;
constexpr size_t WS_W = 2 * MiB;
constexpr size_t W_IN = WS_W, W_UQ = W_IN + 1280ull * 1024 * 2, W_UKV = W_UQ + 1536ull * 768 * 2, W_O = W_UKV + 2048ull * 256 * 2, W_HIN = W_O + 1024ull * 1024 * 2,
                 W_HO = W_HIN + 5120ull * 1024 * 2, W_UP0 = W_HO + 1024ull * 1024 * 2, W_UP1 = W_UP0 + 5632ull * 1024 * 2, W_DN0 = W_UP1 + 5632ull * 1024 * 2, W_DN1 = W_DN0 + 1024ull * 2816 * 2,
                 W_END = W_DN1 + 1024ull * 2816 * 2;
static_assert(W_END <= 55 * MiB, "weights");
constexpr int SLACK = 256;
constexpr size_t ROWB = 2048;
constexpr size_t WS_B0 = 55 * MiB, B0_BYTES = (size_t)(M + 2 * SLACK) * ROWB;
static_assert(B0_BYTES <= 164 * MiB, "B0");
constexpr size_t WS_R = 219 * MiB;
constexpr size_t R_CQKV = WS_R;
constexpr size_t R_Q = R_CQKV + 164 * MiB;
constexpr size_t R_KV = R_Q + 245 * MiB;
constexpr size_t R_KROPE = R_KV + 326 * MiB;
constexpr size_t R_SSQ = R_KROPE + 6 * MiB;
constexpr size_t R_X_L0 = R_Q;
constexpr size_t R_ACT = WS_R;
constexpr size_t R_X_FFN = WS_R + 448 * MiB;
constexpr size_t R_HV = WS_R, R_HKF = WS_R + 163 * MiB, R_HKB = WS_R + 326 * MiB, R_HSG = WS_R + 489 * MiB;
constexpr size_t R_X_HG = WS_R;
constexpr size_t WS_END = 1024 * MiB;
static_assert(R_SSQ + (size_t)M * 16 * 4 <= WS_END && R_X_FFN + (size_t)M * 4096 <= WS_END && R_HSG + (size_t)M * ROWB <= WS_END, "d_ws map");
static_assert((size_t)M * 1536 * 2 + 64 * 3072 <= 245 * MiB && (size_t)M * 4096 + 64 * 4096 <= 326 * MiB && (size_t)M * DFF * 2 <= 448 * MiB && (size_t)M * ROWB <= 163 * MiB, "d_ws map 2");

constexpr int RING_OFF = 0, RING_BYTES = 131072;
constexpr int LDSCTL_OFF = RING_BYTES, MISC_OFF = LDSCTL_OFF + 320;
constexpr int LDS_BYTES = 147456;
constexpr int NWAVES = 8;

#define RLX_AGENT __ATOMIC_RELAXED, __HIP_MEMORY_SCOPE_AGENT
#define XB_TMO      128
#define XB_XCNT(j)  (256  + 64 * (j))
#define XB_XSUB(j)  (1280 + 64 * (j))
#define XB_XGEN(j)  (2304 + 64 * (j))
#define XB_TOP      3328
#define XB_TOPGEN   3392
#define XCD_BAR_WORDS 3456
#define XB_SPIN_CAP (1u << 18)

__device__ __forceinline__ unsigned xb_ld(unsigned* p)              { return __hip_atomic_load(p, __ATOMIC_RELAXED, __HIP_MEMORY_SCOPE_AGENT); }
__device__ __forceinline__ unsigned xb_add(unsigned* p, unsigned v) { return __hip_atomic_fetch_add(p, v, __ATOMIC_RELAXED, __HIP_MEMORY_SCOPE_AGENT); }
__device__ __forceinline__ unsigned xb_xcc_id() { return (unsigned)__builtin_amdgcn_s_getreg((3 << 11) | 20) & 0xFu; }
#define XB_SPIN(cond, bar) do { unsigned _sp = 0; while (cond) { __builtin_amdgcn_s_sleep(1); \
    if ((++_sp & 255u) == 0u) { if (xb_ld(&(bar)[XB_TMO])) break; if (_sp > XB_SPIN_CAP) { atomicAdd(&(bar)[XB_TMO], 1u); break; } } } } while (0)

struct XcdBarrier {
    unsigned* bar; unsigned x;
    volatile LAS unsigned* st;
};

__device__ __forceinline__ XcdBarrier xcd_barrier_post(unsigned* bar, volatile LAS unsigned* st) {
    XcdBarrier b; b.bar = bar; b.x = xb_xcc_id(); b.st = st;
    if (threadIdx.x == 0) (void)xb_add(&bar[XB_XCNT(b.x)], 1u);
    return b;
}
__device__ __forceinline__ void xcd_barrier_complete(unsigned* bar, unsigned x, unsigned& nloc, unsigned& nx) {
    const unsigned G = gridDim.x * gridDim.y * gridDim.z;
    unsigned sum, cnt, mine, sp = 0u;
    for (;;) {
        sum = 0u; cnt = 0u; mine = 0u;
#pragma unroll
        for (unsigned j = 0; j < 16; ++j) { const unsigned c = xb_ld(&bar[XB_XCNT(j)]); sum += c; cnt += (c > 0u) ? 1u : 0u; mine = (j == x) ? c : mine; }
        if (sum == G) break;
        __builtin_amdgcn_s_sleep(1);
        if ((++sp & 255u) == 0u) { if (xb_ld(&bar[XB_TMO])) break; if (sp > XB_SPIN_CAP) { atomicAdd(&bar[XB_TMO], 1u); break; } }
    }
    nloc = mine > 0u ? mine : 1u; nx = cnt > 0u ? cnt : 1u;
}

__device__ __forceinline__ void xcd_barrier(const XcdBarrier& b) {
    asm volatile("s_waitcnt vmcnt(0)" ::: "memory");
    __syncthreads();
    if (threadIdx.x == 0) {
        unsigned* bar = b.bar;
        __builtin_amdgcn_s_waitcnt(0);
        unsigned nloc = b.st[0], nx = b.st[1];
        if (nloc == 0u) { xcd_barrier_complete(bar, b.x, nloc, nx); b.st[0] = nloc; b.st[1] = nx; }
        const unsigned old = xb_add(&bar[XB_XSUB(b.x)], 1u);
        const unsigned gen = old / nloc;
        if (old + 1u == (gen + 1u) * nloc) {
            __builtin_amdgcn_fence(__ATOMIC_RELEASE, "agent");
            asm volatile("s_waitcnt vmcnt(0)" ::: "memory");
            const unsigned og = xb_add(&bar[XB_TOP], 1u);
            const unsigned tg = og / nx;
            if (og + 1u == (tg + 1u) * nx) xb_add(&bar[XB_TOPGEN], 1u);
            else XB_SPIN(xb_ld(&bar[XB_TOPGEN]) == tg, bar);
            __builtin_amdgcn_fence(__ATOMIC_ACQUIRE, "agent");
            xb_add(&bar[XB_XGEN(b.x)], 1u);
            asm volatile("s_waitcnt vmcnt(0)" ::: "memory");
        } else {
            XB_SPIN(xb_ld(&bar[XB_XGEN(b.x)]) == gen, bar);
            __builtin_amdgcn_fence(__ATOMIC_ACQUIRE, "agent");
            asm volatile("s_waitcnt vmcnt(0)" ::: "memory");
        }
    }
    __syncthreads();
}

struct Frame {
    LAS unsigned char* lds;
    volatile LAS unsigned* MISC;
    int tid, lane, wave;
    int vcu, G;
};
__device__ __forceinline__ float wave_sum(float v) {
#pragma unroll
    for (int o = 1; o < 64; o <<= 1) v += __shfl_xor(v, o);
    return v;
}
__device__ __forceinline__ unsigned f2bf(float f) { unsigned u = __builtin_bit_cast(unsigned, f); return (u + 0x7fffu + ((u >> 16) & 1u)) >> 16; }
__device__ __forceinline__ unsigned pk2(float lo, float hi) { return f2bf(lo) | (f2bf(hi) << 16); }

__device__ __forceinline__ int src_col(int kind, int n) {
    if (kind == 1) { if (n < 1024) return n; if (n >= 1056) return -1; const int e = n - 1024; return 1024 + ((e & 1) ? 16 + (e >> 1) : (e >> 1)); }
    if (kind == 2) { const int hd = n / 96, d = n % 96; if (d < 64) return n; const int e = d - 64; return hd * 96 + 64 + ((e & 1) ? 16 + (e >> 1) : (e >> 1)); }
    if (kind == 3) { const int pn = n >> 8, r = n & 255; return r < 128 ? 128 * pn + r : DFF + 128 * pn + (r - 128); }
    return n;
}
__device__ __forceinline__ void p0_transpose_item(const float* W, int K, int N, bf16* WT, int kind, const float* gain, LAS float* scr, int item, int lane, int NP) {
    const int nblk = NP / 32, kb = item / nblk, nb = item % nblk, k0 = 64 * kb, n0 = 32 * nb;
    const int sc = src_col(kind, n0 + (lane & 31));
#pragma unroll 8
    for (int i = 0; i < 32; ++i) { const int kk = 2 * i + (lane >> 5); float v = sc >= 0 ? W[(size_t)(k0 + kk) * N + sc] : 0.f; if (gain) v *= gain[k0 + kk]; scr[kk * 33 + (lane & 31)] = v; }
    asm volatile("s_waitcnt lgkmcnt(0)" ::: "memory");
    const int c = lane & 7;
#pragma unroll
    for (int j = 0; j < 4; ++j) { const int n = (lane >> 3) + 8 * j; const LAS float* s = scr + (8 * c) * 33 + n;
        v4u o; o.x = pk2(s[0 * 33], s[1 * 33]); o.y = pk2(s[2 * 33], s[3 * 33]); o.z = pk2(s[4 * 33], s[5 * 33]); o.w = pk2(s[6 * 33], s[7 * 33]);
        *(GAS v4u*)(WT + (size_t)(n0 + n) * K + k0 + 8 * c) = o; }
    asm volatile("s_waitcnt lgkmcnt(0)" ::: "memory");
}
struct WJob { const float* W; bf16* WT; const float* gain; int K, N, NP, kind; };
__device__ __forceinline__ void p0_prologue(Frame& F, const float* const* in, unsigned char* ws, bf16* h0) {
    LAS float* scr = (LAS float*)(F.lds + RING_OFF + F.wave * 16384);
    const int gw = F.vcu * NWAVES + F.wave, NGW = F.G * NWAVES;
#define WJOB(SRC, DST, GAIN, K_, N_, NP_, KIND) { const int nitems = ((K_) / 64) * ((NP_) / 32); for (int it = gw; it < nitems; it += NGW) p0_transpose_item(SRC, K_, N_, (bf16*)(ws + (DST)), KIND, GAIN, scr, it, F.lane, NP_); }
    WJOB(in[3], W_IN, nullptr, 1024, 1056, 1280, 1)
    WJOB(in[6], W_UQ, in[4], 768, 1536, 1536, 2)
    WJOB(in[7], W_UKV, in[5], 256, 2048, 2048, 0)
    WJOB(in[8], W_O, nullptr, 1024, 1024, 1024, 0)
    WJOB(in[9], W_HIN, nullptr, 1024, 5120, 5120, 0)
    WJOB(in[12], W_HO, nullptr, 1024, 1024, 1024, 0)
    WJOB(in[13], W_UP0, nullptr, 1024, NUP, NUP, 3)
    WJOB(in[13] + (size_t)1024 * NUP, W_UP1, nullptr, 1024, NUP, NUP, 3)
    WJOB(in[16], W_DN0, nullptr, DFF, 1024, 1024, 0)
    WJOB(in[16] + (size_t)DFF * 1024, W_DN1, nullptr, DFF, 1024, 1024, 0)
#undef WJOB
    for (int row = gw; row < M; row += NGW) {
        const int b = row / LP, s = row % LP;
        GAS unsigned long long* o8 = (GAS unsigned long long*)(h0 + (size_t)row * 1024) + F.lane;
        if (s < PADR) {
#pragma unroll
            for (int j = 0; j < 4; ++j) o8[64 * j] = 0ull;
        } else {
            const float* src = s < PADR + 16 ? in[2] + (size_t)(s - PADR) * 1024 : (b < 16 ? in[0] + ((size_t)b * SEQ + (s - 64)) * 1024 : in[1] + ((size_t)(b - 16) * SEQ + (s - 64)) * 1024);
            const GAS f32x4* xr = (const GAS f32x4*)src + F.lane;
#pragma unroll
            for (int j = 0; j < 4; ++j) { const f32x4 v = xr[64 * j]; o8[64 * j] = (unsigned long long)pk2(v.x, v.y) | ((unsigned long long)pk2(v.z, v.w) << 32); }
        }
    }
    { const int gt = gw * 64 + F.lane, NGT = NGW * 64; GAS v4u* z0 = (GAS v4u*)(ws + WS_B0); GAS v4u* z1 = (GAS v4u*)(ws + WS_B0 + (size_t)(SLACK + M) * ROWB);
      const int n16 = SLACK * (int)ROWB / 16;
      for (int i = gt; i < n16; i += NGT) { z0[i] = (v4u){0u, 0u, 0u, 0u}; z1[i] = (v4u){0u, 0u, 0u, 0u}; } }
    { const int gt = gw * 64 + F.lane, NGT = NGW * 64; f32x2* tab = (f32x2*)(ws + WS_ROPE);
      for (int i = gt; i < LTOK * 16; i += NGT) { const int pos = i >> 4, k = i & 15;
          const float inv = 1.0f / powf(10000.0f, (float)(2 * k) / 32.0f); const float ang = (float)pos * inv;
          f32x2 cs; cs.x = (float)cos((double)ang); cs.y = (float)sin((double)ang); tab[i] = cs; } }
    { const int gt = gw * 64 + F.lane; float* lb = (float*)(ws + WS_LB);
      if (gt < 2048) { const int d = gt >> 10, k = gt & 1023; const float x0 = in[10][(size_t)(d * 2 + 0) * 1024 + k], x1 = in[10][(size_t)(d * 2 + 1) * 1024 + k];
          lb[gt] = 1.0f / (1.0f + expf(x0 - x1)); } }
}

template <bool FINAL> __device__ __forceinline__ void ln_pass(Frame& F, const float* X, const float* gain, const float* bias, bf16* hout, float* out) {
    const int gw = F.vcu * NWAVES + F.wave, NGW = F.G * NWAVES;
    f32x4 g[4], bb[4];
#pragma unroll
    for (int j = 0; j < 4; ++j) { g[j] = ((const f32x4*)gain)[64 * j + F.lane]; bb[j] = ((const f32x4*)bias)[64 * j + F.lane]; }
    for (int row = gw; row < M; row += NGW) {
        const int b = row / LP, s = row % LP;
        if (FINAL) { if (s < 64) continue; }
        else if (s < PADR) { GAS unsigned long long* o8 = (GAS unsigned long long*)(hout + (size_t)row * 1024) + F.lane;
#pragma unroll
            for (int j = 0; j < 4; ++j) o8[64 * j] = 0ull;
            continue; }
        const GAS f32x4* xr = (const GAS f32x4*)(X + (size_t)row * 1024) + F.lane;
        f32x4 v[4]; float sm = 0.f;
#pragma unroll
        for (int j = 0; j < 4; ++j) { v[j] = xr[64 * j]; sm += (v[j].x + v[j].y) + (v[j].z + v[j].w); }
        const float mean = wave_sum(sm) * (1.f / 1024.f); float s2 = 0.f;
#pragma unroll
        for (int j = 0; j < 4; ++j) { v[j] = v[j] - mean; s2 += (v[j].x * v[j].x + v[j].y * v[j].y) + (v[j].z * v[j].z + v[j].w * v[j].w); }
        const float rstd = 1.f / sqrtf(wave_sum(s2) * (1.f / 1024.f) + EPS);
        if (FINAL) { GAS f32x4* o = (GAS f32x4*)(out + ((size_t)b * SEQ + (s - 64)) * 1024) + F.lane;
#pragma unroll
            for (int j = 0; j < 4; ++j) o[64 * j] = v[j] * rstd * g[j] + bb[j];
        } else { GAS unsigned long long* o8 = (GAS unsigned long long*)(hout + (size_t)row * 1024) + F.lane;
#pragma unroll
            for (int j = 0; j < 4; ++j) { const f32x4 y = v[j] * rstd * g[j] + bb[j]; o8[64 * j] = (unsigned long long)cvt_pk_bf16(y.x, y.y) | ((unsigned long long)cvt_pk_bf16(y.z, y.w) << 32); } }
    }
}
__device__ __forceinline__ void attn_simple(Frame& F, const bf16* Q, const bf16* KV, const bf16* KR, bf16* O) {
    LAS float* Ks = (LAS float*)(F.lds);
    LAS float* Vs = (LAS float*)(F.lds + 64 * 96 * 4);
    constexpr int NQC = 17;
    const int hf = F.tid & 1;
    for (int u = F.vcu; u < NB * 16 * NQC; u += F.G) {
        const int bh = u / NQC, qc = u % NQC, b = bh >> 4, h = bh & 15;
        const int sq = qc * 256 + (F.tid >> 1); const bool vq = sq < LP; const size_t rowq = (size_t)b * LP + (vq ? sq : LP - 1);
        float q[48];
#pragma unroll
        for (int c = 0; c < 6; ++c) { const v4u w = *(const GAS v4u*)(Q + rowq * 1536 + h * 96 + hf * 48 + c * 8);
            q[c * 8 + 0] = bf_lo(w.x); q[c * 8 + 1] = bf_hi(w.x); q[c * 8 + 2] = bf_lo(w.y); q[c * 8 + 3] = bf_hi(w.y);
            q[c * 8 + 4] = bf_lo(w.z); q[c * 8 + 5] = bf_hi(w.z); q[c * 8 + 6] = bf_lo(w.w); q[c * 8 + 7] = bf_hi(w.w); }
        float o[32];
#pragma unroll
        for (int d = 0; d < 32; ++d) o[d] = 0.f;
        float mx = -1e30f, l = 0.f;
        for (int kt = 0; kt < 65; ++kt) {
            __syncthreads();
            for (int idx = F.tid; idx < 64 * 12; idx += 512) { const int j = idx / 12, c = idx % 12; int sk = PADR + kt * 64 + j; sk = sk < LP ? sk : LP - 1; const size_t rk = (size_t)b * LP + sk;
                const v4u w = c < 8 ? *(const GAS v4u*)(KV + rk * 2048 + h * 128 + c * 8) : *(const GAS v4u*)(KR + rk * 32 + (c - 8) * 8);
                LAS float* d = Ks + j * 96 + c * 8; d[0] = bf_lo(w.x); d[1] = bf_hi(w.x); d[2] = bf_lo(w.y); d[3] = bf_hi(w.y); d[4] = bf_lo(w.z); d[5] = bf_hi(w.z); d[6] = bf_lo(w.w); d[7] = bf_hi(w.w); }
            { const int j = F.tid >> 3, c = F.tid & 7; int sk = PADR + kt * 64 + j; sk = sk < LP ? sk : LP - 1; const size_t rk = (size_t)b * LP + sk;
                const v4u w = *(const GAS v4u*)(KV + rk * 2048 + h * 128 + 64 + c * 8);
                LAS float* d = Vs + j * 64 + c * 8; d[0] = bf_lo(w.x); d[1] = bf_hi(w.x); d[2] = bf_lo(w.y); d[3] = bf_hi(w.y); d[4] = bf_lo(w.z); d[5] = bf_hi(w.z); d[6] = bf_lo(w.w); d[7] = bf_hi(w.w); }
            __syncthreads();
            const int nk = (LTOK - kt * 64) < 64 ? (LTOK - kt * 64) : 64;
#pragma unroll 1
            for (int jj = 0; jj < nk; ++jj) {
                const LAS f32x4* kr = (const LAS f32x4*)(Ks + jj * 96 + hf * 48); float a0 = 0.f, a1 = 0.f;
#pragma unroll
                for (int c = 0; c < 12; c += 2) { const f32x4 k0 = kr[c], k1 = kr[c + 1];
                    a0 += q[4 * c] * k0.x + q[4 * c + 1] * k0.y + q[4 * c + 2] * k0.z + q[4 * c + 3] * k0.w;
                    a1 += q[4 * c + 4] * k1.x + q[4 * c + 5] * k1.y + q[4 * c + 6] * k1.z + q[4 * c + 7] * k1.w; }
                float sc = a0 + a1; sc += __shfl_xor(sc, 1); sc *= SM_C;
                const float mn = fmaxf(mx, sc);
                const float al = __builtin_amdgcn_exp2f(mx - mn), p = __builtin_amdgcn_exp2f(sc - mn); mx = mn; l = l * al + p;
                const LAS f32x4* vr = (const LAS f32x4*)(Vs + jj * 64 + hf * 32);
#pragma unroll
                for (int c = 0; c < 8; ++c) { const f32x4 vv = vr[c]; o[4 * c] = fmaf(p, vv.x, o[4 * c] * al); o[4 * c + 1] = fmaf(p, vv.y, o[4 * c + 1] * al); o[4 * c + 2] = fmaf(p, vv.z, o[4 * c + 2] * al); o[4 * c + 3] = fmaf(p, vv.w, o[4 * c + 3] * al); }
            }
        }
        if (vq) { const float il = 1.0f / l;
#pragma unroll
            for (int c = 0; c < 4; ++c) { v4u w; w.x = cvt_pk_bf16(o[8 * c] * il, o[8 * c + 1] * il); w.y = cvt_pk_bf16(o[8 * c + 2] * il, o[8 * c + 3] * il); w.z = cvt_pk_bf16(o[8 * c + 4] * il, o[8 * c + 5] * il); w.w = cvt_pk_bf16(o[8 * c + 6] * il, o[8 * c + 7] * il);
                *(GAS v4u*)(O + rowq * 1024 + h * 64 + hf * 32 + c * 8) = w; } }
    }
    __syncthreads();
}

__device__ __forceinline__ void gla_simple(Frame& F, bf16* Qb, const bf16* Vb, bf16* KFb, const bf16* KBb, const bf16* SGb, const float* onorm) {
    LAS float* tq = (LAS float*)(F.lds);
    LAS float* tk = (LAS float*)(F.lds + 16384);
    LAS float* tv = (LAS float*)(F.lds + 32768);
    LAS float* pr = (LAS float*)(F.lds + 49152);
    const int j = F.tid & 127, kq = F.tid >> 7;
    for (int it = F.vcu; it < NB * 8; it += F.G) {
        const int b = it >> 3, h = it & 7; const size_t cbase = (size_t)h * 128;
        for (int dir = 0; dir < 2; ++dir) {
            float S[32];
#pragma unroll
            for (int k = 0; k < 32; ++k) S[k] = 0.f;
            const bf16* Kg = dir == 0 ? KFb : KBb;
            for (int tile = 0; tile < (LTOK + 31) / 32; ++tile) {
                __syncthreads();
                { const int i = F.tid >> 4, c8 = (F.tid & 15) * 8; const int tt = tile * 32 + i; const bool vt = tt < LTOK; const int tok = dir == 0 ? tt : LTOK - 1 - tt;
                  const size_t off = ((size_t)b * LP + PADR + (vt ? tok : 0)) * 1024 + cbase + c8;
                  v4u wq = *(const GAS v4u*)(Qb + off), wk = *(const GAS v4u*)(Kg + off), wv = *(const GAS v4u*)(Vb + off);
                  if (!vt) { wq = (v4u){0u, 0u, 0u, 0u}; wk = wq; wv = wq; }
                  LAS float* dq = tq + i * 128 + c8; LAS float* dk = tk + i * 128 + c8; LAS float* dv = tv + i * 128 + c8;
                  dq[0] = bf_lo(wq.x); dq[1] = bf_hi(wq.x); dq[2] = bf_lo(wq.y); dq[3] = bf_hi(wq.y); dq[4] = bf_lo(wq.z); dq[5] = bf_hi(wq.z); dq[6] = bf_lo(wq.w); dq[7] = bf_hi(wq.w);
                  dk[0] = bf_lo(wk.x); dk[1] = bf_hi(wk.x); dk[2] = bf_lo(wk.y); dk[3] = bf_hi(wk.y); dk[4] = bf_lo(wk.z); dk[5] = bf_hi(wk.z); dk[6] = bf_lo(wk.w); dk[7] = bf_hi(wk.w);
                  dv[0] = bf_lo(wv.x); dv[1] = bf_hi(wv.x); dv[2] = bf_lo(wv.y); dv[3] = bf_hi(wv.y); dv[4] = bf_lo(wv.z); dv[5] = bf_hi(wv.z); dv[6] = bf_lo(wv.w); dv[7] = bf_hi(wv.w); }
                __syncthreads();
                for (int i = 0; i < 32; ++i) {
                    const float vj = tv[i * 128 + j]; float part = 0.f;
                    const LAS f32x4* kr = (const LAS f32x4*)(tk + i * 128 + kq * 32); const LAS f32x4* qr = (const LAS f32x4*)(tq + i * 128 + kq * 32);
#pragma unroll
                    for (int c = 0; c < 8; ++c) { const f32x4 kk = kr[c], qq = qr[c];
                        S[4 * c] = fmaf(kk.x, vj - S[4 * c], S[4 * c]); part = fmaf(S[4 * c], qq.x, part);
                        S[4 * c + 1] = fmaf(kk.y, vj - S[4 * c + 1], S[4 * c + 1]); part = fmaf(S[4 * c + 1], qq.y, part);
                        S[4 * c + 2] = fmaf(kk.z, vj - S[4 * c + 2], S[4 * c + 2]); part = fmaf(S[4 * c + 2], qq.z, part);
                        S[4 * c + 3] = fmaf(kk.w, vj - S[4 * c + 3], S[4 * c + 3]); part = fmaf(S[4 * c + 3], qq.w, part); }
                    pr[(i * 4 + kq) * 128 + j] = part;
                }
                __syncthreads();
#pragma unroll
                for (int ii = 0; ii < 4; ++ii) { const int i = F.wave * 4 + ii; const int tt = tile * 32 + i; const bool vt = tt < LTOK; const int tok = dir == 0 ? tt : LTOK - 1 - tt;
                    const int c = 2 * F.lane;
                    float o0 = pr[(i * 4 + 0) * 128 + c] + pr[(i * 4 + 1) * 128 + c] + pr[(i * 4 + 2) * 128 + c] + pr[(i * 4 + 3) * 128 + c];
                    float o1 = pr[(i * 4 + 0) * 128 + c + 1] + pr[(i * 4 + 1) * 128 + c + 1] + pr[(i * 4 + 2) * 128 + c + 1] + pr[(i * 4 + 3) * 128 + c + 1];
                    const size_t off = ((size_t)b * LP + PADR + (vt ? tok : 0)) * 1024 + cbase + c;
                    if (dir == 0) { if (vt) *(GAS unsigned*)(KFb + off) = cvt_pk_bf16(o0, o1); }
                    else { const unsigned wf = *(const GAS unsigned*)(KFb + off); o0 += bf_lo(wf); o1 += bf_hi(wf);
                        const float ss = wave_sum(o0 * o0 + o1 * o1); const float rstd = 1.0f / sqrtf(ss * (1.0f / 128.0f) + EPS);
                        const unsigned wg = *(const GAS unsigned*)(SGb + off); const f32x2 gn = *(const f32x2*)(onorm + cbase + c);
                        if (vt) *(GAS unsigned*)(Qb + off) = cvt_pk_bf16(o0 * rstd * gn.x * bf_lo(wg), o1 * rstd * gn.y * bf_hi(wg)); } }
            }
            __syncthreads();
        }
    }
    __syncthreads();
}
namespace fa {
using bf16x8 = __attribute__((ext_vector_type(8))) short;
using s16x4  = __attribute__((ext_vector_type(4))) short;
using f32x16 = __attribute__((ext_vector_type(16))) float;
using u32x4  = __attribute__((ext_vector_type(4))) unsigned;
constexpr int KROW = 208;
constexpr int SHM_V = 64 * 64 * 2, SHM_K = 64 * KROW;
constexpr int OFF_V = 0, OFF_K = 2 * SHM_V, OFF_WS = OFF_K + 2 * SHM_K, OFF_STG = OFF_WS + 8 * 256, LDS_TOTAL = OFF_STG + 8 * 4096;
constexpr int NT = 65, NQC = 17;
constexpr float THR_RAW = 8.0f / 0.10206207261596575f;
#define FA_SBAR() __builtin_amdgcn_sched_barrier(0)
__device__ __forceinline__ int crow(int r, int hi) { return (r & 3) + 8 * (r >> 2) + 4 * hi; }
__device__ __forceinline__ void partialSM(f32x16& p0, f32x16& p1, float& m_reg, float& mn, float& alpha) {
  constexpr float C = SM_C;
  float pmax = p0[0];
#pragma unroll
  for (int r = 1; r < 16; ++r) pmax = fmaxf(pmax, p0[r]);
#pragma unroll
  for (int r = 0; r < 16; ++r) pmax = fmaxf(pmax, p1[r]);
  { auto rr = __builtin_amdgcn_permlane32_swap(__float_as_uint(pmax), __float_as_uint(pmax), false, false);
    pmax = fmaxf(__uint_as_float(rr[0]), __uint_as_float(rr[1])); }
  if (__builtin_expect(__all(pmax - m_reg <= THR_RAW), 1)) { mn = m_reg; alpha = 1.f; }
  else { mn = fmaxf(m_reg, pmax); alpha = __builtin_amdgcn_exp2f((m_reg - mn) * C); m_reg = mn; }
  const float mnC = -mn * C;
#pragma unroll
  for (int r = 0; r < 16; ++r) p0[r] = fmaf(p0[r], C, mnC);
#pragma unroll
  for (int r = 0; r < 16; ++r) p1[r] = fmaf(p1[r], C, mnC);
#pragma unroll
  for (int r = 0; r < 16; ++r) p0[r] = __builtin_amdgcn_exp2f(p0[r]);
}
__device__ __forceinline__ void finishSM(f32x16& p0, f32x16& p1, float alpha, float& l_reg, bf16x8& pa0, bf16x8& pa1, bf16x8& pa2, bf16x8& pa3) {
#pragma unroll
  for (int r = 0; r < 16; ++r) p1[r] = __builtin_amdgcn_exp2f(p1[r]);
  float ps = 0;
#pragma unroll
  for (int r = 0; r < 16; ++r) ps += p0[r];
#pragma unroll
  for (int r = 0; r < 16; ++r) ps += p1[r];
  { auto rr = __builtin_amdgcn_permlane32_swap(__float_as_uint(ps), __float_as_uint(ps), false, false);
    ps = __uint_as_float(rr[0]) + __uint_as_float(rr[1]); }
  l_reg = l_reg * alpha + ps;
#define FA_PK4(P, BASE, OUT) do { unsigned a0 = cvt_pk_bf16(P[BASE + 0], P[BASE + 1]), a1 = cvt_pk_bf16(P[BASE + 2], P[BASE + 3]);   \
    unsigned b0 = cvt_pk_bf16(P[BASE + 4], P[BASE + 5]), b1 = cvt_pk_bf16(P[BASE + 6], P[BASE + 7]);                              \
    auto r0 = __builtin_amdgcn_permlane32_swap(a0, b0, false, false); auto r1 = __builtin_amdgcn_permlane32_swap(a1, b1, false, false); \
    u32x4 w = {r0[0], r1[0], r0[1], r1[1]}; OUT = *reinterpret_cast<bf16x8*>(&w); } while (0)
  FA_PK4(p0, 0, pa0); FA_PK4(p0, 8, pa1); FA_PK4(p1, 0, pa2); FA_PK4(p1, 8, pa3);
#undef FA_PK4
}
__device__ __forceinline__ void qkt(f32x16& p0, f32x16& p1, const char* Ks, const bf16x8* qr, int r32, int hi) {
  p0 = f32x16{}; p1 = f32x16{};
#pragma unroll
  for (int d0 = 0; d0 < 6; ++d0) { const int cb = (d0 * 16 + hi * 8) * 2;
    const bf16x8 b0 = *reinterpret_cast<const bf16x8*>(Ks + r32 * KROW + cb);
    const bf16x8 b1 = *reinterpret_cast<const bf16x8*>(Ks + (32 + r32) * KROW + cb);
    p0 = __builtin_amdgcn_mfma_f32_32x32x16_bf16(b0, qr[d0], p0, 0, 0, 0);
    p1 = __builtin_amdgcn_mfma_f32_32x32x16_bf16(b1, qr[d0], p1, 0, 0, 0); }
}
__device__ __forceinline__ int v_st(int k, int c) { const int kk = (k & ~0xC) | ((k & 4) << 1) | ((k & 8) >> 1); return ((kk >> 3) * 2 + (c >> 5)) * 512 + ((kk & 7) * 32 + (c & 31)) * 2; }
__device__ __forceinline__ int v_rd_base(int lane) { return ((lane & 3) << 3) | (((lane >> 2) & 3) << 6) | (((lane >> 4) & 1) << 5) | (((lane >> 5) & 1) << 8); }
constexpr int v_rd_off(int d0, int ks, int half) { return d0 * 512 + ks * 2048 + half * 1024; }
template <int OFF> __device__ __forceinline__ s16x4 tr_read(int vb) {
  s16x4 r; asm volatile("ds_read_b64_tr_b16 %0, %1 offset:%2" : "=&v"(r) : "v"(vb), "i"(OFF) : "memory"); return r;
}
template <int D0> __device__ __forceinline__ void pv_one(f32x16& od, int vb, bf16x8 pa0, bf16x8 pa1, bf16x8 pa2, bf16x8 pa3) {
  const s16x4 l0 = tr_read<v_rd_off(D0, 0, 0)>(vb), h0 = tr_read<v_rd_off(D0, 0, 1)>(vb), l1 = tr_read<v_rd_off(D0, 1, 0)>(vb), h1 = tr_read<v_rd_off(D0, 1, 1)>(vb);
  const s16x4 l2 = tr_read<v_rd_off(D0, 2, 0)>(vb), h2 = tr_read<v_rd_off(D0, 2, 1)>(vb), l3 = tr_read<v_rd_off(D0, 3, 0)>(vb), h3 = tr_read<v_rd_off(D0, 3, 1)>(vb);
  asm volatile("s_waitcnt lgkmcnt(0)" ::: "memory"); FA_SBAR();
#define FA_PK(L, H) (bf16x8){L[0], L[1], L[2], L[3], H[0], H[1], H[2], H[3]}
  od = __builtin_amdgcn_mfma_f32_32x32x16_bf16(pa0, FA_PK(l0, h0), od, 0, 0, 0);
  od = __builtin_amdgcn_mfma_f32_32x32x16_bf16(pa1, FA_PK(l1, h1), od, 0, 0, 0);
  od = __builtin_amdgcn_mfma_f32_32x32x16_bf16(pa2, FA_PK(l2, h2), od, 0, 0, 0);
  od = __builtin_amdgcn_mfma_f32_32x32x16_bf16(pa3, FA_PK(l3, h3), od, 0, 0, 0);
#undef FA_PK
}
__device__ __forceinline__ void pv_d0(f32x16* o, int vb, bf16x8 pa0, bf16x8 pa1, bf16x8 pa2, bf16x8 pa3) {
  pv_one<0>(o[0], vb, pa0, pa1, pa2, pa3); pv_one<1>(o[1], vb, pa0, pa1, pa2, pa3);
}
__device__ __forceinline__ void attn_unit(int b, int h, int q0, const bf16* __restrict__ Q, const bf16* __restrict__ KV, const bf16* __restrict__ KR, bf16* __restrict__ O, char* lds) {
  const int tid = threadIdx.x, wid = tid >> 6, lane = tid & 63, r32 = lane & 31, hi = lane >> 5;
  char* V_lds = lds + OFF_V; char* K_lds = lds + OFF_K;
  float* ws = (float*)(lds + OFF_WS) + wid * 64; float* li_l = ws; float* al_l = ws + 32;
  float m_reg = -1e30f, l_reg = 0; f32x16 o[2] = {}; bf16x8 qr[6];
  const size_t seq0 = (size_t)b * LP;
  { int sq = q0 + wid * 32 + r32; sq = sq < LP ? sq : LP - 1;
    const bf16* Qw = Q + (seq0 + sq) * 1536 + h * 96 + hi * 8;
#pragma unroll
    for (int d0 = 0; d0 < 6; ++d0) qr[d0] = *reinterpret_cast<const bf16x8*>(Qw + d0 * 16); }
  const int sr = tid >> 3, sc = (tid & 7) * 8, rr = (tid >> 2) & 63, rc = (tid & 3) * 8; const bool hasr = tid < 256;
  const int vst = v_st(sr, sc), kst = sr * KROW + sc * 2, rst = rr * KROW + 128 + rc * 2;
  const bf16* Kn = KV + seq0 * 2048 + h * 128 + (size_t)sr * 2048 + sc; const bf16* Vn = Kn + 64; const bf16* Rn = KR + seq0 * 32 + (size_t)rr * 32 + rc;
  const int vb0 = (int)(uintptr_t)V_lds + v_rd_base(lane);
  struct { bf16x8 vs, ks, rs; } sr_[2];
#define FA_SLOAD(i, k0) do { sr_[i].vs = *reinterpret_cast<const bf16x8*>(Vn + (size_t)(k0) * 2048); sr_[i].ks = *reinterpret_cast<const bf16x8*>(Kn + (size_t)(k0) * 2048); \
    if (hasr) sr_[i].rs = *reinterpret_cast<const bf16x8*>(Rn + (size_t)(k0) * 32); } while (0)
#define FA_SWRITE(bf, i) do { *(bf16x8*)(V_lds + (bf) * SHM_V + vst) = sr_[i].vs; *(bf16x8*)(K_lds + (bf) * SHM_K + kst) = sr_[i].ks; \
    if (hasr) *(bf16x8*)(K_lds + (bf) * SHM_K + rst) = sr_[i].rs; } while (0)
#define FA_SWAIT() asm volatile("s_waitcnt vmcnt(3)" ::: "memory")
#define FA_RESC(a) do { if (__any((a) < 1.f)) { if (hi == 0) al_l[r32] = (a); asm volatile("s_waitcnt lgkmcnt(0)" ::: "memory"); \
    _Pragma("unroll") for (int d = 0; d < 2; ++d) _Pragma("unroll") for (int r = 0; r < 16; ++r) o[d][r] *= al_l[crow(r, hi)]; } } while (0)
  f32x16 pA0, pA1, pB0, pB1; float mnA, mnB, alA, alB; bf16x8 pa0, pa1, pa2, pa3;
  constexpr int SE = 0, SO = 1;
  __syncthreads();
  FA_SLOAD(SE, 0); asm volatile("s_waitcnt vmcnt(0)" ::: "memory"); FA_SWRITE(0, SE); __syncthreads();
  qkt(pA0, pA1, K_lds, qr, r32, hi);
  { const float NEG = -INFINITY;
#pragma unroll
    for (int r = 0; r < 16; ++r) pA0[r] = NEG;
#pragma unroll
    for (int r = 0; r < 8; ++r) pA1[r] = NEG; }
  partialSM(pA0, pA1, m_reg, mnA, alA);
  FA_SLOAD(SO, 64); FA_SLOAD(SE, 128);
  FA_SWAIT(); FA_SWRITE(1, SO); __syncthreads();
  for (int j = 1; j + 1 < NT; j += 2) {
    FA_SBAR(); qkt(pB0, pB1, K_lds + SHM_K, qr, r32, hi);
    finishSM(pA0, pA1, alA, l_reg, pa0, pa1, pa2, pa3); FA_SBAR();
    if (j + 2 < NT) FA_SLOAD(SO, (j + 2) * 64); FA_SBAR();
    pv_d0(o, vb0, pa0, pa1, pa2, pa3); partialSM(pB0, pB1, m_reg, mnB, alB);
    __syncthreads(); FA_SWAIT(); FA_SWRITE(0, SE);
    FA_RESC(alB); __syncthreads();
    FA_SBAR(); qkt(pA0, pA1, K_lds, qr, r32, hi);
    finishSM(pB0, pB1, alB, l_reg, pa0, pa1, pa2, pa3); FA_SBAR();
    if (j + 3 < NT) FA_SLOAD(SE, (j + 3) * 64); FA_SBAR();
    pv_d0(o, vb0 + SHM_V, pa0, pa1, pa2, pa3); partialSM(pA0, pA1, m_reg, mnA, alA);
    __syncthreads(); FA_SWAIT(); if (j + 2 < NT) FA_SWRITE(1, SO);
    FA_RESC(alA); __syncthreads();
  }
  finishSM(pA0, pA1, alA, l_reg, pa0, pa1, pa2, pa3); FA_SBAR();
  pv_d0(o, vb0, pa0, pa1, pa2, pa3);
  if (hi == 0) li_l[r32] = l_reg; asm volatile("s_waitcnt lgkmcnt(0)" ::: "memory");
  float rli[16];
#pragma unroll
  for (int r = 0; r < 16; ++r) rli[r] = __builtin_amdgcn_rcpf(li_l[crow(r, hi)]);
  { unsigned short* stg = (unsigned short*)(lds + OFF_STG) + wid * 2048;
#pragma unroll
    for (int r = 0; r < 16; ++r) { const int orow = crow(r, hi);
#pragma unroll
      for (int d0 = 0; d0 < 2; ++d0) stg[orow * 64 + d0 * 32 + r32] = (unsigned short)(cvt_pk_bf16(o[d0][r] * rli[r], 0.f) & 0xffffu); }
    asm volatile("s_waitcnt lgkmcnt(0)" ::: "memory");
#pragma unroll
    for (int i = 0; i < 4; ++i) { const int row = i * 8 + (lane >> 3), ch = lane & 7; const int sq = q0 + wid * 32 + row; const u32x4 v = *(const u32x4*)(stg + row * 64 + ch * 8);
      if (sq < LP) *(u32x4*)(O + (seq0 + sq) * 1024 + h * 64 + ch * 8) = v; } }
#undef FA_SLOAD
#undef FA_SWRITE
#undef FA_SWAIT
#undef FA_RESC
}
__device__ __forceinline__ void attn_phase(int vcu, int G, const bf16* Q, const bf16* KV, const bf16* KR, bf16* O, char* lds) {
  for (int u = vcu; u < NB * 16 * NQC; u += G) { const int bh = u / NQC, qc = u % NQC; attn_unit(bh >> 4, bh & 15, qc * 256, Q, KV, KR, O, lds); }
  __syncthreads();
}
#undef FA_SBAR
}
constexpr int NPHASE = 16;
#ifndef ATTN_SIMPLE
#define ATTN_SIMPLE 0
#endif
#ifndef MK_ONE_LAUNCH
#define MK_ONE_LAUNCH 1
#endif
struct Args { const float* in[19]; float* out; unsigned char* ws; int ph_lo, ph_hi; };
__global__ void __launch_bounds__(NWAVES * 64, 2) fwd(Args args) {
    extern __shared__ __attribute__((aligned(16))) unsigned char lds[];
    Frame F;
    F.lds = (LAS unsigned char*)lds;
    F.MISC = (volatile LAS unsigned*)(F.lds + MISC_OFF);
    F.tid = threadIdx.x; F.lane = F.tid & 63; F.wave = __builtin_amdgcn_readfirstlane(F.tid >> 6);
    F.G = gridDim.x; { const int bx = blockIdx.x; F.vcu = (F.G % 8 == 0) ? (bx % 8) * (F.G / 8) + bx / 8 : bx; }
    unsigned char* ws = args.ws;
    for (int u = F.tid; u < (LDS_BYTES - LDSCTL_OFF) / 4; u += NWAVES * 64) ((LAS unsigned*)(F.lds + LDSCTL_OFF))[u] = 0u;
    __syncthreads();
    const int lo = args.ph_lo, hi = args.ph_hi;
    XcdBarrier bar; bar.bar = (unsigned*)(ws + WS_CTL); bar.x = 0; bar.st = nullptr;
    if (hi - lo > 1) bar = xcd_barrier_post((unsigned*)(ws + WS_CTL), F.MISC + 8);
#ifndef ONLY_PHASE
#define ONLY_PHASE -1
#endif
#define IN(k) (lo <= (k) && (k) < hi && (ONLY_PHASE < 0 || ONLY_PHASE == (k)))
#define SEAM(k) do { if (IN(k) && IN((k) + 1)) xcd_barrier(bar); } while (0)
    const float* const* in = args.in;
    bf16* hD = (bf16*)args.out;
    bf16* hB = (bf16*)(ws + WS_B0 + (size_t)SLACK * ROWB);
    const pg8::f32x2* rope = (const pg8::f32x2*)(ws + WS_ROPE);
    using pg8::Gemm; using pg8::StaticOrder;
    const int cid = (int)blockIdx.x;

    if (IN(0)) { p0_prologue(F, in, ws, hD); } SEAM(0);
    if (IN(1)) { Gemm g{hD, (const bf16*)(ws + W_IN), 1024, 1024, 1024}; StaticOrder S; S.init(MT, 5, F.G, cid);
        pg8::EpiProj E{(bf16*)(ws + R_CQKV), (float*)(ws + R_SSQ), (bf16*)(ws + R_KROPE), rope};
        pg8::gemm_phase<pg8::EpiProj, StaticOrder, true, true>(F.lds + RING_OFF, g, S, E); } SEAM(1);
    if (IN(2)) {
        { Gemm g{(const bf16*)(ws + R_CQKV), (const bf16*)(ws + W_UQ), 768, 1024, 768}; StaticOrder S; S.init(MT, 6, F.G, cid);
          pg8::EpiQ E{(bf16*)(ws + R_Q), (const float*)(ws + R_SSQ), rope};
          pg8::gemm_phase<pg8::EpiQ, StaticOrder, true, true>(F.lds + RING_OFF, g, S, E); }
        { Gemm g{(const bf16*)(ws + R_CQKV) + 768, (const bf16*)(ws + W_UKV), 256, 1024, 256}; StaticOrder S; S.init(MT, 8, F.G, cid);
          pg8::EpiKV E{(bf16*)(ws + R_KV), (const float*)(ws + R_SSQ)};
          pg8::gemm_phase<pg8::EpiKV, StaticOrder, true, true>(F.lds + RING_OFF, g, S, E); }
    } SEAM(2);
    if (IN(3)) {
#if ATTN_SIMPLE
        attn_simple(F, (const bf16*)(ws + R_Q), (const bf16*)(ws + R_KV), (const bf16*)(ws + R_KROPE), (bf16*)(ws + R_CQKV));
#else
        fa::attn_phase(F.vcu, F.G, (const bf16*)(ws + R_Q), (const bf16*)(ws + R_KV), (const bf16*)(ws + R_KROPE), (bf16*)(ws + R_CQKV), (char*)lds);
#endif
    } SEAM(3);
    if (IN(4)) { Gemm g{(const bf16*)(ws + R_CQKV), (const bf16*)(ws + W_O), 1024, 1024, 1024}; StaticOrder S; S.init(MT, 4, F.G, cid);
        pg8::EpiResid E{hD, (float*)(ws + R_X_L0)};
        pg8::gemm_phase<pg8::EpiResid, StaticOrder, true, true>(F.lds + RING_OFF, g, S, E); } SEAM(4);
    if (IN(5)) { ln_pass<false>(F, (const float*)(ws + R_X_L0), in[17] + 0 * 1024, in[18] + 0 * 1024, hB, nullptr); } SEAM(5);
    if (IN(6)) { Gemm g{hB - 1024, (const bf16*)(ws + W_UP0), 1024, 1024, 1024}; StaticOrder S; S.init(MT_UP, 22, F.G, cid);
        pg8::EpiConvGate E{(bf16*)(ws + R_ACT), in[14], in[15]};
        pg8::gemm_phase<pg8::EpiConvGate, StaticOrder, true, true, true>(F.lds + RING_OFF, g, S, E); } SEAM(6);
    if (IN(7)) { Gemm g{(const bf16*)(ws + R_ACT), (const bf16*)(ws + W_DN0), DFF, DFF, DFF}; StaticOrder S; S.init(MT, 4, F.G, cid);
        pg8::EpiResid E{hB, (float*)(ws + R_X_FFN)};
        pg8::gemm_phase<pg8::EpiResid, StaticOrder, true, true>(F.lds + RING_OFF, g, S, E); } SEAM(7);
    if (IN(8)) { ln_pass<false>(F, (const float*)(ws + R_X_FFN), in[17] + 1 * 1024, in[18] + 1 * 1024, hD, nullptr); } SEAM(8);
    if (IN(9)) { Gemm g{hD, (const bf16*)(ws + W_HIN), 1024, 1024, 1024}; StaticOrder S; S.init(MT, 20, F.G, cid);
        pg8::EpiHgIn E{hB, (bf16*)(ws + R_HV), (bf16*)(ws + R_HKF), (bf16*)(ws + R_HKB), (bf16*)(ws + R_HSG), (const float*)(ws + WS_LB)};
        pg8::gemm_phase<pg8::EpiHgIn, StaticOrder, true, true>(F.lds + RING_OFF, g, S, E); } SEAM(9);
    if (IN(10)) { gla_simple(F, hB, (const bf16*)(ws + R_HV), (bf16*)(ws + R_HKF), (const bf16*)(ws + R_HKB), (const bf16*)(ws + R_HSG), in[11]); } SEAM(10);
    if (IN(11)) { Gemm g{hB, (const bf16*)(ws + W_HO), 1024, 1024, 1024}; StaticOrder S; S.init(MT, 4, F.G, cid);
        pg8::EpiResid E{hD, (float*)(ws + R_X_HG)};
        pg8::gemm_phase<pg8::EpiResid, StaticOrder, true, true>(F.lds + RING_OFF, g, S, E); } SEAM(11);
    if (IN(12)) { ln_pass<false>(F, (const float*)(ws + R_X_HG), in[17] + 2 * 1024, in[18] + 2 * 1024, hB, nullptr); } SEAM(12);
    if (IN(13)) { Gemm g{hB - 1024, (const bf16*)(ws + W_UP1), 1024, 1024, 1024}; StaticOrder S; S.init(MT_UP, 22, F.G, cid);
        pg8::EpiConvGate E{(bf16*)(ws + R_ACT), in[14] + 3 * NUP, in[15] + NUP};
        pg8::gemm_phase<pg8::EpiConvGate, StaticOrder, true, true, true>(F.lds + RING_OFF, g, S, E); } SEAM(13);
    if (IN(14)) { Gemm g{(const bf16*)(ws + R_ACT), (const bf16*)(ws + W_DN1), DFF, DFF, DFF}; StaticOrder S; S.init(MT, 4, F.G, cid);
        pg8::EpiResid E{hB, (float*)(ws + R_X_FFN)};
        pg8::gemm_phase<pg8::EpiResid, StaticOrder, true, true>(F.lds + RING_OFF, g, S, E); } SEAM(14);
    if (IN(15)) { ln_pass<true>(F, (const float*)(ws + R_X_FFN), in[17] + 3 * 1024, in[18] + 3 * 1024, nullptr, args.out); }
#undef IN
#undef SEAM
}

__global__ void nan_fill(float* o, long n) { const float q = __builtin_nanf(""); for (long i = blockIdx.x * 256L + threadIdx.x; i < n; i += gridDim.x * 256L) o[i] = q; }
extern "C" void kernel_launch(void* const* d_in, const int* in_sizes, int n_in, void* d_out, int out_size, void* d_ws, size_t ws_size, hipStream_t stream) {
    static int grid = 0;
    if (grid == 0) {
        bool ok = (n_in == 19) && in_sizes[0] == 16 * SEQ * 1024 && in_sizes[1] == 4 * SEQ * 1024 && out_size == NB * SEQ * 1024 && ws_size >= WS_END;
        int dev = 0, cus = 0;
        if (ok) ok = hipGetDevice(&dev) == hipSuccess && hipDeviceGetAttribute(&cus, hipDeviceAttributeMultiprocessorCount, dev) == hipSuccess;
        if (ok) ok = hipFuncSetAttribute((const void*)fwd, hipFuncAttributeMaxDynamicSharedMemorySize, LDS_BYTES) == hipSuccess;
        if (!ok) { fprintf(stderr, "kernel_launch: unexpected shapes / workspace (%zu) / device\n", ws_size); grid = -1; }
        else grid = cus;
        (void)hipGetLastError();
    }
    if (grid < 0) { hipLaunchKernelGGL(nan_fill, dim3(1024), dim3(256), 0, stream, (float*)d_out, (long)out_size); return; }
    (void)hipMemsetAsync((char*)d_ws + WS_CTL, 0, CTL_ZERO_BYTES, stream);
    Args a{};
    for (int i = 0; i < 19; ++i) a.in[i] = (const float*)d_in[i];
    a.out = (float*)d_out; a.ws = (unsigned char*)d_ws;
#if MK_ONE_LAUNCH
    a.ph_lo = 0; a.ph_hi = NPHASE;
    hipLaunchKernelGGL(fwd, dim3(grid), dim3(NWAVES * 64), LDS_BYTES, stream, a);
#else
    for (int p = 0; p < NPHASE; ++p) { a.ph_lo = p; a.ph_hi = p + 1; hipLaunchKernelGGL(fwd, dim3(grid), dim3(NWAVES * 64), LDS_BYTES, stream, a); }
#endif
}
```

```cpp
#include <hip/hip_runtime.h>
#include <cstdio>
constexpr int NB = 20;
constexpr int LP = 4160;
constexpr int PADR = 48, LTOK = 4112, SEQ = 4096, DM = 1024;
constexpr int M = NB * LP;
constexpr int MT = M / 256;
constexpr int DFF = 2816, NUP = 2 * DFF;
constexpr int NBLK62 = (M + 61) / 62;
constexpr int MT_UP = (NBLK62 + 3) / 4;
constexpr float EPS = 1e-6f, ALPHA = 1.4142135623730951f;
constexpr float SM_C = 0.10206207261596575f * 1.4426950408889634f;
#include <cstdint>
namespace pg8 {
#define PG8_LAS __attribute__((address_space(3)))
typedef unsigned short bf16_t;
typedef short bf16x8 __attribute__((ext_vector_type(8)));
typedef float f32x4 __attribute__((ext_vector_type(4)));
typedef unsigned u32x4 __attribute__((ext_vector_type(4)));
typedef unsigned u32x2 __attribute__((ext_vector_type(2)));
constexpr int BM = 256, BK = 64, HALF = 128, HTB = HALF * BK * 2  , STAGE_BYTES = 8 * HTB, NXCD = 8, WGM = 8;

__host__ __device__ __forceinline__ int lds_byte(int r, int c) { const int st = (r >> 4) * 2 + (c >> 5), rr = r & 15, cc = c & 31, ob = rr * 64 + cc * 2; return st * 1024 + (ob ^ (((ob >> 9) & 1) << 5)); }
__host__ __device__ __forceinline__ void stage_rc(int b, int& R, int& C) { const int st = b / 1024, sb = b % 1024, swz = sb ^ (((sb >> 9) & 1) << 5); R = (st >> 1) * 16 + swz / 64; C = (st & 1) * 32 + (swz % 64) / 2; }
__host__ __device__ __forceinline__ int perm32(int rho) { const int n = rho >> 4, i = rho & 15; return 8 * (i >> 2) + 4 * n + (i & 3); }

struct Unit { int pm, pn; };
struct Gemm { const bf16_t* A; const bf16_t* Bt; int K, lda, ldb; };

struct StaticOrder {
    int nM, nN, nwg, G, c;
    __host__ __device__ void init(int nM_, int nN_, int G_, int c_) { nM = nM_; nN = nN_; nwg = nM * nN; G = G_; c = c_; }
    __host__ __device__ bool next(int i, Unit& u) const {
        const long L = (long)i * G + c; if (L >= nwg) return false;
        int wgid = (int)L; { const int q = nwg / NXCD, r = nwg % NXCD, xcd = wgid % NXCD, off = wgid / NXCD; wgid = (xcd < r ? xcd * (q + 1) : r * (q + 1) + (xcd - r) * q) + off; }
        const int nig = WGM * nN, gid = wgid / nig, fm = gid * WGM, gsz = (nM - fm) < WGM ? (nM - fm) : WGM;
        u.pm = fm + ((wgid % nig) % gsz); u.pn = (wgid % nig) / gsz; return true;
    }
    __device__ __forceinline__ void a_ready(const Unit&) const {}
    __device__ __forceinline__ void done(const Unit&) const {}
};
__device__ __forceinline__ unsigned cvt_pk_bf16(float lo, float hi) { unsigned r; asm volatile("v_cvt_pk_bf16_f32 %0, %1, %2" : "=v"(r) : "v"(lo), "v"(hi)); return r; }
__device__ __forceinline__ float bf_lo(unsigned w) { return __uint_as_float(w << 16); }
__device__ __forceinline__ float bf_hi(unsigned w) { return __uint_as_float(w & 0xffff0000u); }
typedef float f32x2 __attribute__((ext_vector_type(2)));
__device__ __forceinline__ u32x4 pack8(const f32x4 v0, const f32x4 v1) { u32x4 w; w.x = cvt_pk_bf16(v0[0], v0[1]); w.y = cvt_pk_bf16(v0[2], v0[3]); w.z = cvt_pk_bf16(v1[0], v1[1]); w.w = cvt_pk_bf16(v1[2], v1[3]); return w; }
__device__ __forceinline__ void rope8(f32x4& v0, f32x4& v1, const f32x2* tab, int pos, int i0) {
    const f32x2* t = tab + pos * 16 + i0;
    const f32x2 c0 = t[0], c1 = t[1], c2 = t[2], c3 = t[3];
    f32x4 a, b;
    a[0] = v0[0] * c0.x - v0[1] * c0.y; a[1] = v0[0] * c0.y + v0[1] * c0.x;
    a[2] = v0[2] * c1.x - v0[3] * c1.y; a[3] = v0[2] * c1.y + v0[3] * c1.x;
    b[0] = v1[0] * c2.x - v1[1] * c2.y; b[1] = v1[0] * c2.y + v1[1] * c2.x;
    b[2] = v1[2] * c3.x - v1[3] * c3.y; b[3] = v1[2] * c3.y + v1[3] * c3.x;
    v0 = a; v1 = b;
}
struct EpiProj {
    static constexpr bool PERM = true, AFTER_DRAIN = false;
    bf16_t* cqkv; float* ssq; bf16_t* krope; const f32x2* rope;
    __device__ __forceinline__ void operator()(const f32x4 (&acc)[2][2][4][2], const Unit& u, int wr, int wc, int fr, int fq) const {
        const int row0 = u.pm * BM + wr * 64 + fr;
        if (u.pn < 4) {
            const int col0 = u.pn * BM + wc * 32 + 8 * fq;
#pragma unroll
            for (int ai = 0; ai < 2; ++ai)
#pragma unroll
                for (int m = 0; m < 4; ++m) { const int row = row0 + ai * HALF + m * 16; float s = 0.f;
#pragma unroll
                    for (int bj = 0; bj < 2; ++bj) { const f32x4 v0 = acc[ai][bj][m][0], v1 = acc[ai][bj][m][1];
                        s += (v0[0] * v0[0] + v0[1] * v0[1]) + (v0[2] * v0[2] + v0[3] * v0[3]) + (v1[0] * v1[0] + v1[1] * v1[1]) + (v1[2] * v1[2] + v1[3] * v1[3]);
                        *(u32x4*)(cqkv + (size_t)row * 1024 + col0 + bj * HALF) = pack8(v0, v1); }
                    s += __shfl_xor(s, 16); s += __shfl_xor(s, 32);
                    if (fq == 0) ssq[(size_t)row * 16 + u.pn * 4 + wc] = s; }
        } else if (wc == 0) {
#pragma unroll
            for (int ai = 0; ai < 2; ++ai)
#pragma unroll
                for (int m = 0; m < 4; ++m) { const int row = row0 + ai * HALF + m * 16; int pos = row % LP - PADR; pos = pos < 0 ? 0 : pos;
                    f32x4 v0 = acc[ai][0][m][0], v1 = acc[ai][0][m][1]; rope8(v0, v1, rope, pos, 4 * fq);
                    *(u32x4*)(krope + (size_t)row * 32 + 8 * fq) = pack8(v0, v1); }
        }
    }
};
struct EpiQ {
    static constexpr bool PERM = true, AFTER_DRAIN = false;
    bf16_t* Q; const float* ssq; const f32x2* rope;
    __device__ __forceinline__ void operator()(const f32x4 (&acc)[2][2][4][2], const Unit& u, int wr, int wc, int fr, int fq) const {
        const int row0 = u.pm * BM + wr * 64 + fr, col0 = u.pn * BM + wc * 32 + 8 * fq;
#pragma unroll
        for (int ai = 0; ai < 2; ++ai)
#pragma unroll
            for (int m = 0; m < 4; ++m) { const int row = row0 + ai * HALF + m * 16; int pos = row % LP - PADR; pos = pos < 0 ? 0 : pos;
                const f32x4* sp = (const f32x4*)(ssq + (size_t)row * 16); const f32x4 s0 = sp[0], s1 = sp[1], s2 = sp[2];
                const float ss = ((s0[0] + s0[1]) + (s0[2] + s0[3])) + ((s1[0] + s1[1]) + (s1[2] + s1[3])) + ((s2[0] + s2[1]) + (s2[2] + s2[3]));
                const float rstd = 1.0f / sqrtf(ss * (1.0f / 768.0f) + EPS);
#pragma unroll
                for (int bj = 0; bj < 2; ++bj) { const int c = col0 + bj * HALF, d = c % 96; f32x4 v0 = acc[ai][bj][m][0] * rstd, v1 = acc[ai][bj][m][1] * rstd;
                    if (d >= 64) rope8(v0, v1, rope, pos, (d - 64) >> 1);
                    *(u32x4*)(Q + (size_t)row * 1536 + c) = pack8(v0, v1); } }
    }
};
struct EpiKV {
    static constexpr bool PERM = true, AFTER_DRAIN = false;
    bf16_t* KV; const float* ssq;
    __device__ __forceinline__ void operator()(const f32x4 (&acc)[2][2][4][2], const Unit& u, int wr, int wc, int fr, int fq) const {
        const int row0 = u.pm * BM + wr * 64 + fr, col0 = u.pn * BM + wc * 32 + 8 * fq;
#pragma unroll
        for (int ai = 0; ai < 2; ++ai)
#pragma unroll
            for (int m = 0; m < 4; ++m) { const int row = row0 + ai * HALF + m * 16;
                const f32x4 s3 = *(const f32x4*)(ssq + (size_t)row * 16 + 12);
                const float rstd = 1.0f / sqrtf(((s3[0] + s3[1]) + (s3[2] + s3[3])) * (1.0f / 256.0f) + EPS);
#pragma unroll
                for (int bj = 0; bj < 2; ++bj) *(u32x4*)(KV + (size_t)row * 2048 + col0 + bj * HALF) = pack8(acc[ai][bj][m][0] * rstd, acc[ai][bj][m][1] * rstd); }
    }
};
struct EpiResid {
    static constexpr bool PERM = false, AFTER_DRAIN = false;
    const bf16_t* h; float* X;
    __device__ __forceinline__ void operator()(const f32x4 (&acc)[2][2][4][2], const Unit& u, int wr, int wc, int fr, int fq) const {
        const int row0 = u.pm * BM + wr * 64 + fr, col0 = u.pn * BM + wc * 32 + 4 * fq;
#pragma unroll
        for (int ai = 0; ai < 2; ++ai)
#pragma unroll
            for (int m = 0; m < 4; ++m) { const size_t off = (size_t)(row0 + ai * HALF + m * 16) * 1024 + col0;
#pragma unroll
                for (int bj = 0; bj < 2; ++bj)
#pragma unroll
                    for (int n = 0; n < 2; ++n) { const u32x2 hw = *(const u32x2*)(h + off + bj * HALF + n * 16);
                        f32x4 hv; hv[0] = bf_lo(hw.x); hv[1] = bf_hi(hw.x); hv[2] = bf_lo(hw.y); hv[3] = bf_hi(hw.y);
                        *(f32x4*)(X + off + bj * HALF + n * 16) = hv * ALPHA + acc[ai][bj][m][n]; } }
    }
};
struct EpiHgIn {
    static constexpr bool PERM = true, AFTER_DRAIN = false;
    bf16_t* q; bf16_t* v; bf16_t* kf; bf16_t* kb; bf16_t* sg; const float* lb;
    __device__ __forceinline__ void operator()(const f32x4 (&acc)[2][2][4][2], const Unit& u, int wr, int wc, int fr, int fq) const {
        const int row0 = u.pm * BM + wr * 64 + fr, t = u.pn >> 2, col0 = (u.pn & 3) * BM + wc * 32 + 8 * fq;
        bf16_t* dst = t == 0 ? q : t == 1 ? v : t == 2 ? kf : t == 3 ? kb : sg;
#pragma unroll
        for (int bj = 0; bj < 2; ++bj) { const int c = col0 + bj * HALF;
            f32x4 om0 = {1.f, 1.f, 1.f, 1.f}, om1 = om0;
            if (t == 2 || t == 3) { const f32x4* lp = (const f32x4*)(lb + (t - 2) * 1024 + c); om0 = 1.0f - lp[0]; om1 = 1.0f - lp[1]; }
#pragma unroll
            for (int ai = 0; ai < 2; ++ai)
#pragma unroll
                for (int m = 0; m < 4; ++m) { const int row = row0 + ai * HALF + m * 16; const bool pad = (row % LP) < PADR;
                    f32x4 v0 = acc[ai][bj][m][0], v1 = acc[ai][bj][m][1];
                    if (t == 2 || t == 3) {
#pragma unroll
                        for (int j = 0; j < 4; ++j) { v0[j] = pad ? 0.f : om0[j] * __builtin_amdgcn_rcpf(1.0f + __builtin_amdgcn_exp2f(v0[j] * 1.4426950408889634f));
                                                      v1[j] = pad ? 0.f : om1[j] * __builtin_amdgcn_rcpf(1.0f + __builtin_amdgcn_exp2f(v1[j] * 1.4426950408889634f)); }
                    } else if (t == 4) {
#pragma unroll
                        for (int j = 0; j < 4; ++j) { v0[j] = v0[j] * __builtin_amdgcn_rcpf(1.0f + __builtin_amdgcn_exp2f(v0[j] * -1.4426950408889634f));
                                                      v1[j] = v1[j] * __builtin_amdgcn_rcpf(1.0f + __builtin_amdgcn_exp2f(v1[j] * -1.4426950408889634f)); }
                    }
                    *(u32x4*)(dst + (size_t)row * 1024 + c) = pack8(v0, v1); } }
    }
};
struct EpiConvGate {
    static constexpr bool PERM = true, AFTER_DRAIN = false;
    bf16_t* act; const float* cw; const float* cb;
    __device__ __forceinline__ void operator()(const f32x4 (&acc)[2][2][4][2], const Unit& u, int wr, int wc, int fr, int fq) const {
        const int lane = fq * 16 + fr, lprev = fq * 16 + ((fr + 15) & 15), lnext = fq * 16 + ((fr + 1) & 15);
        const int cv0 = 128 * u.pn + 32 * wc + 8 * fq;
#pragma unroll
        for (int n = 0; n < 2; ++n)
#pragma unroll
          for (int jp = 0; jp < 2; ++jp) { const int cv = cv0 + 4 * n + 2 * jp;
            const f32x2 wv0 = *(const f32x2*)(cw + cv), wv1 = *(const f32x2*)(cw + NUP + cv), wv2 = *(const f32x2*)(cw + 2 * NUP + cv), bv = *(const f32x2*)(cb + cv);
            const f32x2 wg0 = *(const f32x2*)(cw + DFF + cv), wg1 = *(const f32x2*)(cw + NUP + DFF + cv), wg2 = *(const f32x2*)(cw + 2 * NUP + DFF + cv), bg = *(const f32x2*)(cb + DFF + cv);
#pragma unroll
            for (int ai = 0; ai < 2; ++ai) { const int J = 4 * u.pm + 2 * ai + wr;
                float o[4][2];
#pragma unroll
                for (int jj = 0; jj < 2; ++jj) { const int j = 2 * jp + jj;
                    float rv[4], lv[4], rg[4], lg[4];
#pragma unroll
                    for (int m = 0; m < 4; ++m) { rv[m] = __shfl(acc[ai][0][m][n][j], lprev); lv[m] = __shfl(acc[ai][0][m][n][j], lnext);
                                                  rg[m] = __shfl(acc[ai][1][m][n][j], lprev); lg[m] = __shfl(acc[ai][1][m][n][j], lnext); }
#pragma unroll
                    for (int m = 0; m < 4; ++m) {
                        const float pv = fr == 0 ? rv[m == 0 ? 0 : m - 1] : rv[m], nv = fr == 15 ? lv[m == 3 ? 3 : m + 1] : lv[m];
                        const float pg = fr == 0 ? rg[m == 0 ? 0 : m - 1] : rg[m], ng = fr == 15 ? lg[m == 3 ? 3 : m + 1] : lg[m];
                        const float val = wv0[jj] * pv + wv1[jj] * acc[ai][0][m][n][j] + wv2[jj] * nv + bv[jj];
                        const float gat = wg0[jj] * pg + wg1[jj] * acc[ai][1][m][n][j] + wg2[jj] * ng + bg[jj];
                        o[m][jj] = val * gat * __builtin_amdgcn_rcpf(1.0f + __builtin_amdgcn_exp2f(gat * -1.4426950408889634f)); } }
#pragma unroll
                for (int m = 0; m < 4; ++m) { const int R64 = 16 * m + fr; const int rowo = 62 * J - 1 + R64;
                    if (R64 >= 1 && R64 <= 62 && rowo < M) *(unsigned*)(act + (size_t)rowo * DFF + cv) = cvt_pk_bf16(o[m][0], o[m][1]); }
                asm volatile("" ::: "memory"); } }
        (void)lane;
    }
};
template <class Epi, class Sched, bool ALIGN_EPI = false, bool SP2 = false, bool SHIFT = false>
__device__ __forceinline__ void gemm_phase(PG8_LAS unsigned char* lds, const Gemm g, const Sched& S, const Epi& E) {
    const int tid = threadIdx.x, wid = __builtin_amdgcn_readfirstlane(tid >> 6), lane = tid & 63, wr = wid >> 2, wc = wid & 3, fr = lane & 15, fq = lane >> 4;
    const int K = g.K, nt = K / BK;
    unsigned voffA[2], voffB[2];
#pragma unroll
    for (int i = 0; i < 2; ++i) { int R, C; stage_rc(tid * 16 + i * 8192, R, C); const int Rb = Epi::PERM ? ((R & ~31) + perm32(R & 31)) : R;
        const int Ra = SHIFT ? (R - 2 * (R >> 6)) : R; voffA[i] = (unsigned)(Ra * g.lda + C) * 2u; voffB[i] = (unsigned)(Rb * g.ldb + C) * 2u; }
    const size_t kstep = (size_t)(BK * 2);
    const size_t hstepA = (size_t)(SHIFT ? 124 : HALF) * g.lda * 2, hstepB = (size_t)HALF * g.ldb * 2;
    const size_t tstepA = 2 * hstepA, tstepB = 2 * hstepB;
    const unsigned ldsw = (unsigned)wid * 1024u;
    const int aoff = lds_byte(wr * 64 + fr, fq * 8), boff = lds_byte(wc * 32 + fr, fq * 8);
#define PG8_SA(b, h) (((b) * 2 + (h)) * HTB)
#define PG8_SB(b, h) ((4 + (b) * 2 + (h)) * HTB)
#define PG8_STAGE(bufoff, gbase, voff) do { _Pragma("unroll") for (int _i = 0; _i < 2; ++_i) \
        __builtin_amdgcn_global_load_lds((const unsigned*)((const char*)(gbase) + (voff)[_i]), (PG8_LAS unsigned*)(lds + (bufoff) + ldsw + _i * 8192), 16, 0, 0); } while (0)
#define PG8_LDA(dst, b, h) do { _Pragma("unroll") for (int m = 0; m < 4; ++m) _Pragma("unroll") for (int k = 0; k < 2; ++k) dst[m][k] = *(const PG8_LAS bf16x8*)(lds + PG8_SA(b, h) + aoff + m * 2048 + k * 1024); } while (0)
#define PG8_LDB(dst, b, h) do { _Pragma("unroll") for (int n = 0; n < 2; ++n) _Pragma("unroll") for (int k = 0; k < 2; ++k) dst[n][k] = *(const PG8_LAS bf16x8*)(lds + PG8_SB(b, h) + boff + n * 2048 + k * 1024); } while (0)
#define PG8_MMA(ai, bj, At, Bt) do { __builtin_amdgcn_s_setprio(1); _Pragma("unroll") for (int m = 0; m < 4; ++m) _Pragma("unroll") for (int n = 0; n < 2; ++n) _Pragma("unroll") for (int k = 0; k < 2; ++k) \
        acc[ai][bj][m][n] = __builtin_amdgcn_mfma_f32_16x16x32_bf16(Bt[n][k], At[m][k], acc[ai][bj][m][n], 0, 0, 0); __builtin_amdgcn_s_setprio(0); } while (0)
#define PG8_WAIT_V(n) asm volatile("s_waitcnt vmcnt(" #n ")" ::: "memory")
#define PG8_WAIT_L(n) asm volatile("s_waitcnt lgkmcnt(" #n ")" ::: "memory")
#define PG8_BAR __builtin_amdgcn_s_barrier()
#define PG8_SCHED __builtin_amdgcn_sched_barrier(0)
    Unit cur, nxt; int ui = 0;
    if (!S.next(0, cur)) return;
    f32x4 acc[2][2][4][2];
#pragma unroll
    for (int a = 0; a < 2; ++a)
#pragma unroll
        for (int b = 0; b < 2; ++b)
#pragma unroll
            for (int m = 0; m < 4; ++m)
#pragma unroll
                for (int n = 0; n < 2; ++n) acc[a][b][m][n] = (f32x4){0.f, 0.f, 0.f, 0.f};
    bf16x8 At[4][2], B0[2][2], B1[2][2];
    const char* cA = (const char*)g.A + (size_t)cur.pm * tstepA; const char* cB = (const char*)g.Bt + (size_t)cur.pn * tstepB;
    S.a_ready(cur);
    if constexpr (SP2) {
        PG8_STAGE(PG8_SB(0, 0), cB, voffB); PG8_STAGE(PG8_SB(0, 1), cB + hstepB, voffB); PG8_STAGE(PG8_SA(0, 0), cA, voffA); PG8_STAGE(PG8_SA(0, 1), cA + hstepA, voffA);
        if (wr == 1) PG8_BAR;
        PG8_WAIT_V(2); PG8_BAR;
        PG8_STAGE(PG8_SB(1, 0), cB + kstep, voffB); PG8_STAGE(PG8_SA(1, 0), cA + kstep, voffA); PG8_STAGE(PG8_SB(1, 1), cB + hstepB + kstep, voffB);
        PG8_WAIT_V(6); PG8_BAR;
    } else {
        PG8_STAGE(PG8_SB(0, 0), cB, voffB); PG8_STAGE(PG8_SA(0, 0), cA, voffA); PG8_STAGE(PG8_SB(0, 1), cB + hstepB, voffB); PG8_STAGE(PG8_SA(0, 1), cA + hstepA, voffA);
        if (wr == 1) PG8_BAR;
        PG8_WAIT_V(4); PG8_BAR;
        PG8_STAGE(PG8_SB(1, 0), cB + kstep, voffB); PG8_STAGE(PG8_SA(1, 0), cA + kstep, voffA); PG8_STAGE(PG8_SB(1, 1), cB + hstepB + kstep, voffB);
        PG8_WAIT_V(6); PG8_BAR;
    }
    for (;;) {
        const bool has_next = S.next(ui + 1, nxt);
        const char* nA = has_next ? (const char*)g.A + (size_t)nxt.pm * tstepA : cA; const char* nB = has_next ? (const char*)g.Bt + (size_t)nxt.pn * tstepB : cB;
        for (int t = 0; t < nt; t += 2) {
            const bool last = (t == nt - 2);
            const char* a1 = cA + (size_t)(t + 1) * kstep;
            const char* a2 = last ? nA : cA + (size_t)(t + 2) * kstep; const char* b2 = last ? nB : cB + (size_t)(t + 2) * kstep;
            const char* a3 = a2 + kstep; const char* b3 = b2 + kstep;
            if (last && has_next) S.a_ready(nxt);
            if constexpr (SP2) {
            PG8_LDB(B0, 0, 0); PG8_LDB(B1, 0, 1); PG8_SCHED; PG8_LDA(At, 0, 0); PG8_STAGE(PG8_SA(1, 1), a1 + hstepA, voffA);
            PG8_WAIT_V(8); PG8_WAIT_L(0); PG8_BAR; PG8_MMA(0, 0, At, B0); PG8_MMA(0, 1, At, B1); PG8_BAR; PG8_SCHED;
            PG8_LDA(At, 0, 1); PG8_STAGE(PG8_SB(0, 0), b2, voffB); PG8_STAGE(PG8_SB(0, 1), b2 + hstepB, voffB); PG8_STAGE(PG8_SA(0, 0), a2, voffA);
            PG8_WAIT_V(8); PG8_WAIT_L(0); PG8_BAR; PG8_MMA(1, 0, At, B0); PG8_MMA(1, 1, At, B1); PG8_BAR; PG8_SCHED;
            PG8_LDB(B0, 1, 0); PG8_LDB(B1, 1, 1); PG8_SCHED; PG8_LDA(At, 1, 0); PG8_STAGE(PG8_SA(0, 1), a2 + hstepA, voffA);
            PG8_WAIT_V(8); PG8_WAIT_L(0); PG8_BAR; PG8_MMA(0, 0, At, B0); PG8_MMA(0, 1, At, B1); PG8_BAR; PG8_SCHED;
            PG8_LDA(At, 1, 1); PG8_STAGE(PG8_SB(1, 0), b3, voffB); PG8_STAGE(PG8_SB(1, 1), b3 + hstepB, voffB); PG8_STAGE(PG8_SA(1, 0), a3, voffA);
            PG8_WAIT_V(8); PG8_WAIT_L(0); PG8_BAR; PG8_MMA(1, 0, At, B0); PG8_MMA(1, 1, At, B1); PG8_BAR; PG8_SCHED;
            } else {
            PG8_LDB(B0, 0, 0); PG8_SCHED; PG8_LDA(At, 0, 0); PG8_STAGE(PG8_SA(1, 1), a1 + hstepA, voffA);
            PG8_WAIT_L(8); PG8_BAR; PG8_WAIT_L(0); PG8_MMA(0, 0, At, B0); PG8_BAR; PG8_SCHED;
            PG8_LDB(B1, 0, 1); PG8_STAGE(PG8_SB(0, 0), b2, voffB);
            PG8_BAR; PG8_WAIT_L(0); PG8_MMA(0, 1, At, B1); PG8_BAR;
            PG8_LDA(At, 0, 1); PG8_STAGE(PG8_SA(0, 0), a2, voffA);
            PG8_BAR; PG8_WAIT_L(0); PG8_MMA(1, 0, At, B0); PG8_BAR; PG8_SCHED;
            PG8_STAGE(PG8_SB(0, 1), b2 + hstepB, voffB);
            PG8_WAIT_V(6); PG8_BAR; PG8_MMA(1, 1, At, B1); PG8_BAR;
            PG8_LDB(B0, 1, 0); PG8_SCHED; PG8_LDA(At, 1, 0); PG8_STAGE(PG8_SA(0, 1), a2 + hstepA, voffA);
            PG8_WAIT_L(8); PG8_BAR; PG8_WAIT_L(0); PG8_MMA(0, 0, At, B0); PG8_BAR; PG8_SCHED;
            PG8_LDB(B1, 1, 1); PG8_STAGE(PG8_SB(1, 0), b3, voffB);
            PG8_BAR; PG8_WAIT_L(0); PG8_MMA(0, 1, At, B1); PG8_BAR;
            PG8_LDA(At, 1, 1); PG8_STAGE(PG8_SA(1, 0), a3, voffA);
            PG8_BAR; PG8_WAIT_L(0); PG8_MMA(1, 0, At, B0); PG8_BAR; PG8_SCHED;
            PG8_STAGE(PG8_SB(1, 1), b3 + hstepB, voffB);
            PG8_WAIT_V(6); PG8_BAR; PG8_MMA(1, 1, At, B1); PG8_BAR;
            }
        }
        if constexpr (ALIGN_EPI) { if (wr == 0) PG8_BAR; }
        if constexpr (!Epi::AFTER_DRAIN) { E(acc, cur, wr, wc, fr, fq); S.done(cur); }
        if (!has_next) break;
#pragma unroll
        for (int a = 0; a < 2; ++a)
#pragma unroll
            for (int b = 0; b < 2; ++b)
#pragma unroll
                for (int m = 0; m < 4; ++m)
#pragma unroll
                    for (int n = 0; n < 2; ++n) acc[a][b][m][n] = (f32x4){0.f, 0.f, 0.f, 0.f};
        cur = nxt; cA = nA; cB = nB; ++ui;
        if constexpr (ALIGN_EPI) { if (wr == 1) PG8_BAR; }
    }
    PG8_WAIT_V(0);
    if constexpr (!ALIGN_EPI) { if (wr == 0) PG8_BAR; }
    PG8_BAR;
    if constexpr (Epi::AFTER_DRAIN) { E.fused(acc, cur, wr, wc, fr, fq, lds, wid, lane); S.done(cur); }
#undef PG8_SA
#undef PG8_SB
#undef PG8_STAGE
#undef PG8_LDA
#undef PG8_LDB
#undef PG8_MMA
#undef PG8_WAIT_V
#undef PG8_WAIT_L
#undef PG8_BAR
#undef PG8_SCHED
}
}
#define GAS __attribute__((address_space(1)))
#define LAS __attribute__((address_space(3)))
typedef unsigned short bf16;
typedef unsigned v4u __attribute__((ext_vector_type(4)));
typedef unsigned v2u __attribute__((ext_vector_type(2)));
typedef float f32x4 __attribute__((ext_vector_type(4)));
typedef float f32x2 __attribute__((ext_vector_type(2)));
typedef GAS unsigned gu32;
using pg8::cvt_pk_bf16; using pg8::bf_lo; using pg8::bf_hi;

constexpr size_t MiB = 1u << 20;
constexpr size_t WS_CTL = 0, CTL_ZERO_BYTES = 64 * 1024;
constexpr size_t WS_ROPE = 1 * MiB;
constexpr size_t WS_LB = WS_ROPE + 640 * 1024;
constexpr size_t WS_W = 2 * MiB;
constexpr size_t W_IN = WS_W, W_UQ = W_IN + 1280ull * 1024 * 2, W_UKV = W_UQ + 1536ull * 768 * 2, W_O = W_UKV + 2048ull * 256 * 2, W_HIN = W_O + 1024ull * 1024 * 2,
                 W_HO = W_HIN + 5120ull * 1024 * 2, W_UP0 = W_HO + 1024ull * 1024 * 2, W_UP1 = W_UP0 + 5632ull * 1024 * 2, W_DN0 = W_UP1 + 5632ull * 1024 * 2, W_DN1 = W_DN0 + 1024ull * 2816 * 2,
                 W_END = W_DN1 + 1024ull * 2816 * 2;
static_assert(W_END <= 55 * MiB, "weights");
constexpr int SLACK = 256;
constexpr size_t ROWB = 2048;
constexpr size_t WS_B0 = 55 * MiB, B0_BYTES = (size_t)(M + 2 * SLACK) * ROWB;
static_assert(B0_BYTES <= 164 * MiB, "B0");
constexpr size_t WS_R = 219 * MiB;
constexpr size_t R_CQKV = WS_R;
constexpr size_t R_Q = R_CQKV + 164 * MiB;
constexpr size_t R_KV = R_Q + 245 * MiB;
constexpr size_t R_KROPE = R_KV + 326 * MiB;
constexpr size_t R_SSQ = R_KROPE + 6 * MiB;
constexpr size_t R_X_L0 = R_Q;
constexpr size_t R_ACT = WS_R;
constexpr size_t R_X_FFN = WS_R + 448 * MiB;
constexpr size_t R_HV = WS_R, R_HKF = WS_R + 163 * MiB, R_HKB = WS_R + 326 * MiB, R_HSG = WS_R + 489 * MiB;
constexpr size_t R_X_HG = WS_R;
constexpr size_t WS_END = 1024 * MiB;
static_assert(R_SSQ + (size_t)M * 16 * 4 <= WS_END && R_X_FFN + (size_t)M * 4096 <= WS_END && R_HSG + (size_t)M * ROWB <= WS_END, "d_ws map");
static_assert((size_t)M * 1536 * 2 + 64 * 3072 <= 245 * MiB && (size_t)M * 4096 + 64 * 4096 <= 326 * MiB && (size_t)M * DFF * 2 <= 448 * MiB && (size_t)M * ROWB <= 163 * MiB, "d_ws map 2");

constexpr int RING_OFF = 0, RING_BYTES = 131072;
constexpr int LDSCTL_OFF = 146432, MISC_OFF = LDSCTL_OFF + 320;
constexpr int LDS_BYTES = 147456;
constexpr int NWAVES = 8;

#define RLX_AGENT __ATOMIC_RELAXED, __HIP_MEMORY_SCOPE_AGENT
#define XB_TMO      128
#define XB_XCNT(j)  (256  + 64 * (j))
#define XB_XSUB(j)  (1280 + 64 * (j))
#define XB_XGEN(j)  (2304 + 64 * (j))
#define XB_TOP      3328
#define XB_TOPGEN   3392
#define XCD_BAR_WORDS 3456
#define XB_SPIN_CAP (1u << 18)

__device__ __forceinline__ unsigned xb_ld(unsigned* p)              { return __hip_atomic_load(p, __ATOMIC_RELAXED, __HIP_MEMORY_SCOPE_AGENT); }
__device__ __forceinline__ unsigned xb_add(unsigned* p, unsigned v) { return __hip_atomic_fetch_add(p, v, __ATOMIC_RELAXED, __HIP_MEMORY_SCOPE_AGENT); }
__device__ __forceinline__ unsigned xb_xcc_id() { return (unsigned)__builtin_amdgcn_s_getreg((3 << 11) | 20) & 0xFu; }
#define XB_SPIN(cond, bar) do { unsigned _sp = 0; while (cond) { __builtin_amdgcn_s_sleep(1); \
    if ((++_sp & 255u) == 0u) { if (xb_ld(&(bar)[XB_TMO])) break; if (_sp > XB_SPIN_CAP) { atomicAdd(&(bar)[XB_TMO], 1u); break; } } } } while (0)

struct XcdBarrier {
    unsigned* bar; unsigned x;
    volatile LAS unsigned* st;
};

__device__ __forceinline__ XcdBarrier xcd_barrier_post(unsigned* bar, volatile LAS unsigned* st) {
    XcdBarrier b; b.bar = bar; b.x = xb_xcc_id(); b.st = st;
    if (threadIdx.x == 0) (void)xb_add(&bar[XB_XCNT(b.x)], 1u);
    return b;
}
__device__ __forceinline__ void xcd_barrier_complete(unsigned* bar, unsigned x, unsigned& nloc, unsigned& nx) {
    const unsigned G = gridDim.x * gridDim.y * gridDim.z;
    unsigned sum, cnt, mine, sp = 0u;
    for (;;) {
        sum = 0u; cnt = 0u; mine = 0u;
#pragma unroll
        for (unsigned j = 0; j < 16; ++j) { const unsigned c = xb_ld(&bar[XB_XCNT(j)]); sum += c; cnt += (c > 0u) ? 1u : 0u; mine = (j == x) ? c : mine; }
        if (sum == G) break;
        __builtin_amdgcn_s_sleep(1);
        if ((++sp & 255u) == 0u) { if (xb_ld(&bar[XB_TMO])) break; if (sp > XB_SPIN_CAP) { atomicAdd(&bar[XB_TMO], 1u); break; } }
    }
    nloc = mine > 0u ? mine : 1u; nx = cnt > 0u ? cnt : 1u;
}

__device__ __forceinline__ void xcd_barrier(const XcdBarrier& b) {
    asm volatile("s_waitcnt vmcnt(0)" ::: "memory");
    __syncthreads();
    if (threadIdx.x == 0) {
        unsigned* bar = b.bar;
        __builtin_amdgcn_s_waitcnt(0);
        unsigned nloc = b.st[0], nx = b.st[1];
        if (nloc == 0u) { xcd_barrier_complete(bar, b.x, nloc, nx); b.st[0] = nloc; b.st[1] = nx; }
        const unsigned old = xb_add(&bar[XB_XSUB(b.x)], 1u);
        const unsigned gen = old / nloc;
        if (old + 1u == (gen + 1u) * nloc) {
            __builtin_amdgcn_fence(__ATOMIC_RELEASE, "agent");
            asm volatile("s_waitcnt vmcnt(0)" ::: "memory");
            const unsigned og = xb_add(&bar[XB_TOP], 1u);
            const unsigned tg = og / nx;
            if (og + 1u == (tg + 1u) * nx) xb_add(&bar[XB_TOPGEN], 1u);
            else XB_SPIN(xb_ld(&bar[XB_TOPGEN]) == tg, bar);
            __builtin_amdgcn_fence(__ATOMIC_ACQUIRE, "agent");
            xb_add(&bar[XB_XGEN(b.x)], 1u);
            asm volatile("s_waitcnt vmcnt(0)" ::: "memory");
        } else {
            XB_SPIN(xb_ld(&bar[XB_XGEN(b.x)]) == gen, bar);
            __builtin_amdgcn_fence(__ATOMIC_ACQUIRE, "agent");
            asm volatile("s_waitcnt vmcnt(0)" ::: "memory");
        }
    }
    __syncthreads();
}

struct Frame {
    LAS unsigned char* lds;
    volatile LAS unsigned* MISC;
    int tid, lane, wave;
    int vcu, G;
};
__device__ __forceinline__ float wave_sum(float v) {
#pragma unroll
    for (int o = 1; o < 64; o <<= 1) v += __shfl_xor(v, o);
    return v;
}
__device__ __forceinline__ unsigned f2bf(float f) { unsigned u = __builtin_bit_cast(unsigned, f); return (u + 0x7fffu + ((u >> 16) & 1u)) >> 16; }
__device__ __forceinline__ unsigned pk2(float lo, float hi) { return f2bf(lo) | (f2bf(hi) << 16); }

__device__ __forceinline__ int src_col(int kind, int n) {
    if (kind == 1) { if (n < 1024) return n; if (n >= 1056) return -1; const int e = n - 1024; return 1024 + ((e & 1) ? 16 + (e >> 1) : (e >> 1)); }
    if (kind == 2) { const int hd = n / 96, d = n % 96; if (d < 64) return n; const int e = d - 64; return hd * 96 + 64 + ((e & 1) ? 16 + (e >> 1) : (e >> 1)); }
    if (kind == 3) { const int pn = n >> 8, r = n & 255; return r < 128 ? 128 * pn + r : DFF + 128 * pn + (r - 128); }
    return n;
}
__device__ __forceinline__ void p0_transpose_item(const float* W, int K, int N, bf16* WT, int kind, const float* gain, LAS float* scr, int item, int lane, int NP) {
    const int nblk = NP / 32, kb = item / nblk, nb = item % nblk, k0 = 64 * kb, n0 = 32 * nb;
    const int sc = src_col(kind, n0 + (lane & 31));
#pragma unroll 8
    for (int i = 0; i < 32; ++i) { const int kk = 2 * i + (lane >> 5); float v = sc >= 0 ? W[(size_t)(k0 + kk) * N + sc] : 0.f; if (gain) v *= gain[k0 + kk]; scr[kk * 33 + (lane & 31)] = v; }
    asm volatile("s_waitcnt lgkmcnt(0)" ::: "memory");
    const int c = lane & 7;
#pragma unroll
    for (int j = 0; j < 4; ++j) { const int n = (lane >> 3) + 8 * j; const LAS float* s = scr + (8 * c) * 33 + n;
        v4u o; o.x = pk2(s[0 * 33], s[1 * 33]); o.y = pk2(s[2 * 33], s[3 * 33]); o.z = pk2(s[4 * 33], s[5 * 33]); o.w = pk2(s[6 * 33], s[7 * 33]);
        *(GAS v4u*)(WT + (size_t)(n0 + n) * K + k0 + 8 * c) = o; }
    asm volatile("s_waitcnt lgkmcnt(0)" ::: "memory");
}
struct WJob { const float* W; bf16* WT; const float* gain; int K, N, NP, kind; };
__device__ __forceinline__ void p0_prologue(Frame& F, const float* const* in, unsigned char* ws, bf16* h0) {
    LAS float* scr = (LAS float*)(F.lds + RING_OFF + F.wave * 16384);
    const int gw = F.vcu * NWAVES + F.wave, NGW = F.G * NWAVES;
#define WJOB(SRC, DST, GAIN, K_, N_, NP_, KIND) { const int nitems = ((K_) / 64) * ((NP_) / 32); for (int it = gw; it < nitems; it += NGW) p0_transpose_item(SRC, K_, N_, (bf16*)(ws + (DST)), KIND, GAIN, scr, it, F.lane, NP_); }
    WJOB(in[3], W_IN, nullptr, 1024, 1056, 1280, 1)
    WJOB(in[6], W_UQ, in[4], 768, 1536, 1536, 2)
    WJOB(in[7], W_UKV, in[5], 256, 2048, 2048, 0)
    WJOB(in[8], W_O, nullptr, 1024, 1024, 1024, 0)
    WJOB(in[9], W_HIN, nullptr, 1024, 5120, 5120, 0)
    WJOB(in[12], W_HO, nullptr, 1024, 1024, 1024, 0)
    WJOB(in[13], W_UP0, nullptr, 1024, NUP, NUP, 3)
    WJOB(in[13] + (size_t)1024 * NUP, W_UP1, nullptr, 1024, NUP, NUP, 3)
    WJOB(in[16], W_DN0, nullptr, DFF, 1024, 1024, 0)
    WJOB(in[16] + (size_t)DFF * 1024, W_DN1, nullptr, DFF, 1024, 1024, 0)
#undef WJOB
    for (int row = gw; row < M; row += NGW) {
        const int b = row / LP, s = row % LP;
        GAS unsigned long long* o8 = (GAS unsigned long long*)(h0 + (size_t)row * 1024) + F.lane;
        if (s < PADR) {
#pragma unroll
            for (int j = 0; j < 4; ++j) o8[64 * j] = 0ull;
        } else {
            const float* src = s < PADR + 16 ? in[2] + (size_t)(s - PADR) * 1024 : (b < 16 ? in[0] + ((size_t)b * SEQ + (s - 64)) * 1024 : in[1] + ((size_t)(b - 16) * SEQ + (s - 64)) * 1024);
            const GAS f32x4* xr = (const GAS f32x4*)src + F.lane;
#pragma unroll
            for (int j = 0; j < 4; ++j) { const f32x4 v = xr[64 * j]; o8[64 * j] = (unsigned long long)pk2(v.x, v.y) | ((unsigned long long)pk2(v.z, v.w) << 32); }
        }
    }
    { const int gt = gw * 64 + F.lane, NGT = NGW * 64; GAS v4u* z0 = (GAS v4u*)(ws + WS_B0); GAS v4u* z1 = (GAS v4u*)(ws + WS_B0 + (size_t)(SLACK + M) * ROWB);
      const int n16 = SLACK * (int)ROWB / 16;
      for (int i = gt; i < n16; i += NGT) { z0[i] = (v4u){0u, 0u, 0u, 0u}; z1[i] = (v4u){0u, 0u, 0u, 0u}; } }
    { const int gt = gw * 64 + F.lane, NGT = NGW * 64; f32x2* tab = (f32x2*)(ws + WS_ROPE);
      for (int i = gt; i < LTOK * 16; i += NGT) { const int pos = i >> 4, k = i & 15;
          const float inv = 1.0f / powf(10000.0f, (float)(2 * k) / 32.0f); const float ang = (float)pos * inv;
          f32x2 cs; cs.x = (float)cos((double)ang); cs.y = (float)sin((double)ang); tab[i] = cs; } }
    { const int gt = gw * 64 + F.lane; float* lb = (float*)(ws + WS_LB);
      if (gt < 2048) { const int d = gt >> 10, k = gt & 1023; const float x0 = in[10][(size_t)(d * 2 + 0) * 1024 + k], x1 = in[10][(size_t)(d * 2 + 1) * 1024 + k];
          lb[gt] = 1.0f / (1.0f + expf(x0 - x1)); } }
}

template <bool FINAL> __device__ __forceinline__ void ln_pass(Frame& F, const float* X, const float* gain, const float* bias, bf16* hout, float* out) {
    const int gw = F.vcu * NWAVES + F.wave, NGW = F.G * NWAVES;
    f32x4 g[4], bb[4];
#pragma unroll
    for (int j = 0; j < 4; ++j) { g[j] = ((const f32x4*)gain)[64 * j + F.lane]; bb[j] = ((const f32x4*)bias)[64 * j + F.lane]; }
    for (int row = gw; row < M; row += NGW) {
        const int b = row / LP, s = row % LP;
        if (FINAL) { if (s < 64) continue; }
        else if (s < PADR) { GAS unsigned long long* o8 = (GAS unsigned long long*)(hout + (size_t)row * 1024) + F.lane;
#pragma unroll
            for (int j = 0; j < 4; ++j) o8[64 * j] = 0ull;
            continue; }
        const GAS f32x4* xr = (const GAS f32x4*)(X + (size_t)row * 1024) + F.lane;
        f32x4 v[4]; float sm = 0.f;
#pragma unroll
        for (int j = 0; j < 4; ++j) { v[j] = xr[64 * j]; sm += (v[j].x + v[j].y) + (v[j].z + v[j].w); }
        const float mean = wave_sum(sm) * (1.f / 1024.f); float s2 = 0.f;
#pragma unroll
        for (int j = 0; j < 4; ++j) { v[j] = v[j] - mean; s2 += (v[j].x * v[j].x + v[j].y * v[j].y) + (v[j].z * v[j].z + v[j].w * v[j].w); }
        const float rstd = 1.f / sqrtf(wave_sum(s2) * (1.f / 1024.f) + EPS);
        if (FINAL) { GAS f32x4* o = (GAS f32x4*)(out + ((size_t)b * SEQ + (s - 64)) * 1024) + F.lane;
#pragma unroll
            for (int j = 0; j < 4; ++j) o[64 * j] = v[j] * rstd * g[j] + bb[j];
        } else { GAS unsigned long long* o8 = (GAS unsigned long long*)(hout + (size_t)row * 1024) + F.lane;
#pragma unroll
            for (int j = 0; j < 4; ++j) { const f32x4 y = v[j] * rstd * g[j] + bb[j]; o8[64 * j] = (unsigned long long)cvt_pk_bf16(y.x, y.y) | ((unsigned long long)cvt_pk_bf16(y.z, y.w) << 32); } }
    }
}
__device__ __forceinline__ void attn_simple(Frame& F, const bf16* Q, const bf16* KV, const bf16* KR, bf16* O) {
    LAS float* Ks = (LAS float*)(F.lds);
    LAS float* Vs = (LAS float*)(F.lds + 64 * 96 * 4);
    constexpr int NQC = 17;
    const int hf = F.tid & 1;
    for (int u = F.vcu; u < NB * 16 * NQC; u += F.G) {
        const int bh = u / NQC, qc = u % NQC, b = bh >> 4, h = bh & 15;
        const int sq = qc * 256 + (F.tid >> 1); const bool vq = sq < LP; const size_t rowq = (size_t)b * LP + (vq ? sq : LP - 1);
        float q[48];
#pragma unroll
        for (int c = 0; c < 6; ++c) { const v4u w = *(const GAS v4u*)(Q + rowq * 1536 + h * 96 + hf * 48 + c * 8);
            q[c * 8 + 0] = bf_lo(w.x); q[c * 8 + 1] = bf_hi(w.x); q[c * 8 + 2] = bf_lo(w.y); q[c * 8 + 3] = bf_hi(w.y);
            q[c * 8 + 4] = bf_lo(w.z); q[c * 8 + 5] = bf_hi(w.z); q[c * 8 + 6] = bf_lo(w.w); q[c * 8 + 7] = bf_hi(w.w); }
        float o[32];
#pragma unroll
        for (int d = 0; d < 32; ++d) o[d] = 0.f;
        float mx = -1e30f, l = 0.f;
        for (int kt = 0; kt < 65; ++kt) {
            __syncthreads();
            for (int idx = F.tid; idx < 64 * 12; idx += 512) { const int j = idx / 12, c = idx % 12; int sk = PADR + kt * 64 + j; sk = sk < LP ? sk : LP - 1; const size_t rk = (size_t)b * LP + sk;
                const v4u w = c < 8 ? *(const GAS v4u*)(KV + rk * 2048 + h * 128 + c * 8) : *(const GAS v4u*)(KR + rk * 32 + (c - 8) * 8);
                LAS float* d = Ks + j * 96 + c * 8; d[0] = bf_lo(w.x); d[1] = bf_hi(w.x); d[2] = bf_lo(w.y); d[3] = bf_hi(w.y); d[4] = bf_lo(w.z); d[5] = bf_hi(w.z); d[6] = bf_lo(w.w); d[7] = bf_hi(w.w); }
            { const int j = F.tid >> 3, c = F.tid & 7; int sk = PADR + kt * 64 + j; sk = sk < LP ? sk : LP - 1; const size_t rk = (size_t)b * LP + sk;
                const v4u w = *(const GAS v4u*)(KV + rk * 2048 + h * 128 + 64 + c * 8);
                LAS float* d = Vs + j * 64 + c * 8; d[0] = bf_lo(w.x); d[1] = bf_hi(w.x); d[2] = bf_lo(w.y); d[3] = bf_hi(w.y); d[4] = bf_lo(w.z); d[5] = bf_hi(w.z); d[6] = bf_lo(w.w); d[7] = bf_hi(w.w); }
            __syncthreads();
            const int nk = (LTOK - kt * 64) < 64 ? (LTOK - kt * 64) : 64;
#pragma unroll 1
            for (int jj = 0; jj < nk; ++jj) {
                const LAS f32x4* kr = (const LAS f32x4*)(Ks + jj * 96 + hf * 48); float a0 = 0.f, a1 = 0.f;
#pragma unroll
                for (int c = 0; c < 12; c += 2) { const f32x4 k0 = kr[c], k1 = kr[c + 1];
                    a0 += q[4 * c] * k0.x + q[4 * c + 1] * k0.y + q[4 * c + 2] * k0.z + q[4 * c + 3] * k0.w;
                    a1 += q[4 * c + 4] * k1.x + q[4 * c + 5] * k1.y + q[4 * c + 6] * k1.z + q[4 * c + 7] * k1.w; }
                float sc = a0 + a1; sc += __shfl_xor(sc, 1); sc *= SM_C;
                const float mn = fmaxf(mx, sc);
                const float al = __builtin_amdgcn_exp2f(mx - mn), p = __builtin_amdgcn_exp2f(sc - mn); mx = mn; l = l * al + p;
                const LAS f32x4* vr = (const LAS f32x4*)(Vs + jj * 64 + hf * 32);
#pragma unroll
                for (int c = 0; c < 8; ++c) { const f32x4 vv = vr[c]; o[4 * c] = fmaf(p, vv.x, o[4 * c] * al); o[4 * c + 1] = fmaf(p, vv.y, o[4 * c + 1] * al); o[4 * c + 2] = fmaf(p, vv.z, o[4 * c + 2] * al); o[4 * c + 3] = fmaf(p, vv.w, o[4 * c + 3] * al); }
            }
        }
        if (vq) { const float il = 1.0f / l;
#pragma unroll
            for (int c = 0; c < 4; ++c) { v4u w; w.x = cvt_pk_bf16(o[8 * c] * il, o[8 * c + 1] * il); w.y = cvt_pk_bf16(o[8 * c + 2] * il, o[8 * c + 3] * il); w.z = cvt_pk_bf16(o[8 * c + 4] * il, o[8 * c + 5] * il); w.w = cvt_pk_bf16(o[8 * c + 6] * il, o[8 * c + 7] * il);
                *(GAS v4u*)(O + rowq * 1024 + h * 64 + hf * 32 + c * 8) = w; } }
    }
    __syncthreads();
}

__device__ __forceinline__ void gla_simple(Frame& F, bf16* Qb, const bf16* Vb, bf16* KFb, const bf16* KBb, const bf16* SGb, const float* onorm) {
    LAS float* tq = (LAS float*)(F.lds);
    LAS float* tk = (LAS float*)(F.lds + 16384);
    LAS float* tv = (LAS float*)(F.lds + 32768);
    LAS float* pr = (LAS float*)(F.lds + 49152);
    const int j = F.tid & 127, kq = F.tid >> 7;
    for (int it = F.vcu; it < NB * 8; it += F.G) {
        const int b = it >> 3, h = it & 7; const size_t cbase = (size_t)h * 128;
        for (int dir = 0; dir < 2; ++dir) {
            float S[32];
#pragma unroll
            for (int k = 0; k < 32; ++k) S[k] = 0.f;
            const bf16* Kg = dir == 0 ? KFb : KBb;
            for (int tile = 0; tile < (LTOK + 31) / 32; ++tile) {
                __syncthreads();
                { const int i = F.tid >> 4, c8 = (F.tid & 15) * 8; const int tt = tile * 32 + i; const bool vt = tt < LTOK; const int tok = dir == 0 ? tt : LTOK - 1 - tt;
                  const size_t off = ((size_t)b * LP + PADR + (vt ? tok : 0)) * 1024 + cbase + c8;
                  v4u wq = *(const GAS v4u*)(Qb + off), wk = *(const GAS v4u*)(Kg + off), wv = *(const GAS v4u*)(Vb + off);
                  if (!vt) { wq = (v4u){0u, 0u, 0u, 0u}; wk = wq; wv = wq; }
                  LAS float* dq = tq + i * 128 + c8; LAS float* dk = tk + i * 128 + c8; LAS float* dv = tv + i * 128 + c8;
                  dq[0] = bf_lo(wq.x); dq[1] = bf_hi(wq.x); dq[2] = bf_lo(wq.y); dq[3] = bf_hi(wq.y); dq[4] = bf_lo(wq.z); dq[5] = bf_hi(wq.z); dq[6] = bf_lo(wq.w); dq[7] = bf_hi(wq.w);
                  dk[0] = bf_lo(wk.x); dk[1] = bf_hi(wk.x); dk[2] = bf_lo(wk.y); dk[3] = bf_hi(wk.y); dk[4] = bf_lo(wk.z); dk[5] = bf_hi(wk.z); dk[6] = bf_lo(wk.w); dk[7] = bf_hi(wk.w);
                  dv[0] = bf_lo(wv.x); dv[1] = bf_hi(wv.x); dv[2] = bf_lo(wv.y); dv[3] = bf_hi(wv.y); dv[4] = bf_lo(wv.z); dv[5] = bf_hi(wv.z); dv[6] = bf_lo(wv.w); dv[7] = bf_hi(wv.w); }
                __syncthreads();
                for (int i = 0; i < 32; ++i) {
                    const float vj = tv[i * 128 + j]; float part = 0.f;
                    const LAS f32x4* kr = (const LAS f32x4*)(tk + i * 128 + kq * 32); const LAS f32x4* qr = (const LAS f32x4*)(tq + i * 128 + kq * 32);
#pragma unroll
                    for (int c = 0; c < 8; ++c) { const f32x4 kk = kr[c], qq = qr[c];
                        S[4 * c] = fmaf(kk.x, vj - S[4 * c], S[4 * c]); part = fmaf(S[4 * c], qq.x, part);
                        S[4 * c + 1] = fmaf(kk.y, vj - S[4 * c + 1], S[4 * c + 1]); part = fmaf(S[4 * c + 1], qq.y, part);
                        S[4 * c + 2] = fmaf(kk.z, vj - S[4 * c + 2], S[4 * c + 2]); part = fmaf(S[4 * c + 2], qq.z, part);
                        S[4 * c + 3] = fmaf(kk.w, vj - S[4 * c + 3], S[4 * c + 3]); part = fmaf(S[4 * c + 3], qq.w, part); }
                    pr[(i * 4 + kq) * 128 + j] = part;
                }
                __syncthreads();
#pragma unroll
                for (int ii = 0; ii < 4; ++ii) { const int i = F.wave * 4 + ii; const int tt = tile * 32 + i; const bool vt = tt < LTOK; const int tok = dir == 0 ? tt : LTOK - 1 - tt;
                    const int c = 2 * F.lane;
                    float o0 = pr[(i * 4 + 0) * 128 + c] + pr[(i * 4 + 1) * 128 + c] + pr[(i * 4 + 2) * 128 + c] + pr[(i * 4 + 3) * 128 + c];
                    float o1 = pr[(i * 4 + 0) * 128 + c + 1] + pr[(i * 4 + 1) * 128 + c + 1] + pr[(i * 4 + 2) * 128 + c + 1] + pr[(i * 4 + 3) * 128 + c + 1];
                    const size_t off = ((size_t)b * LP + PADR + (vt ? tok : 0)) * 1024 + cbase + c;
                    if (dir == 0) { if (vt) *(GAS unsigned*)(KFb + off) = cvt_pk_bf16(o0, o1); }
                    else { const unsigned wf = *(const GAS unsigned*)(KFb + off); o0 += bf_lo(wf); o1 += bf_hi(wf);
                        const float ss = wave_sum(o0 * o0 + o1 * o1); const float rstd = 1.0f / sqrtf(ss * (1.0f / 128.0f) + EPS);
                        const unsigned wg = *(const GAS unsigned*)(SGb + off); const f32x2 gn = *(const f32x2*)(onorm + cbase + c);
                        if (vt) *(GAS unsigned*)(Qb + off) = cvt_pk_bf16(o0 * rstd * gn.x * bf_lo(wg), o1 * rstd * gn.y * bf_hi(wg)); } }
            }
            __syncthreads();
        }
    }
    __syncthreads();
}
namespace fa {
using bf16x8 = __attribute__((ext_vector_type(8))) short;
using s16x4  = __attribute__((ext_vector_type(4))) short;
using f32x16 = __attribute__((ext_vector_type(16))) float;
using u32x4  = __attribute__((ext_vector_type(4))) unsigned;
constexpr int KROW = 208;
constexpr int SHM_V = 64 * 64 * 2, SHM_K = 64 * KROW;
constexpr int OFF_V = 0, OFF_K = 2 * SHM_V, OFF_WS = OFF_K + 2 * SHM_K, OFF_STG = OFF_WS + 8 * 256, LDS_TOTAL = OFF_STG + 8 * 4096;
constexpr int NT = 65, NQC = 17;
constexpr float THR_RAW = 8.0f / 0.10206207261596575f;
#define FA_SBAR() __builtin_amdgcn_sched_barrier(0)
__device__ __forceinline__ int crow(int r, int hi) { return (r & 3) + 8 * (r >> 2) + 4 * hi; }
__device__ __forceinline__ void partialSM(f32x16& p0, f32x16& p1, float& m_reg, float& mn, float& alpha) {
  constexpr float C = SM_C;
  float pmax = p0[0];
#pragma unroll
  for (int r = 1; r < 16; ++r) pmax = fmaxf(pmax, p0[r]);
#pragma unroll
  for (int r = 0; r < 16; ++r) pmax = fmaxf(pmax, p1[r]);
  { auto rr = __builtin_amdgcn_permlane32_swap(__float_as_uint(pmax), __float_as_uint(pmax), false, false);
    pmax = fmaxf(__uint_as_float(rr[0]), __uint_as_float(rr[1])); }
  if (__builtin_expect(__all(pmax - m_reg <= THR_RAW), 1)) { mn = m_reg; alpha = 1.f; }
  else { mn = fmaxf(m_reg, pmax); alpha = __builtin_amdgcn_exp2f((m_reg - mn) * C); m_reg = mn; }
  const float mnC = -mn * C;
#pragma unroll
  for (int r = 0; r < 16; ++r) p0[r] = fmaf(p0[r], C, mnC);
#pragma unroll
  for (int r = 0; r < 16; ++r) p1[r] = fmaf(p1[r], C, mnC);
#pragma unroll
  for (int r = 0; r < 16; ++r) p0[r] = __builtin_amdgcn_exp2f(p0[r]);
}
__device__ __forceinline__ void finishSM(f32x16& p0, f32x16& p1, float alpha, float& l_reg, bf16x8& pa0, bf16x8& pa1, bf16x8& pa2, bf16x8& pa3) {
#pragma unroll
  for (int r = 0; r < 16; ++r) p1[r] = __builtin_amdgcn_exp2f(p1[r]);
  float ps = 0;
#pragma unroll
  for (int r = 0; r < 16; ++r) ps += p0[r];
#pragma unroll
  for (int r = 0; r < 16; ++r) ps += p1[r];
  { auto rr = __builtin_amdgcn_permlane32_swap(__float_as_uint(ps), __float_as_uint(ps), false, false);
    ps = __uint_as_float(rr[0]) + __uint_as_float(rr[1]); }
  l_reg = l_reg * alpha + ps;
#define FA_PK4(P, BASE, OUT) do { unsigned a0 = cvt_pk_bf16(P[BASE + 0], P[BASE + 1]), a1 = cvt_pk_bf16(P[BASE + 2], P[BASE + 3]);   \
    unsigned b0 = cvt_pk_bf16(P[BASE + 4], P[BASE + 5]), b1 = cvt_pk_bf16(P[BASE + 6], P[BASE + 7]);                              \
    auto r0 = __builtin_amdgcn_permlane32_swap(a0, b0, false, false); auto r1 = __builtin_amdgcn_permlane32_swap(a1, b1, false, false); \
    u32x4 w = {r0[0], r1[0], r0[1], r1[1]}; OUT = *reinterpret_cast<bf16x8*>(&w); } while (0)
  FA_PK4(p0, 0, pa0); FA_PK4(p0, 8, pa1); FA_PK4(p1, 0, pa2); FA_PK4(p1, 8, pa3);
#undef FA_PK4
}
__device__ __forceinline__ void qkt(f32x16& p0, f32x16& p1, const char* Ks, const bf16x8* qr, int r32, int hi) {
  p0 = f32x16{}; p1 = f32x16{};
#pragma unroll
  for (int d0 = 0; d0 < 6; ++d0) { const int cb = (d0 * 16 + hi * 8) * 2;
    const bf16x8 b0 = *reinterpret_cast<const bf16x8*>(Ks + r32 * KROW + cb);
    const bf16x8 b1 = *reinterpret_cast<const bf16x8*>(Ks + (32 + r32) * KROW + cb);
    p0 = __builtin_amdgcn_mfma_f32_32x32x16_bf16(b0, qr[d0], p0, 0, 0, 0);
    p1 = __builtin_amdgcn_mfma_f32_32x32x16_bf16(b1, qr[d0], p1, 0, 0, 0); }
}
__device__ __forceinline__ int v_st(int k, int c) { const int kk = (k & ~0xC) | ((k & 4) << 1) | ((k & 8) >> 1); return ((kk >> 3) * 2 + (c >> 5)) * 512 + ((kk & 7) * 32 + (c & 31)) * 2; }
__device__ __forceinline__ int v_rd_base(int lane) { return ((lane & 3) << 3) | (((lane >> 2) & 3) << 6) | (((lane >> 4) & 1) << 5) | (((lane >> 5) & 1) << 8); }
constexpr int v_rd_off(int d0, int ks, int half) { return d0 * 512 + ks * 2048 + half * 1024; }
template <int OFF> __device__ __forceinline__ s16x4 tr_read(int vb) {
  s16x4 r; asm volatile("ds_read_b64_tr_b16 %0, %1 offset:%2" : "=&v"(r) : "v"(vb), "i"(OFF) : "memory"); return r;
}
template <int D0> __device__ __forceinline__ void pv_one(f32x16& od, int vb, bf16x8 pa0, bf16x8 pa1, bf16x8 pa2, bf16x8 pa3) {
  const s16x4 l0 = tr_read<v_rd_off(D0, 0, 0)>(vb), h0 = tr_read<v_rd_off(D0, 0, 1)>(vb), l1 = tr_read<v_rd_off(D0, 1, 0)>(vb), h1 = tr_read<v_rd_off(D0, 1, 1)>(vb);
  const s16x4 l2 = tr_read<v_rd_off(D0, 2, 0)>(vb), h2 = tr_read<v_rd_off(D0, 2, 1)>(vb), l3 = tr_read<v_rd_off(D0, 3, 0)>(vb), h3 = tr_read<v_rd_off(D0, 3, 1)>(vb);
  asm volatile("s_waitcnt lgkmcnt(0)" ::: "memory"); FA_SBAR();
#define FA_PK(L, H) (bf16x8){L[0], L[1], L[2], L[3], H[0], H[1], H[2], H[3]}
  od = __builtin_amdgcn_mfma_f32_32x32x16_bf16(pa0, FA_PK(l0, h0), od, 0, 0, 0);
  od = __builtin_amdgcn_mfma_f32_32x32x16_bf16(pa1, FA_PK(l1, h1), od, 0, 0, 0);
  od = __builtin_amdgcn_mfma_f32_32x32x16_bf16(pa2, FA_PK(l2, h2), od, 0, 0, 0);
  od = __builtin_amdgcn_mfma_f32_32x32x16_bf16(pa3, FA_PK(l3, h3), od, 0, 0, 0);
#undef FA_PK
}
__device__ __forceinline__ void pv_d0(f32x16* o, int vb, bf16x8 pa0, bf16x8 pa1, bf16x8 pa2, bf16x8 pa3) {
  pv_one<0>(o[0], vb, pa0, pa1, pa2, pa3); pv_one<1>(o[1], vb, pa0, pa1, pa2, pa3);
}
__device__ __forceinline__ void attn_unit(int b, int h, int q0, const bf16* __restrict__ Q, const bf16* __restrict__ KV, const bf16* __restrict__ KR, bf16* __restrict__ O, char* lds) {
  const int tid = threadIdx.x, wid = tid >> 6, lane = tid & 63, r32 = lane & 31, hi = lane >> 5;
  char* V_lds = lds + OFF_V; char* K_lds = lds + OFF_K;
  float* ws = (float*)(lds + OFF_WS) + wid * 64; float* li_l = ws; float* al_l = ws + 32;
  float m_reg = -1e30f, l_reg = 0; f32x16 o[2] = {}; bf16x8 qr[6];
  const size_t seq0 = (size_t)b * LP;
  { int sq = q0 + wid * 32 + r32; sq = sq < LP ? sq : LP - 1;
    const bf16* Qw = Q + (seq0 + sq) * 1536 + h * 96 + hi * 8;
#pragma unroll
    for (int d0 = 0; d0 < 6; ++d0) qr[d0] = *reinterpret_cast<const bf16x8*>(Qw + d0 * 16); }
  const int sr = tid >> 3, sc = (tid & 7) * 8, rr = (tid >> 2) & 63, rc = (tid & 3) * 8; const bool hasr = tid < 256;
  const int vst = v_st(sr, sc), kst = sr * KROW + sc * 2, rst = rr * KROW + 128 + rc * 2;
  const bf16* Kn = KV + seq0 * 2048 + h * 128 + (size_t)sr * 2048 + sc; const bf16* Vn = Kn + 64; const bf16* Rn = KR + seq0 * 32 + (size_t)rr * 32 + rc;
  const int vb0 = (int)(uintptr_t)V_lds + v_rd_base(lane);
  struct { bf16x8 vs, ks, rs; } sr_[2];
#define FA_SLOAD(i, k0) do { sr_[i].vs = *reinterpret_cast<const bf16x8*>(Vn + (size_t)(k0) * 2048); sr_[i].ks = *reinterpret_cast<const bf16x8*>(Kn + (size_t)(k0) * 2048); \
    if (hasr) sr_[i].rs = *reinterpret_cast<const bf16x8*>(Rn + (size_t)(k0) * 32); } while (0)
#define FA_SWRITE(bf, i) do { *(bf16x8*)(V_lds + (bf) * SHM_V + vst) = sr_[i].vs; *(bf16x8*)(K_lds + (bf) * SHM_K + kst) = sr_[i].ks; \
    if (hasr) *(bf16x8*)(K_lds + (bf) * SHM_K + rst) = sr_[i].rs; } while (0)
#define FA_SWAIT() asm volatile("s_waitcnt vmcnt(3)" ::: "memory")
#define FA_RESC(a) do { if (__any((a) < 1.f)) { if (hi == 0) al_l[r32] = (a); asm volatile("s_waitcnt lgkmcnt(0)" ::: "memory"); \
    _Pragma("unroll") for (int d = 0; d < 2; ++d) _Pragma("unroll") for (int r = 0; r < 16; ++r) o[d][r] *= al_l[crow(r, hi)]; } } while (0)
  f32x16 pA0, pA1, pB0, pB1; float mnA, mnB, alA, alB; bf16x8 pa0, pa1, pa2, pa3;
  constexpr int SE = 0, SO = 1;
  __syncthreads();
  FA_SLOAD(SE, 0); asm volatile("s_waitcnt vmcnt(0)" ::: "memory"); FA_SWRITE(0, SE); __syncthreads();
  qkt(pA0, pA1, K_lds, qr, r32, hi);
  { const float NEG = -INFINITY;
#pragma unroll
    for (int r = 0; r < 16; ++r) pA0[r] = NEG;
#pragma unroll
    for (int r = 0; r < 8; ++r) pA1[r] = NEG; }
  partialSM(pA0, pA1, m_reg, mnA, alA);
  FA_SLOAD(SO, 64); FA_SLOAD(SE, 128);
  FA_SWAIT(); FA_SWRITE(1, SO); __syncthreads();
  for (int j = 1; j + 1 < NT; j += 2) {
    FA_SBAR(); qkt(pB0, pB1, K_lds + SHM_K, qr, r32, hi);
    finishSM(pA0, pA1, alA, l_reg, pa0, pa1, pa2, pa3); FA_SBAR();
    if (j + 2 < NT) FA_SLOAD(SO, (j + 2) * 64); FA_SBAR();
    pv_d0(o, vb0, pa0, pa1, pa2, pa3); partialSM(pB0, pB1, m_reg, mnB, alB);
    __syncthreads(); FA_SWAIT(); FA_SWRITE(0, SE);
    FA_RESC(alB); __syncthreads();
    FA_SBAR(); qkt(pA0, pA1, K_lds, qr, r32, hi);
    finishSM(pB0, pB1, alB, l_reg, pa0, pa1, pa2, pa3); FA_SBAR();
    if (j + 3 < NT) FA_SLOAD(SE, (j + 3) * 64); FA_SBAR();
    pv_d0(o, vb0 + SHM_V, pa0, pa1, pa2, pa3); partialSM(pA0, pA1, m_reg, mnA, alA);
    __syncthreads(); FA_SWAIT(); if (j + 2 < NT) FA_SWRITE(1, SO);
    FA_RESC(alA); __syncthreads();
  }
  finishSM(pA0, pA1, alA, l_reg, pa0, pa1, pa2, pa3); FA_SBAR();
  pv_d0(o, vb0, pa0, pa1, pa2, pa3);
  if (hi == 0) li_l[r32] = l_reg; asm volatile("s_waitcnt lgkmcnt(0)" ::: "memory");
  float rli[16];
#pragma unroll
  for (int r = 0; r < 16; ++r) rli[r] = __builtin_amdgcn_rcpf(li_l[crow(r, hi)]);
  { unsigned short* stg = (unsigned short*)(lds + OFF_STG) + wid * 2048;
#pragma unroll
    for (int r = 0; r < 16; ++r) { const int orow = crow(r, hi);
#pragma unroll
      for (int d0 = 0; d0 < 2; ++d0) stg[orow * 64 + d0 * 32 + r32] = (unsigned short)(cvt_pk_bf16(o[d0][r] * rli[r], 0.f) & 0xffffu); }
    asm volatile("s_waitcnt lgkmcnt(0)" ::: "memory");
#pragma unroll
    for (int i = 0; i < 4; ++i) { const int row = i * 8 + (lane >> 3), ch = lane & 7; const int sq = q0 + wid * 32 + row; const u32x4 v = *(const u32x4*)(stg + row * 64 + ch * 8);
      if (sq < LP) *(u32x4*)(O + (seq0 + sq) * 1024 + h * 64 + ch * 8) = v; } }
#undef FA_SLOAD
#undef FA_SWRITE
#undef FA_SWAIT
#undef FA_RESC
}
__device__ __forceinline__ void attn_phase(int vcu, int G, const bf16* Q, const bf16* KV, const bf16* KR, bf16* O, char* lds) {
  for (int u = vcu; u < NB * 16 * NQC; u += G) { const int bh = u / NQC, qc = u % NQC; attn_unit(bh >> 4, bh & 15, qc * 256, Q, KV, KR, O, lds); }
  __syncthreads();
}
#undef FA_SBAR
}
namespace gla {
using bf16x8 = __attribute__((ext_vector_type(8))) short;
using s16x4  = __attribute__((ext_vector_type(4))) short;
using f32x16 = __attribute__((ext_vector_type(16))) float;
using u32x4  = __attribute__((ext_vector_type(4))) unsigned;
using u32x2  = __attribute__((ext_vector_type(2))) unsigned;
constexpr int RS = 264;
constexpr int O_QI = 0, O_KI = 64 * RS, O_KD = 2 * 64 * RS, O_VV = O_KD + 16384, O_VEC = O_VV + 16384;
constexpr int V_DEC = O_VEC, V_EREF = O_VEC + 512, V_TOT = O_VEC + 1024, V_F2 = O_VEC + 1024 + 2048;
constexpr int CH_BYTES = O_VEC + 3584;
static_assert(CH_BYTES % 16 == 0 && 2 * CH_BYTES <= 146432, "gla LDS");
#define GLA_SBAR() __builtin_amdgcn_sched_barrier(0)
__device__ __forceinline__ int crow(int r, int hi) { return (r & 3) + 8 * (r >> 2) + 4 * hi; }
__device__ __forceinline__ int v_st4(int k, int c) { const int kk = (k & ~0xC) | ((k & 4) << 1) | ((k & 8) >> 1); return ((kk >> 3) * 4 + (c >> 5)) * 512 + ((kk & 7) * 32 + (c & 31)) * 2; }
__device__ __forceinline__ int v_rd_base(int lane) { return ((lane & 3) << 3) | (((lane >> 2) & 3) << 6) | (((lane >> 4) & 1) << 5) | (((lane >> 5) & 1) << 8); }
template <int OFF> __device__ __forceinline__ s16x4 tr_read(int vb) {
  s16x4 r; asm volatile("ds_read_b64_tr_b16 %0, %1 offset:%2" : "=&v"(r) : "v"(vb), "i"(OFF) : "memory"); return r;
}
__device__ __forceinline__ bf16x8 nat_frag(const char* img, int row, int ks, int hi) {
  const u32x2 a = *(const u32x2*)(img + row * RS + (16 * ks + 4 * hi) * 2), b = *(const u32x2*)(img + row * RS + (16 * ks + 8 + 4 * hi) * 2);
  u32x4 w = {a.x, a.y, b.x, b.y}; return *reinterpret_cast<bf16x8*>(&w);
}
__device__ __forceinline__ bf16x8 pk4(const f32x16& P, int BASE_IS_8) {
  const int B = BASE_IS_8 ? 8 : 0;
  const unsigned a0 = cvt_pk_bf16(P[B + 0], P[B + 1]), a1 = cvt_pk_bf16(P[B + 2], P[B + 3]), b0 = cvt_pk_bf16(P[B + 4], P[B + 5]), b1 = cvt_pk_bf16(P[B + 6], P[B + 7]);
  auto r0 = __builtin_amdgcn_permlane32_swap(a0, b0, false, false); auto r1 = __builtin_amdgcn_permlane32_swap(a1, b1, false, false);
  u32x4 w = {r0[0], r1[0], r0[1], r1[1]}; return *reinterpret_cast<bf16x8*>(&w);
}
#define GLA_PK(L, H) (bf16x8){L[0], L[1], L[2], L[3], H[0], H[1], H[2], H[3]}
__device__ __forceinline__ void gla_phase(int vcu, int G, bf16* Qb, const bf16* Vb, bf16* KFb, bf16* KBb, const bf16* SGb, const float* onorm, char* lds) {
  const int tid = threadIdx.x, wid = __builtin_amdgcn_readfirstlane(tid >> 6), lane = tid & 63, r32 = lane & 31, hi = lane >> 5;
  const int dir = wid >> 2, w4 = wid & 3, ct = tid & 255, kp = ct & 63;
  char* L = lds + dir * CH_BYTES;
  const int lbase = (int)(uintptr_t)L;
  const int vbV = lbase + O_VV + v_rd_base(lane) + w4 * 512, vbK = lbase + O_KD + v_rd_base(lane);
  bf16* Kown = dir ? KBb : KFb; const bf16* Koth = dir ? KFb : KBb;
  for (int it = vcu; it < NB * 8; it += G) {
    const int b = it >> 3, h = it & 7, cb = h * 128; const size_t seq0 = (size_t)b * LP;
    f32x16 S[4];
#pragma unroll
    for (int kb = 0; kb < 4; ++kb) S[kb] = f32x16{};
    unsigned pq[16], pk[16]; bf16x8 pvv[4];
#define GLA_ROW(n, tl) ((n) * 64 + (dir ? 63 - (tl) : (tl)))
#define GLA_LOAD(n) do { _Pragma("unroll") for (int i = 0; i < 16; ++i) { const size_t off = (seq0 + GLA_ROW(n, 16 * w4 + i)) * 1024 + cb + 2 * kp; \
        pq[i] = *(const unsigned*)(Qb + off); pk[i] = *(const unsigned*)(Kown + off); } \
      _Pragma("unroll") for (int i = 0; i < 4; ++i) { const int id = ct + 256 * i; pvv[i] = *(const bf16x8*)(Vb + (seq0 + GLA_ROW(n, id >> 4)) * 1024 + cb + (id & 15) * 8); } } while (0)
    GLA_LOAD(dir ? 64 : 0);
    for (int step = 0; step < 65; ++step) {
      const int n = dir ? 64 - step : step;
      const bool fin = dir ? (step >= 32) : (step >= 33);
      int lane_o = lane; asm volatile("" : "+v"(lane_o));
      const int r32 = lane_o & 31, hi = lane_o >> 5, kp = lane_o, ct = (w4 << 6) | lane_o;
      const int vbV = lbase + O_VV + v_rd_base(lane_o) + w4 * 512, vbK = lbase + O_KD + v_rd_base(lane_o);
      { float run0 = 0.f, run1 = 0.f, f20 = 0.f, f21 = 0.f;
#pragma unroll
        for (int i = 0; i < 16; ++i) { run0 += __builtin_amdgcn_logf(1.0f - bf_lo(pk[i])) * 0.6931471805599453f; run1 += __builtin_amdgcn_logf(1.0f - bf_hi(pk[i])) * 0.6931471805599453f; if (i == 0) { f20 = run0; f21 = run1; } }
        *(f32x2*)(L + V_TOT + (w4 * 128 + 2 * kp) * 4) = (f32x2){run0, run1};
        if (w4 == 2) *(f32x2*)(L + V_F2 + (2 * kp) * 4) = (f32x2){f20, f21}; }
      __syncthreads();
      { const f32x2 t0 = *(const f32x2*)(L + V_TOT + (0 * 128 + 2 * kp) * 4), t1 = *(const f32x2*)(L + V_TOT + (1 * 128 + 2 * kp) * 4), t2 = *(const f32x2*)(L + V_TOT + (2 * 128 + 2 * kp) * 4),
                    t3 = *(const f32x2*)(L + V_TOT + (3 * 128 + 2 * kp) * 4), f2 = *(const f32x2*)(L + V_F2 + (2 * kp) * 4);
        const f32x2 pre = w4 == 0 ? (f32x2){0.f, 0.f} : w4 == 1 ? t0 : w4 == 2 ? t0 + t1 : t0 + t1 + t2;
        const f32x2 ref = t0 + t1 + f2, bl = (t0 + t1) + (t2 + t3);
        const float LOG2E = 1.4426950408889634f;
        const float c30 = __builtin_amdgcn_exp2f((bl.x - ref.x) * LOG2E), c31 = __builtin_amdgcn_exp2f((bl.y - ref.y) * LOG2E);
        float run0 = pre.x - ref.x, run1 = pre.y - ref.y;
#pragma unroll
        for (int i = 0; i < 16; ++i) { const int t = 16 * w4 + i;
          run0 += __builtin_amdgcn_logf(1.0f - bf_lo(pk[i])) * 0.6931471805599453f; run1 += __builtin_amdgcn_logf(1.0f - bf_hi(pk[i])) * 0.6931471805599453f;
          const float x0 = run0 * LOG2E, x1 = run1 * LOG2E;
          const float e10 = __builtin_amdgcn_exp2f(x0), e11 = __builtin_amdgcn_exp2f(x1), e20 = __builtin_amdgcn_exp2f(-x0), e21 = __builtin_amdgcn_exp2f(-x1);
          const float ki0 = bf_lo(pk[i]) * e20, ki1 = bf_hi(pk[i]) * e21;
          *(unsigned*)(L + O_QI + t * RS + 4 * kp) = cvt_pk_bf16(bf_lo(pq[i]) * e10, bf_hi(pq[i]) * e11);
          *(unsigned*)(L + O_KI + t * RS + 4 * kp) = cvt_pk_bf16(ki0, ki1);
          *(unsigned*)(L + O_KD + v_st4(t, 2 * kp)) = cvt_pk_bf16(ki0 * c30, ki1 * c31); }
        if (w4 == 0) { *(f32x2*)(L + V_DEC + (2 * kp) * 4) = (f32x2){__builtin_amdgcn_exp2f(bl.x * LOG2E), __builtin_amdgcn_exp2f(bl.y * LOG2E)};
                       *(f32x2*)(L + V_EREF + (2 * kp) * 4) = (f32x2){__builtin_amdgcn_exp2f(ref.x * LOG2E), __builtin_amdgcn_exp2f(ref.y * LOG2E)}; }
#pragma unroll
        for (int i = 0; i < 4; ++i) { const int id = ct + 256 * i; *(bf16x8*)(L + O_VV + v_st4(id >> 4, (id & 15) * 8)) = pvv[i]; } }
      __syncthreads();
      f32x16 o[2]; o[0] = f32x16{}; o[1] = f32x16{};
      { bf16x8 Sb[8];
#pragma unroll
        for (int kb = 0; kb < 4; ++kb)
#pragma unroll
          for (int s = 0; s < 2; ++s) { const f32x4 e0 = *(const f32x4*)(L + V_EREF + (32 * kb + 16 * s + 4 * hi) * 4), e1 = *(const f32x4*)(L + V_EREF + (32 * kb + 16 * s + 8 + 4 * hi) * 4);
            u32x4 w; w.x = cvt_pk_bf16(S[kb][8 * s + 0] * e0[0], S[kb][8 * s + 1] * e0[1]); w.y = cvt_pk_bf16(S[kb][8 * s + 2] * e0[2], S[kb][8 * s + 3] * e0[3]);
                     w.z = cvt_pk_bf16(S[kb][8 * s + 4] * e1[0], S[kb][8 * s + 5] * e1[1]); w.w = cvt_pk_bf16(S[kb][8 * s + 6] * e1[2], S[kb][8 * s + 7] * e1[3]);
            Sb[2 * kb + s] = *reinterpret_cast<bf16x8*>(&w); }
#pragma unroll
        for (int tb = 0; tb < 2; ++tb)
#pragma unroll
          for (int ks = 0; ks < 8; ++ks) { o[tb] = __builtin_amdgcn_mfma_f32_32x32x16_bf16(nat_frag(L + O_QI, 32 * tb + r32, ks, hi), Sb[ks], o[tb], 0, 0, 0);
                                           if ((ks & 3) == 3) asm volatile("" ::: "memory"); } }
      { f32x16 a0 = f32x16{};
#pragma unroll
        for (int ks = 0; ks < 8; ++ks) { a0 = __builtin_amdgcn_mfma_f32_32x32x16_bf16(nat_frag(L + O_KI, r32, ks, hi), nat_frag(L + O_QI, r32, ks, hi), a0, 0, 0, 0);
                                         if ((ks & 3) == 3) asm volatile("" ::: "memory"); }
#pragma unroll
        for (int r = 0; r < 16; ++r) a0[r] = crow(r, hi) > r32 ? 0.f : a0[r];
        const bf16x8 pa0 = pk4(a0, 0), pa1 = pk4(a0, 1);
        const s16x4 l0 = tr_read<0 * 4096>(vbV), h0 = tr_read<0 * 4096 + 2048>(vbV), l1 = tr_read<1 * 4096>(vbV), h1 = tr_read<1 * 4096 + 2048>(vbV);
        asm volatile("s_waitcnt lgkmcnt(0)" ::: "memory"); GLA_SBAR();
        o[0] = __builtin_amdgcn_mfma_f32_32x32x16_bf16(pa0, GLA_PK(l0, h0), o[0], 0, 0, 0);
        o[0] = __builtin_amdgcn_mfma_f32_32x32x16_bf16(pa1, GLA_PK(l1, h1), o[0], 0, 0, 0); }
      { f32x16 a0 = f32x16{}, a1 = f32x16{};
#pragma unroll
        for (int ks = 0; ks < 8; ++ks) { const bf16x8 qf = nat_frag(L + O_QI, 32 + r32, ks, hi);
                                         a0 = __builtin_amdgcn_mfma_f32_32x32x16_bf16(nat_frag(L + O_KI, r32, ks, hi), qf, a0, 0, 0, 0);
                                         a1 = __builtin_amdgcn_mfma_f32_32x32x16_bf16(nat_frag(L + O_KI, 32 + r32, ks, hi), qf, a1, 0, 0, 0);
                                         if (ks & 1) asm volatile("" ::: "memory"); }
#pragma unroll
        for (int r = 0; r < 16; ++r) a1[r] = crow(r, hi) > r32 ? 0.f : a1[r];
        const bf16x8 pa0 = pk4(a0, 0), pa1 = pk4(a0, 1), pa2 = pk4(a1, 0), pa3 = pk4(a1, 1);
        const s16x4 l0 = tr_read<0 * 4096>(vbV), h0 = tr_read<0 * 4096 + 2048>(vbV), l1 = tr_read<1 * 4096>(vbV), h1 = tr_read<1 * 4096 + 2048>(vbV);
        const s16x4 l2 = tr_read<2 * 4096>(vbV), h2 = tr_read<2 * 4096 + 2048>(vbV), l3 = tr_read<3 * 4096>(vbV), h3 = tr_read<3 * 4096 + 2048>(vbV);
        asm volatile("s_waitcnt lgkmcnt(0)" ::: "memory"); GLA_SBAR();
        o[1] = __builtin_amdgcn_mfma_f32_32x32x16_bf16(pa0, GLA_PK(l0, h0), o[1], 0, 0, 0);
        o[1] = __builtin_amdgcn_mfma_f32_32x32x16_bf16(pa1, GLA_PK(l1, h1), o[1], 0, 0, 0);
        o[1] = __builtin_amdgcn_mfma_f32_32x32x16_bf16(pa2, GLA_PK(l2, h2), o[1], 0, 0, 0);
        o[1] = __builtin_amdgcn_mfma_f32_32x32x16_bf16(pa3, GLA_PK(l3, h3), o[1], 0, 0, 0); }
      __syncthreads();
      { unsigned short* ot = (unsigned short*)(L + O_KI);
#pragma unroll
        for (int tb = 0; tb < 2; ++tb)
#pragma unroll
          for (int r = 0; r < 16; ++r) ot[(32 * tb + crow(r, hi)) * (RS / 2) + 32 * w4 + r32] = (unsigned short)(cvt_pk_bf16(o[tb][r], 0.f) & 0xffffu); }
      if (step < 64) { const int nn = dir ? n - 1 : n + 1; GLA_LOAD(nn); }
#pragma unroll
      for (int kb = 0; kb < 4; ++kb)
#pragma unroll
        for (int g4 = 0; g4 < 4; ++g4) { const f32x4 dc = *(const f32x4*)(L + V_DEC + (32 * kb + 8 * g4 + 4 * hi) * 4);
          S[kb][4 * g4 + 0] *= dc[0]; S[kb][4 * g4 + 1] *= dc[1]; S[kb][4 * g4 + 2] *= dc[2]; S[kb][4 * g4 + 3] *= dc[3]; }
      { const s16x4 l0 = tr_read<0 * 4096>(vbV), h0 = tr_read<0 * 4096 + 2048>(vbV), l1 = tr_read<1 * 4096>(vbV), h1 = tr_read<1 * 4096 + 2048>(vbV);
        const s16x4 l2 = tr_read<2 * 4096>(vbV), h2 = tr_read<2 * 4096 + 2048>(vbV), l3 = tr_read<3 * 4096>(vbV), h3 = tr_read<3 * 4096 + 2048>(vbV);
        asm volatile("s_waitcnt lgkmcnt(0)" ::: "memory"); GLA_SBAR();
        const bf16x8 vf0 = GLA_PK(l0, h0), vf1 = GLA_PK(l1, h1), vf2 = GLA_PK(l2, h2), vf3 = GLA_PK(l3, h3);
#define GLA_UPD(kb) do { const s16x4 a0 = tr_read<(kb) * 512 + 0 * 4096>(vbK), b0 = tr_read<(kb) * 512 + 0 * 4096 + 2048>(vbK), a1 = tr_read<(kb) * 512 + 1 * 4096>(vbK), b1 = tr_read<(kb) * 512 + 1 * 4096 + 2048>(vbK); \
          const s16x4 a2 = tr_read<(kb) * 512 + 2 * 4096>(vbK), b2 = tr_read<(kb) * 512 + 2 * 4096 + 2048>(vbK), a3 = tr_read<(kb) * 512 + 3 * 4096>(vbK), b3 = tr_read<(kb) * 512 + 3 * 4096 + 2048>(vbK); \
          asm volatile("s_waitcnt lgkmcnt(0)" ::: "memory"); GLA_SBAR(); \
          S[kb] = __builtin_amdgcn_mfma_f32_32x32x16_bf16(GLA_PK(a0, b0), vf0, S[kb], 0, 0, 0); S[kb] = __builtin_amdgcn_mfma_f32_32x32x16_bf16(GLA_PK(a1, b1), vf1, S[kb], 0, 0, 0); \
          S[kb] = __builtin_amdgcn_mfma_f32_32x32x16_bf16(GLA_PK(a2, b2), vf2, S[kb], 0, 0, 0); S[kb] = __builtin_amdgcn_mfma_f32_32x32x16_bf16(GLA_PK(a3, b3), vf3, S[kb], 0, 0, 0); } while (0)
        GLA_UPD(0); GLA_UPD(1); GLA_UPD(2); GLA_UPD(3);
#undef GLA_UPD
      }
      __syncthreads();
      const int t = ct >> 2, q4 = ct & 3; const size_t goff = (seq0 + GLA_ROW(n, t)) * 1024 + cb + 32 * q4;
      u32x2 ow[8];
#pragma unroll
      for (int i = 0; i < 8; ++i) ow[i] = *(const u32x2*)(L + O_KI + t * RS + q4 * 64 + i * 8);
      if (!fin) {
#pragma unroll
        for (int i = 0; i < 4; ++i) *(u32x4*)(Kown + goff + 8 * i) = (u32x4){ow[2 * i].x, ow[2 * i].y, ow[2 * i + 1].x, ow[2 * i + 1].y};
      }
      __syncthreads();
      if (fin) {
        float ov[32]; float ss = 0.f;
#pragma unroll
        for (int i = 0; i < 4; ++i) { const u32x4 pw = *(const u32x4*)(Koth + goff + 8 * i);
          ov[8 * i + 0] = bf_lo(ow[2 * i].x) + bf_lo(pw.x); ov[8 * i + 1] = bf_hi(ow[2 * i].x) + bf_hi(pw.x); ov[8 * i + 2] = bf_lo(ow[2 * i].y) + bf_lo(pw.y); ov[8 * i + 3] = bf_hi(ow[2 * i].y) + bf_hi(pw.y);
          ov[8 * i + 4] = bf_lo(ow[2 * i + 1].x) + bf_lo(pw.z); ov[8 * i + 5] = bf_hi(ow[2 * i + 1].x) + bf_hi(pw.z); ov[8 * i + 6] = bf_lo(ow[2 * i + 1].y) + bf_lo(pw.w); ov[8 * i + 7] = bf_hi(ow[2 * i + 1].y) + bf_hi(pw.w); }
#pragma unroll
        for (int i = 0; i < 32; ++i) ss += ov[i] * ov[i];
        ss += __shfl_xor(ss, 1); ss += __shfl_xor(ss, 2);
        const float rstd = 1.0f / sqrtf(ss * (1.0f / 128.0f) + EPS);
#pragma unroll
        for (int i = 0; i < 4; ++i) { const u32x4 gw = *(const u32x4*)(SGb + goff + 8 * i); const f32x4 n0 = *(const f32x4*)(onorm + cb + 32 * q4 + 8 * i), n1 = *(const f32x4*)(onorm + cb + 32 * q4 + 8 * i + 4);
          u32x4 w; w.x = cvt_pk_bf16(ov[8 * i + 0] * rstd * n0[0] * bf_lo(gw.x), ov[8 * i + 1] * rstd * n0[1] * bf_hi(gw.x)); w.y = cvt_pk_bf16(ov[8 * i + 2] * rstd * n0[2] * bf_lo(gw.y), ov[8 * i + 3] * rstd * n0[3] * bf_hi(gw.y));
                   w.z = cvt_pk_bf16(ov[8 * i + 4] * rstd * n1[0] * bf_lo(gw.z), ov[8 * i + 5] * rstd * n1[1] * bf_hi(gw.z)); w.w = cvt_pk_bf16(ov[8 * i + 6] * rstd * n1[2] * bf_lo(gw.w), ov[8 * i + 7] * rstd * n1[3] * bf_hi(gw.w));
          *(u32x4*)(Qb + goff + 8 * i) = w; }
      }
      __syncthreads();
    }
#undef GLA_ROW
#undef GLA_LOAD
  }
  __syncthreads();
}
#undef GLA_PK
#undef GLA_SBAR
}
constexpr int NPHASE = 16;
#ifndef GLA_SIMPLE
#define GLA_SIMPLE 0
#endif
#ifndef ATTN_SIMPLE
#define ATTN_SIMPLE 0
#endif
#ifndef MK_ONE_LAUNCH
#define MK_ONE_LAUNCH 1
#endif
struct Args { const float* in[19]; float* out; unsigned char* ws; int ph_lo, ph_hi; };
__global__ void __launch_bounds__(NWAVES * 64, 2) fwd(Args args) {
    extern __shared__ __attribute__((aligned(16))) unsigned char lds[];
    Frame F;
    F.lds = (LAS unsigned char*)lds;
    F.MISC = (volatile LAS unsigned*)(F.lds + MISC_OFF);
    F.tid = threadIdx.x; F.lane = F.tid & 63; F.wave = __builtin_amdgcn_readfirstlane(F.tid >> 6);
    F.G = gridDim.x; { const int bx = blockIdx.x; F.vcu = (F.G % 8 == 0) ? (bx % 8) * (F.G / 8) + bx / 8 : bx; }
    unsigned char* ws = args.ws;
    for (int u = F.tid; u < (LDS_BYTES - LDSCTL_OFF) / 4; u += NWAVES * 64) ((LAS unsigned*)(F.lds + LDSCTL_OFF))[u] = 0u;
    __syncthreads();
    const int lo = args.ph_lo, hi = args.ph_hi;
    XcdBarrier bar; bar.bar = (unsigned*)(ws + WS_CTL); bar.x = 0; bar.st = nullptr;
    if (hi - lo > 1) bar = xcd_barrier_post((unsigned*)(ws + WS_CTL), F.MISC + 8);
#ifndef ONLY_PHASE
#define ONLY_PHASE -1
#endif
#define IN(k) (lo <= (k) && (k) < hi && (ONLY_PHASE < 0 || ONLY_PHASE == (k)))
#define SEAM(k) do { if (IN(k) && IN((k) + 1)) xcd_barrier(bar); } while (0)
    const float* const* in = args.in;
    bf16* hD = (bf16*)args.out;
    bf16* hB = (bf16*)(ws + WS_B0 + (size_t)SLACK * ROWB);
    const pg8::f32x2* rope = (const pg8::f32x2*)(ws + WS_ROPE);
    using pg8::Gemm; using pg8::StaticOrder;
    const int cid = (int)blockIdx.x;

    if (IN(0)) { p0_prologue(F, in, ws, hD); } SEAM(0);
    if (IN(1)) { Gemm g{hD, (const bf16*)(ws + W_IN), 1024, 1024, 1024}; StaticOrder S; S.init(MT, 5, F.G, cid);
        pg8::EpiProj E{(bf16*)(ws + R_CQKV), (float*)(ws + R_SSQ), (bf16*)(ws + R_KROPE), rope};
        pg8::gemm_phase<pg8::EpiProj, StaticOrder, true, true>(F.lds + RING_OFF, g, S, E); } SEAM(1);
    if (IN(2)) {
        { Gemm g{(const bf16*)(ws + R_CQKV), (const bf16*)(ws + W_UQ), 768, 1024, 768}; StaticOrder S; S.init(MT, 6, F.G, cid);
          pg8::EpiQ E{(bf16*)(ws + R_Q), (const float*)(ws + R_SSQ), rope};
          pg8::gemm_phase<pg8::EpiQ, StaticOrder, true, true>(F.lds + RING_OFF, g, S, E); }
        { Gemm g{(const bf16*)(ws + R_CQKV) + 768, (const bf16*)(ws + W_UKV), 256, 1024, 256}; StaticOrder S; S.init(MT, 8, F.G, cid);
          pg8::EpiKV E{(bf16*)(ws + R_KV), (const float*)(ws + R_SSQ)};
          pg8::gemm_phase<pg8::EpiKV, StaticOrder, true, true>(F.lds + RING_OFF, g, S, E); }
    } SEAM(2);
    if (IN(3)) {
#if ATTN_SIMPLE
        attn_simple(F, (const bf16*)(ws + R_Q), (const bf16*)(ws + R_KV), (const bf16*)(ws + R_KROPE), (bf16*)(ws + R_CQKV));
#else
        fa::attn_phase(F.vcu, F.G, (const bf16*)(ws + R_Q), (const bf16*)(ws + R_KV), (const bf16*)(ws + R_KROPE), (bf16*)(ws + R_CQKV), (char*)lds);
#endif
    } SEAM(3);
    if (IN(4)) { Gemm g{(const bf16*)(ws + R_CQKV), (const bf16*)(ws + W_O), 1024, 1024, 1024}; StaticOrder S; S.init(MT, 4, F.G, cid);
        pg8::EpiResid E{hD, (float*)(ws + R_X_L0)};
        pg8::gemm_phase<pg8::EpiResid, StaticOrder, true, true>(F.lds + RING_OFF, g, S, E); } SEAM(4);
    if (IN(5)) { ln_pass<false>(F, (const float*)(ws + R_X_L0), in[17] + 0 * 1024, in[18] + 0 * 1024, hB, nullptr); } SEAM(5);
    if (IN(6)) { Gemm g{hB - 1024, (const bf16*)(ws + W_UP0), 1024, 1024, 1024}; StaticOrder S; S.init(MT_UP, 22, F.G, cid);
        pg8::EpiConvGate E{(bf16*)(ws + R_ACT), in[14], in[15]};
        pg8::gemm_phase<pg8::EpiConvGate, StaticOrder, true, true, true>(F.lds + RING_OFF, g, S, E); } SEAM(6);
    if (IN(7)) { Gemm g{(const bf16*)(ws + R_ACT), (const bf16*)(ws + W_DN0), DFF, DFF, DFF}; StaticOrder S; S.init(MT, 4, F.G, cid);
        pg8::EpiResid E{hB, (float*)(ws + R_X_FFN)};
        pg8::gemm_phase<pg8::EpiResid, StaticOrder, true, true>(F.lds + RING_OFF, g, S, E); } SEAM(7);
    if (IN(8)) { ln_pass<false>(F, (const float*)(ws + R_X_FFN), in[17] + 1 * 1024, in[18] + 1 * 1024, hD, nullptr); } SEAM(8);
    if (IN(9)) { Gemm g{hD, (const bf16*)(ws + W_HIN), 1024, 1024, 1024}; StaticOrder S; S.init(MT, 20, F.G, cid);
        pg8::EpiHgIn E{hB, (bf16*)(ws + R_HV), (bf16*)(ws + R_HKF), (bf16*)(ws + R_HKB), (bf16*)(ws + R_HSG), (const float*)(ws + WS_LB)};
        pg8::gemm_phase<pg8::EpiHgIn, StaticOrder, true, true>(F.lds + RING_OFF, g, S, E); } SEAM(9);
    if (IN(10)) {
#if GLA_SIMPLE
        gla_simple(F, hB, (const bf16*)(ws + R_HV), (bf16*)(ws + R_HKF), (const bf16*)(ws + R_HKB), (const bf16*)(ws + R_HSG), in[11]);
#else
        gla::gla_phase(F.vcu, F.G, hB, (const bf16*)(ws + R_HV), (bf16*)(ws + R_HKF), (bf16*)(ws + R_HKB), (const bf16*)(ws + R_HSG), in[11], (char*)lds);
#endif
    } SEAM(10);
    if (IN(11)) { Gemm g{hB, (const bf16*)(ws + W_HO), 1024, 1024, 1024}; StaticOrder S; S.init(MT, 4, F.G, cid);
        pg8::EpiResid E{hD, (float*)(ws + R_X_HG)};
        pg8::gemm_phase<pg8::EpiResid, StaticOrder, true, true>(F.lds + RING_OFF, g, S, E); } SEAM(11);
    if (IN(12)) { ln_pass<false>(F, (const float*)(ws + R_X_HG), in[17] + 2 * 1024, in[18] + 2 * 1024, hB, nullptr); } SEAM(12);
    if (IN(13)) { Gemm g{hB - 1024, (const bf16*)(ws + W_UP1), 1024, 1024, 1024}; StaticOrder S; S.init(MT_UP, 22, F.G, cid);
        pg8::EpiConvGate E{(bf16*)(ws + R_ACT), in[14] + 3 * NUP, in[15] + NUP};
        pg8::gemm_phase<pg8::EpiConvGate, StaticOrder, true, true, true>(F.lds + RING_OFF, g, S, E); } SEAM(13);
    if (IN(14)) { Gemm g{(const bf16*)(ws + R_ACT), (const bf16*)(ws + W_DN1), DFF, DFF, DFF}; StaticOrder S; S.init(MT, 4, F.G, cid);
        pg8::EpiResid E{hB, (float*)(ws + R_X_FFN)};
        pg8::gemm_phase<pg8::EpiResid, StaticOrder, true, true>(F.lds + RING_OFF, g, S, E); } SEAM(14);
    if (IN(15)) { ln_pass<true>(F, (const float*)(ws + R_X_FFN), in[17] + 3 * 1024, in[18] + 3 * 1024, nullptr, args.out); }
#undef IN
#undef SEAM
}

__global__ void nan_fill(float* o, long n) { const float q = __builtin_nanf(""); for (long i = blockIdx.x * 256L + threadIdx.x; i < n; i += gridDim.x * 256L) o[i] = q; }
extern "C" void kernel_launch(void* const* d_in, const int* in_sizes, int n_in, void* d_out, int out_size, void* d_ws, size_t ws_size, hipStream_t stream) {
    static int grid = 0;
    if (grid == 0) {
        bool ok = (n_in == 19) && in_sizes[0] == 16 * SEQ * 1024 && in_sizes[1] == 4 * SEQ * 1024 && out_size == NB * SEQ * 1024 && ws_size >= WS_END;
        int dev = 0, cus = 0;
        if (ok) ok = hipGetDevice(&dev) == hipSuccess && hipDeviceGetAttribute(&cus, hipDeviceAttributeMultiprocessorCount, dev) == hipSuccess;
        if (ok) ok = hipFuncSetAttribute((const void*)fwd, hipFuncAttributeMaxDynamicSharedMemorySize, LDS_BYTES) == hipSuccess;
        if (!ok) { fprintf(stderr, "kernel_launch: unexpected shapes / workspace (%zu) / device\n", ws_size); grid = -1; }
        else grid = cus;
        (void)hipGetLastError();
    }
    if (grid < 0) { hipLaunchKernelGGL(nan_fill, dim3(1024), dim3(256), 0, stream, (float*)d_out, (long)out_size); return; }
    (void)hipMemsetAsync((char*)d_ws + WS_CTL, 0, CTL_ZERO_BYTES, stream);
    Args a{};
    for (int i = 0; i < 19; ++i) a.in[i] = (const float*)d_in[i];
    a.out = (float*)d_out; a.ws = (unsigned char*)d_ws;
#if MK_ONE_LAUNCH
    a.ph_lo = 0; a.ph_hi = NPHASE;
    hipLaunchKernelGGL(fwd, dim3(grid), dim3(NWAVES * 64), LDS_BYTES, stream, a);
#else
    for (int p = 0; p < NPHASE; ++p) { a.ph_lo = p; a.ph_hi = p + 1; hipLaunchKernelGGL(fwd, dim3(grid), dim3(NWAVES * 64), LDS_BYTES, stream, a); }
#endif
}
```

```cpp
#include <hip/hip_runtime.h>
#include <cstdio>
constexpr int NB = 20;
constexpr int LP = 4160;
constexpr int PADR = 48, LTOK = 4112, SEQ = 4096, DM = 1024;
constexpr int M = NB * LP;
constexpr int MT = M / 256;
constexpr int DFF = 2816, NUP = 2 * DFF;
constexpr int NBLK62 = (M + 61) / 62;
constexpr int MT_UP = (NBLK62 + 3) / 4;
constexpr float EPS = 1e-6f, ALPHA = 1.4142135623730951f;
constexpr float SM_C = 0.10206207261596575f * 1.4426950408889634f;
#include <cstdint>
namespace pg8 {
#define PG8_LAS __attribute__((address_space(3)))
typedef unsigned short bf16_t;
typedef short bf16x8 __attribute__((ext_vector_type(8)));
typedef float f32x4 __attribute__((ext_vector_type(4)));
typedef unsigned u32x4 __attribute__((ext_vector_type(4)));
typedef unsigned u32x2 __attribute__((ext_vector_type(2)));
constexpr int BM = 256, BK = 64, HALF = 128, HTB = HALF * BK * 2  , STAGE_BYTES = 8 * HTB, NXCD = 8, WGM = 8;

__host__ __device__ __forceinline__ int lds_byte(int r, int c) { const int st = (r >> 4) * 2 + (c >> 5), rr = r & 15, cc = c & 31, ob = rr * 64 + cc * 2; return st * 1024 + (ob ^ (((ob >> 9) & 1) << 5)); }
__host__ __device__ __forceinline__ void stage_rc(int b, int& R, int& C) { const int st = b / 1024, sb = b % 1024, swz = sb ^ (((sb >> 9) & 1) << 5); R = (st >> 1) * 16 + swz / 64; C = (st & 1) * 32 + (swz % 64) / 2; }
__host__ __device__ __forceinline__ int perm32(int rho) { const int n = rho >> 4, i = rho & 15; return 8 * (i >> 2) + 4 * n + (i & 3); }

struct Unit { int pm, pn; };
struct Gemm { const bf16_t* A; const bf16_t* Bt; int K, lda, ldb; };

struct StaticOrder {
    int nM, nN, nwg, G, c;
    __host__ __device__ void init(int nM_, int nN_, int G_, int c_) { nM = nM_; nN = nN_; nwg = nM * nN; G = G_; c = c_; }
    __host__ __device__ bool next(int i, Unit& u) const {
        const long L = (long)i * G + c; if (L >= nwg) return false;
        int wgid = (int)L; { const int q = nwg / NXCD, r = nwg % NXCD, xcd = wgid % NXCD, off = wgid / NXCD; wgid = (xcd < r ? xcd * (q + 1) : r * (q + 1) + (xcd - r) * q) + off; }
        const int nig = WGM * nN, gid = wgid / nig, fm = gid * WGM, gsz = (nM - fm) < WGM ? (nM - fm) : WGM;
        u.pm = fm + ((wgid % nig) % gsz); u.pn = (wgid % nig) / gsz; return true;
    }
    __device__ __forceinline__ void a_ready(const Unit&) const {}
    __device__ __forceinline__ void done(const Unit&) const {}
};
__device__ __forceinline__ unsigned cvt_pk_bf16(float lo, float hi) { unsigned r; asm volatile("v_cvt_pk_bf16_f32 %0, %1, %2" : "=v"(r) : "v"(lo), "v"(hi)); return r; }
__device__ __forceinline__ float bf_lo(unsigned w) { return __uint_as_float(w << 16); }
__device__ __forceinline__ float bf_hi(unsigned w) { return __uint_as_float(w & 0xffff0000u); }
typedef float f32x2 __attribute__((ext_vector_type(2)));
__device__ __forceinline__ u32x4 pack8(const f32x4 v0, const f32x4 v1) { u32x4 w; w.x = cvt_pk_bf16(v0[0], v0[1]); w.y = cvt_pk_bf16(v0[2], v0[3]); w.z = cvt_pk_bf16(v1[0], v1[1]); w.w = cvt_pk_bf16(v1[2], v1[3]); return w; }
__device__ __forceinline__ void rope8(f32x4& v0, f32x4& v1, const f32x2* tab, int pos, int i0) {
    const f32x2* t = tab + pos * 16 + i0;
    const f32x2 c0 = t[0], c1 = t[1], c2 = t[2], c3 = t[3];
    f32x4 a, b;
    a[0] = v0[0] * c0.x - v0[1] * c0.y; a[1] = v0[0] * c0.y + v0[1] * c0.x;
    a[2] = v0[2] * c1.x - v0[3] * c1.y; a[3] = v0[2] * c1.y + v0[3] * c1.x;
    b[0] = v1[0] * c2.x - v1[1] * c2.y; b[1] = v1[0] * c2.y + v1[1] * c2.x;
    b[2] = v1[2] * c3.x - v1[3] * c3.y; b[3] = v1[2] * c3.y + v1[3] * c3.x;
    v0 = a; v1 = b;
}
struct EpiProj {
    static constexpr bool PERM = true, AFTER_DRAIN = false;
    bf16_t* cqkv; float* ssq; bf16_t* krope; const f32x2* rope;
    __device__ __forceinline__ void operator()(const f32x4 (&acc)[2][2][4][2], const Unit& u, int wr, int wc, int fr, int fq) const {
        const int row0 = u.pm * BM + wr * 64 + fr;
        if (u.pn < 4) {
            const int col0 = u.pn * BM + wc * 32 + 8 * fq;
#pragma unroll
            for (int ai = 0; ai < 2; ++ai)
#pragma unroll
                for (int m = 0; m < 4; ++m) { const int row = row0 + ai * HALF + m * 16; float s = 0.f;
#pragma unroll
                    for (int bj = 0; bj < 2; ++bj) { const f32x4 v0 = acc[ai][bj][m][0], v1 = acc[ai][bj][m][1];
                        s += (v0[0] * v0[0] + v0[1] * v0[1]) + (v0[2] * v0[2] + v0[3] * v0[3]) + (v1[0] * v1[0] + v1[1] * v1[1]) + (v1[2] * v1[2] + v1[3] * v1[3]);
                        *(u32x4*)(cqkv + (size_t)row * 1024 + col0 + bj * HALF) = pack8(v0, v1); }
                    s += __shfl_xor(s, 16); s += __shfl_xor(s, 32);
                    if (fq == 0) ssq[(size_t)row * 16 + u.pn * 4 + wc] = s; }
        } else if (wc == 0) {
#pragma unroll
            for (int ai = 0; ai < 2; ++ai)
#pragma unroll
                for (int m = 0; m < 4; ++m) { const int row = row0 + ai * HALF + m * 16; int pos = row % LP - PADR; pos = pos < 0 ? 0 : pos;
                    f32x4 v0 = acc[ai][0][m][0], v1 = acc[ai][0][m][1]; rope8(v0, v1, rope, pos, 4 * fq);
                    *(u32x4*)(krope + (size_t)row * 32 + 8 * fq) = pack8(v0, v1); }
        }
    }
};
struct EpiQ {
    static constexpr bool PERM = true, AFTER_DRAIN = false;
    bf16_t* Q; const float* ssq; const f32x2* rope;
    __device__ __forceinline__ void operator()(const f32x4 (&acc)[2][2][4][2], const Unit& u, int wr, int wc, int fr, int fq) const {
        const int row0 = u.pm * BM + wr * 64 + fr, col0 = u.pn * BM + wc * 32 + 8 * fq;
#pragma unroll
        for (int ai = 0; ai < 2; ++ai)
#pragma unroll
            for (int m = 0; m < 4; ++m) { const int row = row0 + ai * HALF + m * 16; int pos = row % LP - PADR; pos = pos < 0 ? 0 : pos;
                const f32x4* sp = (const f32x4*)(ssq + (size_t)row * 16); const f32x4 s0 = sp[0], s1 = sp[1], s2 = sp[2];
                const float ss = ((s0[0] + s0[1]) + (s0[2] + s0[3])) + ((s1[0] + s1[1]) + (s1[2] + s1[3])) + ((s2[0] + s2[1]) + (s2[2] + s2[3]));
                const float rstd = SM_C / sqrtf(ss * (1.0f / 768.0f) + EPS);
#pragma unroll
                for (int bj = 0; bj < 2; ++bj) { const int c = col0 + bj * HALF, d = c % 96; f32x4 v0 = acc[ai][bj][m][0] * rstd, v1 = acc[ai][bj][m][1] * rstd;
                    if (d >= 64) rope8(v0, v1, rope, pos, (d - 64) >> 1);
                    *(u32x4*)(Q + (size_t)row * 1536 + c) = pack8(v0, v1); } }
    }
};
struct EpiKV {
    static constexpr bool PERM = true, AFTER_DRAIN = false;
    bf16_t* KV; const float* ssq;
    __device__ __forceinline__ void operator()(const f32x4 (&acc)[2][2][4][2], const Unit& u, int wr, int wc, int fr, int fq) const {
        const int row0 = u.pm * BM + wr * 64 + fr, col0 = u.pn * BM + wc * 32 + 8 * fq;
#pragma unroll
        for (int ai = 0; ai < 2; ++ai)
#pragma unroll
            for (int m = 0; m < 4; ++m) { const int row = row0 + ai * HALF + m * 16;
                const f32x4 s3 = *(const f32x4*)(ssq + (size_t)row * 16 + 12);
                const float rstd = 1.0f / sqrtf(((s3[0] + s3[1]) + (s3[2] + s3[3])) * (1.0f / 256.0f) + EPS);
#pragma unroll
                for (int bj = 0; bj < 2; ++bj) *(u32x4*)(KV + (size_t)row * 2048 + col0 + bj * HALF) = pack8(acc[ai][bj][m][0] * rstd, acc[ai][bj][m][1] * rstd); }
    }
};
struct EpiResid {
    static constexpr bool PERM = false, AFTER_DRAIN = false;
    const bf16_t* h; float* X;
    __device__ __forceinline__ void operator()(const f32x4 (&acc)[2][2][4][2], const Unit& u, int wr, int wc, int fr, int fq) const {
        const int row0 = u.pm * BM + wr * 64 + fr, col0 = u.pn * BM + wc * 32 + 4 * fq;
#pragma unroll
        for (int ai = 0; ai < 2; ++ai)
#pragma unroll
            for (int m = 0; m < 4; ++m) { const size_t off = (size_t)(row0 + ai * HALF + m * 16) * 1024 + col0;
#pragma unroll
                for (int bj = 0; bj < 2; ++bj)
#pragma unroll
                    for (int n = 0; n < 2; ++n) { const u32x2 hw = *(const u32x2*)(h + off + bj * HALF + n * 16);
                        f32x4 hv; hv[0] = bf_lo(hw.x); hv[1] = bf_hi(hw.x); hv[2] = bf_lo(hw.y); hv[3] = bf_hi(hw.y);
                        *(f32x4*)(X + off + bj * HALF + n * 16) = hv * ALPHA + acc[ai][bj][m][n]; } }
    }
};
struct EpiHgIn {
    static constexpr bool PERM = true, AFTER_DRAIN = false;
    bf16_t* q; bf16_t* v; bf16_t* kf; bf16_t* kb; bf16_t* sg; const float* lb;
    __device__ __forceinline__ void operator()(const f32x4 (&acc)[2][2][4][2], const Unit& u, int wr, int wc, int fr, int fq) const {
        const int row0 = u.pm * BM + wr * 64 + fr, t = u.pn >> 2, col0 = (u.pn & 3) * BM + wc * 32 + 8 * fq;
        bf16_t* dst = t == 0 ? q : t == 1 ? v : t == 2 ? kf : t == 3 ? kb : sg;
#pragma unroll
        for (int bj = 0; bj < 2; ++bj) { const int c = col0 + bj * HALF;
            f32x4 om0 = {1.f, 1.f, 1.f, 1.f}, om1 = om0;
            if (t == 2 || t == 3) { const f32x4* lp = (const f32x4*)(lb + (t - 2) * 1024 + c); om0 = 1.0f - lp[0]; om1 = 1.0f - lp[1]; }
#pragma unroll
            for (int ai = 0; ai < 2; ++ai)
#pragma unroll
                for (int m = 0; m < 4; ++m) { const int row = row0 + ai * HALF + m * 16; const bool pad = (row % LP) < PADR;
                    f32x4 v0 = acc[ai][bj][m][0], v1 = acc[ai][bj][m][1];
                    if (t == 2 || t == 3) {
#pragma unroll
                        for (int j = 0; j < 4; ++j) { v0[j] = pad ? 0.f : om0[j] * __builtin_amdgcn_rcpf(1.0f + __builtin_amdgcn_exp2f(v0[j] * 1.4426950408889634f));
                                                      v1[j] = pad ? 0.f : om1[j] * __builtin_amdgcn_rcpf(1.0f + __builtin_amdgcn_exp2f(v1[j] * 1.4426950408889634f)); }
                    } else if (t == 4) {
#pragma unroll
                        for (int j = 0; j < 4; ++j) { v0[j] = v0[j] * __builtin_amdgcn_rcpf(1.0f + __builtin_amdgcn_exp2f(v0[j] * -1.4426950408889634f));
                                                      v1[j] = v1[j] * __builtin_amdgcn_rcpf(1.0f + __builtin_amdgcn_exp2f(v1[j] * -1.4426950408889634f)); }
                    }
                    *(u32x4*)(dst + (size_t)row * 1024 + c) = pack8(v0, v1); } }
    }
};
struct EpiConvGate {
    static constexpr bool PERM = true, AFTER_DRAIN = false;
    bf16_t* act; const float* cw; const float* cb;
    static __device__ __forceinline__ float dpp_mirror(float x) { return __builtin_bit_cast(float, __builtin_amdgcn_update_dpp(0, __builtin_bit_cast(int, x), 0x140, 0xf, 0xf, false)); }
    static __device__ __forceinline__ float dpp_prev(float old, float x) { return __builtin_bit_cast(float, __builtin_amdgcn_update_dpp(__builtin_bit_cast(int, old), __builtin_bit_cast(int, x), 0x111, 0xf, 0xf, false)); }
    static __device__ __forceinline__ float dpp_next(float old, float x) { return __builtin_bit_cast(float, __builtin_amdgcn_update_dpp(__builtin_bit_cast(int, old), __builtin_bit_cast(int, x), 0x101, 0xf, 0xf, false)); }
    __device__ __forceinline__ void operator()(const f32x4 (&acc)[2][2][4][2], const Unit& u, int wr, int wc, int fr, int fq) const {
        const int cv0 = 128 * u.pn + 32 * wc + 8 * fq;
#pragma unroll
        for (int n = 0; n < 2; ++n) { const int cv = cv0 + 4 * n;
            const f32x4 wv0 = *(const f32x4*)(cw + cv), wv1 = *(const f32x4*)(cw + NUP + cv), wv2 = *(const f32x4*)(cw + 2 * NUP + cv), bv = *(const f32x4*)(cb + cv);
            const f32x4 wg0 = *(const f32x4*)(cw + DFF + cv), wg1 = *(const f32x4*)(cw + NUP + DFF + cv), wg2 = *(const f32x4*)(cw + 2 * NUP + DFF + cv), bg = *(const f32x4*)(cb + DFF + cv);
#pragma unroll
            for (int ai = 0; ai < 2; ++ai) { const int J = 4 * u.pm + 2 * ai + wr;
                f32x4 o[4];
#pragma unroll
                for (int j = 0; j < 4; ++j) {
                    float mv[4], mg[4];
#pragma unroll
                    for (int m = 0; m < 4; ++m) { mv[m] = dpp_mirror(acc[ai][0][m][n][j]); mg[m] = dpp_mirror(acc[ai][1][m][n][j]); }
#pragma unroll
                    for (int m = 0; m < 4; ++m) {
                        const float pv = dpp_prev(m == 0 ? 0.f : mv[m - 1], acc[ai][0][m][n][j]), nv = dpp_next(m == 3 ? 0.f : mv[m + 1], acc[ai][0][m][n][j]);
                        const float pg = dpp_prev(m == 0 ? 0.f : mg[m - 1], acc[ai][1][m][n][j]), ng = dpp_next(m == 3 ? 0.f : mg[m + 1], acc[ai][1][m][n][j]);
                        const float val = wv0[j] * pv + wv1[j] * acc[ai][0][m][n][j] + wv2[j] * nv + bv[j];
                        const float gat = wg0[j] * pg + wg1[j] * acc[ai][1][m][n][j] + wg2[j] * ng + bg[j];
                        o[m][j] = val * gat * __builtin_amdgcn_rcpf(1.0f + __builtin_amdgcn_exp2f(gat * -1.4426950408889634f)); }
                    asm volatile("" : "+v"(o[0][j]), "+v"(o[1][j]), "+v"(o[2][j]), "+v"(o[3][j])); }
#pragma unroll
                for (int m = 0; m < 4; ++m) { const int R64 = 16 * m + fr; const int rowo = 62 * J - 1 + R64;
                    if (R64 >= 1 && R64 <= 62 && rowo < M) { u32x2 w; w.x = cvt_pk_bf16(o[m][0], o[m][1]); w.y = cvt_pk_bf16(o[m][2], o[m][3]); *(u32x2*)(act + (size_t)rowo * DFF + cv) = w; } }
                asm volatile("" ::: "memory"); } }
    }
};
template <class Epi, class Sched, bool ALIGN_EPI = false, bool SP2 = false, bool SHIFT = false>
__device__ __forceinline__ void gemm_phase(PG8_LAS unsigned char* lds, const Gemm g, const Sched& S, const Epi& E) {
    const int tid = threadIdx.x, wid = __builtin_amdgcn_readfirstlane(tid >> 6), lane = tid & 63, wr = wid >> 2, wc = wid & 3, fr = lane & 15, fq = lane >> 4;
    const int K = g.K, nt = K / BK;
    unsigned voffA[2], voffB[2];
#pragma unroll
    for (int i = 0; i < 2; ++i) { int R, C; stage_rc(tid * 16 + i * 8192, R, C); const int Rb = Epi::PERM ? ((R & ~31) + perm32(R & 31)) : R;
        const int Ra = SHIFT ? (R - 2 * (R >> 6)) : R; voffA[i] = (unsigned)(Ra * g.lda + C) * 2u; voffB[i] = (unsigned)(Rb * g.ldb + C) * 2u; }
    const size_t kstep = (size_t)(BK * 2);
    const size_t hstepA = (size_t)(SHIFT ? 124 : HALF) * g.lda * 2, hstepB = (size_t)HALF * g.ldb * 2;
    const size_t tstepA = 2 * hstepA, tstepB = 2 * hstepB;
    const unsigned ldsw = (unsigned)wid * 1024u;
    const int aoff = lds_byte(wr * 64 + fr, fq * 8), boff = lds_byte(wc * 32 + fr, fq * 8);
#define PG8_SA(b, h) (((b) * 2 + (h)) * HTB)
#define PG8_SB(b, h) ((4 + (b) * 2 + (h)) * HTB)
#define PG8_STAGE(bufoff, gbase, voff) do { _Pragma("unroll") for (int _i = 0; _i < 2; ++_i) \
        __builtin_amdgcn_global_load_lds((const unsigned*)((const char*)(gbase) + (voff)[_i]), (PG8_LAS unsigned*)(lds + (bufoff) + ldsw + _i * 8192), 16, 0, 0); } while (0)
#define PG8_LDA(dst, b, h) do { _Pragma("unroll") for (int m = 0; m < 4; ++m) _Pragma("unroll") for (int k = 0; k < 2; ++k) dst[m][k] = *(const PG8_LAS bf16x8*)(lds + PG8_SA(b, h) + aoff + m * 2048 + k * 1024); } while (0)
#define PG8_LDB(dst, b, h) do { _Pragma("unroll") for (int n = 0; n < 2; ++n) _Pragma("unroll") for (int k = 0; k < 2; ++k) dst[n][k] = *(const PG8_LAS bf16x8*)(lds + PG8_SB(b, h) + boff + n * 2048 + k * 1024); } while (0)
#define PG8_MMA(ai, bj, At, Bt) do { __builtin_amdgcn_s_setprio(1); _Pragma("unroll") for (int m = 0; m < 4; ++m) _Pragma("unroll") for (int n = 0; n < 2; ++n) _Pragma("unroll") for (int k = 0; k < 2; ++k) \
        acc[ai][bj][m][n] = __builtin_amdgcn_mfma_f32_16x16x32_bf16(Bt[n][k], At[m][k], acc[ai][bj][m][n], 0, 0, 0); __builtin_amdgcn_s_setprio(0); } while (0)
#define PG8_WAIT_V(n) asm volatile("s_waitcnt vmcnt(" #n ")" ::: "memory")
#define PG8_WAIT_L(n) asm volatile("s_waitcnt lgkmcnt(" #n ")" ::: "memory")
#define PG8_BAR __builtin_amdgcn_s_barrier()
#define PG8_SCHED __builtin_amdgcn_sched_barrier(0)
    Unit cur, nxt; int ui = 0;
    if (!S.next(0, cur)) return;
    f32x4 acc[2][2][4][2];
#pragma unroll
    for (int a = 0; a < 2; ++a)
#pragma unroll
        for (int b = 0; b < 2; ++b)
#pragma unroll
            for (int m = 0; m < 4; ++m)
#pragma unroll
                for (int n = 0; n < 2; ++n) acc[a][b][m][n] = (f32x4){0.f, 0.f, 0.f, 0.f};
    bf16x8 At[4][2], B0[2][2], B1[2][2];
    const char* cA = (const char*)g.A + (size_t)cur.pm * tstepA; const char* cB = (const char*)g.Bt + (size_t)cur.pn * tstepB;
    S.a_ready(cur);
    if constexpr (SP2) {
        PG8_STAGE(PG8_SB(0, 0), cB, voffB); PG8_STAGE(PG8_SB(0, 1), cB + hstepB, voffB); PG8_STAGE(PG8_SA(0, 0), cA, voffA); PG8_STAGE(PG8_SA(0, 1), cA + hstepA, voffA);
        if (wr == 1) PG8_BAR;
        PG8_WAIT_V(2); PG8_BAR;
        PG8_STAGE(PG8_SB(1, 0), cB + kstep, voffB); PG8_STAGE(PG8_SA(1, 0), cA + kstep, voffA); PG8_STAGE(PG8_SB(1, 1), cB + hstepB + kstep, voffB);
        PG8_WAIT_V(6); PG8_BAR;
    } else {
        PG8_STAGE(PG8_SB(0, 0), cB, voffB); PG8_STAGE(PG8_SA(0, 0), cA, voffA); PG8_STAGE(PG8_SB(0, 1), cB + hstepB, voffB); PG8_STAGE(PG8_SA(0, 1), cA + hstepA, voffA);
        if (wr == 1) PG8_BAR;
        PG8_WAIT_V(4); PG8_BAR;
        PG8_STAGE(PG8_SB(1, 0), cB + kstep, voffB); PG8_STAGE(PG8_SA(1, 0), cA + kstep, voffA); PG8_STAGE(PG8_SB(1, 1), cB + hstepB + kstep, voffB);
        PG8_WAIT_V(6); PG8_BAR;
    }
    for (;;) {
        const bool has_next = S.next(ui + 1, nxt);
        const char* nA = has_next ? (const char*)g.A + (size_t)nxt.pm * tstepA : cA; const char* nB = has_next ? (const char*)g.Bt + (size_t)nxt.pn * tstepB : cB;
        for (int t = 0; t < nt; t += 2) {
            const bool last = (t == nt - 2);
            const char* a1 = cA + (size_t)(t + 1) * kstep;
            const char* a2 = last ? nA : cA + (size_t)(t + 2) * kstep; const char* b2 = last ? nB : cB + (size_t)(t + 2) * kstep;
            const char* a3 = a2 + kstep; const char* b3 = b2 + kstep;
            if (last && has_next) S.a_ready(nxt);
            if constexpr (SP2) {
            PG8_LDB(B0, 0, 0); PG8_LDB(B1, 0, 1); PG8_SCHED; PG8_LDA(At, 0, 0); PG8_STAGE(PG8_SA(1, 1), a1 + hstepA, voffA);
            PG8_WAIT_V(8); PG8_WAIT_L(0); PG8_BAR; PG8_MMA(0, 0, At, B0); PG8_MMA(0, 1, At, B1); PG8_BAR; PG8_SCHED;
            PG8_LDA(At, 0, 1); PG8_STAGE(PG8_SB(0, 0), b2, voffB); PG8_STAGE(PG8_SB(0, 1), b2 + hstepB, voffB); PG8_STAGE(PG8_SA(0, 0), a2, voffA);
            PG8_WAIT_V(8); PG8_WAIT_L(0); PG8_BAR; PG8_MMA(1, 0, At, B0); PG8_MMA(1, 1, At, B1); PG8_BAR; PG8_SCHED;
            PG8_LDB(B0, 1, 0); PG8_LDB(B1, 1, 1); PG8_SCHED; PG8_LDA(At, 1, 0); PG8_STAGE(PG8_SA(0, 1), a2 + hstepA, voffA);
            PG8_WAIT_V(8); PG8_WAIT_L(0); PG8_BAR; PG8_MMA(0, 0, At, B0); PG8_MMA(0, 1, At, B1); PG8_BAR; PG8_SCHED;
            PG8_LDA(At, 1, 1); PG8_STAGE(PG8_SB(1, 0), b3, voffB); PG8_STAGE(PG8_SB(1, 1), b3 + hstepB, voffB); PG8_STAGE(PG8_SA(1, 0), a3, voffA);
            PG8_WAIT_V(8); PG8_WAIT_L(0); PG8_BAR; PG8_MMA(1, 0, At, B0); PG8_MMA(1, 1, At, B1); PG8_BAR; PG8_SCHED;
            } else {
            PG8_LDB(B0, 0, 0); PG8_SCHED; PG8_LDA(At, 0, 0); PG8_STAGE(PG8_SA(1, 1), a1 + hstepA, voffA);
            PG8_WAIT_L(8); PG8_BAR; PG8_WAIT_L(0); PG8_MMA(0, 0, At, B0); PG8_BAR; PG8_SCHED;
            PG8_LDB(B1, 0, 1); PG8_STAGE(PG8_SB(0, 0), b2, voffB);
            PG8_BAR; PG8_WAIT_L(0); PG8_MMA(0, 1, At, B1); PG8_BAR;
            PG8_LDA(At, 0, 1); PG8_STAGE(PG8_SA(0, 0), a2, voffA);
            PG8_BAR; PG8_WAIT_L(0); PG8_MMA(1, 0, At, B0); PG8_BAR; PG8_SCHED;
            PG8_STAGE(PG8_SB(0, 1), b2 + hstepB, voffB);
            PG8_WAIT_V(6); PG8_BAR; PG8_MMA(1, 1, At, B1); PG8_BAR;
            PG8_LDB(B0, 1, 0); PG8_SCHED; PG8_LDA(At, 1, 0); PG8_STAGE(PG8_SA(0, 1), a2 + hstepA, voffA);
            PG8_WAIT_L(8); PG8_BAR; PG8_WAIT_L(0); PG8_MMA(0, 0, At, B0); PG8_BAR; PG8_SCHED;
            PG8_LDB(B1, 1, 1); PG8_STAGE(PG8_SB(1, 0), b3, voffB);
            PG8_BAR; PG8_WAIT_L(0); PG8_MMA(0, 1, At, B1); PG8_BAR;
            PG8_LDA(At, 1, 1); PG8_STAGE(PG8_SA(1, 0), a3, voffA);
            PG8_BAR; PG8_WAIT_L(0); PG8_MMA(1, 0, At, B0); PG8_BAR; PG8_SCHED;
            PG8_STAGE(PG8_SB(1, 1), b3 + hstepB, voffB);
            PG8_WAIT_V(6); PG8_BAR; PG8_MMA(1, 1, At, B1); PG8_BAR;
            }
        }
        if constexpr (ALIGN_EPI) { if (wr == 0) PG8_BAR; }
        if constexpr (!Epi::AFTER_DRAIN) { E(acc, cur, wr, wc, fr, fq); S.done(cur); }
        if (!has_next) break;
#pragma unroll
        for (int a = 0; a < 2; ++a)
#pragma unroll
            for (int b = 0; b < 2; ++b)
#pragma unroll
                for (int m = 0; m < 4; ++m)
#pragma unroll
                    for (int n = 0; n < 2; ++n) acc[a][b][m][n] = (f32x4){0.f, 0.f, 0.f, 0.f};
        cur = nxt; cA = nA; cB = nB; ++ui;
        if constexpr (ALIGN_EPI) { if (wr == 1) PG8_BAR; }
    }
    PG8_WAIT_V(0);
    if constexpr (!ALIGN_EPI) { if (wr == 0) PG8_BAR; }
    PG8_BAR;
    if constexpr (Epi::AFTER_DRAIN) { E.fused(acc, cur, wr, wc, fr, fq, lds, wid, lane); S.done(cur); }
#undef PG8_SA
#undef PG8_SB
#undef PG8_STAGE
#undef PG8_LDA
#undef PG8_LDB
#undef PG8_MMA
#undef PG8_WAIT_V
#undef PG8_WAIT_L
#undef PG8_BAR
#undef PG8_SCHED
}
}
#define GAS __attribute__((address_space(1)))
#define LAS __attribute__((address_space(3)))
typedef unsigned short bf16;
typedef unsigned v4u __attribute__((ext_vector_type(4)));
typedef unsigned v2u __attribute__((ext_vector_type(2)));
typedef float f32x4 __attribute__((ext_vector_type(4)));
typedef float f32x2 __attribute__((ext_vector_type(2)));
typedef GAS unsigned gu32;
using pg8::cvt_pk_bf16; using pg8::bf_lo; using pg8::bf_hi;

constexpr size_t MiB = 1u << 20;
constexpr size_t WS_CTL = 0, CTL_ZERO_BYTES = 64 * 1024;
constexpr size_t WS_ROPE = 1 * MiB;
constexpr size_t WS_LB = WS_ROPE + 640 * 1024;
constexpr size_t WS_W = 2 * MiB;
constexpr size_t W_IN = WS_W, W_UQ = W_IN + 1280ull * 1024 * 2, W_UKV = W_UQ + 1536ull * 768 * 2, W_O = W_UKV + 2048ull * 256 * 2, W_HIN = W_O + 1024ull * 1024 * 2,
                 W_HO = W_HIN + 5120ull * 1024 * 2, W_UP0 = W_HO + 1024ull * 1024 * 2, W_UP1 = W_UP0 + 5632ull * 1024 * 2, W_DN0 = W_UP1 + 5632ull * 1024 * 2, W_DN1 = W_DN0 + 1024ull * 2816 * 2,
                 W_END = W_DN1 + 1024ull * 2816 * 2;
static_assert(W_END <= 55 * MiB, "weights");
constexpr int SLACK = 256;
constexpr size_t ROWB = 2048;
constexpr size_t WS_B0 = 55 * MiB, B0_BYTES = (size_t)(M + 2 * SLACK) * ROWB;
static_assert(B0_BYTES <= 164 * MiB, "B0");
constexpr size_t WS_R = 219 * MiB;
constexpr size_t R_CQKV = WS_R;
constexpr size_t R_Q = R_CQKV + 164 * MiB;
constexpr size_t R_KV = R_Q + 245 * MiB;
constexpr size_t R_KROPE = R_KV + 326 * MiB;
constexpr size_t R_SSQ = R_KROPE + 6 * MiB;
constexpr size_t R_X_L0 = R_Q;
constexpr size_t R_ACT = WS_R;
constexpr size_t R_X_FFN = WS_R + 448 * MiB;
constexpr size_t R_HV = WS_R, R_HKF = WS_R + 163 * MiB, R_HKB = WS_R + 326 * MiB, R_HSG = WS_R + 489 * MiB;
constexpr size_t R_X_HG = WS_R;
constexpr size_t WS_END = 1024 * MiB;
static_assert(R_SSQ + (size_t)M * 16 * 4 <= WS_END && R_X_FFN + (size_t)M * 4096 <= WS_END && R_HSG + (size_t)M * ROWB <= WS_END, "d_ws map");
static_assert((size_t)M * 1536 * 2 + 64 * 3072 <= 245 * MiB && (size_t)M * 4096 + 64 * 4096 <= 326 * MiB && (size_t)M * DFF * 2 <= 448 * MiB && (size_t)M * ROWB <= 163 * MiB, "d_ws map 2");

constexpr int RING_OFF = 0, RING_BYTES = 131072;
constexpr int LDSCTL_OFF = 146432, MISC_OFF = LDSCTL_OFF + 320;
constexpr int LDS_BYTES = 147456;
constexpr int NWAVES = 8;

#define RLX_AGENT __ATOMIC_RELAXED, __HIP_MEMORY_SCOPE_AGENT
#define XB_TMO      128
#define XB_XCNT(j)  (256  + 64 * (j))
#define XB_XSUB(j)  (1280 + 64 * (j))
#define XB_XGEN(j)  (2304 + 64 * (j))
#define XB_TOP      3328
#define XB_TOPGEN   3392
#define XCD_BAR_WORDS 3456
#define XB_SPIN_CAP (1u << 18)

__device__ __forceinline__ unsigned xb_ld(unsigned* p)              { return __hip_atomic_load(p, __ATOMIC_RELAXED, __HIP_MEMORY_SCOPE_AGENT); }
__device__ __forceinline__ unsigned xb_add(unsigned* p, unsigned v) { return __hip_atomic_fetch_add(p, v, __ATOMIC_RELAXED, __HIP_MEMORY_SCOPE_AGENT); }
__device__ __forceinline__ unsigned xb_xcc_id() { return (unsigned)__builtin_amdgcn_s_getreg((3 << 11) | 20) & 0xFu; }
#define XB_SPIN(cond, bar) do { unsigned _sp = 0; while (cond) { __builtin_amdgcn_s_sleep(1); \
    if ((++_sp & 255u) == 0u) { if (xb_ld(&(bar)[XB_TMO])) break; if (_sp > XB_SPIN_CAP) { atomicAdd(&(bar)[XB_TMO], 1u); break; } } } } while (0)

struct XcdBarrier {
    unsigned* bar; unsigned x;
    volatile LAS unsigned* st;
};

__device__ __forceinline__ XcdBarrier xcd_barrier_post(unsigned* bar, volatile LAS unsigned* st) {
    XcdBarrier b; b.bar = bar; b.x = xb_xcc_id(); b.st = st;
    if (threadIdx.x == 0) (void)xb_add(&bar[XB_XCNT(b.x)], 1u);
    return b;
}
__device__ __forceinline__ void xcd_barrier_complete(unsigned* bar, unsigned x, unsigned& nloc, unsigned& nx) {
    const unsigned G = gridDim.x * gridDim.y * gridDim.z;
    unsigned sum, cnt, mine, sp = 0u;
    for (;;) {
        sum = 0u; cnt = 0u; mine = 0u;
#pragma unroll
        for (unsigned j = 0; j < 16; ++j) { const unsigned c = xb_ld(&bar[XB_XCNT(j)]); sum += c; cnt += (c > 0u) ? 1u : 0u; mine = (j == x) ? c : mine; }
        if (sum == G) break;
        __builtin_amdgcn_s_sleep(1);
        if ((++sp & 255u) == 0u) { if (xb_ld(&bar[XB_TMO])) break; if (sp > XB_SPIN_CAP) { atomicAdd(&bar[XB_TMO], 1u); break; } }
    }
    nloc = mine > 0u ? mine : 1u; nx = cnt > 0u ? cnt : 1u;
}

__device__ __forceinline__ void xcd_barrier(const XcdBarrier& b) {
    asm volatile("s_waitcnt vmcnt(0)" ::: "memory");
    __syncthreads();
    if (threadIdx.x == 0) {
        unsigned* bar = b.bar;
        __builtin_amdgcn_s_waitcnt(0);
        unsigned nloc = b.st[0], nx = b.st[1];
        if (nloc == 0u) { xcd_barrier_complete(bar, b.x, nloc, nx); b.st[0] = nloc; b.st[1] = nx; }
        const unsigned old = xb_add(&bar[XB_XSUB(b.x)], 1u);
        const unsigned gen = old / nloc;
        if (old + 1u == (gen + 1u) * nloc) {
            __builtin_amdgcn_fence(__ATOMIC_RELEASE, "agent");
            asm volatile("s_waitcnt vmcnt(0)" ::: "memory");
            const unsigned og = xb_add(&bar[XB_TOP], 1u);
            const unsigned tg = og / nx;
            if (og + 1u == (tg + 1u) * nx) xb_add(&bar[XB_TOPGEN], 1u);
            else XB_SPIN(xb_ld(&bar[XB_TOPGEN]) == tg, bar);
            __builtin_amdgcn_fence(__ATOMIC_ACQUIRE, "agent");
            xb_add(&bar[XB_XGEN(b.x)], 1u);
            asm volatile("s_waitcnt vmcnt(0)" ::: "memory");
        } else {
            XB_SPIN(xb_ld(&bar[XB_XGEN(b.x)]) == gen, bar);
            __builtin_amdgcn_fence(__ATOMIC_ACQUIRE, "agent");
            asm volatile("s_waitcnt vmcnt(0)" ::: "memory");
        }
    }
    __syncthreads();
}

struct Frame {
    LAS unsigned char* lds;
    volatile LAS unsigned* MISC;
    int tid, lane, wave;
    int vcu, G;
};
__device__ __forceinline__ float wave_sum(float v) {
#pragma unroll
    for (int o = 1; o < 64; o <<= 1) v += __shfl_xor(v, o);
    return v;
}
__device__ __forceinline__ unsigned f2bf(float f) { unsigned u = __builtin_bit_cast(unsigned, f); return (u + 0x7fffu + ((u >> 16) & 1u)) >> 16; }
__device__ __forceinline__ unsigned pk2(float lo, float hi) { return f2bf(lo) | (f2bf(hi) << 16); }

__device__ __forceinline__ int src_col(int kind, int n) {
    if (kind == 1) { if (n < 1024) return n; if (n >= 1056) return -1; const int e = n - 1024; return 1024 + ((e & 1) ? 16 + (e >> 1) : (e >> 1)); }
    if (kind == 2) { const int hd = n / 96, d = n % 96; if (d < 64) return n; const int e = d - 64; return hd * 96 + 64 + ((e & 1) ? 16 + (e >> 1) : (e >> 1)); }
    if (kind == 3) { const int pn = n >> 8, r = n & 255; return r < 128 ? 128 * pn + r : DFF + 128 * pn + (r - 128); }
    return n;
}
__device__ __forceinline__ void p0_transpose_item(const float* W, int K, int N, bf16* WT, int kind, const float* gain, LAS float* scr, int item, int lane, int NP) {
    const int nblk = NP / 32, kb = item / nblk, nb = item % nblk, k0 = 64 * kb, n0 = 32 * nb;
    const int sc = src_col(kind, n0 + (lane & 31));
#pragma unroll 8
    for (int i = 0; i < 32; ++i) { const int kk = 2 * i + (lane >> 5); float v = sc >= 0 ? W[(size_t)(k0 + kk) * N + sc] : 0.f; if (gain) v *= gain[k0 + kk]; scr[kk * 33 + (lane & 31)] = v; }
    asm volatile("s_waitcnt lgkmcnt(0)" ::: "memory");
    const int c = lane & 7;
#pragma unroll
    for (int j = 0; j < 4; ++j) { const int n = (lane >> 3) + 8 * j; const LAS float* s = scr + (8 * c) * 33 + n;
        v4u o; o.x = pk2(s[0 * 33], s[1 * 33]); o.y = pk2(s[2 * 33], s[3 * 33]); o.z = pk2(s[4 * 33], s[5 * 33]); o.w = pk2(s[6 * 33], s[7 * 33]);
        *(GAS v4u*)(WT + (size_t)(n0 + n) * K + k0 + 8 * c) = o; }
    asm volatile("s_waitcnt lgkmcnt(0)" ::: "memory");
}
struct WJob { const float* W; bf16* WT; const float* gain; int K, N, NP, kind; };
__device__ __forceinline__ void p0_prologue(Frame& F, const float* const* in, unsigned char* ws, bf16* h0) {
    LAS float* scr = (LAS float*)(F.lds + RING_OFF + F.wave * 16384);
    const int gw = F.vcu * NWAVES + F.wave, NGW = F.G * NWAVES;
#define WJOB(SRC, DST, GAIN, K_, N_, NP_, KIND) { const int nitems = ((K_) / 64) * ((NP_) / 32); for (int it = gw; it < nitems; it += NGW) p0_transpose_item(SRC, K_, N_, (bf16*)(ws + (DST)), KIND, GAIN, scr, it, F.lane, NP_); }
    WJOB(in[3], W_IN, nullptr, 1024, 1056, 1280, 1)
    WJOB(in[6], W_UQ, in[4], 768, 1536, 1536, 2)
    WJOB(in[7], W_UKV, in[5], 256, 2048, 2048, 0)
    WJOB(in[8], W_O, nullptr, 1024, 1024, 1024, 0)
    WJOB(in[9], W_HIN, nullptr, 1024, 5120, 5120, 0)
    WJOB(in[12], W_HO, nullptr, 1024, 1024, 1024, 0)
    WJOB(in[13], W_UP0, nullptr, 1024, NUP, NUP, 3)
    WJOB(in[13] + (size_t)1024 * NUP, W_UP1, nullptr, 1024, NUP, NUP, 3)
    WJOB(in[16], W_DN0, nullptr, DFF, 1024, 1024, 0)
    WJOB(in[16] + (size_t)DFF * 1024, W_DN1, nullptr, DFF, 1024, 1024, 0)
#undef WJOB
    for (int row0 = gw; row0 < M; row0 += 4 * NGW) {
        f32x4 v[4][4];
#pragma unroll
        for (int u = 0; u < 4; ++u) { const int row = row0 + u * NGW; const int rc = row < M ? row : M - 1; const int b = rc / LP, s = rc % LP;
            const float* src = s < PADR ? in[2] : s < PADR + 16 ? in[2] + (size_t)(s - PADR) * 1024 : (b < 16 ? in[0] + ((size_t)b * SEQ + (s - 64)) * 1024 : in[1] + ((size_t)(b - 16) * SEQ + (s - 64)) * 1024);
            const GAS f32x4* xr = (const GAS f32x4*)src + F.lane;
#pragma unroll
            for (int j = 0; j < 4; ++j) v[u][j] = xr[64 * j]; }
#pragma unroll
        for (int u = 0; u < 4; ++u) { const int row = row0 + u * NGW; if (row >= M) continue; const int s = row % LP;
            GAS unsigned long long* o8 = (GAS unsigned long long*)(h0 + (size_t)row * 1024) + F.lane;
#pragma unroll
            for (int j = 0; j < 4; ++j) o8[64 * j] = s < PADR ? 0ull : ((unsigned long long)pk2(v[u][j].x, v[u][j].y) | ((unsigned long long)pk2(v[u][j].z, v[u][j].w) << 32)); }
    }
    { const int gt = gw * 64 + F.lane, NGT = NGW * 64; GAS v4u* z0 = (GAS v4u*)(ws + WS_B0); GAS v4u* z1 = (GAS v4u*)(ws + WS_B0 + (size_t)(SLACK + M) * ROWB);
      const int n16 = SLACK * (int)ROWB / 16;
      for (int i = gt; i < n16; i += NGT) { z0[i] = (v4u){0u, 0u, 0u, 0u}; z1[i] = (v4u){0u, 0u, 0u, 0u}; } }
    { const int gt = gw * 64 + F.lane, NGT = NGW * 64; f32x2* tab = (f32x2*)(ws + WS_ROPE);
      for (int i = gt; i < LTOK * 16; i += NGT) { const int pos = i >> 4, k = i & 15;
          const float inv = 1.0f / powf(10000.0f, (float)(2 * k) / 32.0f); const float ang = (float)pos * inv;
          f32x2 cs; cs.x = (float)cos((double)ang); cs.y = (float)sin((double)ang); tab[i] = cs; } }
    { const int gt = gw * 64 + F.lane; float* lb = (float*)(ws + WS_LB);
      if (gt < 2048) { const int d = gt >> 10, k = gt & 1023; const float x0 = in[10][(size_t)(d * 2 + 0) * 1024 + k], x1 = in[10][(size_t)(d * 2 + 1) * 1024 + k];
          lb[gt] = 1.0f / (1.0f + expf(x0 - x1)); } }
}

template <bool FINAL> __device__ __forceinline__ void ln_pass(Frame& F, const float* X, const float* gain, const float* bias, bf16* hout, float* out) {
    const int gw = F.vcu * NWAVES + F.wave, NGW = F.G * NWAVES;
    f32x4 g[4], bb[4];
#pragma unroll
    for (int j = 0; j < 4; ++j) { g[j] = ((const f32x4*)gain)[64 * j + F.lane]; bb[j] = ((const f32x4*)bias)[64 * j + F.lane]; }
    for (int row0 = gw; row0 < M; row0 += 4 * NGW) {
        f32x4 v[4][4];
#pragma unroll
        for (int u = 0; u < 4; ++u) { const int row = row0 + u * NGW; const int rc = row < M ? row : M - 1; const GAS f32x4* xr = (const GAS f32x4*)(X + (size_t)rc * 1024) + F.lane;
#pragma unroll
            for (int j = 0; j < 4; ++j) v[u][j] = xr[64 * j]; }
#pragma unroll
        for (int u = 0; u < 4; ++u) { const int row = row0 + u * NGW; if (row >= M) continue;
            const int b = row / LP, s = row % LP;
            if (FINAL) { if (s < 64) continue; }
            else if (s < PADR) { GAS unsigned long long* o8 = (GAS unsigned long long*)(hout + (size_t)row * 1024) + F.lane;
#pragma unroll
                for (int j = 0; j < 4; ++j) o8[64 * j] = 0ull;
                continue; }
            float sm = 0.f;
#pragma unroll
            for (int j = 0; j < 4; ++j) sm += (v[u][j].x + v[u][j].y) + (v[u][j].z + v[u][j].w);
            const float mean = wave_sum(sm) * (1.f / 1024.f); float s2 = 0.f;
#pragma unroll
            for (int j = 0; j < 4; ++j) { v[u][j] = v[u][j] - mean; s2 += (v[u][j].x * v[u][j].x + v[u][j].y * v[u][j].y) + (v[u][j].z * v[u][j].z + v[u][j].w * v[u][j].w); }
            const float rstd = 1.f / sqrtf(wave_sum(s2) * (1.f / 1024.f) + EPS);
            if (FINAL) { GAS f32x4* o = (GAS f32x4*)(out + ((size_t)b * SEQ + (s - 64)) * 1024) + F.lane;
#pragma unroll
                for (int j = 0; j < 4; ++j) o[64 * j] = v[u][j] * rstd * g[j] + bb[j];
            } else { GAS unsigned long long* o8 = (GAS unsigned long long*)(hout + (size_t)row * 1024) + F.lane;
#pragma unroll
                for (int j = 0; j < 4; ++j) { const f32x4 y = v[u][j] * rstd * g[j] + bb[j]; o8[64 * j] = (unsigned long long)cvt_pk_bf16(y.x, y.y) | ((unsigned long long)cvt_pk_bf16(y.z, y.w) << 32); } }
        }
    }
}
__device__ __forceinline__ void attn_simple(Frame& F, const bf16* Q, const bf16* KV, const bf16* KR, bf16* O) {
    LAS float* Ks = (LAS float*)(F.lds);
    LAS float* Vs = (LAS float*)(F.lds + 64 * 96 * 4);
    constexpr int NQC = 17;
    const int hf = F.tid & 1;
    for (int u = F.vcu; u < NB * 16 * NQC; u += F.G) {
        const int bh = u / NQC, qc = u % NQC, b = bh >> 4, h = bh & 15;
        const int sq = qc * 256 + (F.tid >> 1); const bool vq = sq < LP; const size_t rowq = (size_t)b * LP + (vq ? sq : LP - 1);
        float q[48];
#pragma unroll
        for (int c = 0; c < 6; ++c) { const v4u w = *(const GAS v4u*)(Q + rowq * 1536 + h * 96 + hf * 48 + c * 8);
            q[c * 8 + 0] = bf_lo(w.x); q[c * 8 + 1] = bf_hi(w.x); q[c * 8 + 2] = bf_lo(w.y); q[c * 8 + 3] = bf_hi(w.y);
            q[c * 8 + 4] = bf_lo(w.z); q[c * 8 + 5] = bf_hi(w.z); q[c * 8 + 6] = bf_lo(w.w); q[c * 8 + 7] = bf_hi(w.w); }
        float o[32];
#pragma unroll
        for (int d = 0; d < 32; ++d) o[d] = 0.f;
        float mx = -1e30f, l = 0.f;
        for (int kt = 0; kt < 65; ++kt) {
            __syncthreads();
            for (int idx = F.tid; idx < 64 * 12; idx += 512) { const int j = idx / 12, c = idx % 12; int sk = PADR + kt * 64 + j; sk = sk < LP ? sk : LP - 1; const size_t rk = (size_t)b * LP + sk;
                const v4u w = c < 8 ? *(const GAS v4u*)(KV + rk * 2048 + h * 128 + c * 8) : *(const GAS v4u*)(KR + rk * 32 + (c - 8) * 8);
                LAS float* d = Ks + j * 96 + c * 8; d[0] = bf_lo(w.x); d[1] = bf_hi(w.x); d[2] = bf_lo(w.y); d[3] = bf_hi(w.y); d[4] = bf_lo(w.z); d[5] = bf_hi(w.z); d[6] = bf_lo(w.w); d[7] = bf_hi(w.w); }
            { const int j = F.tid >> 3, c = F.tid & 7; int sk = PADR + kt * 64 + j; sk = sk < LP ? sk : LP - 1; const size_t rk = (size_t)b * LP + sk;
                const v4u w = *(const GAS v4u*)(KV + rk * 2048 + h * 128 + 64 + c * 8);
                LAS float* d = Vs + j * 64 + c * 8; d[0] = bf_lo(w.x); d[1] = bf_hi(w.x); d[2] = bf_lo(w.y); d[3] = bf_hi(w.y); d[4] = bf_lo(w.z); d[5] = bf_hi(w.z); d[6] = bf_lo(w.w); d[7] = bf_hi(w.w); }
            __syncthreads();
            const int nk = (LTOK - kt * 64) < 64 ? (LTOK - kt * 64) : 64;
#pragma unroll 1
            for (int jj = 0; jj < nk; ++jj) {
                const LAS f32x4* kr = (const LAS f32x4*)(Ks + jj * 96 + hf * 48); float a0 = 0.f, a1 = 0.f;
#pragma unroll
                for (int c = 0; c < 12; c += 2) { const f32x4 k0 = kr[c], k1 = kr[c + 1];
                    a0 += q[4 * c] * k0.x + q[4 * c + 1] * k0.y + q[4 * c + 2] * k0.z + q[4 * c + 3] * k0.w;
                    a1 += q[4 * c + 4] * k1.x + q[4 * c + 5] * k1.y + q[4 * c + 6] * k1.z + q[4 * c + 7] * k1.w; }
                float sc = a0 + a1; sc += __shfl_xor(sc, 1);
                const float mn = fmaxf(mx, sc);
                const float al = __builtin_amdgcn_exp2f(mx - mn), p = __builtin_amdgcn_exp2f(sc - mn); mx = mn; l = l * al + p;
                const LAS f32x4* vr = (const LAS f32x4*)(Vs + jj * 64 + hf * 32);
#pragma unroll
                for (int c = 0; c < 8; ++c) { const f32x4 vv = vr[c]; o[4 * c] = fmaf(p, vv.x, o[4 * c] * al); o[4 * c + 1] = fmaf(p, vv.y, o[4 * c + 1] * al); o[4 * c + 2] = fmaf(p, vv.z, o[4 * c + 2] * al); o[4 * c + 3] = fmaf(p, vv.w, o[4 * c + 3] * al); }
            }
        }
        if (vq) { const float il = 1.0f / l;
#pragma unroll
            for (int c = 0; c < 4; ++c) { v4u w; w.x = cvt_pk_bf16(o[8 * c] * il, o[8 * c + 1] * il); w.y = cvt_pk_bf16(o[8 * c + 2] * il, o[8 * c + 3] * il); w.z = cvt_pk_bf16(o[8 * c + 4] * il, o[8 * c + 5] * il); w.w = cvt_pk_bf16(o[8 * c + 6] * il, o[8 * c + 7] * il);
                *(GAS v4u*)(O + rowq * 1024 + h * 64 + hf * 32 + c * 8) = w; } }
    }
    __syncthreads();
}

__device__ __forceinline__ void gla_simple(Frame& F, bf16* Qb, const bf16* Vb, bf16* KFb, const bf16* KBb, const bf16* SGb, const float* onorm) {
    LAS float* tq = (LAS float*)(F.lds);
    LAS float* tk = (LAS float*)(F.lds + 16384);
    LAS float* tv = (LAS float*)(F.lds + 32768);
    LAS float* pr = (LAS float*)(F.lds + 49152);
    const int j = F.tid & 127, kq = F.tid >> 7;
    for (int it = F.vcu; it < NB * 8; it += F.G) {
        const int b = it >> 3, h = it & 7; const size_t cbase = (size_t)h * 128;
        for (int dir = 0; dir < 2; ++dir) {
            float S[32];
#pragma unroll
            for (int k = 0; k < 32; ++k) S[k] = 0.f;
            const bf16* Kg = dir == 0 ? KFb : KBb;
            for (int tile = 0; tile < (LTOK + 31) / 32; ++tile) {
                __syncthreads();
                { const int i = F.tid >> 4, c8 = (F.tid & 15) * 8; const int tt = tile * 32 + i; const bool vt = tt < LTOK; const int tok = dir == 0 ? tt : LTOK - 1 - tt;
                  const size_t off = ((size_t)b * LP + PADR + (vt ? tok : 0)) * 1024 + cbase + c8;
                  v4u wq = *(const GAS v4u*)(Qb + off), wk = *(const GAS v4u*)(Kg + off), wv = *(const GAS v4u*)(Vb + off);
                  if (!vt) { wq = (v4u){0u, 0u, 0u, 0u}; wk = wq; wv = wq; }
                  LAS float* dq = tq + i * 128 + c8; LAS float* dk = tk + i * 128 + c8; LAS float* dv = tv + i * 128 + c8;
                  dq[0] = bf_lo(wq.x); dq[1] = bf_hi(wq.x); dq[2] = bf_lo(wq.y); dq[3] = bf_hi(wq.y); dq[4] = bf_lo(wq.z); dq[5] = bf_hi(wq.z); dq[6] = bf_lo(wq.w); dq[7] = bf_hi(wq.w);
                  dk[0] = bf_lo(wk.x); dk[1] = bf_hi(wk.x); dk[2] = bf_lo(wk.y); dk[3] = bf_hi(wk.y); dk[4] = bf_lo(wk.z); dk[5] = bf_hi(wk.z); dk[6] = bf_lo(wk.w); dk[7] = bf_hi(wk.w);
                  dv[0] = bf_lo(wv.x); dv[1] = bf_hi(wv.x); dv[2] = bf_lo(wv.y); dv[3] = bf_hi(wv.y); dv[4] = bf_lo(wv.z); dv[5] = bf_hi(wv.z); dv[6] = bf_lo(wv.w); dv[7] = bf_hi(wv.w); }
                __syncthreads();
                for (int i = 0; i < 32; ++i) {
                    const float vj = tv[i * 128 + j]; float part = 0.f;
                    const LAS f32x4* kr = (const LAS f32x4*)(tk + i * 128 + kq * 32); const LAS f32x4* qr = (const LAS f32x4*)(tq + i * 128 + kq * 32);
#pragma unroll
                    for (int c = 0; c < 8; ++c) { const f32x4 kk = kr[c], qq = qr[c];
                        S[4 * c] = fmaf(kk.x, vj - S[4 * c], S[4 * c]); part = fmaf(S[4 * c], qq.x, part);
                        S[4 * c + 1] = fmaf(kk.y, vj - S[4 * c + 1], S[4 * c + 1]); part = fmaf(S[4 * c + 1], qq.y, part);
                        S[4 * c + 2] = fmaf(kk.z, vj - S[4 * c + 2], S[4 * c + 2]); part = fmaf(S[4 * c + 2], qq.z, part);
                        S[4 * c + 3] = fmaf(kk.w, vj - S[4 * c + 3], S[4 * c + 3]); part = fmaf(S[4 * c + 3], qq.w, part); }
                    pr[(i * 4 + kq) * 128 + j] = part;
                }
                __syncthreads();
#pragma unroll
                for (int ii = 0; ii < 4; ++ii) { const int i = F.wave * 4 + ii; const int tt = tile * 32 + i; const bool vt = tt < LTOK; const int tok = dir == 0 ? tt : LTOK - 1 - tt;
                    const int c = 2 * F.lane;
                    float o0 = pr[(i * 4 + 0) * 128 + c] + pr[(i * 4 + 1) * 128 + c] + pr[(i * 4 + 2) * 128 + c] + pr[(i * 4 + 3) * 128 + c];
                    float o1 = pr[(i * 4 + 0) * 128 + c + 1] + pr[(i * 4 + 1) * 128 + c + 1] + pr[(i * 4 + 2) * 128 + c + 1] + pr[(i * 4 + 3) * 128 + c + 1];
                    const size_t off = ((size_t)b * LP + PADR + (vt ? tok : 0)) * 1024 + cbase + c;
                    if (dir == 0) { if (vt) *(GAS unsigned*)(KFb + off) = cvt_pk_bf16(o0, o1); }
                    else { const unsigned wf = *(const GAS unsigned*)(KFb + off); o0 += bf_lo(wf); o1 += bf_hi(wf);
                        const float ss = wave_sum(o0 * o0 + o1 * o1); const float rstd = 1.0f / sqrtf(ss * (1.0f / 128.0f) + EPS);
                        const unsigned wg = *(const GAS unsigned*)(SGb + off); const f32x2 gn = *(const f32x2*)(onorm + cbase + c);
                        if (vt) *(GAS unsigned*)(Qb + off) = cvt_pk_bf16(o0 * rstd * gn.x * bf_lo(wg), o1 * rstd * gn.y * bf_hi(wg)); } }
            }
            __syncthreads();
        }
    }
    __syncthreads();
}
namespace fa {
using bf16x8 = __attribute__((ext_vector_type(8))) short;
using s16x4  = __attribute__((ext_vector_type(4))) short;
using f32x16 = __attribute__((ext_vector_type(16))) float;
using u32x4  = __attribute__((ext_vector_type(4))) unsigned;
constexpr int KROW = 208;
constexpr int SHM_V = 64 * 64 * 2, SHM_K = 64 * KROW;
constexpr int OFF_V = 0, OFF_K = 2 * SHM_V, OFF_WS = OFF_K + 2 * SHM_K, OFF_STG = OFF_WS + 8 * 256, LDS_TOTAL = OFF_STG + 8 * 4096;
constexpr int NT = 65, NQC = 17;
#define FA_SBAR() __builtin_amdgcn_sched_barrier(0)
__device__ __forceinline__ int crow(int r, int hi) { return (r & 3) + 8 * (r >> 2) + 4 * hi; }
constexpr float THRL = 11.5f;
__device__ __forceinline__ void partialSM(f32x16& p0, f32x16& p1, float& mhat, f32x16& negm, float& alpha, bool first) {
  float a = fmaxf(fmaxf(p0[0], p0[1]), p1[0]), b = fmaxf(fmaxf(p0[2], p0[3]), p1[1]); a = fmaxf(fmaxf(a, p1[2]), p1[3]);
#pragma unroll
  for (int r = 4; r < 16; r += 4) { a = fmaxf(fmaxf(a, p0[r]), p0[r + 1]); b = fmaxf(fmaxf(b, p0[r + 2]), p0[r + 3]); a = fmaxf(fmaxf(a, p1[r]), p1[r + 1]); b = fmaxf(fmaxf(b, p1[r + 2]), p1[r + 3]); }
  float rm = fmaxf(a, b);
  { auto rr = __builtin_amdgcn_permlane32_swap(__float_as_uint(rm), __float_as_uint(rm), false, false);
    rm = fmaxf(__uint_as_float(rr[0]), __uint_as_float(rr[1])); }
  alpha = 1.f;
  if (first || __builtin_expect(__any(rm > THRL), 0)) { const float dl = first ? rm : fmaxf(rm, 0.f); mhat += dl;
#pragma unroll
    for (int r = 0; r < 16; ++r) { p0[r] -= dl; p1[r] -= dl; }
#pragma unroll
    for (int r = 0; r < 16; ++r) negm[r] = -mhat;
    asm volatile("" : "+v"(negm));
    alpha = __builtin_amdgcn_exp2f(-dl); }
#pragma unroll
  for (int r = 0; r < 16; ++r) p0[r] = __builtin_amdgcn_exp2f(p0[r]);
}
__device__ __forceinline__ void finishSM(f32x16& p0, f32x16& p1, float alpha, float& l_reg, bf16x8& pa0, bf16x8& pa1, bf16x8& pa2, bf16x8& pa3) {
#pragma unroll
  for (int r = 0; r < 16; ++r) p1[r] = __builtin_amdgcn_exp2f(p1[r]);
  float ps = 0;
#pragma unroll
  for (int r = 0; r < 16; ++r) ps += p0[r];
#pragma unroll
  for (int r = 0; r < 16; ++r) ps += p1[r];
  { auto rr = __builtin_amdgcn_permlane32_swap(__float_as_uint(ps), __float_as_uint(ps), false, false);
    ps = __uint_as_float(rr[0]) + __uint_as_float(rr[1]); }
  l_reg = l_reg * alpha + ps;
#define FA_PK4(P, BASE, OUT) do { unsigned a0 = cvt_pk_bf16(P[BASE + 0], P[BASE + 1]), a1 = cvt_pk_bf16(P[BASE + 2], P[BASE + 3]);   \
    unsigned b0 = cvt_pk_bf16(P[BASE + 4], P[BASE + 5]), b1 = cvt_pk_bf16(P[BASE + 6], P[BASE + 7]);                              \
    auto r0 = __builtin_amdgcn_permlane32_swap(a0, b0, false, false); auto r1 = __builtin_amdgcn_permlane32_swap(a1, b1, false, false); \
    u32x4 w = {r0[0], r1[0], r0[1], r1[1]}; OUT = *reinterpret_cast<bf16x8*>(&w); } while (0)
  FA_PK4(p0, 0, pa0); FA_PK4(p0, 8, pa1); FA_PK4(p1, 0, pa2); FA_PK4(p1, 8, pa3);
#undef FA_PK4
}
__device__ __forceinline__ void qkt(f32x16& p0, f32x16& p1, const char* Ks, const bf16x8* qr, const f32x16& negm, int r32, int hi) {
#pragma unroll
  for (int d0 = 0; d0 < 6; ++d0) { const int cb = (d0 * 16 + hi * 8) * 2;
    const bf16x8 b0 = *reinterpret_cast<const bf16x8*>(Ks + r32 * KROW + cb);
    const bf16x8 b1 = *reinterpret_cast<const bf16x8*>(Ks + (32 + r32) * KROW + cb);
    if (d0 == 0) { p0 = __builtin_amdgcn_mfma_f32_32x32x16_bf16(b0, qr[0], negm, 0, 0, 0); p1 = __builtin_amdgcn_mfma_f32_32x32x16_bf16(b1, qr[0], negm, 0, 0, 0); }
    else { p0 = __builtin_amdgcn_mfma_f32_32x32x16_bf16(b0, qr[d0], p0, 0, 0, 0); p1 = __builtin_amdgcn_mfma_f32_32x32x16_bf16(b1, qr[d0], p1, 0, 0, 0); } }
}
__device__ __forceinline__ int v_st(int k, int c) { const int kk = (k & ~0xC) | ((k & 4) << 1) | ((k & 8) >> 1); return ((kk >> 3) * 2 + (c >> 5)) * 512 + ((kk & 7) * 32 + (c & 31)) * 2; }
__device__ __forceinline__ int v_rd_base(int lane) { return ((lane & 3) << 3) | (((lane >> 2) & 3) << 6) | (((lane >> 4) & 1) << 5) | (((lane >> 5) & 1) << 8); }
constexpr int v_rd_off(int d0, int ks, int half) { return d0 * 512 + ks * 2048 + half * 1024; }
template <int OFF> __device__ __forceinline__ s16x4 tr_read(int vb) {
  s16x4 r; asm volatile("ds_read_b64_tr_b16 %0, %1 offset:%2" : "=&v"(r) : "v"(vb), "i"(OFF) : "memory"); return r;
}
template <int D0> __device__ __forceinline__ void pv_one(f32x16& od, int vb, bf16x8 pa0, bf16x8 pa1, bf16x8 pa2, bf16x8 pa3) {
  const s16x4 l0 = tr_read<v_rd_off(D0, 0, 0)>(vb), h0 = tr_read<v_rd_off(D0, 0, 1)>(vb), l1 = tr_read<v_rd_off(D0, 1, 0)>(vb), h1 = tr_read<v_rd_off(D0, 1, 1)>(vb);
  const s16x4 l2 = tr_read<v_rd_off(D0, 2, 0)>(vb), h2 = tr_read<v_rd_off(D0, 2, 1)>(vb), l3 = tr_read<v_rd_off(D0, 3, 0)>(vb), h3 = tr_read<v_rd_off(D0, 3, 1)>(vb);
  asm volatile("s_waitcnt lgkmcnt(0)" ::: "memory"); FA_SBAR();
#define FA_PK(L, H) (bf16x8){L[0], L[1], L[2], L[3], H[0], H[1], H[2], H[3]}
  od = __builtin_amdgcn_mfma_f32_32x32x16_bf16(pa0, FA_PK(l0, h0), od, 0, 0, 0);
  od = __builtin_amdgcn_mfma_f32_32x32x16_bf16(pa1, FA_PK(l1, h1), od, 0, 0, 0);
  od = __builtin_amdgcn_mfma_f32_32x32x16_bf16(pa2, FA_PK(l2, h2), od, 0, 0, 0);
  od = __builtin_amdgcn_mfma_f32_32x32x16_bf16(pa3, FA_PK(l3, h3), od, 0, 0, 0);
#undef FA_PK
}
__device__ __forceinline__ void pv_d0(f32x16* o, int vb, bf16x8 pa0, bf16x8 pa1, bf16x8 pa2, bf16x8 pa3) {
  pv_one<0>(o[0], vb, pa0, pa1, pa2, pa3); pv_one<1>(o[1], vb, pa0, pa1, pa2, pa3);
}
__device__ __forceinline__ void attn_unit(int b, int h, int q0, const bf16* __restrict__ Q, const bf16* __restrict__ KV, const bf16* __restrict__ KR, bf16* __restrict__ O, char* lds) {
  const int tid = threadIdx.x, wid = tid >> 6, lane = tid & 63, r32 = lane & 31, hi = lane >> 5;
  char* V_lds = lds + OFF_V; char* K_lds = lds + OFF_K;
  float* ws = (float*)(lds + OFF_WS) + wid * 64; float* li_l = ws; float* al_l = ws + 32;
  float mhat = 0.f, l_reg = 0; f32x16 o[2] = {}; bf16x8 qr[6]; f32x16 negm = f32x16{}; asm volatile("" : "+v"(negm));
  const size_t seq0 = (size_t)b * LP;
  { int sq = q0 + wid * 32 + r32; sq = sq < LP ? sq : LP - 1;
    const bf16* Qw = Q + (seq0 + sq) * 1536 + h * 96 + hi * 8;
#pragma unroll
    for (int d0 = 0; d0 < 6; ++d0) qr[d0] = *reinterpret_cast<const bf16x8*>(Qw + d0 * 16); }
  const int sr = tid >> 3, sc = (tid & 7) * 8, rr = (tid >> 2) & 63, rc = (tid & 3) * 8; const bool hasr = tid < 256;
  const int vst = v_st(sr, sc), kst = sr * KROW + sc * 2, rst = rr * KROW + 128 + rc * 2;
  const bf16* Kn = KV + seq0 * 2048 + h * 128 + (size_t)sr * 2048 + sc; const bf16* Vn = Kn + 64; const bf16* Rn = KR + seq0 * 32 + (size_t)rr * 32 + rc;
  const int vb0 = (int)(uintptr_t)V_lds + v_rd_base(lane);
  struct { bf16x8 vs, ks, rs; } sr_[2];
#define FA_SLOAD(i, k0) do { sr_[i].vs = *reinterpret_cast<const bf16x8*>(Vn + (size_t)(k0) * 2048); sr_[i].ks = *reinterpret_cast<const bf16x8*>(Kn + (size_t)(k0) * 2048); \
    if (hasr) sr_[i].rs = *reinterpret_cast<const bf16x8*>(Rn + (size_t)(k0) * 32); } while (0)
#define FA_SWRITE(bf, i) do { *(bf16x8*)(V_lds + (bf) * SHM_V + vst) = sr_[i].vs; *(bf16x8*)(K_lds + (bf) * SHM_K + kst) = sr_[i].ks; \
    if (hasr) *(bf16x8*)(K_lds + (bf) * SHM_K + rst) = sr_[i].rs; } while (0)
#define FA_SWAIT() asm volatile("s_waitcnt vmcnt(3)" ::: "memory")
#define FA_RESC(a) do { if (__any((a) < 1.f)) { if (hi == 0) al_l[r32] = (a); asm volatile("s_waitcnt lgkmcnt(0)" ::: "memory"); \
    _Pragma("unroll") for (int d = 0; d < 2; ++d) _Pragma("unroll") for (int r = 0; r < 16; ++r) o[d][r] *= al_l[crow(r, hi)]; } } while (0)
  f32x16 pA0, pA1, pB0, pB1; float alA, alB; bf16x8 pa0, pa1, pa2, pa3;
  constexpr int SE = 0, SO = 1;
  __syncthreads();
  FA_SLOAD(SE, 0); asm volatile("s_waitcnt vmcnt(0)" ::: "memory"); FA_SWRITE(0, SE); __syncthreads();
  qkt(pA0, pA1, K_lds, qr, negm, r32, hi);
  { const float NEG = -INFINITY;
#pragma unroll
    for (int r = 0; r < 16; ++r) pA0[r] = NEG;
#pragma unroll
    for (int r = 0; r < 8; ++r) pA1[r] = NEG; }
  partialSM(pA0, pA1, mhat, negm, alA, true);
  FA_SLOAD(SO, 64); FA_SLOAD(SE, 128);
  FA_SWAIT(); FA_SWRITE(1, SO); __syncthreads();
  for (int j = 1; j + 1 < NT; j += 2) {
    FA_SBAR(); qkt(pB0, pB1, K_lds + SHM_K, qr, negm, r32, hi);
    finishSM(pA0, pA1, alA, l_reg, pa0, pa1, pa2, pa3); FA_SBAR();
    if (j + 2 < NT) FA_SLOAD(SO, (j + 2) * 64); FA_SBAR();
    pv_d0(o, vb0, pa0, pa1, pa2, pa3); partialSM(pB0, pB1, mhat, negm, alB, false);
    __syncthreads(); FA_SWAIT(); FA_SWRITE(0, SE);
    FA_RESC(alB); __syncthreads();
    FA_SBAR(); qkt(pA0, pA1, K_lds, qr, negm, r32, hi);
    finishSM(pB0, pB1, alB, l_reg, pa0, pa1, pa2, pa3); FA_SBAR();
    if (j + 3 < NT) FA_SLOAD(SE, (j + 3) * 64); FA_SBAR();
    pv_d0(o, vb0 + SHM_V, pa0, pa1, pa2, pa3); partialSM(pA0, pA1, mhat, negm, alA, false);
    __syncthreads(); FA_SWAIT(); if (j + 2 < NT) FA_SWRITE(1, SO);
    FA_RESC(alA); __syncthreads();
  }
  finishSM(pA0, pA1, alA, l_reg, pa0, pa1, pa2, pa3); FA_SBAR();
  pv_d0(o, vb0, pa0, pa1, pa2, pa3);
  if (hi == 0) li_l[r32] = l_reg; asm volatile("s_waitcnt lgkmcnt(0)" ::: "memory");
  float rli[16];
#pragma unroll
  for (int r = 0; r < 16; ++r) rli[r] = __builtin_amdgcn_rcpf(li_l[crow(r, hi)]);
  { unsigned short* stg = (unsigned short*)(lds + OFF_STG) + wid * 2048;
#pragma unroll
    for (int r = 0; r < 16; ++r) { const int orow = crow(r, hi);
#pragma unroll
      for (int d0 = 0; d0 < 2; ++d0) stg[orow * 64 + d0 * 32 + r32] = (unsigned short)(cvt_pk_bf16(o[d0][r] * rli[r], 0.f) & 0xffffu); }
    asm volatile("s_waitcnt lgkmcnt(0)" ::: "memory");
#pragma unroll
    for (int i = 0; i < 4; ++i) { const int row = i * 8 + (lane >> 3), ch = lane & 7; const int sq = q0 + wid * 32 + row; const u32x4 v = *(const u32x4*)(stg + row * 64 + ch * 8);
      if (sq < LP) *(u32x4*)(O + (seq0 + sq) * 1024 + h * 64 + ch * 8) = v; } }
#undef FA_SLOAD
#undef FA_SWRITE
#undef FA_SWAIT
#undef FA_RESC
}
__device__ __forceinline__ void attn_phase(int vcu, int G, const bf16* Q, const bf16* KV, const bf16* KR, bf16* O, char* lds) {
  for (int u = vcu; u < NB * 16 * NQC; u += G) { const int bh = u / NQC, qc = u % NQC; attn_unit(bh >> 4, bh & 15, qc * 256, Q, KV, KR, O, lds); }
  __syncthreads();
}
#undef FA_SBAR
}
namespace gla {
using bf16x8 = __attribute__((ext_vector_type(8))) short;
using s16x4  = __attribute__((ext_vector_type(4))) short;
using f32x16 = __attribute__((ext_vector_type(16))) float;
using u32x4  = __attribute__((ext_vector_type(4))) unsigned;
using u32x2  = __attribute__((ext_vector_type(2))) unsigned;
constexpr int RS = 264;
constexpr int O_QI = 0, O_KI = 64 * RS, O_KD = 2 * 64 * RS, O_VV = O_KD + 16384, O_VEC = O_VV + 16384;
constexpr int V_DEC = O_VEC, V_EREF = O_VEC + 512, V_TOT = O_VEC + 1024, V_F2 = O_VEC + 1024 + 2048;
constexpr int CH_BYTES = O_VEC + 3584;
static_assert(CH_BYTES % 16 == 0 && 2 * CH_BYTES <= 146432, "gla LDS");
#define GLA_SBAR() __builtin_amdgcn_sched_barrier(0)
__device__ __forceinline__ int crow(int r, int hi) { return (r & 3) + 8 * (r >> 2) + 4 * hi; }
__device__ __forceinline__ int v_st4(int k, int c) { const int kk = (k & ~0xC) | ((k & 4) << 1) | ((k & 8) >> 1); return ((kk >> 3) * 4 + (c >> 5)) * 512 + ((kk & 7) * 32 + (c & 31)) * 2; }
__device__ __forceinline__ int v_rd_base(int lane) { return ((lane & 3) << 3) | (((lane >> 2) & 3) << 6) | (((lane >> 4) & 1) << 5) | (((lane >> 5) & 1) << 8); }
template <int OFF> __device__ __forceinline__ s16x4 tr_read(int vb) {
  s16x4 r; asm volatile("ds_read_b64_tr_b16 %0, %1 offset:%2" : "=&v"(r) : "v"(vb), "i"(OFF) : "memory"); return r;
}
__device__ __forceinline__ bf16x8 nat_frag(const char* img, int row, int ks, int hi) {
  const u32x2 a = *(const u32x2*)(img + row * RS + (16 * ks + 4 * hi) * 2), b = *(const u32x2*)(img + row * RS + (16 * ks + 8 + 4 * hi) * 2);
  u32x4 w = {a.x, a.y, b.x, b.y}; return *reinterpret_cast<bf16x8*>(&w);
}
__device__ __forceinline__ bf16x8 pk4(const f32x16& P, int BASE_IS_8) {
  const int B = BASE_IS_8 ? 8 : 0;
  const unsigned a0 = cvt_pk_bf16(P[B + 0], P[B + 1]), a1 = cvt_pk_bf16(P[B + 2], P[B + 3]), b0 = cvt_pk_bf16(P[B + 4], P[B + 5]), b1 = cvt_pk_bf16(P[B + 6], P[B + 7]);
  auto r0 = __builtin_amdgcn_permlane32_swap(a0, b0, false, false); auto r1 = __builtin_amdgcn_permlane32_swap(a1, b1, false, false);
  u32x4 w = {r0[0], r1[0], r0[1], r1[1]}; return *reinterpret_cast<bf16x8*>(&w);
}
#define GLA_PK(L, H) (bf16x8){L[0], L[1], L[2], L[3], H[0], H[1], H[2], H[3]}
__device__ __forceinline__ void gla_phase(int vcu, int G, bf16* Qb, const bf16* Vb, bf16* KFb, bf16* KBb, const bf16* SGb, const float* onorm, char* lds) {
  const int tid = threadIdx.x, wid = __builtin_amdgcn_readfirstlane(tid >> 6), lane = tid & 63, r32 = lane & 31, hi = lane >> 5;
  const int dir = wid >> 2, w4 = wid & 3, ct = tid & 255, kp = ct & 63;
  char* L = lds + dir * CH_BYTES;
  const int lbase = (int)(uintptr_t)L;
  const int vbV = lbase + O_VV + v_rd_base(lane) + w4 * 512, vbK = lbase + O_KD + v_rd_base(lane);
  bf16* Kown = dir ? KBb : KFb; const bf16* Koth = dir ? KFb : KBb;
  for (int it = vcu; it < NB * 8; it += G) {
    const int b = it >> 3, h = it & 7, cb = h * 128; const size_t seq0 = (size_t)b * LP;
    f32x16 S[4];
#pragma unroll
    for (int kb = 0; kb < 4; ++kb) S[kb] = f32x16{};
    unsigned pq[16], pk[16]; bf16x8 pvv[4];
#define GLA_ROW(n, tl) ((n) * 64 + (dir ? 63 - (tl) : (tl)))
#define GLA_LOAD(n) do { _Pragma("unroll") for (int i = 0; i < 16; ++i) { const size_t off = (seq0 + GLA_ROW(n, 16 * w4 + i)) * 1024 + cb + 2 * kp; \
        pq[i] = *(const unsigned*)(Qb + off); pk[i] = *(const unsigned*)(Kown + off); } \
      _Pragma("unroll") for (int i = 0; i < 4; ++i) { const int id = ct + 256 * i; pvv[i] = *(const bf16x8*)(Vb + (seq0 + GLA_ROW(n, id >> 4)) * 1024 + cb + (id & 15) * 8); } } while (0)
    GLA_LOAD(dir ? 64 : 0);
    for (int step = 0; step < 65; ++step) {
      const int n = dir ? 64 - step : step;
      const bool fin = dir ? (step >= 32) : (step >= 33);
      int lane_o = lane; asm volatile("" : "+v"(lane_o));
      const int r32 = lane_o & 31, hi = lane_o >> 5, kp = lane_o, ct = (w4 << 6) | lane_o;
      const int vbV = lbase + O_VV + v_rd_base(lane_o) + w4 * 512, vbK = lbase + O_KD + v_rd_base(lane_o);
      { float run0 = 1.f, run1 = 1.f, f20 = 1.f, f21 = 1.f;
#pragma unroll
        for (int i = 0; i < 16; ++i) { run0 *= 1.0f - bf_lo(pk[i]); run1 *= 1.0f - bf_hi(pk[i]); if (i == 0) { f20 = run0; f21 = run1; } }
        *(f32x2*)(L + V_TOT + (w4 * 128 + 2 * kp) * 4) = (f32x2){run0, run1};
        if (w4 == 2) *(f32x2*)(L + V_F2 + (2 * kp) * 4) = (f32x2){f20, f21}; }
      __syncthreads();
      { const f32x2 t0 = *(const f32x2*)(L + V_TOT + (0 * 128 + 2 * kp) * 4), t1 = *(const f32x2*)(L + V_TOT + (1 * 128 + 2 * kp) * 4), t2 = *(const f32x2*)(L + V_TOT + (2 * 128 + 2 * kp) * 4),
                    t3 = *(const f32x2*)(L + V_TOT + (3 * 128 + 2 * kp) * 4), f2 = *(const f32x2*)(L + V_F2 + (2 * kp) * 4);
        const f32x2 pre = w4 == 0 ? (f32x2){1.f, 1.f} : w4 == 1 ? t0 : w4 == 2 ? t0 * t1 : t0 * t1 * t2;
        const f32x2 pref = t0 * t1 * f2, plast = (t0 * t1) * (t2 * t3);
        const float ir0 = __builtin_amdgcn_rcpf(pref.x), ir1 = __builtin_amdgcn_rcpf(pref.y);
        const float c30 = plast.x * ir0, c31 = plast.y * ir1;
        float run0 = pre.x, run1 = pre.y;
#pragma unroll
        for (int i = 0; i < 16; ++i) { const int t = 16 * w4 + i;
          const float kg0 = bf_lo(pk[i]), kg1 = bf_hi(pk[i]);
          run0 *= 1.0f - kg0; run1 *= 1.0f - kg1;
          const float ki0 = kg0 * pref.x * __builtin_amdgcn_rcpf(run0), ki1 = kg1 * pref.y * __builtin_amdgcn_rcpf(run1);
          *(unsigned*)(L + O_QI + t * RS + 4 * kp) = cvt_pk_bf16(bf_lo(pq[i]) * run0 * ir0, bf_hi(pq[i]) * run1 * ir1);
          *(unsigned*)(L + O_KI + t * RS + 4 * kp) = cvt_pk_bf16(ki0, ki1);
          *(unsigned*)(L + O_KD + v_st4(t, 2 * kp)) = cvt_pk_bf16(ki0 * c30, ki1 * c31); }
        if (w4 == 0) { *(f32x2*)(L + V_DEC + (2 * kp) * 4) = plast; *(f32x2*)(L + V_EREF + (2 * kp) * 4) = pref; }
#pragma unroll
        for (int i = 0; i < 4; ++i) { const int id = ct + 256 * i; *(bf16x8*)(L + O_VV + v_st4(id >> 4, (id & 15) * 8)) = pvv[i]; } }
      __syncthreads();
      f32x16 o[2]; o[0] = f32x16{}; o[1] = f32x16{};
      { bf16x8 Sb[8];
#pragma unroll
        for (int kb = 0; kb < 4; ++kb)
#pragma unroll
          for (int s = 0; s < 2; ++s) { const f32x4 e0 = *(const f32x4*)(L + V_EREF + (32 * kb + 16 * s + 4 * hi) * 4), e1 = *(const f32x4*)(L + V_EREF + (32 * kb + 16 * s + 8 + 4 * hi) * 4);
            u32x4 w; w.x = cvt_pk_bf16(S[kb][8 * s + 0] * e0[0], S[kb][8 * s + 1] * e0[1]); w.y = cvt_pk_bf16(S[kb][8 * s + 2] * e0[2], S[kb][8 * s + 3] * e0[3]);
                     w.z = cvt_pk_bf16(S[kb][8 * s + 4] * e1[0], S[kb][8 * s + 5] * e1[1]); w.w = cvt_pk_bf16(S[kb][8 * s + 6] * e1[2], S[kb][8 * s + 7] * e1[3]);
            Sb[2 * kb + s] = *reinterpret_cast<bf16x8*>(&w); }
#pragma unroll
        for (int tb = 0; tb < 2; ++tb)
#pragma unroll
          for (int ks = 0; ks < 8; ++ks) { o[tb] = __builtin_amdgcn_mfma_f32_32x32x16_bf16(nat_frag(L + O_QI, 32 * tb + r32, ks, hi), Sb[ks], o[tb], 0, 0, 0);
                                           if ((ks & 3) == 3) asm volatile("" ::: "memory"); } }
      { f32x16 a0 = f32x16{};
#pragma unroll
        for (int ks = 0; ks < 8; ++ks) { a0 = __builtin_amdgcn_mfma_f32_32x32x16_bf16(nat_frag(L + O_KI, r32, ks, hi), nat_frag(L + O_QI, r32, ks, hi), a0, 0, 0, 0);
                                         if ((ks & 3) == 3) asm volatile("" ::: "memory"); }
#pragma unroll
        for (int r = 0; r < 16; ++r) a0[r] = crow(r, hi) > r32 ? 0.f : a0[r];
        const bf16x8 pa0 = pk4(a0, 0), pa1 = pk4(a0, 1);
        const s16x4 l0 = tr_read<0 * 4096>(vbV), h0 = tr_read<0 * 4096 + 2048>(vbV), l1 = tr_read<1 * 4096>(vbV), h1 = tr_read<1 * 4096 + 2048>(vbV);
        asm volatile("s_waitcnt lgkmcnt(0)" ::: "memory"); GLA_SBAR();
        o[0] = __builtin_amdgcn_mfma_f32_32x32x16_bf16(pa0, GLA_PK(l0, h0), o[0], 0, 0, 0);
        o[0] = __builtin_amdgcn_mfma_f32_32x32x16_bf16(pa1, GLA_PK(l1, h1), o[0], 0, 0, 0); }
      { f32x16 a0 = f32x16{}, a1 = f32x16{};
#pragma unroll
        for (int ks = 0; ks < 8; ++ks) { const bf16x8 qf = nat_frag(L + O_QI, 32 + r32, ks, hi);
                                         a0 = __builtin_amdgcn_mfma_f32_32x32x16_bf16(nat_frag(L + O_KI, r32, ks, hi), qf, a0, 0, 0, 0);
                                         a1 = __builtin_amdgcn_mfma_f32_32x32x16_bf16(nat_frag(L + O_KI, 32 + r32, ks, hi), qf, a1, 0, 0, 0);
                                         if (ks & 1) asm volatile("" ::: "memory"); }
#pragma unroll
        for (int r = 0; r < 16; ++r) a1[r] = crow(r, hi) > r32 ? 0.f : a1[r];
        const bf16x8 pa0 = pk4(a0, 0), pa1 = pk4(a0, 1), pa2 = pk4(a1, 0), pa3 = pk4(a1, 1);
        const s16x4 l0 = tr_read<0 * 4096>(vbV), h0 = tr_read<0 * 4096 + 2048>(vbV), l1 = tr_read<1 * 4096>(vbV), h1 = tr_read<1 * 4096 + 2048>(vbV);
        const s16x4 l2 = tr_read<2 * 4096>(vbV), h2 = tr_read<2 * 4096 + 2048>(vbV), l3 = tr_read<3 * 4096>(vbV), h3 = tr_read<3 * 4096 + 2048>(vbV);
        asm volatile("s_waitcnt lgkmcnt(0)" ::: "memory"); GLA_SBAR();
        o[1] = __builtin_amdgcn_mfma_f32_32x32x16_bf16(pa0, GLA_PK(l0, h0), o[1], 0, 0, 0);
        o[1] = __builtin_amdgcn_mfma_f32_32x32x16_bf16(pa1, GLA_PK(l1, h1), o[1], 0, 0, 0);
        o[1] = __builtin_amdgcn_mfma_f32_32x32x16_bf16(pa2, GLA_PK(l2, h2), o[1], 0, 0, 0);
        o[1] = __builtin_amdgcn_mfma_f32_32x32x16_bf16(pa3, GLA_PK(l3, h3), o[1], 0, 0, 0); }
      __syncthreads();
      { unsigned short* ot = (unsigned short*)(L + O_KI);
#pragma unroll
        for (int tb = 0; tb < 2; ++tb)
#pragma unroll
          for (int r = 0; r < 16; ++r) ot[(32 * tb + crow(r, hi)) * (RS / 2) + 32 * w4 + r32] = (unsigned short)(cvt_pk_bf16(o[tb][r], 0.f) & 0xffffu); }
      if (step < 64) { const int nn = dir ? n - 1 : n + 1; GLA_LOAD(nn); }
#pragma unroll
      for (int kb = 0; kb < 4; ++kb)
#pragma unroll
        for (int g4 = 0; g4 < 4; ++g4) { const f32x4 dc = *(const f32x4*)(L + V_DEC + (32 * kb + 8 * g4 + 4 * hi) * 4);
          S[kb][4 * g4 + 0] *= dc[0]; S[kb][4 * g4 + 1] *= dc[1]; S[kb][4 * g4 + 2] *= dc[2]; S[kb][4 * g4 + 3] *= dc[3]; }
      { const s16x4 l0 = tr_read<0 * 4096>(vbV), h0 = tr_read<0 * 4096 + 2048>(vbV), l1 = tr_read<1 * 4096>(vbV), h1 = tr_read<1 * 4096 + 2048>(vbV);
        const s16x4 l2 = tr_read<2 * 4096>(vbV), h2 = tr_read<2 * 4096 + 2048>(vbV), l3 = tr_read<3 * 4096>(vbV), h3 = tr_read<3 * 4096 + 2048>(vbV);
        asm volatile("s_waitcnt lgkmcnt(0)" ::: "memory"); GLA_SBAR();
        const bf16x8 vf0 = GLA_PK(l0, h0), vf1 = GLA_PK(l1, h1), vf2 = GLA_PK(l2, h2), vf3 = GLA_PK(l3, h3);
#define GLA_UPD(kb) do { const s16x4 a0 = tr_read<(kb) * 512 + 0 * 4096>(vbK), b0 = tr_read<(kb) * 512 + 0 * 4096 + 2048>(vbK), a1 = tr_read<(kb) * 512 + 1 * 4096>(vbK), b1 = tr_read<(kb) * 512 + 1 * 4096 + 2048>(vbK); \
          const s16x4 a2 = tr_read<(kb) * 512 + 2 * 4096>(vbK), b2 = tr_read<(kb) * 512 + 2 * 4096 + 2048>(vbK), a3 = tr_read<(kb) * 512 + 3 * 4096>(vbK), b3 = tr_read<(kb) * 512 + 3 * 4096 + 2048>(vbK); \
          asm volatile("s_waitcnt lgkmcnt(0)" ::: "memory"); GLA_SBAR(); \
          S[kb] = __builtin_amdgcn_mfma_f32_32x32x16_bf16(GLA_PK(a0, b0), vf0, S[kb], 0, 0, 0); S[kb] = __builtin_amdgcn_mfma_f32_32x32x16_bf16(GLA_PK(a1, b1), vf1, S[kb], 0, 0, 0); \
          S[kb] = __builtin_amdgcn_mfma_f32_32x32x16_bf16(GLA_PK(a2, b2), vf2, S[kb], 0, 0, 0); S[kb] = __builtin_amdgcn_mfma_f32_32x32x16_bf16(GLA_PK(a3, b3), vf3, S[kb], 0, 0, 0); } while (0)
        GLA_UPD(0); GLA_UPD(1); GLA_UPD(2); GLA_UPD(3);
#undef GLA_UPD
      }
      __syncthreads();
      const int t = ct >> 2, q4 = ct & 3; const size_t goff = (seq0 + GLA_ROW(n, t)) * 1024 + cb + 32 * q4;
      u32x2 ow[8];
#pragma unroll
      for (int i = 0; i < 8; ++i) ow[i] = *(const u32x2*)(L + O_KI + t * RS + q4 * 64 + i * 8);
      if (!fin) {
#pragma unroll
        for (int i = 0; i < 4; ++i) *(u32x4*)(Kown + goff + 8 * i) = (u32x4){ow[2 * i].x, ow[2 * i].y, ow[2 * i + 1].x, ow[2 * i + 1].y};
      }
      __syncthreads();
      if (fin) {
        float ov[32]; float ss = 0.f;
#pragma unroll
        for (int i = 0; i < 4; ++i) { const u32x4 pw = *(const u32x4*)(Koth + goff + 8 * i);
          ov[8 * i + 0] = bf_lo(ow[2 * i].x) + bf_lo(pw.x); ov[8 * i + 1] = bf_hi(ow[2 * i].x) + bf_hi(pw.x); ov[8 * i + 2] = bf_lo(ow[2 * i].y) + bf_lo(pw.y); ov[8 * i + 3] = bf_hi(ow[2 * i].y) + bf_hi(pw.y);
          ov[8 * i + 4] = bf_lo(ow[2 * i + 1].x) + bf_lo(pw.z); ov[8 * i + 5] = bf_hi(ow[2 * i + 1].x) + bf_hi(pw.z); ov[8 * i + 6] = bf_lo(ow[2 * i + 1].y) + bf_lo(pw.w); ov[8 * i + 7] = bf_hi(ow[2 * i + 1].y) + bf_hi(pw.w); }
#pragma unroll
        for (int i = 0; i < 32; ++i) ss += ov[i] * ov[i];
        ss += __shfl_xor(ss, 1); ss += __shfl_xor(ss, 2);
        const float rstd = 1.0f / sqrtf(ss * (1.0f / 128.0f) + EPS);
#pragma unroll
        for (int i = 0; i < 4; ++i) { const u32x4 gw = *(const u32x4*)(SGb + goff + 8 * i); const f32x4 n0 = *(const f32x4*)(onorm + cb + 32 * q4 + 8 * i), n1 = *(const f32x4*)(onorm + cb + 32 * q4 + 8 * i + 4);
          u32x4 w; w.x = cvt_pk_bf16(ov[8 * i + 0] * rstd * n0[0] * bf_lo(gw.x), ov[8 * i + 1] * rstd * n0[1] * bf_hi(gw.x)); w.y = cvt_pk_bf16(ov[8 * i + 2] * rstd * n0[2] * bf_lo(gw.y), ov[8 * i + 3] * rstd * n0[3] * bf_hi(gw.y));
                   w.z = cvt_pk_bf16(ov[8 * i + 4] * rstd * n1[0] * bf_lo(gw.z), ov[8 * i + 5] * rstd * n1[1] * bf_hi(gw.z)); w.w = cvt_pk_bf16(ov[8 * i + 6] * rstd * n1[2] * bf_lo(gw.w), ov[8 * i + 7] * rstd * n1[3] * bf_hi(gw.w));
          *(u32x4*)(Qb + goff + 8 * i) = w; }
      }
      __syncthreads();
    }
#undef GLA_ROW
#undef GLA_LOAD
  }
  __syncthreads();
}
#undef GLA_PK
#undef GLA_SBAR
}
constexpr int NPHASE = 16;
#ifndef GLA_SIMPLE
#define GLA_SIMPLE 0
#endif
#ifndef ATTN_SIMPLE
#define ATTN_SIMPLE 0
#endif
#ifndef MK_ONE_LAUNCH
#define MK_ONE_LAUNCH 1
#endif
struct Args { const float* in[19]; float* out; unsigned char* ws; int ph_lo, ph_hi; };
__global__ void __launch_bounds__(NWAVES * 64, 2) fwd(Args args) {
    extern __shared__ __attribute__((aligned(16))) unsigned char lds[];
    Frame F;
    F.lds = (LAS unsigned char*)lds;
    F.MISC = (volatile LAS unsigned*)(F.lds + MISC_OFF);
    F.tid = threadIdx.x; F.lane = F.tid & 63; F.wave = __builtin_amdgcn_readfirstlane(F.tid >> 6);
    F.G = gridDim.x; { const int bx = blockIdx.x; F.vcu = (F.G % 8 == 0) ? (bx % 8) * (F.G / 8) + bx / 8 : bx; }
    unsigned char* ws = args.ws;
    for (int u = F.tid; u < (LDS_BYTES - LDSCTL_OFF) / 4; u += NWAVES * 64) ((LAS unsigned*)(F.lds + LDSCTL_OFF))[u] = 0u;
    __syncthreads();
    const int lo = args.ph_lo, hi = args.ph_hi;
    XcdBarrier bar; bar.bar = (unsigned*)(ws + WS_CTL); bar.x = 0; bar.st = nullptr;
    if (hi - lo > 1) bar = xcd_barrier_post((unsigned*)(ws + WS_CTL), F.MISC + 8);
#ifndef ONLY_PHASE
#define ONLY_PHASE -1
#endif
#define IN(k) (lo <= (k) && (k) < hi && (ONLY_PHASE < 0 || ONLY_PHASE == (k)))
#ifndef DUP_MASK
#define DUP_MASK 0
#endif
#ifndef DUP_GLA
#define DUP_GLA 0
#endif
#define SEAM(k) do { if (IN(k) && IN((k) + 1)) xcd_barrier(bar); } while (0)
    const float* const* in = args.in;
    bf16* hD = (bf16*)args.out;
    bf16* hB = (bf16*)(ws + WS_B0 + (size_t)SLACK * ROWB);
    const pg8::f32x2* rope = (const pg8::f32x2*)(ws + WS_ROPE);
    using pg8::Gemm; using pg8::StaticOrder;
    const int cid = (int)blockIdx.x;

    if (IN(0)) { p0_prologue(F, in, ws, hD); } SEAM(0);
    if (IN(1)) { Gemm g{hD, (const bf16*)(ws + W_IN), 1024, 1024, 1024}; StaticOrder S; S.init(MT, 5, F.G, cid);
        pg8::EpiProj E{(bf16*)(ws + R_CQKV), (float*)(ws + R_SSQ), (bf16*)(ws + R_KROPE), rope};
        pg8::gemm_phase<pg8::EpiProj, StaticOrder, true, true>(F.lds + RING_OFF, g, S, E); } SEAM(1);
    if (IN(2)) {
        { Gemm g{(const bf16*)(ws + R_CQKV), (const bf16*)(ws + W_UQ), 768, 1024, 768}; StaticOrder S; S.init(MT, 6, F.G, cid);
          pg8::EpiQ E{(bf16*)(ws + R_Q), (const float*)(ws + R_SSQ), rope};
          pg8::gemm_phase<pg8::EpiQ, StaticOrder, true, true>(F.lds + RING_OFF, g, S, E); }
        { Gemm g{(const bf16*)(ws + R_CQKV) + 768, (const bf16*)(ws + W_UKV), 256, 1024, 256}; StaticOrder S; S.init(MT, 8, F.G, cid);
          pg8::EpiKV E{(bf16*)(ws + R_KV), (const float*)(ws + R_SSQ)};
          pg8::gemm_phase<pg8::EpiKV, StaticOrder, true, true>(F.lds + RING_OFF, g, S, E); }
    } SEAM(2);
    if (IN(3)) {
#if ATTN_SIMPLE
        attn_simple(F, (const bf16*)(ws + R_Q), (const bf16*)(ws + R_KV), (const bf16*)(ws + R_KROPE), (bf16*)(ws + R_CQKV));
#else
        fa::attn_phase(F.vcu, F.G, (const bf16*)(ws + R_Q), (const bf16*)(ws + R_KV), (const bf16*)(ws + R_KROPE), (bf16*)(ws + R_CQKV), (char*)lds);
#endif
    } SEAM(3);
    if (IN(4)) { Gemm g{(const bf16*)(ws + R_CQKV), (const bf16*)(ws + W_O), 1024, 1024, 1024}; StaticOrder S; S.init(MT, 4, F.G, cid);
        pg8::EpiResid E{hD, (float*)(ws + R_X_L0)};
        pg8::gemm_phase<pg8::EpiResid, StaticOrder, true, true>(F.lds + RING_OFF, g, S, E); } SEAM(4);
    if (IN(5)) { ln_pass<false>(F, (const float*)(ws + R_X_L0), in[17] + 0 * 1024, in[18] + 0 * 1024, hB, nullptr); } SEAM(5);
    if (IN(6)) { Gemm g{hB - 1024, (const bf16*)(ws + W_UP0), 1024, 1024, 1024}; StaticOrder S; S.init(MT_UP, 22, F.G, cid);
        pg8::EpiConvGate E{(bf16*)(ws + R_ACT), in[14], in[15]};
        pg8::gemm_phase<pg8::EpiConvGate, StaticOrder, true, true, true>(F.lds + RING_OFF, g, S, E); } SEAM(6);
    if (IN(7)) { Gemm g{(const bf16*)(ws + R_ACT), (const bf16*)(ws + W_DN0), DFF, DFF, DFF}; StaticOrder S; S.init(MT, 4, F.G, cid);
        pg8::EpiResid E{hB, (float*)(ws + R_X_FFN)};
        pg8::gemm_phase<pg8::EpiResid, StaticOrder, true, true>(F.lds + RING_OFF, g, S, E); } SEAM(7);
    if (IN(8)) { ln_pass<false>(F, (const float*)(ws + R_X_FFN), in[17] + 1 * 1024, in[18] + 1 * 1024, hD, nullptr); } SEAM(8);
    if (IN(9)) { Gemm g{hD, (const bf16*)(ws + W_HIN), 1024, 1024, 1024}; StaticOrder S; S.init(MT, 20, F.G, cid);
        pg8::EpiHgIn E{hB, (bf16*)(ws + R_HV), (bf16*)(ws + R_HKF), (bf16*)(ws + R_HKB), (bf16*)(ws + R_HSG), (const float*)(ws + WS_LB)};
        pg8::gemm_phase<pg8::EpiHgIn, StaticOrder, true, true>(F.lds + RING_OFF, g, S, E); } SEAM(9);
    if (IN(10)) {
#if GLA_SIMPLE
        gla_simple(F, hB, (const bf16*)(ws + R_HV), (bf16*)(ws + R_HKF), (const bf16*)(ws + R_HKB), (const bf16*)(ws + R_HSG), in[11]);
#else
        gla::gla_phase(F.vcu, F.G, hB, (const bf16*)(ws + R_HV), (bf16*)(ws + R_HKF), (bf16*)(ws + R_HKB), (const bf16*)(ws + R_HSG), in[11], (char*)lds);
#endif
    } SEAM(10);
    if (IN(11)) { Gemm g{hB, (const bf16*)(ws + W_HO), 1024, 1024, 1024}; StaticOrder S; S.init(MT, 4, F.G, cid);
        pg8::EpiResid E{hD, (float*)(ws + R_X_HG)};
        pg8::gemm_phase<pg8::EpiResid, StaticOrder, true, true>(F.lds + RING_OFF, g, S, E); } SEAM(11);
    if (IN(12)) { ln_pass<false>(F, (const float*)(ws + R_X_HG), in[17] + 2 * 1024, in[18] + 2 * 1024, hB, nullptr); } SEAM(12);
    if (IN(13)) { Gemm g{hB - 1024, (const bf16*)(ws + W_UP1), 1024, 1024, 1024}; StaticOrder S; S.init(MT_UP, 22, F.G, cid);
        pg8::EpiConvGate E{(bf16*)(ws + R_ACT), in[14] + 3 * NUP, in[15] + NUP};
        pg8::gemm_phase<pg8::EpiConvGate, StaticOrder, true, true, true>(F.lds + RING_OFF, g, S, E); } SEAM(13);
    if (IN(14)) { Gemm g{(const bf16*)(ws + R_ACT), (const bf16*)(ws + W_DN1), DFF, DFF, DFF}; StaticOrder S; S.init(MT, 4, F.G, cid);
        pg8::EpiResid E{hB, (float*)(ws + R_X_FFN)};
        pg8::gemm_phase<pg8::EpiResid, StaticOrder, true, true>(F.lds + RING_OFF, g, S, E); } SEAM(14);
    if (IN(15)) { ln_pass<true>(F, (const float*)(ws + R_X_FFN), in[17] + 3 * 1024, in[18] + 3 * 1024, nullptr, args.out); }
#undef IN
#undef SEAM
}

__global__ void nan_fill(float* o, long n) { const float q = __builtin_nanf(""); for (long i = blockIdx.x * 256L + threadIdx.x; i < n; i += gridDim.x * 256L) o[i] = q; }
extern "C" void kernel_launch(void* const* d_in, const int* in_sizes, int n_in, void* d_out, int out_size, void* d_ws, size_t ws_size, hipStream_t stream) {
    static int grid = 0;
    if (grid == 0) {
        bool ok = (n_in == 19) && in_sizes[0] == 16 * SEQ * 1024 && in_sizes[1] == 4 * SEQ * 1024 && out_size == NB * SEQ * 1024 && ws_size >= WS_END;
        int dev = 0, cus = 0;
        if (ok) ok = hipGetDevice(&dev) == hipSuccess && hipDeviceGetAttribute(&cus, hipDeviceAttributeMultiprocessorCount, dev) == hipSuccess;
        if (ok) ok = hipFuncSetAttribute((const void*)fwd, hipFuncAttributeMaxDynamicSharedMemorySize, LDS_BYTES) == hipSuccess;
        if (!ok) { fprintf(stderr, "kernel_launch: unexpected shapes / workspace (%zu) / device\n", ws_size); grid = -1; }
        else grid = cus;
        (void)hipGetLastError();
    }
    if (grid < 0) { hipLaunchKernelGGL(nan_fill, dim3(1024), dim3(256), 0, stream, (float*)d_out, (long)out_size); return; }
    (void)hipMemsetAsync((char*)d_ws + WS_CTL, 0, CTL_ZERO_BYTES, stream);
    Args a{};
    for (int i = 0; i < 19; ++i) a.in[i] = (const float*)d_in[i];
    a.out = (float*)d_out; a.ws = (unsigned char*)d_ws;
#if MK_ONE_LAUNCH
    a.ph_lo = 0; a.ph_hi = NPHASE;
    hipLaunchKernelGGL(fwd, dim3(grid), dim3(NWAVES * 64), LDS_BYTES, stream, a);
#else
    for (int p = 0; p < NPHASE; ++p) { for (int r = 0; r < 1 + ((DUP_MASK >> p) & 1); ++r) { a.ph_lo = p; a.ph_hi = p + 1; hipLaunchKernelGGL(fwd, dim3(grid), dim3(NWAVES * 64), LDS_BYTES, stream, a); }
        if (p == 10 && DUP_GLA) for (int q = 9; q <= 10; ++q) { a.ph_lo = q; a.ph_hi = q + 1; hipLaunchKernelGGL(fwd, dim3(grid), dim3(NWAVES * 64), LDS_BYTES, stream, a); } }
#endif
}
```

```cpp
#include <hip/hip_runtime.h>
#include <cstdio>
constexpr int NB = 20;
constexpr int LP = 4160;
constexpr int PADR = 48, LTOK = 4112, SEQ = 4096, DM = 1024;
constexpr int M = NB * LP;
constexpr int MT = M / 256;
constexpr int DFF = 2816, NUP = 2 * DFF;
constexpr int NBLK62 = (M + 61) / 62;
constexpr int MT_UP = (NBLK62 + 3) / 4;
constexpr float EPS = 1e-6f, ALPHA = 1.4142135623730951f;
constexpr float SM_C = 0.10206207261596575f * 1.4426950408889634f;
#include <cstdint>
namespace pg8 {
#define PG8_LAS __attribute__((address_space(3)))
typedef unsigned short bf16_t;
typedef short bf16x8 __attribute__((ext_vector_type(8)));
typedef float f32x4 __attribute__((ext_vector_type(4)));
typedef unsigned u32x4 __attribute__((ext_vector_type(4)));
typedef unsigned u32x2 __attribute__((ext_vector_type(2)));
constexpr int BM = 256, BK = 64, HALF = 128, HTB = HALF * BK * 2  , STAGE_BYTES = 8 * HTB, NXCD = 8, WGM = 8;

__host__ __device__ __forceinline__ int lds_byte(int r, int c) { const int st = (r >> 4) * 2 + (c >> 5), rr = r & 15, cc = c & 31, ob = rr * 64 + cc * 2; return st * 1024 + (ob ^ (((ob >> 9) & 1) << 5)); }
__host__ __device__ __forceinline__ void stage_rc(int b, int& R, int& C) { const int st = b / 1024, sb = b % 1024, swz = sb ^ (((sb >> 9) & 1) << 5); R = (st >> 1) * 16 + swz / 64; C = (st & 1) * 32 + (swz % 64) / 2; }
__host__ __device__ __forceinline__ int perm32(int rho) { const int n = rho >> 4, i = rho & 15; return 8 * (i >> 2) + 4 * n + (i & 3); }

struct Unit { int pm, pn; };
struct Gemm { const bf16_t* A; const bf16_t* Bt; int K, lda, ldb; };

struct StaticOrder {
    int nM, nN, nwg, G, c;
    __host__ __device__ void init(int nM_, int nN_, int G_, int c_) { nM = nM_; nN = nN_; nwg = nM * nN; G = G_; c = c_; }
    __host__ __device__ bool next(int i, Unit& u) const {
        const long L = (long)i * G + c; if (L >= nwg) return false;
        int wgid = (int)L; { const int q = nwg / NXCD, r = nwg % NXCD, xcd = wgid % NXCD, off = wgid / NXCD; wgid = (xcd < r ? xcd * (q + 1) : r * (q + 1) + (xcd - r) * q) + off; }
        const int nig = WGM * nN, gid = wgid / nig, fm = gid * WGM, gsz = (nM - fm) < WGM ? (nM - fm) : WGM;
        u.pm = fm + ((wgid % nig) % gsz); u.pn = (wgid % nig) / gsz; return true;
    }
    __device__ __forceinline__ void a_ready(const Unit&) const {}
    __device__ __forceinline__ void done(const Unit&) const {}
};
__device__ __forceinline__ unsigned cvt_pk_bf16(float lo, float hi) { unsigned r; asm volatile("v_cvt_pk_bf16_f32 %0, %1, %2" : "=v"(r) : "v"(lo), "v"(hi)); return r; }
__device__ __forceinline__ float bf_lo(unsigned w) { return __uint_as_float(w << 16); }
__device__ __forceinline__ float bf_hi(unsigned w) { return __uint_as_float(w & 0xffff0000u); }
typedef float f32x2 __attribute__((ext_vector_type(2)));
__device__ __forceinline__ u32x4 pack8(const f32x4 v0, const f32x4 v1) { u32x4 w; w.x = cvt_pk_bf16(v0[0], v0[1]); w.y = cvt_pk_bf16(v0[2], v0[3]); w.z = cvt_pk_bf16(v1[0], v1[1]); w.w = cvt_pk_bf16(v1[2], v1[3]); return w; }
__device__ __forceinline__ void rope8(f32x4& v0, f32x4& v1, const f32x2* tab, int pos, int i0) {
    const f32x2* t = tab + pos * 16 + i0;
    const f32x2 c0 = t[0], c1 = t[1], c2 = t[2], c3 = t[3];
    f32x4 a, b;
    a[0] = v0[0] * c0.x - v0[1] * c0.y; a[1] = v0[0] * c0.y + v0[1] * c0.x;
    a[2] = v0[2] * c1.x - v0[3] * c1.y; a[3] = v0[2] * c1.y + v0[3] * c1.x;
    b[0] = v1[0] * c2.x - v1[1] * c2.y; b[1] = v1[0] * c2.y + v1[1] * c2.x;
    b[2] = v1[2] * c3.x - v1[3] * c3.y; b[3] = v1[2] * c3.y + v1[3] * c3.x;
    v0 = a; v1 = b;
}
__device__ __forceinline__ void glds16(const void* src, PG8_LAS unsigned char* dst_wave_base) { __builtin_amdgcn_global_load_lds((const unsigned*)src, (PG8_LAS unsigned*)dst_wave_base, 16, 0, 0); }
struct EpiProj {
    static constexpr bool PERM = true, AFTER_DRAIN = false, STAGED = false;
    bf16_t* cqkv; float* ssq; bf16_t* krope; const f32x2* rope;
    __device__ __forceinline__ void operator()(const f32x4 (&acc)[2][2][4][2], const Unit& u, int wr, int wc, int fr, int fq, PG8_LAS unsigned char*) const {
        const int row0 = u.pm * BM + wr * 64 + fr;
        if (u.pn < 4) {
            const int col0 = u.pn * BM + wc * 32 + 8 * fq;
#pragma unroll
            for (int ai = 0; ai < 2; ++ai)
#pragma unroll
                for (int m = 0; m < 4; ++m) { const int row = row0 + ai * HALF + m * 16; float s = 0.f;
#pragma unroll
                    for (int bj = 0; bj < 2; ++bj) { const f32x4 v0 = acc[ai][bj][m][0], v1 = acc[ai][bj][m][1];
                        s += (v0[0] * v0[0] + v0[1] * v0[1]) + (v0[2] * v0[2] + v0[3] * v0[3]) + (v1[0] * v1[0] + v1[1] * v1[1]) + (v1[2] * v1[2] + v1[3] * v1[3]);
                        *(u32x4*)(cqkv + (size_t)row * 1024 + col0 + bj * HALF) = pack8(v0, v1); }
                    s += __shfl_xor(s, 16); s += __shfl_xor(s, 32);
                    if (fq == 0) __hip_atomic_fetch_add(ssq + (size_t)row * 2 + (u.pn == 3 ? 1 : 0), s, __ATOMIC_RELAXED, __HIP_MEMORY_SCOPE_AGENT); }
        } else if (wc == 0) {
#pragma unroll
            for (int ai = 0; ai < 2; ++ai)
#pragma unroll
                for (int m = 0; m < 4; ++m) { const int row = row0 + ai * HALF + m * 16; int pos = row % LP - PADR; pos = pos < 0 ? 0 : pos;
                    f32x4 v0 = acc[ai][0][m][0], v1 = acc[ai][0][m][1]; rope8(v0, v1, rope, pos, 4 * fq);
                    *(u32x4*)(krope + (size_t)row * 32 + 8 * fq) = pack8(v0, v1); }
        }
    }
};
struct EpiQ {
    static constexpr bool PERM = true, AFTER_DRAIN = false, STAGED = true;
    bf16_t* Q; const float* ssq; const f32x2* rope;
    __device__ __forceinline__ void stage(PG8_LAS unsigned char* slot, const Unit& u, int tid, int wid) const { asm volatile("" : "+v"(tid)); if (tid < 128) glds16(ssq + ((size_t)u.pm * BM + tid * 2) * 2, slot + wid * 1024); }
    __device__ __forceinline__ void operator()(const f32x4 (&acc)[2][2][4][2], const Unit& u, int wr, int wc, int fr, int fq, PG8_LAS unsigned char* slot) const {
        const int col0 = u.pn * BM + wc * 32 + 8 * fq; const PG8_LAS unsigned char* rb = slot + (wr * 64 + fr) * 8;
#pragma unroll
        for (int ai = 0; ai < 2; ++ai)
#pragma unroll
            for (int m = 0; m < 4; ++m) { const int lr = ai * HALF + wr * 64 + m * 16 + fr, row = u.pm * BM + lr; int pos = row % LP - PADR; pos = pos < 0 ? 0 : pos;
                const float ss = *(const PG8_LAS float*)(rb + (ai * HALF + m * 16) * 8);
                const float rstd = SM_C / sqrtf(ss * (1.0f / 768.0f) + EPS);
#pragma unroll
                for (int bj = 0; bj < 2; ++bj) { const int c = col0 + bj * HALF, d = c % 96; f32x4 v0 = acc[ai][bj][m][0] * rstd, v1 = acc[ai][bj][m][1] * rstd;
                    if (d >= 64) rope8(v0, v1, rope, pos, (d - 64) >> 1);
                    *(u32x4*)(Q + (size_t)row * 1536 + c) = pack8(v0, v1); }
                asm volatile("" ::: "memory"); }
    }
};
struct EpiKV {
    static constexpr bool PERM = true, AFTER_DRAIN = false, STAGED = true;
    bf16_t* KV; const float* ssq;
    __device__ __forceinline__ void stage(PG8_LAS unsigned char* slot, const Unit& u, int tid, int wid) const { asm volatile("" : "+v"(tid)); if (tid < 128) glds16(ssq + ((size_t)u.pm * BM + tid * 2) * 2, slot + wid * 1024); }
    __device__ __forceinline__ void operator()(const f32x4 (&acc)[2][2][4][2], const Unit& u, int wr, int wc, int fr, int fq, PG8_LAS unsigned char* slot) const {
        const int col0 = u.pn * BM + wc * 32 + 8 * fq; const PG8_LAS unsigned char* rb = slot + (wr * 64 + fr) * 8 + 4;
#pragma unroll
        for (int ai = 0; ai < 2; ++ai)
#pragma unroll
            for (int m = 0; m < 4; ++m) { const int lr = ai * HALF + wr * 64 + m * 16 + fr, row = u.pm * BM + lr;
                const float rstd = 1.0f / sqrtf(*(const PG8_LAS float*)(rb + (ai * HALF + m * 16) * 8) * (1.0f / 256.0f) + EPS);
#pragma unroll
                for (int bj = 0; bj < 2; ++bj) *(u32x4*)(KV + (size_t)row * 2048 + col0 + bj * HALF) = pack8(acc[ai][bj][m][0] * rstd, acc[ai][bj][m][1] * rstd); }
    }
};
__device__ __forceinline__ void mean_rstd(const f32x2 sq, float& mean, float& rstd) { mean = sq.x * (1.0f / 1024.0f); rstd = 1.0f / sqrtf(fmaxf(sq.y * (1.0f / 1024.0f) - mean * mean, 0.f) + EPS); }
template <bool BASE_LN, bool OUT_F32> struct EpiResidLN {
    static constexpr bool PERM = false, AFTER_DRAIN = false, STAGED = BASE_LN;
    const bf16_t* hb; const f32x2* SUMp; const float* g; const float* b; bf16_t* xo; f32x2* SUMo; float* of32;
    __device__ __forceinline__ void stage(PG8_LAS unsigned char* slot, const Unit& u, int tid, int wid) const {
        asm volatile("" : "+v"(tid));
        const int c = tid; const void* src = c < 64 ? (const void*)(g + u.pn * BM + c * 4) : c < 128 ? (const void*)(b + u.pn * BM + (c - 64) * 4) : (const void*)(SUMp + u.pm * BM + (c - 128) * 2);
        if (c < 256) glds16(src, slot + wid * 1024);
    }
    __device__ __forceinline__ void operator()(const f32x4 (&acc)[2][2][4][2], const Unit& u, int wr, int wc, int fr, int fq, PG8_LAS unsigned char* slot) const {
        const int row0 = u.pm * BM + wr * 64 + fr, col0 = u.pn * BM + wc * 32 + 4 * fq, lc0 = wc * 32 + 4 * fq;
#pragma unroll
        for (int ai = 0; ai < 2; ++ai)
#pragma unroll
            for (int m = 0; m < 4; ++m) { const int lr = ai * HALF + wr * 64 + m * 16 + fr, row = u.pm * BM + lr; const size_t off = (size_t)row * 1024 + col0; const int sq = row % LP;
                float mean = 0.f, rstd = 0.f; if (BASE_LN) mean_rstd(*(const PG8_LAS f32x2*)(slot + (wr * 64 + fr) * 8 + (2048 + (ai * HALF + m * 16) * 8)), mean, rstd);
                const bool pad = sq < PADR; float s = 0.f, q = 0.f; f32x4 x[2][2];
#pragma unroll
                for (int bj = 0; bj < 2; ++bj)
#pragma unroll
                    for (int n = 0; n < 2; ++n) { const u32x2 hw = *(const u32x2*)(hb + off + bj * HALF + n * 16);
                        f32x4 hv; hv[0] = bf_lo(hw.x); hv[1] = bf_hi(hw.x); hv[2] = bf_lo(hw.y); hv[3] = bf_hi(hw.y);
                        if (BASE_LN) { const f32x4 gv = *(const PG8_LAS f32x4*)(slot + (lc0 + bj * HALF + n * 16) * 4), bv = *(const PG8_LAS f32x4*)(slot + 1024 + (lc0 + bj * HALF + n * 16) * 4);
                            hv = (hv - mean) * rstd * gv + bv; if (pad) hv = (f32x4){0.f, 0.f, 0.f, 0.f}; }
                        const f32x4 xv = hv * ALPHA + acc[ai][bj][m][n]; x[bj][n] = xv;
                        s += (xv[0] + xv[1]) + (xv[2] + xv[3]); q += (xv[0] * xv[0] + xv[1] * xv[1]) + (xv[2] * xv[2] + xv[3] * xv[3]); }
                if (OUT_F32) { if (sq >= 64) { float* orow = of32 + ((size_t)(row / LP) * SEQ + (sq - 64)) * 1024 + col0;
#pragma unroll
                        for (int bj = 0; bj < 2; ++bj)
#pragma unroll
                            for (int n = 0; n < 2; ++n) *(f32x4*)(orow + bj * HALF + n * 16) = x[bj][n]; }
                } else {
#pragma unroll
                    for (int bj = 0; bj < 2; ++bj)
#pragma unroll
                        for (int n = 0; n < 2; ++n) { u32x2 w; w.x = cvt_pk_bf16(x[bj][n][0], x[bj][n][1]); w.y = cvt_pk_bf16(x[bj][n][2], x[bj][n][3]); *(u32x2*)(xo + off + bj * HALF + n * 16) = w; }
                    s += __shfl_xor(s, 16); q += __shfl_xor(q, 16); s += __shfl_xor(s, 32); q += __shfl_xor(q, 32);
                    if (fq == 0) { float* sp = (float*)(SUMo + row); __hip_atomic_fetch_add(sp, s, __ATOMIC_RELAXED, __HIP_MEMORY_SCOPE_AGENT); __hip_atomic_fetch_add(sp + 1, q, __ATOMIC_RELAXED, __HIP_MEMORY_SCOPE_AGENT); } } }
        (void)row0;
    }
};
struct EpiHgIn {
    static constexpr bool PERM = true, AFTER_DRAIN = false, STAGED = true;
    bf16_t* q; bf16_t* v; bf16_t* kf; bf16_t* kb; bf16_t* sg; const float* lb;
    const f32x2* SUM; const float* c1; const float* c2;
    __device__ __forceinline__ void stage(PG8_LAS unsigned char* slot, const Unit& u, int tid, int wid) const {
        asm volatile("" : "+v"(tid));
        const int c = tid, t = u.pn >> 2;
        const void* src = c < 64 ? (const void*)(c1 + u.pn * BM + c * 4) : c < 128 ? (const void*)(c2 + u.pn * BM + (c - 64) * 4)
                        : c < 192 ? (const void*)(lb + ((t == 3) ? 1024 : 0) + (u.pn & 3) * BM + (c - 128) * 4) : (const void*)(SUM + u.pm * BM + (c - 192) * 2);
        if (c < 320) glds16(src, slot + wid * 1024);
    }
    __device__ __forceinline__ void operator()(const f32x4 (&acc)[2][2][4][2], const Unit& u, int wr, int wc, int fr, int fq, PG8_LAS unsigned char* slot) const {
        const int t = u.pn >> 2, col0 = (u.pn & 3) * BM + wc * 32 + 8 * fq, lc0 = wc * 32 + 8 * fq;
        bf16_t* dst = t == 0 ? q : t == 1 ? v : t == 2 ? kf : t == 3 ? kb : sg;
#pragma unroll
        for (int bj = 0; bj < 2; ++bj) { const int c = col0 + bj * HALF, lc = lc0 + bj * HALF;
            f32x4 om0 = {1.f, 1.f, 1.f, 1.f}, om1 = om0;
            if (t == 2 || t == 3) { om0 = 1.0f - *(const PG8_LAS f32x4*)(slot + 2048 + lc * 4); om1 = 1.0f - *(const PG8_LAS f32x4*)(slot + 2048 + lc * 4 + 16); }
            const f32x4 k10 = *(const PG8_LAS f32x4*)(slot + lc * 4), k11 = *(const PG8_LAS f32x4*)(slot + lc * 4 + 16), k20 = *(const PG8_LAS f32x4*)(slot + 1024 + lc * 4), k21 = *(const PG8_LAS f32x4*)(slot + 1024 + lc * 4 + 16);
#pragma unroll
            for (int ai = 0; ai < 2; ++ai)
#pragma unroll
                for (int m = 0; m < 4; ++m) { const int lr = ai * HALF + wr * 64 + m * 16 + fr, row = u.pm * BM + lr; const bool pad = (row % LP) < PADR;
                    float mean, rstd; mean_rstd(*(const PG8_LAS f32x2*)(slot + (wr * 64 + fr) * 8 + (3072 + (ai * HALF + m * 16) * 8)), mean, rstd);
                    f32x4 v0 = (acc[ai][bj][m][0] - k10 * mean) * rstd + k20, v1 = (acc[ai][bj][m][1] - k11 * mean) * rstd + k21;
                    if (pad) { v0 = (f32x4){0.f, 0.f, 0.f, 0.f}; v1 = v0; }
                    if (t == 2 || t == 3) {
#pragma unroll
                        for (int j = 0; j < 4; ++j) { v0[j] = pad ? 0.f : om0[j] * __builtin_amdgcn_rcpf(1.0f + __builtin_amdgcn_exp2f(v0[j] * 1.4426950408889634f));
                                                      v1[j] = pad ? 0.f : om1[j] * __builtin_amdgcn_rcpf(1.0f + __builtin_amdgcn_exp2f(v1[j] * 1.4426950408889634f)); }
                    } else if (t == 4) {
#pragma unroll
                        for (int j = 0; j < 4; ++j) { v0[j] = v0[j] * __builtin_amdgcn_rcpf(1.0f + __builtin_amdgcn_exp2f(v0[j] * -1.4426950408889634f));
                                                      v1[j] = v1[j] * __builtin_amdgcn_rcpf(1.0f + __builtin_amdgcn_exp2f(v1[j] * -1.4426950408889634f)); }
                    }
                    *(u32x4*)(dst + (size_t)row * 1024 + c) = pack8(v0, v1); } }
    }
};
struct EpiConvGate {
    static constexpr bool PERM = true, AFTER_DRAIN = false, STAGED = true;
    bf16_t* act; const float* cw; const float* cb;
    const f32x2* SUM; const float* c1; const float* c2;
    static __device__ __forceinline__ float dpp_mirror(float x) { return __builtin_bit_cast(float, __builtin_amdgcn_update_dpp(0, __builtin_bit_cast(int, x), 0x140, 0xf, 0xf, false)); }
    static __device__ __forceinline__ float dpp_prev(float old, float x) { return __builtin_bit_cast(float, __builtin_amdgcn_update_dpp(__builtin_bit_cast(int, old), __builtin_bit_cast(int, x), 0x111, 0xf, 0xf, false)); }
    static __device__ __forceinline__ float dpp_next(float old, float x) { return __builtin_bit_cast(float, __builtin_amdgcn_update_dpp(__builtin_bit_cast(int, old), __builtin_bit_cast(int, x), 0x101, 0xf, 0xf, false)); }
    __device__ __forceinline__ void stage(PG8_LAS unsigned char* slot, const Unit& u, int tid, int wid) const {
        asm volatile("" : "+v"(tid));
        const int c = tid; const void* src;
        if (c < 384) { const int arr = c >> 5, off = (c & 31) * 4;
            src = arr < 3 ? (const void*)(cw + arr * NUP + 128 * u.pn + off) : arr == 3 ? (const void*)(cb + 128 * u.pn + off) : arr < 7 ? (const void*)(cw + (arr - 4) * NUP + DFF + 128 * u.pn + off)
                : arr == 7 ? (const void*)(cb + DFF + 128 * u.pn + off) : arr == 8 ? (const void*)(c1 + 256 * u.pn + off) : arr == 9 ? (const void*)(c1 + 256 * u.pn + 128 + off)
                : arr == 10 ? (const void*)(c2 + 256 * u.pn + off) : (const void*)(c2 + 256 * u.pn + 128 + off);
        } else { const int i = 2 * (c - 384); src = (const void*)(SUM + (62 * (4 * u.pm + (i >> 6)) - 1 + (i & 63))); }
        glds16(src, slot + wid * 1024);
    }
    __device__ __forceinline__ void operator()(const f32x4 (&acc)[2][2][4][2], const Unit& u, int wr, int wc, int fr, int fq, PG8_LAS unsigned char* slot) const {
        const int cv0 = 128 * u.pn + 32 * wc + 8 * fq;
        float mean[2][4], rstd[2][4];
#pragma unroll
        for (int ai = 0; ai < 2; ++ai)
#pragma unroll
            for (int m = 0; m < 4; ++m) { const int arow = 62 * (4 * u.pm + 2 * ai + wr) - 1 + 16 * m + fr; const bool ok = arow >= 0 && arow < M && (arow % LP) >= PADR;
                mean_rstd(*(const PG8_LAS f32x2*)(slot + (64 * wr + fr) * 8 + (6144 + (128 * ai + 16 * m) * 8)), mean[ai][m], rstd[ai][m]); if (!ok) { rstd[ai][m] = 0.f; mean[ai][m] = 0.f; } }
#pragma unroll
        for (int n = 0; n < 2; ++n) { const int cv = cv0 + 4 * n;
            const int lc = (32 * wc + 8 * fq + 4 * n) * 4;
            const f32x4 k1v = *(const PG8_LAS f32x4*)(slot + 8 * 512 + lc), k1g = *(const PG8_LAS f32x4*)(slot + 9 * 512 + lc), k2v = *(const PG8_LAS f32x4*)(slot + 10 * 512 + lc), k2g = *(const PG8_LAS f32x4*)(slot + 11 * 512 + lc);
            const f32x4 wv0 = *(const PG8_LAS f32x4*)(slot + 0 * 512 + lc), wv1 = *(const PG8_LAS f32x4*)(slot + 1 * 512 + lc), wv2 = *(const PG8_LAS f32x4*)(slot + 2 * 512 + lc), bv = *(const PG8_LAS f32x4*)(slot + 3 * 512 + lc);
            const f32x4 wg0 = *(const PG8_LAS f32x4*)(slot + 4 * 512 + lc), wg1 = *(const PG8_LAS f32x4*)(slot + 5 * 512 + lc), wg2 = *(const PG8_LAS f32x4*)(slot + 6 * 512 + lc), bg = *(const PG8_LAS f32x4*)(slot + 7 * 512 + lc);
#pragma unroll
            for (int ai = 0; ai < 2; ++ai) { const int J = 4 * u.pm + 2 * ai + wr;
                f32x4 o[4];
#pragma unroll
                for (int j = 0; j < 4; ++j) {
                    float uv[4], ug[4], mv[4], mg[4];
#pragma unroll
                    for (int m = 0; m < 4; ++m) { const bool okr = rstd[ai][m] != 0.f; uv[m] = (acc[ai][0][m][n][j] - k1v[j] * mean[ai][m]) * rstd[ai][m] + (okr ? k2v[j] : 0.f); ug[m] = (acc[ai][1][m][n][j] - k1g[j] * mean[ai][m]) * rstd[ai][m] + (okr ? k2g[j] : 0.f);
                                                  mv[m] = dpp_mirror(uv[m]); mg[m] = dpp_mirror(ug[m]); }
#pragma unroll
                    for (int m = 0; m < 4; ++m) {
                        const float pv = dpp_prev(m == 0 ? 0.f : mv[m - 1], uv[m]), nv = dpp_next(m == 3 ? 0.f : mv[m + 1], uv[m]);
                        const float pg = dpp_prev(m == 0 ? 0.f : mg[m - 1], ug[m]), ng = dpp_next(m == 3 ? 0.f : mg[m + 1], ug[m]);
                        const float val = wv0[j] * pv + wv1[j] * uv[m] + wv2[j] * nv + bv[j];
                        const float gat = wg0[j] * pg + wg1[j] * ug[m] + wg2[j] * ng + bg[j];
                        o[m][j] = val * gat * __builtin_amdgcn_rcpf(1.0f + __builtin_amdgcn_exp2f(gat * -1.4426950408889634f)); }
                    asm volatile("" : "+v"(o[0][j]), "+v"(o[1][j]), "+v"(o[2][j]), "+v"(o[3][j])); }
#pragma unroll
                for (int m = 0; m < 4; ++m) { const int R64 = 16 * m + fr; const int rowo = 62 * J - 1 + R64;
                    if (R64 >= 1 && R64 <= 62 && rowo < M) { u32x2 w; w.x = cvt_pk_bf16(o[m][0], o[m][1]); w.y = cvt_pk_bf16(o[m][2], o[m][3]); *(u32x2*)(act + (size_t)rowo * DFF + cv) = w; } }
                asm volatile("" ::: "memory"); } }
    }
};
template <class Epi, class Sched, bool ALIGN_EPI = false, bool SP2 = false, bool SHIFT = false>
__device__ __forceinline__ void gemm_phase(PG8_LAS unsigned char* lds, const Gemm g, const Sched& S, const Epi& E) {
    const int tid = threadIdx.x, wid = __builtin_amdgcn_readfirstlane(tid >> 6), lane = tid & 63, wr = wid >> 2, wc = wid & 3, fr = lane & 15, fq = lane >> 4;
    const int K = g.K, nt = K / BK;
    unsigned voffA[2], voffB[2];
#pragma unroll
    for (int i = 0; i < 2; ++i) { int R, C; stage_rc(tid * 16 + i * 8192, R, C); const int Rb = Epi::PERM ? ((R & ~31) + perm32(R & 31)) : R;
        const int Ra = SHIFT ? (R - 2 * (R >> 6)) : R; voffA[i] = (unsigned)(Ra * g.lda + C) * 2u; voffB[i] = (unsigned)(Rb * g.ldb + C) * 2u; }
    const size_t kstep = (size_t)(BK * 2);
    const size_t hstepA = (size_t)(SHIFT ? 124 : HALF) * g.lda * 2, hstepB = (size_t)HALF * g.ldb * 2;
    const size_t tstepA = 2 * hstepA, tstepB = 2 * hstepB;
    const unsigned ldsw = (unsigned)wid * 1024u;
    const int aoff = lds_byte(wr * 64 + fr, fq * 8), boff = lds_byte(wc * 32 + fr, fq * 8);
#define PG8_SA(b, h) (((b) * 2 + (h)) * HTB)
#define PG8_SB(b, h) ((4 + (b) * 2 + (h)) * HTB)
#define PG8_STAGE(bufoff, gbase, voff) do { _Pragma("unroll") for (int _i = 0; _i < 2; ++_i) \
        __builtin_amdgcn_global_load_lds((const unsigned*)((const char*)(gbase) + (voff)[_i]), (PG8_LAS unsigned*)(lds + (bufoff) + ldsw + _i * 8192), 16, 0, 0); } while (0)
#define PG8_LDA(dst, b, h) do { _Pragma("unroll") for (int m = 0; m < 4; ++m) _Pragma("unroll") for (int k = 0; k < 2; ++k) dst[m][k] = *(const PG8_LAS bf16x8*)(lds + PG8_SA(b, h) + aoff + m * 2048 + k * 1024); } while (0)
#define PG8_LDB(dst, b, h) do { _Pragma("unroll") for (int n = 0; n < 2; ++n) _Pragma("unroll") for (int k = 0; k < 2; ++k) dst[n][k] = *(const PG8_LAS bf16x8*)(lds + PG8_SB(b, h) + boff + n * 2048 + k * 1024); } while (0)
#define PG8_MMA(ai, bj, At, Bt) do { __builtin_amdgcn_s_setprio(1); _Pragma("unroll") for (int m = 0; m < 4; ++m) _Pragma("unroll") for (int n = 0; n < 2; ++n) _Pragma("unroll") for (int k = 0; k < 2; ++k) \
        acc[ai][bj][m][n] = __builtin_amdgcn_mfma_f32_16x16x32_bf16(Bt[n][k], At[m][k], acc[ai][bj][m][n], 0, 0, 0); __builtin_amdgcn_s_setprio(0); } while (0)
#define PG8_WAIT_V(n) asm volatile("s_waitcnt vmcnt(" #n ")" ::: "memory")
#define PG8_WAIT_L(n) asm volatile("s_waitcnt lgkmcnt(" #n ")" ::: "memory")
#define PG8_BAR __builtin_amdgcn_s_barrier()
#define PG8_SCHED __builtin_amdgcn_sched_barrier(0)
    Unit cur, nxt; int ui = 0;
    if (!S.next(0, cur)) return;
    f32x4 acc[2][2][4][2];
#pragma unroll
    for (int a = 0; a < 2; ++a)
#pragma unroll
        for (int b = 0; b < 2; ++b)
#pragma unroll
            for (int m = 0; m < 4; ++m)
#pragma unroll
                for (int n = 0; n < 2; ++n) acc[a][b][m][n] = (f32x4){0.f, 0.f, 0.f, 0.f};
    bf16x8 At[4][2], B0[2][2], B1[2][2];
    const char* cA = (const char*)g.A + (size_t)cur.pm * tstepA; const char* cB = (const char*)g.Bt + (size_t)cur.pn * tstepB;
    S.a_ready(cur);
    if constexpr (SP2) {
        PG8_STAGE(PG8_SB(0, 0), cB, voffB); PG8_STAGE(PG8_SB(0, 1), cB + hstepB, voffB); PG8_STAGE(PG8_SA(0, 0), cA, voffA); PG8_STAGE(PG8_SA(0, 1), cA + hstepA, voffA);
        if (wr == 1) PG8_BAR;
        PG8_WAIT_V(2); PG8_BAR;
        PG8_STAGE(PG8_SB(1, 0), cB + kstep, voffB); PG8_STAGE(PG8_SA(1, 0), cA + kstep, voffA); PG8_STAGE(PG8_SB(1, 1), cB + hstepB + kstep, voffB);
        PG8_WAIT_V(6); PG8_BAR;
    } else {
        PG8_STAGE(PG8_SB(0, 0), cB, voffB); PG8_STAGE(PG8_SA(0, 0), cA, voffA); PG8_STAGE(PG8_SB(0, 1), cB + hstepB, voffB); PG8_STAGE(PG8_SA(0, 1), cA + hstepA, voffA);
        if (wr == 1) PG8_BAR;
        PG8_WAIT_V(4); PG8_BAR;
        PG8_STAGE(PG8_SB(1, 0), cB + kstep, voffB); PG8_STAGE(PG8_SA(1, 0), cA + kstep, voffA); PG8_STAGE(PG8_SB(1, 1), cB + hstepB + kstep, voffB);
        PG8_WAIT_V(6); PG8_BAR;
    }
    for (;;) {
        if constexpr (Epi::STAGED) E.stage(lds + STAGE_BYTES + (ui & 1) * 8192, cur, tid, wid);
        const bool has_next = S.next(ui + 1, nxt);
        const char* nA = has_next ? (const char*)g.A + (size_t)nxt.pm * tstepA : cA; const char* nB = has_next ? (const char*)g.Bt + (size_t)nxt.pn * tstepB : cB;
        for (int t = 0; t < nt; t += 2) {
            const bool last = (t == nt - 2);
            const char* a1 = cA + (size_t)(t + 1) * kstep;
            const char* a2 = last ? nA : cA + (size_t)(t + 2) * kstep; const char* b2 = last ? nB : cB + (size_t)(t + 2) * kstep;
            const char* a3 = a2 + kstep; const char* b3 = b2 + kstep;
            if (last && has_next) S.a_ready(nxt);
            if constexpr (SP2) {
            PG8_LDB(B0, 0, 0); PG8_LDB(B1, 0, 1); PG8_SCHED; PG8_LDA(At, 0, 0); PG8_STAGE(PG8_SA(1, 1), a1 + hstepA, voffA);
            PG8_WAIT_V(8); PG8_WAIT_L(0); PG8_BAR; PG8_MMA(0, 0, At, B0); PG8_MMA(0, 1, At, B1); PG8_BAR; PG8_SCHED;
            PG8_LDA(At, 0, 1); PG8_STAGE(PG8_SB(0, 0), b2, voffB); PG8_STAGE(PG8_SB(0, 1), b2 + hstepB, voffB); PG8_STAGE(PG8_SA(0, 0), a2, voffA);
            PG8_WAIT_V(8); PG8_WAIT_L(0); PG8_BAR; PG8_MMA(1, 0, At, B0); PG8_MMA(1, 1, At, B1); PG8_BAR; PG8_SCHED;
            PG8_LDB(B0, 1, 0); PG8_LDB(B1, 1, 1); PG8_SCHED; PG8_LDA(At, 1, 0); PG8_STAGE(PG8_SA(0, 1), a2 + hstepA, voffA);
            PG8_WAIT_V(8); PG8_WAIT_L(0); PG8_BAR; PG8_MMA(0, 0, At, B0); PG8_MMA(0, 1, At, B1); PG8_BAR; PG8_SCHED;
            PG8_LDA(At, 1, 1); PG8_STAGE(PG8_SB(1, 0), b3, voffB); PG8_STAGE(PG8_SB(1, 1), b3 + hstepB, voffB); PG8_STAGE(PG8_SA(1, 0), a3, voffA);
            PG8_WAIT_V(8); PG8_WAIT_L(0); PG8_BAR; PG8_MMA(1, 0, At, B0); PG8_MMA(1, 1, At, B1); PG8_BAR; PG8_SCHED;
            } else {
            PG8_LDB(B0, 0, 0); PG8_SCHED; PG8_LDA(At, 0, 0); PG8_STAGE(PG8_SA(1, 1), a1 + hstepA, voffA);
            PG8_WAIT_L(8); PG8_BAR; PG8_WAIT_L(0); PG8_MMA(0, 0, At, B0); PG8_BAR; PG8_SCHED;
            PG8_LDB(B1, 0, 1); PG8_STAGE(PG8_SB(0, 0), b2, voffB);
            PG8_BAR; PG8_WAIT_L(0); PG8_MMA(0, 1, At, B1); PG8_BAR;
            PG8_LDA(At, 0, 1); PG8_STAGE(PG8_SA(0, 0), a2, voffA);
            PG8_BAR; PG8_WAIT_L(0); PG8_MMA(1, 0, At, B0); PG8_BAR; PG8_SCHED;
            PG8_STAGE(PG8_SB(0, 1), b2 + hstepB, voffB);
            PG8_WAIT_V(6); PG8_BAR; PG8_MMA(1, 1, At, B1); PG8_BAR;
            PG8_LDB(B0, 1, 0); PG8_SCHED; PG8_LDA(At, 1, 0); PG8_STAGE(PG8_SA(0, 1), a2 + hstepA, voffA);
            PG8_WAIT_L(8); PG8_BAR; PG8_WAIT_L(0); PG8_MMA(0, 0, At, B0); PG8_BAR; PG8_SCHED;
            PG8_LDB(B1, 1, 1); PG8_STAGE(PG8_SB(1, 0), b3, voffB);
            PG8_BAR; PG8_WAIT_L(0); PG8_MMA(0, 1, At, B1); PG8_BAR;
            PG8_LDA(At, 1, 1); PG8_STAGE(PG8_SA(1, 0), a3, voffA);
            PG8_BAR; PG8_WAIT_L(0); PG8_MMA(1, 0, At, B0); PG8_BAR; PG8_SCHED;
            PG8_STAGE(PG8_SB(1, 1), b3 + hstepB, voffB);
            PG8_WAIT_V(6); PG8_BAR; PG8_MMA(1, 1, At, B1); PG8_BAR;
            }
        }
        if constexpr (ALIGN_EPI) { if (wr == 0) PG8_BAR; }
        if constexpr (!Epi::AFTER_DRAIN) { E(acc, cur, wr, wc, fr, fq, lds + STAGE_BYTES + (ui & 1) * 8192); S.done(cur); }
        if (!has_next) break;
#pragma unroll
        for (int a = 0; a < 2; ++a)
#pragma unroll
            for (int b = 0; b < 2; ++b)
#pragma unroll
                for (int m = 0; m < 4; ++m)
#pragma unroll
                    for (int n = 0; n < 2; ++n) acc[a][b][m][n] = (f32x4){0.f, 0.f, 0.f, 0.f};
        cur = nxt; cA = nA; cB = nB; ++ui;
        if constexpr (ALIGN_EPI) { if (wr == 1) PG8_BAR; }
    }
    PG8_WAIT_V(0);
    if constexpr (!ALIGN_EPI) { if (wr == 0) PG8_BAR; }
    PG8_BAR;
    if constexpr (Epi::AFTER_DRAIN) { E.fused(acc, cur, wr, wc, fr, fq, lds, wid, lane); S.done(cur); }
#undef PG8_SA
#undef PG8_SB
#undef PG8_STAGE
#undef PG8_LDA
#undef PG8_LDB
#undef PG8_MMA
#undef PG8_WAIT_V
#undef PG8_WAIT_L
#undef PG8_BAR
#undef PG8_SCHED
}
}
#define GAS __attribute__((address_space(1)))
#define LAS __attribute__((address_space(3)))
typedef unsigned short bf16;
typedef unsigned v4u __attribute__((ext_vector_type(4)));
typedef unsigned v2u __attribute__((ext_vector_type(2)));
typedef float f32x4 __attribute__((ext_vector_type(4)));
typedef float f32x2 __attribute__((ext_vector_type(2)));
typedef GAS unsigned gu32;
using pg8::cvt_pk_bf16; using pg8::bf_lo; using pg8::bf_hi;

constexpr size_t MiB = 1u << 20;
constexpr size_t WS_CTL = 0, CTL_ZERO_BYTES = 64 * 1024;
constexpr size_t WS_ROPE = 1 * MiB;
constexpr size_t WS_LB = WS_ROPE + 640 * 1024;
constexpr size_t WS_C12 = WS_LB + 16 * 1024;
constexpr size_t C1_UP0 = WS_C12, C2_UP0 = C1_UP0 + 5632 * 4, C1_HG = C2_UP0 + 5632 * 4, C2_HG = C1_HG + 5120 * 4, C1_UP1 = C2_HG + 5120 * 4, C2_UP1 = C1_UP1 + 5632 * 4;
static_assert(C2_UP1 + 5632 * 4 <= 2 * MiB, "small tables");
constexpr size_t WS_W = 2 * MiB;
constexpr size_t W_IN = WS_W, W_UQ = W_IN + 1280ull * 1024 * 2, W_UKV = W_UQ + 1536ull * 768 * 2, W_O = W_UKV + 2048ull * 256 * 2, W_HIN = W_O + 1024ull * 1024 * 2,
                 W_HO = W_HIN + 5120ull * 1024 * 2, W_UP0 = W_HO + 1024ull * 1024 * 2, W_UP1 = W_UP0 + 5632ull * 1024 * 2, W_DN0 = W_UP1 + 5632ull * 1024 * 2, W_DN1 = W_DN0 + 1024ull * 2816 * 2,
                 W_END = W_DN1 + 1024ull * 2816 * 2;
static_assert(W_END <= 55 * MiB, "weights");
constexpr int SLACK = 256;
constexpr size_t ROWB = 2048;
constexpr size_t WS_B0 = 55 * MiB, B0_BYTES = (size_t)(M + 2 * SLACK) * ROWB;
static_assert(B0_BYTES <= 164 * MiB, "B0");
constexpr size_t WS_R = 219 * MiB;
constexpr size_t R_CQKV = WS_R;
constexpr size_t R_Q = R_CQKV + 164 * MiB;
constexpr size_t R_KV = R_Q + 245 * MiB;
constexpr size_t R_KROPE = R_KV + 326 * MiB;
constexpr size_t R_SSQ = R_KROPE + 6 * MiB;
constexpr size_t R_X_L0 = R_Q;
constexpr size_t R_ACT = WS_R;
constexpr size_t R_X_FFN = WS_R + 448 * MiB;
constexpr size_t R_HV = WS_R, R_HKF = WS_R + 163 * MiB, R_HKB = WS_R + 326 * MiB, R_HSG = WS_R + 489 * MiB;
constexpr size_t R_X_HG = WS_R;
constexpr size_t R_XB3 = R_HSG + (size_t)SLACK * ROWB;
constexpr size_t SUM_ROWS = (size_t)M + 2 * SLACK, SUM_BYTES = SUM_ROWS * 8;
constexpr size_t WS_SUM1 = WS_R + 773 * MiB, WS_SUM2 = WS_SUM1 + SUM_BYTES, WS_SUM3 = WS_SUM2 + SUM_BYTES;
constexpr size_t WS_END = 1024 * MiB;
static_assert(SUM_BYTES % 256 == 0 && WS_SUM3 + SUM_BYTES <= WS_END && R_XB3 + (size_t)(M + SLACK) * ROWB <= WS_SUM1 && R_KV + 326 * MiB + 12 * MiB <= WS_SUM1 && R_ACT + 448 * MiB <= R_HSG, "d_ws map 3");
static_assert(R_SSQ + (size_t)M * 16 * 4 <= WS_END && R_X_FFN + (size_t)M * 4096 <= WS_END && R_HSG + (size_t)M * ROWB <= WS_END, "d_ws map");
static_assert((size_t)M * 1536 * 2 + 64 * 3072 <= 245 * MiB && (size_t)M * 4096 + 64 * 4096 <= 326 * MiB && (size_t)M * DFF * 2 <= 448 * MiB && (size_t)M * ROWB <= 163 * MiB, "d_ws map 2");

constexpr int RING_OFF = 0, RING_BYTES = 131072;
constexpr int EPI_OFF = RING_BYTES, EPI_SLOT = 8192;
constexpr int LDSCTL_OFF = 147456, MISC_OFF = LDSCTL_OFF + 320;
constexpr int LDS_BYTES = 148480;
constexpr int NWAVES = 8;

#define RLX_AGENT __ATOMIC_RELAXED, __HIP_MEMORY_SCOPE_AGENT
#define XB_TMO      128
#define XB_XCNT(j)  (256  + 64 * (j))
#define XB_XSUB(j)  (1280 + 64 * (j))
#define XB_XGEN(j)  (2304 + 64 * (j))
#define XB_TOP      3328
#define XB_TOPGEN   3392
#define XCD_BAR_WORDS 3456
#define XB_SPIN_CAP (1u << 18)

__device__ __forceinline__ unsigned xb_ld(unsigned* p)              { return __hip_atomic_load(p, __ATOMIC_RELAXED, __HIP_MEMORY_SCOPE_AGENT); }
__device__ __forceinline__ unsigned xb_add(unsigned* p, unsigned v) { return __hip_atomic_fetch_add(p, v, __ATOMIC_RELAXED, __HIP_MEMORY_SCOPE_AGENT); }
__device__ __forceinline__ unsigned xb_xcc_id() { return (unsigned)__builtin_amdgcn_s_getreg((3 << 11) | 20) & 0xFu; }
#define XB_SPIN(cond, bar) do { unsigned _sp = 0; while (cond) { __builtin_amdgcn_s_sleep(1); \
    if ((++_sp & 255u) == 0u) { if (xb_ld(&(bar)[XB_TMO])) break; if (_sp > XB_SPIN_CAP) { atomicAdd(&(bar)[XB_TMO], 1u); break; } } } } while (0)

struct XcdBarrier {
    unsigned* bar; unsigned x;
    volatile LAS unsigned* st;
};

__device__ __forceinline__ XcdBarrier xcd_barrier_post(unsigned* bar, volatile LAS unsigned* st) {
    XcdBarrier b; b.bar = bar; b.x = xb_xcc_id(); b.st = st;
    if (threadIdx.x == 0) (void)xb_add(&bar[XB_XCNT(b.x)], 1u);
    return b;
}
__device__ __forceinline__ void xcd_barrier_complete(unsigned* bar, unsigned x, unsigned& nloc, unsigned& nx) {
    const unsigned G = gridDim.x * gridDim.y * gridDim.z;
    unsigned sum, cnt, mine, sp = 0u;
    for (;;) {
        sum = 0u; cnt = 0u; mine = 0u;
#pragma unroll
        for (unsigned j = 0; j < 16; ++j) { const unsigned c = xb_ld(&bar[XB_XCNT(j)]); sum += c; cnt += (c > 0u) ? 1u : 0u; mine = (j == x) ? c : mine; }
        if (sum == G) break;
        __builtin_amdgcn_s_sleep(1);
        if ((++sp & 255u) == 0u) { if (xb_ld(&bar[XB_TMO])) break; if (sp > XB_SPIN_CAP) { atomicAdd(&bar[XB_TMO], 1u); break; } }
    }
    nloc = mine > 0u ? mine : 1u; nx = cnt > 0u ? cnt : 1u;
}

__device__ __forceinline__ void xcd_barrier(const XcdBarrier& b) {
    asm volatile("s_waitcnt vmcnt(0)" ::: "memory");
    __syncthreads();
    if (threadIdx.x == 0) {
        unsigned* bar = b.bar;
        __builtin_amdgcn_s_waitcnt(0);
        unsigned nloc = b.st[0], nx = b.st[1];
        if (nloc == 0u) { xcd_barrier_complete(bar, b.x, nloc, nx); b.st[0] = nloc; b.st[1] = nx; }
        const unsigned old = xb_add(&bar[XB_XSUB(b.x)], 1u);
        const unsigned gen = old / nloc;
        if (old + 1u == (gen + 1u) * nloc) {
            __builtin_amdgcn_fence(__ATOMIC_RELEASE, "agent");
            asm volatile("s_waitcnt vmcnt(0)" ::: "memory");
            const unsigned og = xb_add(&bar[XB_TOP], 1u);
            const unsigned tg = og / nx;
            if (og + 1u == (tg + 1u) * nx) xb_add(&bar[XB_TOPGEN], 1u);
            else XB_SPIN(xb_ld(&bar[XB_TOPGEN]) == tg, bar);
            __builtin_amdgcn_fence(__ATOMIC_ACQUIRE, "agent");
            xb_add(&bar[XB_XGEN(b.x)], 1u);
            asm volatile("s_waitcnt vmcnt(0)" ::: "memory");
        } else {
            XB_SPIN(xb_ld(&bar[XB_XGEN(b.x)]) == gen, bar);
            __builtin_amdgcn_fence(__ATOMIC_ACQUIRE, "agent");
            asm volatile("s_waitcnt vmcnt(0)" ::: "memory");
        }
    }
    __syncthreads();
}

struct Frame {
    LAS unsigned char* lds;
    volatile LAS unsigned* MISC;
    int tid, lane, wave;
    int vcu, G;
};
__device__ __forceinline__ float wave_sum(float v) {
#pragma unroll
    for (int o = 1; o < 64; o <<= 1) v += __shfl_xor(v, o);
    return v;
}
__device__ __forceinline__ unsigned f2bf(float f) { unsigned u = __builtin_bit_cast(unsigned, f); return (u + 0x7fffu + ((u >> 16) & 1u)) >> 16; }
__device__ __forceinline__ unsigned pk2(float lo, float hi) { return f2bf(lo) | (f2bf(hi) << 16); }

__device__ __forceinline__ int src_col(int kind, int n) {
    if (kind == 1) { if (n < 1024) return n; if (n >= 1056) return -1; const int e = n - 1024; return 1024 + ((e & 1) ? 16 + (e >> 1) : (e >> 1)); }
    if (kind == 2) { const int hd = n / 96, d = n % 96; if (d < 64) return n; const int e = d - 64; return hd * 96 + 64 + ((e & 1) ? 16 + (e >> 1) : (e >> 1)); }
    if (kind == 3) { const int pn = n >> 8, r = n & 255; return r < 128 ? 128 * pn + r : DFF + 128 * pn + (r - 128); }
    return n;
}
__device__ __forceinline__ void p0_transpose_item(const float* W, int K, int N, bf16* WT, int kind, const float* gain, LAS float* scr, int item, int lane, int NP) {
    const int nblk = NP / 32, kb = item / nblk, nb = item % nblk, k0 = 64 * kb, n0 = 32 * nb;
    const int sc = src_col(kind, n0 + (lane & 31));
#pragma unroll 8
    for (int i = 0; i < 32; ++i) { const int kk = 2 * i + (lane >> 5); float v = sc >= 0 ? W[(size_t)(k0 + kk) * N + sc] : 0.f; if (gain) v *= gain[k0 + kk]; scr[kk * 33 + (lane & 31)] = v; }
    asm volatile("s_waitcnt lgkmcnt(0)" ::: "memory");
    const int c = lane & 7;
#pragma unroll
    for (int j = 0; j < 4; ++j) { const int n = (lane >> 3) + 8 * j; const LAS float* s = scr + (8 * c) * 33 + n;
        v4u o; o.x = pk2(s[0 * 33], s[1 * 33]); o.y = pk2(s[2 * 33], s[3 * 33]); o.z = pk2(s[4 * 33], s[5 * 33]); o.w = pk2(s[6 * 33], s[7 * 33]);
        *(GAS v4u*)(WT + (size_t)(n0 + n) * K + k0 + 8 * c) = o; }
    asm volatile("s_waitcnt lgkmcnt(0)" ::: "memory");
}
struct WJob { const float* W; bf16* WT; const float* gain; int K, N, NP, kind; };
__device__ __forceinline__ void p0_prologue(Frame& F, const float* const* in, unsigned char* ws, bf16* h0) {
    LAS float* scr = (LAS float*)(F.lds + RING_OFF + F.wave * 16384);
    const int gw = F.vcu * NWAVES + F.wave, NGW = F.G * NWAVES;
#define WJOB(SRC, DST, GAIN, K_, N_, NP_, KIND) { const int nitems = ((K_) / 64) * ((NP_) / 32); for (int it = gw; it < nitems; it += NGW) p0_transpose_item(SRC, K_, N_, (bf16*)(ws + (DST)), KIND, GAIN, scr, it, F.lane, NP_); }
    WJOB(in[3], W_IN, nullptr, 1024, 1056, 1280, 1)
    WJOB(in[6], W_UQ, in[4], 768, 1536, 1536, 2)
    WJOB(in[7], W_UKV, in[5], 256, 2048, 2048, 0)
    WJOB(in[8], W_O, nullptr, 1024, 1024, 1024, 0)
    WJOB(in[9], W_HIN, in[17] + 1024, 1024, 5120, 5120, 0)
    WJOB(in[12], W_HO, nullptr, 1024, 1024, 1024, 0)
    WJOB(in[13], W_UP0, in[17], 1024, NUP, NUP, 3)
    WJOB(in[13] + (size_t)1024 * NUP, W_UP1, in[17] + 2048, 1024, NUP, NUP, 3)
    WJOB(in[16], W_DN0, nullptr, DFF, 1024, 1024, 0)
    WJOB(in[16] + (size_t)DFF * 1024, W_DN1, nullptr, DFF, 1024, 1024, 0)
#undef WJOB
    { const int col = F.vcu * 64 + F.lane;
      const bool live = col < 5632 + 5120 + 5632; const int cc = live ? col : 0;
      const int which = cc < 5632 ? 0 : cc < 5632 + 5120 ? 1 : 2; const int n = which == 0 ? cc : which == 1 ? cc - 5632 : cc - 5632 - 5120;
      const float* W = which == 0 ? in[13] : which == 1 ? in[9] : in[13] + (size_t)1024 * NUP; const int N = which == 1 ? 5120 : NUP;
      const float* gn = in[17] + (which == 0 ? 0 : which == 1 ? 1024 : 2048); const float* bs = in[18] + (which == 0 ? 0 : which == 1 ? 1024 : 2048);
      const int sc = which == 1 ? n : src_col(3, n);
      float a1[4] = {0.f, 0.f, 0.f, 0.f}, a2[4] = {0.f, 0.f, 0.f, 0.f};
      for (int k = F.wave * 128; k < F.wave * 128 + 128; k += 4) {
#pragma unroll
          for (int i = 0; i < 4; ++i) { const float w = W[(size_t)(k + i) * N + sc]; a1[i] += __uint_as_float(f2bf(gn[k + i] * w) << 16); a2[i] += bs[k + i] * w; } }
      LAS float* red = (LAS float*)(F.lds + RING_OFF + 12288);
      red[F.wave * 4096 + F.lane * 2] = (a1[0] + a1[1]) + (a1[2] + a1[3]); red[F.wave * 4096 + F.lane * 2 + 1] = (a2[0] + a2[1]) + (a2[2] + a2[3]);
      __syncthreads();
      if (F.wave == 0 && live) { float s1 = 0.f, s2 = 0.f;
#pragma unroll
          for (int w = 0; w < 8; ++w) { s1 += red[w * 4096 + F.lane * 2]; s2 += red[w * 4096 + F.lane * 2 + 1]; }
          ((float*)(ws + (which == 0 ? C1_UP0 : which == 1 ? C1_HG : C1_UP1)))[n] = s1; ((float*)(ws + (which == 0 ? C2_UP0 : which == 1 ? C2_HG : C2_UP1)))[n] = s2; }
      __syncthreads(); }
    for (int row0 = gw; row0 < M; row0 += 4 * NGW) {
        f32x4 v[4][4];
#pragma unroll
        for (int u = 0; u < 4; ++u) { const int row = row0 + u * NGW; const int rc = row < M ? row : M - 1; const int b = rc / LP, s = rc % LP;
            const float* src = s < PADR ? in[2] : s < PADR + 16 ? in[2] + (size_t)(s - PADR) * 1024 : (b < 16 ? in[0] + ((size_t)b * SEQ + (s - 64)) * 1024 : in[1] + ((size_t)(b - 16) * SEQ + (s - 64)) * 1024);
            const GAS f32x4* xr = (const GAS f32x4*)src + F.lane;
#pragma unroll
            for (int j = 0; j < 4; ++j) v[u][j] = xr[64 * j]; }
#pragma unroll
        for (int u = 0; u < 4; ++u) { const int row = row0 + u * NGW; if (row >= M) continue; const int s = row % LP;
            GAS unsigned long long* o8 = (GAS unsigned long long*)(h0 + (size_t)row * 1024) + F.lane;
#pragma unroll
            for (int j = 0; j < 4; ++j) o8[64 * j] = s < PADR ? 0ull : ((unsigned long long)pk2(v[u][j].x, v[u][j].y) | ((unsigned long long)pk2(v[u][j].z, v[u][j].w) << 32)); }
    }
    { const int gt = gw * 64 + F.lane, NGT = NGW * 64; GAS v4u* z0 = (GAS v4u*)(ws + WS_B0); GAS v4u* z1 = (GAS v4u*)(ws + WS_B0 + (size_t)(SLACK + M) * ROWB);
      const int n16 = SLACK * (int)ROWB / 16;
      for (int i = gt; i < n16; i += NGT) { z0[i] = (v4u){0u, 0u, 0u, 0u}; z1[i] = (v4u){0u, 0u, 0u, 0u}; } }
    { const int gt = gw * 64 + F.lane, NGT = NGW * 64; GAS v4u* z = (GAS v4u*)(ws + WS_SUM1);
      for (int i = gt; i < (int)(3 * SUM_BYTES / 16); i += NGT) z[i] = (v4u){0u, 0u, 0u, 0u}; }
    { const int gt = gw * 64 + F.lane, NGT = NGW * 64; GAS v4u* z = (GAS v4u*)(ws + R_SSQ);
      for (int i = gt; i < M * 8 / 16; i += NGT) z[i] = (v4u){0u, 0u, 0u, 0u}; }
    { const int gt = gw * 64 + F.lane, NGT = NGW * 64; f32x2* tab = (f32x2*)(ws + WS_ROPE);
      for (int i = gt; i < LTOK * 16; i += NGT) { const int pos = i >> 4, k = i & 15;
          const float inv = 1.0f / powf(10000.0f, (float)(2 * k) / 32.0f); const float ang = (float)pos * inv;
          f32x2 cs; cs.x = (float)cos((double)ang); cs.y = (float)sin((double)ang); tab[i] = cs; } }
    { const int gt = gw * 64 + F.lane; float* lb = (float*)(ws + WS_LB);
      if (gt < 2048) { const int d = gt >> 10, k = gt & 1023; const float x0 = in[10][(size_t)(d * 2 + 0) * 1024 + k], x1 = in[10][(size_t)(d * 2 + 1) * 1024 + k];
          lb[gt] = 1.0f / (1.0f + expf(x0 - x1)); } }
}

template <bool FINAL> __device__ __forceinline__ void ln_pass(Frame& F, const float* X, const float* gain, const float* bias, bf16* hout, float* out) {
    const int gw = F.vcu * NWAVES + F.wave, NGW = F.G * NWAVES;
    f32x4 g[4], bb[4];
#pragma unroll
    for (int j = 0; j < 4; ++j) { g[j] = ((const f32x4*)gain)[64 * j + F.lane]; bb[j] = ((const f32x4*)bias)[64 * j + F.lane]; }
    for (int row0 = gw; row0 < M; row0 += 4 * NGW) {
        f32x4 v[4][4];
#pragma unroll
        for (int u = 0; u < 4; ++u) { const int row = row0 + u * NGW; const int rc = row < M ? row : M - 1; const GAS f32x4* xr = (const GAS f32x4*)(X + (size_t)rc * 1024) + F.lane;
#pragma unroll
            for (int j = 0; j < 4; ++j) v[u][j] = xr[64 * j]; }
#pragma unroll
        for (int u = 0; u < 4; ++u) { const int row = row0 + u * NGW; if (row >= M) continue;
            const int b = row / LP, s = row % LP;
            if (FINAL) { if (s < 64) continue; }
            else if (s < PADR) { GAS unsigned long long* o8 = (GAS unsigned long long*)(hout + (size_t)row * 1024) + F.lane;
#pragma unroll
                for (int j = 0; j < 4; ++j) o8[64 * j] = 0ull;
                continue; }
            float sm = 0.f;
#pragma unroll
            for (int j = 0; j < 4; ++j) sm += (v[u][j].x + v[u][j].y) + (v[u][j].z + v[u][j].w);
            const float mean = wave_sum(sm) * (1.f / 1024.f); float s2 = 0.f;
#pragma unroll
            for (int j = 0; j < 4; ++j) { v[u][j] = v[u][j] - mean; s2 += (v[u][j].x * v[u][j].x + v[u][j].y * v[u][j].y) + (v[u][j].z * v[u][j].z + v[u][j].w * v[u][j].w); }
            const float rstd = 1.f / sqrtf(wave_sum(s2) * (1.f / 1024.f) + EPS);
            if (FINAL) { GAS f32x4* o = (GAS f32x4*)(out + ((size_t)b * SEQ + (s - 64)) * 1024) + F.lane;
#pragma unroll
                for (int j = 0; j < 4; ++j) o[64 * j] = v[u][j] * rstd * g[j] + bb[j];
            } else { GAS unsigned long long* o8 = (GAS unsigned long long*)(hout + (size_t)row * 1024) + F.lane;
#pragma unroll
                for (int j = 0; j < 4; ++j) { const f32x4 y = v[u][j] * rstd * g[j] + bb[j]; o8[64 * j] = (unsigned long long)cvt_pk_bf16(y.x, y.y) | ((unsigned long long)cvt_pk_bf16(y.z, y.w) << 32); } }
        }
    }
}

__device__ __forceinline__ void ln_final(Frame& F, float* out, const float* gain, const float* bias) {
    const int gw = F.vcu * NWAVES + F.wave, NGW = F.G * NWAVES; constexpr int NR = NB * SEQ;
    f32x4 g[4], bb[4];
#pragma unroll
    for (int j = 0; j < 4; ++j) { g[j] = ((const f32x4*)gain)[64 * j + F.lane]; bb[j] = ((const f32x4*)bias)[64 * j + F.lane]; }
    for (int row0 = gw; row0 < NR; row0 += 4 * NGW) {
        f32x4 v[4][4];
#pragma unroll
        for (int u = 0; u < 4; ++u) { const int row = row0 + u * NGW; const int rc = row < NR ? row : NR - 1; const GAS f32x4* xr = (const GAS f32x4*)(out + (size_t)rc * 1024) + F.lane;
#pragma unroll
            for (int j = 0; j < 4; ++j) v[u][j] = xr[64 * j]; }
#pragma unroll
        for (int u = 0; u < 4; ++u) { const int row = row0 + u * NGW; if (row >= NR) continue;
            float sm = 0.f;
#pragma unroll
            for (int j = 0; j < 4; ++j) sm += (v[u][j].x + v[u][j].y) + (v[u][j].z + v[u][j].w);
            const float mean = wave_sum(sm) * (1.f / 1024.f); float s2 = 0.f;
#pragma unroll
            for (int j = 0; j < 4; ++j) { v[u][j] = v[u][j] - mean; s2 += (v[u][j].x * v[u][j].x + v[u][j].y * v[u][j].y) + (v[u][j].z * v[u][j].z + v[u][j].w * v[u][j].w); }
            const float rstd = 1.f / sqrtf(wave_sum(s2) * (1.f / 1024.f) + EPS);
            GAS f32x4* o = (GAS f32x4*)(out + (size_t)row * 1024) + F.lane;
#pragma unroll
            for (int j = 0; j < 4; ++j) o[64 * j] = v[u][j] * rstd * g[j] + bb[j]; }
    }
}
__device__ __forceinline__ void attn_simple(Frame& F, const bf16* Q, const bf16* KV, const bf16* KR, bf16* O) {
    LAS float* Ks = (LAS float*)(F.lds);
    LAS float* Vs = (LAS float*)(F.lds + 64 * 96 * 4);
    constexpr int NQC = 17;
    const int hf = F.tid & 1;
    for (int u = F.vcu; u < NB * 16 * NQC; u += F.G) {
        const int bh = u / NQC, qc = u % NQC, b = bh >> 4, h = bh & 15;
        const int sq = qc * 256 + (F.tid >> 1); const bool vq = sq < LP; const size_t rowq = (size_t)b * LP + (vq ? sq : LP - 1);
        float q[48];
#pragma unroll
        for (int c = 0; c < 6; ++c) { const v4u w = *(const GAS v4u*)(Q + rowq * 1536 + h * 96 + hf * 48 + c * 8);
            q[c * 8 + 0] = bf_lo(w.x); q[c * 8 + 1] = bf_hi(w.x); q[c * 8 + 2] = bf_lo(w.y); q[c * 8 + 3] = bf_hi(w.y);
            q[c * 8 + 4] = bf_lo(w.z); q[c * 8 + 5] = bf_hi(w.z); q[c * 8 + 6] = bf_lo(w.w); q[c * 8 + 7] = bf_hi(w.w); }
        float o[32];
#pragma unroll
        for (int d = 0; d < 32; ++d) o[d] = 0.f;
        float mx = -1e30f, l = 0.f;
        for (int kt = 0; kt < 65; ++kt) {
            __syncthreads();
            for (int idx = F.tid; idx < 64 * 12; idx += 512) { const int j = idx / 12, c = idx % 12; int sk = PADR + kt * 64 + j; sk = sk < LP ? sk : LP - 1; const size_t rk = (size_t)b * LP + sk;
                const v4u w = c < 8 ? *(const GAS v4u*)(KV + rk * 2048 + h * 128 + c * 8) : *(const GAS v4u*)(KR + rk * 32 + (c - 8) * 8);
                LAS float* d = Ks + j * 96 + c * 8; d[0] = bf_lo(w.x); d[1] = bf_hi(w.x); d[2] = bf_lo(w.y); d[3] = bf_hi(w.y); d[4] = bf_lo(w.z); d[5] = bf_hi(w.z); d[6] = bf_lo(w.w); d[7] = bf_hi(w.w); }
            { const int j = F.tid >> 3, c = F.tid & 7; int sk = PADR + kt * 64 + j; sk = sk < LP ? sk : LP - 1; const size_t rk = (size_t)b * LP + sk;
                const v4u w = *(const GAS v4u*)(KV + rk * 2048 + h * 128 + 64 + c * 8);
                LAS float* d = Vs + j * 64 + c * 8; d[0] = bf_lo(w.x); d[1] = bf_hi(w.x); d[2] = bf_lo(w.y); d[3] = bf_hi(w.y); d[4] = bf_lo(w.z); d[5] = bf_hi(w.z); d[6] = bf_lo(w.w); d[7] = bf_hi(w.w); }
            __syncthreads();
            const int nk = (LTOK - kt * 64) < 64 ? (LTOK - kt * 64) : 64;
#pragma unroll 1
            for (int jj = 0; jj < nk; ++jj) {
                const LAS f32x4* kr = (const LAS f32x4*)(Ks + jj * 96 + hf * 48); float a0 = 0.f, a1 = 0.f;
#pragma unroll
                for (int c = 0; c < 12; c += 2) { const f32x4 k0 = kr[c], k1 = kr[c + 1];
                    a0 += q[4 * c] * k0.x + q[4 * c + 1] * k0.y + q[4 * c + 2] * k0.z + q[4 * c + 3] * k0.w;
                    a1 += q[4 * c + 4] * k1.x + q[4 * c + 5] * k1.y + q[4 * c + 6] * k1.z + q[4 * c + 7] * k1.w; }
                float sc = a0 + a1; sc += __shfl_xor(sc, 1);
                const float mn = fmaxf(mx, sc);
                const float al = __builtin_amdgcn_exp2f(mx - mn), p = __builtin_amdgcn_exp2f(sc - mn); mx = mn; l = l * al + p;
                const LAS f32x4* vr = (const LAS f32x4*)(Vs + jj * 64 + hf * 32);
#pragma unroll
                for (int c = 0; c < 8; ++c) { const f32x4 vv = vr[c]; o[4 * c] = fmaf(p, vv.x, o[4 * c] * al); o[4 * c + 1] = fmaf(p, vv.y, o[4 * c + 1] * al); o[4 * c + 2] = fmaf(p, vv.z, o[4 * c + 2] * al); o[4 * c + 3] = fmaf(p, vv.w, o[4 * c + 3] * al); }
            }
        }
        if (vq) { const float il = 1.0f / l;
#pragma unroll
            for (int c = 0; c < 4; ++c) { v4u w; w.x = cvt_pk_bf16(o[8 * c] * il, o[8 * c + 1] * il); w.y = cvt_pk_bf16(o[8 * c + 2] * il, o[8 * c + 3] * il); w.z = cvt_pk_bf16(o[8 * c + 4] * il, o[8 * c + 5] * il); w.w = cvt_pk_bf16(o[8 * c + 6] * il, o[8 * c + 7] * il);
                *(GAS v4u*)(O + rowq * 1024 + h * 64 + hf * 32 + c * 8) = w; } }
    }
    __syncthreads();
}

__device__ __forceinline__ void gla_simple(Frame& F, bf16* Qb, const bf16* Vb, bf16* KFb, const bf16* KBb, const bf16* SGb, const float* onorm) {
    LAS float* tq = (LAS float*)(F.lds);
    LAS float* tk = (LAS float*)(F.lds + 16384);
    LAS float* tv = (LAS float*)(F.lds + 32768);
    LAS float* pr = (LAS float*)(F.lds + 49152);
    const int j = F.tid & 127, kq = F.tid >> 7;
    for (int it = F.vcu; it < NB * 8; it += F.G) {
        const int b = it >> 3, h = it & 7; const size_t cbase = (size_t)h * 128;
        for (int dir = 0; dir < 2; ++dir) {
            float S[32];
#pragma unroll
            for (int k = 0; k < 32; ++k) S[k] = 0.f;
            const bf16* Kg = dir == 0 ? KFb : KBb;
            for (int tile = 0; tile < (LTOK + 31) / 32; ++tile) {
                __syncthreads();
                { const int i = F.tid >> 4, c8 = (F.tid & 15) * 8; const int tt = tile * 32 + i; const bool vt = tt < LTOK; const int tok = dir == 0 ? tt : LTOK - 1 - tt;
                  const size_t off = ((size_t)b * LP + PADR + (vt ? tok : 0)) * 1024 + cbase + c8;
                  v4u wq = *(const GAS v4u*)(Qb + off), wk = *(const GAS v4u*)(Kg + off), wv = *(const GAS v4u*)(Vb + off);
                  if (!vt) { wq = (v4u){0u, 0u, 0u, 0u}; wk = wq; wv = wq; }
                  LAS float* dq = tq + i * 128 + c8; LAS float* dk = tk + i * 128 + c8; LAS float* dv = tv + i * 128 + c8;
                  dq[0] = bf_lo(wq.x); dq[1] = bf_hi(wq.x); dq[2] = bf_lo(wq.y); dq[3] = bf_hi(wq.y); dq[4] = bf_lo(wq.z); dq[5] = bf_hi(wq.z); dq[6] = bf_lo(wq.w); dq[7] = bf_hi(wq.w);
                  dk[0] = bf_lo(wk.x); dk[1] = bf_hi(wk.x); dk[2] = bf_lo(wk.y); dk[3] = bf_hi(wk.y); dk[4] = bf_lo(wk.z); dk[5] = bf_hi(wk.z); dk[6] = bf_lo(wk.w); dk[7] = bf_hi(wk.w);
                  dv[0] = bf_lo(wv.x); dv[1] = bf_hi(wv.x); dv[2] = bf_lo(wv.y); dv[3] = bf_hi(wv.y); dv[4] = bf_lo(wv.z); dv[5] = bf_hi(wv.z); dv[6] = bf_lo(wv.w); dv[7] = bf_hi(wv.w); }
                __syncthreads();
                for (int i = 0; i < 32; ++i) {
                    const float vj = tv[i * 128 + j]; float part = 0.f;
                    const LAS f32x4* kr = (const LAS f32x4*)(tk + i * 128 + kq * 32); const LAS f32x4* qr = (const LAS f32x4*)(tq + i * 128 + kq * 32);
#pragma unroll
                    for (int c = 0; c < 8; ++c) { const f32x4 kk = kr[c], qq = qr[c];
                        S[4 * c] = fmaf(kk.x, vj - S[4 * c], S[4 * c]); part = fmaf(S[4 * c], qq.x, part);
                        S[4 * c + 1] = fmaf(kk.y, vj - S[4 * c + 1], S[4 * c + 1]); part = fmaf(S[4 * c + 1], qq.y, part);
                        S[4 * c + 2] = fmaf(kk.z, vj - S[4 * c + 2], S[4 * c + 2]); part = fmaf(S[4 * c + 2], qq.z, part);
                        S[4 * c + 3] = fmaf(kk.w, vj - S[4 * c + 3], S[4 * c + 3]); part = fmaf(S[4 * c + 3], qq.w, part); }
                    pr[(i * 4 + kq) * 128 + j] = part;
                }
                __syncthreads();
#pragma unroll
                for (int ii = 0; ii < 4; ++ii) { const int i = F.wave * 4 + ii; const int tt = tile * 32 + i; const bool vt = tt < LTOK; const int tok = dir == 0 ? tt : LTOK - 1 - tt;
                    const int c = 2 * F.lane;
                    float o0 = pr[(i * 4 + 0) * 128 + c] + pr[(i * 4 + 1) * 128 + c] + pr[(i * 4 + 2) * 128 + c] + pr[(i * 4 + 3) * 128 + c];
                    float o1 = pr[(i * 4 + 0) * 128 + c + 1] + pr[(i * 4 + 1) * 128 + c + 1] + pr[(i * 4 + 2) * 128 + c + 1] + pr[(i * 4 + 3) * 128 + c + 1];
                    const size_t off = ((size_t)b * LP + PADR + (vt ? tok : 0)) * 1024 + cbase + c;
                    if (dir == 0) { if (vt) *(GAS unsigned*)(KFb + off) = cvt_pk_bf16(o0, o1); }
                    else { const unsigned wf = *(const GAS unsigned*)(KFb + off); o0 += bf_lo(wf); o1 += bf_hi(wf);
                        const float ss = wave_sum(o0 * o0 + o1 * o1); const float rstd = 1.0f / sqrtf(ss * (1.0f / 128.0f) + EPS);
                        const unsigned wg = *(const GAS unsigned*)(SGb + off); const f32x2 gn = *(const f32x2*)(onorm + cbase + c);
                        if (vt) *(GAS unsigned*)(Qb + off) = cvt_pk_bf16(o0 * rstd * gn.x * bf_lo(wg), o1 * rstd * gn.y * bf_hi(wg)); } }
            }
            __syncthreads();
        }
    }
    __syncthreads();
}
namespace fa {
using bf16x8 = __attribute__((ext_vector_type(8))) short;
using s16x4  = __attribute__((ext_vector_type(4))) short;
using f32x16 = __attribute__((ext_vector_type(16))) float;
using u32x4  = __attribute__((ext_vector_type(4))) unsigned;
constexpr int KROW = 208;
constexpr int SHM_V = 64 * 64 * 2, SHM_K = 64 * KROW;
constexpr int OFF_V = 0, OFF_K = 2 * SHM_V, OFF_WS = OFF_K + 2 * SHM_K, OFF_STG = OFF_WS + 8 * 256, LDS_TOTAL = OFF_STG + 8 * 4096;
constexpr int NT = 65, NQC = 17;
#define FA_SBAR() __builtin_amdgcn_sched_barrier(0)
__device__ __forceinline__ int crow(int r, int hi) { return (r & 3) + 8 * (r >> 2) + 4 * hi; }
constexpr float THRL = 11.5f;
__device__ __forceinline__ void partialSM(f32x16& p0, f32x16& p1, float& mhat, f32x16& negm, float& alpha, bool first) {
  float a = fmaxf(fmaxf(p0[0], p0[1]), p1[0]), b = fmaxf(fmaxf(p0[2], p0[3]), p1[1]); a = fmaxf(fmaxf(a, p1[2]), p1[3]);
#pragma unroll
  for (int r = 4; r < 16; r += 4) { a = fmaxf(fmaxf(a, p0[r]), p0[r + 1]); b = fmaxf(fmaxf(b, p0[r + 2]), p0[r + 3]); a = fmaxf(fmaxf(a, p1[r]), p1[r + 1]); b = fmaxf(fmaxf(b, p1[r + 2]), p1[r + 3]); }
  float rm = fmaxf(a, b);
  { auto rr = __builtin_amdgcn_permlane32_swap(__float_as_uint(rm), __float_as_uint(rm), false, false);
    rm = fmaxf(__uint_as_float(rr[0]), __uint_as_float(rr[1])); }
  alpha = 1.f;
  if (first || __builtin_expect(__any(rm > THRL), 0)) { const float dl = first ? rm : fmaxf(rm, 0.f); mhat += dl;
#pragma unroll
    for (int r = 0; r < 16; ++r) { p0[r] -= dl; p1[r] -= dl; }
#pragma unroll
    for (int r = 0; r < 16; ++r) negm[r] = -mhat;
    asm volatile("" : "+v"(negm));
    alpha = __builtin_amdgcn_exp2f(-dl); }
#pragma unroll
  for (int r = 0; r < 16; ++r) p0[r] = __builtin_amdgcn_exp2f(p0[r]);
}
__device__ __forceinline__ void finishSM(f32x16& p0, f32x16& p1, float alpha, float& l_reg, bf16x8& pa0, bf16x8& pa1, bf16x8& pa2, bf16x8& pa3) {
#pragma unroll
  for (int r = 0; r < 16; ++r) p1[r] = __builtin_amdgcn_exp2f(p1[r]);
  float ps = 0;
#pragma unroll
  for (int r = 0; r < 16; ++r) ps += p0[r];
#pragma unroll
  for (int r = 0; r < 16; ++r) ps += p1[r];
  { auto rr = __builtin_amdgcn_permlane32_swap(__float_as_uint(ps), __float_as_uint(ps), false, false);
    ps = __uint_as_float(rr[0]) + __uint_as_float(rr[1]); }
  l_reg = l_reg * alpha + ps;
#define FA_PK4(P, BASE, OUT) do { unsigned a0 = cvt_pk_bf16(P[BASE + 0], P[BASE + 1]), a1 = cvt_pk_bf16(P[BASE + 2], P[BASE + 3]);   \
    unsigned b0 = cvt_pk_bf16(P[BASE + 4], P[BASE + 5]), b1 = cvt_pk_bf16(P[BASE + 6], P[BASE + 7]);                              \
    auto r0 = __builtin_amdgcn_permlane32_swap(a0, b0, false, false); auto r1 = __builtin_amdgcn_permlane32_swap(a1, b1, false, false); \
    u32x4 w = {r0[0], r1[0], r0[1], r1[1]}; OUT = *reinterpret_cast<bf16x8*>(&w); } while (0)
  FA_PK4(p0, 0, pa0); FA_PK4(p0, 8, pa1); FA_PK4(p1, 0, pa2); FA_PK4(p1, 8, pa3);
#undef FA_PK4
}
__device__ __forceinline__ void qkt(f32x16& p0, f32x16& p1, const char* Ks, const bf16x8* qr, const f32x16& negm, int r32, int hi) {
#pragma unroll
  for (int d0 = 0; d0 < 6; ++d0) { const int cb = (d0 * 16 + hi * 8) * 2;
    const bf16x8 b0 = *reinterpret_cast<const bf16x8*>(Ks + r32 * KROW + cb);
    const bf16x8 b1 = *reinterpret_cast<const bf16x8*>(Ks + (32 + r32) * KROW + cb);
    if (d0 == 0) { p0 = __builtin_amdgcn_mfma_f32_32x32x16_bf16(b0, qr[0], negm, 0, 0, 0); p1 = __builtin_amdgcn_mfma_f32_32x32x16_bf16(b1, qr[0], negm, 0, 0, 0); }
    else { p0 = __builtin_amdgcn_mfma_f32_32x32x16_bf16(b0, qr[d0], p0, 0, 0, 0); p1 = __builtin_amdgcn_mfma_f32_32x32x16_bf16(b1, qr[d0], p1, 0, 0, 0); } }
}
__device__ __forceinline__ int v_st(int k, int c) { const int kk = (k & ~0xC) | ((k & 4) << 1) | ((k & 8) >> 1); return ((kk >> 3) * 2 + (c >> 5)) * 512 + ((kk & 7) * 32 + (c & 31)) * 2; }
__device__ __forceinline__ int v_rd_base(int lane) { return ((lane & 3) << 3) | (((lane >> 2) & 3) << 6) | (((lane >> 4) & 1) << 5) | (((lane >> 5) & 1) << 8); }
constexpr int v_rd_off(int d0, int ks, int half) { return d0 * 512 + ks * 2048 + half * 1024; }
template <int OFF> __device__ __forceinline__ s16x4 tr_read(int vb) {
  s16x4 r; asm volatile("ds_read_b64_tr_b16 %0, %1 offset:%2" : "=&v"(r) : "v"(vb), "i"(OFF) : "memory"); return r;
}
template <int D0> __device__ __forceinline__ void pv_one(f32x16& od, int vb, bf16x8 pa0, bf16x8 pa1, bf16x8 pa2, bf16x8 pa3) {
  const s16x4 l0 = tr_read<v_rd_off(D0, 0, 0)>(vb), h0 = tr_read<v_rd_off(D0, 0, 1)>(vb), l1 = tr_read<v_rd_off(D0, 1, 0)>(vb), h1 = tr_read<v_rd_off(D0, 1, 1)>(vb);
  const s16x4 l2 = tr_read<v_rd_off(D0, 2, 0)>(vb), h2 = tr_read<v_rd_off(D0, 2, 1)>(vb), l3 = tr_read<v_rd_off(D0, 3, 0)>(vb), h3 = tr_read<v_rd_off(D0, 3, 1)>(vb);
  asm volatile("s_waitcnt lgkmcnt(0)" ::: "memory"); FA_SBAR();
#define FA_PK(L, H) (bf16x8){L[0], L[1], L[2], L[3], H[0], H[1], H[2], H[3]}
  od = __builtin_amdgcn_mfma_f32_32x32x16_bf16(pa0, FA_PK(l0, h0), od, 0, 0, 0);
  od = __builtin_amdgcn_mfma_f32_32x32x16_bf16(pa1, FA_PK(l1, h1), od, 0, 0, 0);
  od = __builtin_amdgcn_mfma_f32_32x32x16_bf16(pa2, FA_PK(l2, h2), od, 0, 0, 0);
  od = __builtin_amdgcn_mfma_f32_32x32x16_bf16(pa3, FA_PK(l3, h3), od, 0, 0, 0);
#undef FA_PK
}
__device__ __forceinline__ void pv_d0(f32x16* o, int vb, bf16x8 pa0, bf16x8 pa1, bf16x8 pa2, bf16x8 pa3) {
  pv_one<0>(o[0], vb, pa0, pa1, pa2, pa3); pv_one<1>(o[1], vb, pa0, pa1, pa2, pa3);
}
__device__ __forceinline__ void attn_unit(int b, int h, int q0, const bf16* __restrict__ Q, const bf16* __restrict__ KV, const bf16* __restrict__ KR, bf16* __restrict__ O, char* lds) {
  const int tid = threadIdx.x, wid = tid >> 6, lane = tid & 63, r32 = lane & 31, hi = lane >> 5;
  char* V_lds = lds + OFF_V; char* K_lds = lds + OFF_K;
  float* ws = (float*)(lds + OFF_WS) + wid * 64; float* li_l = ws; float* al_l = ws + 32;
  float mhat = 0.f, l_reg = 0; f32x16 o[2] = {}; bf16x8 qr[6]; f32x16 negm = f32x16{}; asm volatile("" : "+v"(negm));
  const size_t seq0 = (size_t)b * LP;
  { int sq = q0 + wid * 32 + r32; sq = sq < LP ? sq : LP - 1;
    const bf16* Qw = Q + (seq0 + sq) * 1536 + h * 96 + hi * 8;
#pragma unroll
    for (int d0 = 0; d0 < 6; ++d0) qr[d0] = *reinterpret_cast<const bf16x8*>(Qw + d0 * 16); }
  const int sr = tid >> 3, sc = (tid & 7) * 8, rr = (tid >> 2) & 63, rc = (tid & 3) * 8; const bool hasr = tid < 256;
  const int vst = v_st(sr, sc), kst = sr * KROW + sc * 2, rst = rr * KROW + 128 + rc * 2;
  const bf16* Kn = KV + seq0 * 2048 + h * 128 + (size_t)sr * 2048 + sc; const bf16* Vn = Kn + 64; const bf16* Rn = KR + seq0 * 32 + (size_t)rr * 32 + rc;
  const int vb0 = (int)(uintptr_t)V_lds + v_rd_base(lane);
  struct { bf16x8 vs, ks, rs; } sr_[2];
#define FA_SLOAD(i, k0) do { sr_[i].vs = *reinterpret_cast<const bf16x8*>(Vn + (size_t)(k0) * 2048); sr_[i].ks = *reinterpret_cast<const bf16x8*>(Kn + (size_t)(k0) * 2048); \
    if (hasr) sr_[i].rs = *reinterpret_cast<const bf16x8*>(Rn + (size_t)(k0) * 32); } while (0)
#define FA_SWRITE(bf, i) do { *(bf16x8*)(V_lds + (bf) * SHM_V + vst) = sr_[i].vs; *(bf16x8*)(K_lds + (bf) * SHM_K + kst) = sr_[i].ks; \
    if (hasr) *(bf16x8*)(K_lds + (bf) * SHM_K + rst) = sr_[i].rs; } while (0)
#define FA_SWAIT() asm volatile("s_waitcnt vmcnt(3)" ::: "memory")
#define FA_RESC(a) do { if (__any((a) < 1.f)) { if (hi == 0) al_l[r32] = (a); asm volatile("s_waitcnt lgkmcnt(0)" ::: "memory"); \
    _Pragma("unroll") for (int d = 0; d < 2; ++d) _Pragma("unroll") for (int r = 0; r < 16; ++r) o[d][r] *= al_l[crow(r, hi)]; } } while (0)
  f32x16 pA0, pA1, pB0, pB1; float alA, alB; bf16x8 pa0, pa1, pa2, pa3;
  constexpr int SE = 0, SO = 1;
  const bool act = q0 + wid * 32 < LP;
  if (!act) {
    __syncthreads();
    FA_SLOAD(SE, 0); asm volatile("s_waitcnt vmcnt(0)" ::: "memory"); FA_SWRITE(0, SE); __syncthreads();
    FA_SLOAD(SO, 64); FA_SLOAD(SE, 128);
    FA_SWAIT(); FA_SWRITE(1, SO); __syncthreads();
    for (int j = 1; j + 1 < NT; j += 2) {
      if (j + 2 < NT) FA_SLOAD(SO, (j + 2) * 64);
      __syncthreads(); FA_SWAIT(); FA_SWRITE(0, SE); __syncthreads();
      if (j + 3 < NT) FA_SLOAD(SE, (j + 3) * 64);
      __syncthreads(); FA_SWAIT(); if (j + 2 < NT) FA_SWRITE(1, SO); __syncthreads();
    }
    return;
  }
  __syncthreads();
  FA_SLOAD(SE, 0); asm volatile("s_waitcnt vmcnt(0)" ::: "memory"); FA_SWRITE(0, SE); __syncthreads();
  qkt(pA0, pA1, K_lds, qr, negm, r32, hi);
  { const float NEG = -INFINITY;
#pragma unroll
    for (int r = 0; r < 16; ++r) pA0[r] = NEG;
#pragma unroll
    for (int r = 0; r < 8; ++r) pA1[r] = NEG; }
  partialSM(pA0, pA1, mhat, negm, alA, true);
  FA_SLOAD(SO, 64); FA_SLOAD(SE, 128);
  FA_SWAIT(); FA_SWRITE(1, SO); __syncthreads();
  for (int j = 1; j + 1 < NT; j += 2) {
    FA_SBAR(); qkt(pB0, pB1, K_lds + SHM_K, qr, negm, r32, hi);
    finishSM(pA0, pA1, alA, l_reg, pa0, pa1, pa2, pa3); FA_SBAR();
    if (j + 2 < NT) FA_SLOAD(SO, (j + 2) * 64); FA_SBAR();
    pv_d0(o, vb0, pa0, pa1, pa2, pa3); partialSM(pB0, pB1, mhat, negm, alB, false);
    __syncthreads(); FA_SWAIT(); FA_SWRITE(0, SE);
    FA_RESC(alB); __syncthreads();
    FA_SBAR(); qkt(pA0, pA1, K_lds, qr, negm, r32, hi);
    finishSM(pB0, pB1, alB, l_reg, pa0, pa1, pa2, pa3); FA_SBAR();
    if (j + 3 < NT) FA_SLOAD(SE, (j + 3) * 64); FA_SBAR();
    pv_d0(o, vb0 + SHM_V, pa0, pa1, pa2, pa3); partialSM(pA0, pA1, mhat, negm, alA, false);
    __syncthreads(); FA_SWAIT(); if (j + 2 < NT) FA_SWRITE(1, SO);
    FA_RESC(alA); __syncthreads();
  }
  finishSM(pA0, pA1, alA, l_reg, pa0, pa1, pa2, pa3); FA_SBAR();
  pv_d0(o, vb0, pa0, pa1, pa2, pa3);
  if (hi == 0) li_l[r32] = l_reg; asm volatile("s_waitcnt lgkmcnt(0)" ::: "memory");
  float rli[16];
#pragma unroll
  for (int r = 0; r < 16; ++r) rli[r] = __builtin_amdgcn_rcpf(li_l[crow(r, hi)]);
  { unsigned short* stg = (unsigned short*)(lds + OFF_STG) + wid * 2048;
#pragma unroll
    for (int r = 0; r < 16; ++r) { const int orow = crow(r, hi);
#pragma unroll
      for (int d0 = 0; d0 < 2; ++d0) stg[orow * 64 + d0 * 32 + r32] = (unsigned short)(cvt_pk_bf16(o[d0][r] * rli[r], 0.f) & 0xffffu); }
    asm volatile("s_waitcnt lgkmcnt(0)" ::: "memory");
#pragma unroll
    for (int i = 0; i < 4; ++i) { const int row = i * 8 + (lane >> 3), ch = lane & 7; const int sq = q0 + wid * 32 + row; const u32x4 v = *(const u32x4*)(stg + row * 64 + ch * 8);
      if (sq < LP) *(u32x4*)(O + (seq0 + sq) * 1024 + h * 64 + ch * 8) = v; } }
#undef FA_SLOAD
#undef FA_SWRITE
#undef FA_SWAIT
#undef FA_RESC
}
__device__ __forceinline__ void attn_phase(int vcu, int G, const bf16* Q, const bf16* KV, const bf16* KR, bf16* O, char* lds) {
  for (int u = vcu; u < NB * 16 * NQC; u += G) { const int bh = u / NQC, qc = u % NQC; attn_unit(bh >> 4, bh & 15, qc * 256, Q, KV, KR, O, lds); }
  __syncthreads();
}
#undef FA_SBAR
}
namespace gla {
using bf16x8 = __attribute__((ext_vector_type(8))) short;
using s16x4  = __attribute__((ext_vector_type(4))) short;
using f32x16 = __attribute__((ext_vector_type(16))) float;
using u32x4  = __attribute__((ext_vector_type(4))) unsigned;
using u32x2  = __attribute__((ext_vector_type(2))) unsigned;
constexpr int RS = 264;
constexpr int O_QI = 0, O_KI = 64 * RS, O_KD = 2 * 64 * RS, O_VV = O_KD + 16384, O_VEC = O_VV + 16384;
constexpr int V_DEC = O_VEC, V_EREF = O_VEC + 512, V_TOT = O_VEC + 1024, V_F2 = O_VEC + 1024 + 2048;
constexpr int CH_BYTES = O_VEC + 3584;
static_assert(CH_BYTES % 16 == 0 && 2 * CH_BYTES <= 146432, "gla LDS");
#define GLA_SBAR() __builtin_amdgcn_sched_barrier(0)
__device__ __forceinline__ int crow(int r, int hi) { return (r & 3) + 8 * (r >> 2) + 4 * hi; }
__device__ __forceinline__ int v_st4(int k, int c) { const int kk = (k & ~0xC) | ((k & 4) << 1) | ((k & 8) >> 1); return ((kk >> 3) * 4 + (c >> 5)) * 512 + ((kk & 7) * 32 + (c & 31)) * 2; }
__device__ __forceinline__ int v_rd_base(int lane) { return ((lane & 3) << 3) | (((lane >> 2) & 3) << 6) | (((lane >> 4) & 1) << 5) | (((lane >> 5) & 1) << 8); }
template <int OFF> __device__ __forceinline__ s16x4 tr_read(int vb) {
  s16x4 r; asm volatile("ds_read_b64_tr_b16 %0, %1 offset:%2" : "=&v"(r) : "v"(vb), "i"(OFF) : "memory"); return r;
}
__device__ __forceinline__ bf16x8 nat_frag(const char* img, int row, int ks, int hi) {
  const u32x2 a = *(const u32x2*)(img + row * RS + (16 * ks + 4 * hi) * 2), b = *(const u32x2*)(img + row * RS + (16 * ks + 8 + 4 * hi) * 2);
  u32x4 w = {a.x, a.y, b.x, b.y}; return *reinterpret_cast<bf16x8*>(&w);
}
__device__ __forceinline__ bf16x8 pk4(const f32x16& P, int BASE_IS_8) {
  const int B = BASE_IS_8 ? 8 : 0;
  const unsigned a0 = cvt_pk_bf16(P[B + 0], P[B + 1]), a1 = cvt_pk_bf16(P[B + 2], P[B + 3]), b0 = cvt_pk_bf16(P[B + 4], P[B + 5]), b1 = cvt_pk_bf16(P[B + 6], P[B + 7]);
  auto r0 = __builtin_amdgcn_permlane32_swap(a0, b0, false, false); auto r1 = __builtin_amdgcn_permlane32_swap(a1, b1, false, false);
  u32x4 w = {r0[0], r1[0], r0[1], r1[1]}; return *reinterpret_cast<bf16x8*>(&w);
}
#define GLA_PK(L, H) (bf16x8){L[0], L[1], L[2], L[3], H[0], H[1], H[2], H[3]}
__device__ __forceinline__ void gla_phase(int vcu, int G, bf16* Qb, const bf16* Vb, bf16* KFb, bf16* KBb, const bf16* SGb, const float* onorm, char* lds) {
  const int tid = threadIdx.x, wid = __builtin_amdgcn_readfirstlane(tid >> 6), lane = tid & 63, r32 = lane & 31, hi = lane >> 5;
  const int dir = wid >> 2, w4 = wid & 3, ct = tid & 255, kp = ct & 63;
  char* L = lds + dir * CH_BYTES;
  const int lbase = (int)(uintptr_t)L;
  const int vbV = lbase + O_VV + v_rd_base(lane) + w4 * 512, vbK = lbase + O_KD + v_rd_base(lane);
  bf16* Kown = dir ? KBb : KFb; const bf16* Koth = dir ? KFb : KBb;
  for (int it = vcu; it < NB * 8; it += G) {
    const int b = it >> 3, h = it & 7, cb = h * 128; const size_t seq0 = (size_t)b * LP;
    f32x16 S[4];
#pragma unroll
    for (int kb = 0; kb < 4; ++kb) S[kb] = f32x16{};
    unsigned pq[16], pk[16]; bf16x8 pvv[4];
#define GLA_ROW(n, tl) ((n) * 64 + (dir ? 63 - (tl) : (tl)))
#define GLA_LOAD(n) do { _Pragma("unroll") for (int i = 0; i < 16; ++i) { const size_t off = (seq0 + GLA_ROW(n, 16 * w4 + i)) * 1024 + cb + 2 * kp; \
        pq[i] = *(const unsigned*)(Qb + off); pk[i] = *(const unsigned*)(Kown + off); } \
      _Pragma("unroll") for (int i = 0; i < 4; ++i) { const int id = ct + 256 * i; pvv[i] = *(const bf16x8*)(Vb + (seq0 + GLA_ROW(n, id >> 4)) * 1024 + cb + (id & 15) * 8); } } while (0)
    GLA_LOAD(dir ? 64 : 0);
    for (int step = 0; step < 65; ++step) {
      const int n = dir ? 64 - step : step;
      const bool fin = dir ? (step >= 32) : (step >= 33);
      int lane_o = lane; asm volatile("" : "+v"(lane_o));
      const int r32 = lane_o & 31, hi = lane_o >> 5, kp = lane_o, ct = (w4 << 6) | lane_o;
      const int vbV = lbase + O_VV + v_rd_base(lane_o) + w4 * 512, vbK = lbase + O_KD + v_rd_base(lane_o);
      { float run0 = 1.f, run1 = 1.f, f20 = 1.f, f21 = 1.f;
#pragma unroll
        for (int i = 0; i < 16; ++i) { run0 *= 1.0f - bf_lo(pk[i]); run1 *= 1.0f - bf_hi(pk[i]); if (i == 0) { f20 = run0; f21 = run1; } }
        *(f32x2*)(L + V_TOT + (w4 * 128 + 2 * kp) * 4) = (f32x2){run0, run1};
        if (w4 == 2) *(f32x2*)(L + V_F2 + (2 * kp) * 4) = (f32x2){f20, f21}; }
      __syncthreads();
      { const f32x2 t0 = *(const f32x2*)(L + V_TOT + (0 * 128 + 2 * kp) * 4), t1 = *(const f32x2*)(L + V_TOT + (1 * 128 + 2 * kp) * 4), t2 = *(const f32x2*)(L + V_TOT + (2 * 128 + 2 * kp) * 4),
                    t3 = *(const f32x2*)(L + V_TOT + (3 * 128 + 2 * kp) * 4), f2 = *(const f32x2*)(L + V_F2 + (2 * kp) * 4);
        const f32x2 pre = w4 == 0 ? (f32x2){1.f, 1.f} : w4 == 1 ? t0 : w4 == 2 ? t0 * t1 : t0 * t1 * t2;
        const f32x2 pref = t0 * t1 * f2, plast = (t0 * t1) * (t2 * t3);
        const float ir0 = __builtin_amdgcn_rcpf(pref.x), ir1 = __builtin_amdgcn_rcpf(pref.y);
        const float c30 = plast.x * ir0, c31 = plast.y * ir1;
        float run0 = pre.x, run1 = pre.y;
#pragma unroll
        for (int i = 0; i < 16; ++i) { const int t = 16 * w4 + i;
          const float kg0 = bf_lo(pk[i]), kg1 = bf_hi(pk[i]);
          run0 *= 1.0f - kg0; run1 *= 1.0f - kg1;
          const float ki0 = kg0 * pref.x * __builtin_amdgcn_rcpf(run0), ki1 = kg1 * pref.y * __builtin_amdgcn_rcpf(run1);
          *(unsigned*)(L + O_QI + t * RS + 4 * kp) = cvt_pk_bf16(bf_lo(pq[i]) * run0 * ir0, bf_hi(pq[i]) * run1 * ir1);
          *(unsigned*)(L + O_KI + t * RS + 4 * kp) = cvt_pk_bf16(ki0, ki1);
          *(unsigned*)(L + O_KD + v_st4(t, 2 * kp)) = cvt_pk_bf16(ki0 * c30, ki1 * c31); }
        if (w4 == 0) { *(f32x2*)(L + V_DEC + (2 * kp) * 4) = plast; *(f32x2*)(L + V_EREF + (2 * kp) * 4) = pref; }
#pragma unroll
        for (int i = 0; i < 4; ++i) { const int id = ct + 256 * i; *(bf16x8*)(L + O_VV + v_st4(id >> 4, (id & 15) * 8)) = pvv[i]; } }
      __syncthreads();
      f32x16 o[2]; o[0] = f32x16{}; o[1] = f32x16{};
      { bf16x8 Sb[8];
#pragma unroll
        for (int kb = 0; kb < 4; ++kb)
#pragma unroll
          for (int s = 0; s < 2; ++s) { const f32x4 e0 = *(const f32x4*)(L + V_EREF + (32 * kb + 16 * s + 4 * hi) * 4), e1 = *(const f32x4*)(L + V_EREF + (32 * kb + 16 * s + 8 + 4 * hi) * 4);
            u32x4 w; w.x = cvt_pk_bf16(S[kb][8 * s + 0] * e0[0], S[kb][8 * s + 1] * e0[1]); w.y = cvt_pk_bf16(S[kb][8 * s + 2] * e0[2], S[kb][8 * s + 3] * e0[3]);
                     w.z = cvt_pk_bf16(S[kb][8 * s + 4] * e1[0], S[kb][8 * s + 5] * e1[1]); w.w = cvt_pk_bf16(S[kb][8 * s + 6] * e1[2], S[kb][8 * s + 7] * e1[3]);
            Sb[2 * kb + s] = *reinterpret_cast<bf16x8*>(&w); }
#pragma unroll
        for (int tb = 0; tb < 2; ++tb)
#pragma unroll
          for (int ks = 0; ks < 8; ++ks) { o[tb] = __builtin_amdgcn_mfma_f32_32x32x16_bf16(nat_frag(L + O_QI, 32 * tb + r32, ks, hi), Sb[ks], o[tb], 0, 0, 0);
                                           if ((ks & 3) == 3) asm volatile("" ::: "memory"); } }
      { f32x16 a0 = f32x16{};
#pragma unroll
        for (int ks = 0; ks < 8; ++ks) { a0 = __builtin_amdgcn_mfma_f32_32x32x16_bf16(nat_frag(L + O_KI, r32, ks, hi), nat_frag(L + O_QI, r32, ks, hi), a0, 0, 0, 0);
                                         if ((ks & 3) == 3) asm volatile("" ::: "memory"); }
#pragma unroll
        for (int r = 0; r < 16; ++r) a0[r] = crow(r, hi) > r32 ? 0.f : a0[r];
        const bf16x8 pa0 = pk4(a0, 0), pa1 = pk4(a0, 1);
        const s16x4 l0 = tr_read<0 * 4096>(vbV), h0 = tr_read<0 * 4096 + 2048>(vbV), l1 = tr_read<1 * 4096>(vbV), h1 = tr_read<1 * 4096 + 2048>(vbV);
        asm volatile("s_waitcnt lgkmcnt(0)" ::: "memory"); GLA_SBAR();
        o[0] = __builtin_amdgcn_mfma_f32_32x32x16_bf16(pa0, GLA_PK(l0, h0), o[0], 0, 0, 0);
        o[0] = __builtin_amdgcn_mfma_f32_32x32x16_bf16(pa1, GLA_PK(l1, h1), o[0], 0, 0, 0); }
      { f32x16 a0 = f32x16{}, a1 = f32x16{};
#pragma unroll
        for (int ks = 0; ks < 8; ++ks) { const bf16x8 qf = nat_frag(L + O_QI, 32 + r32, ks, hi);
                                         a0 = __builtin_amdgcn_mfma_f32_32x32x16_bf16(nat_frag(L + O_KI, r32, ks, hi), qf, a0, 0, 0, 0);
                                         a1 = __builtin_amdgcn_mfma_f32_32x32x16_bf16(nat_frag(L + O_KI, 32 + r32, ks, hi), qf, a1, 0, 0, 0);
                                         if (ks & 1) asm volatile("" ::: "memory"); }
#pragma unroll
        for (int r = 0; r < 16; ++r) a1[r] = crow(r, hi) > r32 ? 0.f : a1[r];
        const bf16x8 pa0 = pk4(a0, 0), pa1 = pk4(a0, 1), pa2 = pk4(a1, 0), pa3 = pk4(a1, 1);
        const s16x4 l0 = tr_read<0 * 4096>(vbV), h0 = tr_read<0 * 4096 + 2048>(vbV), l1 = tr_read<1 * 4096>(vbV), h1 = tr_read<1 * 4096 + 2048>(vbV);
        const s16x4 l2 = tr_read<2 * 4096>(vbV), h2 = tr_read<2 * 4096 + 2048>(vbV), l3 = tr_read<3 * 4096>(vbV), h3 = tr_read<3 * 4096 + 2048>(vbV);
        asm volatile("s_waitcnt lgkmcnt(0)" ::: "memory"); GLA_SBAR();
        o[1] = __builtin_amdgcn_mfma_f32_32x32x16_bf16(pa0, GLA_PK(l0, h0), o[1], 0, 0, 0);
        o[1] = __builtin_amdgcn_mfma_f32_32x32x16_bf16(pa1, GLA_PK(l1, h1), o[1], 0, 0, 0);
        o[1] = __builtin_amdgcn_mfma_f32_32x32x16_bf16(pa2, GLA_PK(l2, h2), o[1], 0, 0, 0);
        o[1] = __builtin_amdgcn_mfma_f32_32x32x16_bf16(pa3, GLA_PK(l3, h3), o[1], 0, 0, 0); }
      __syncthreads();
      { unsigned short* ot = (unsigned short*)(L + O_KI);
#pragma unroll
        for (int tb = 0; tb < 2; ++tb)
#pragma unroll
          for (int r = 0; r < 16; ++r) ot[(32 * tb + crow(r, hi)) * (RS / 2) + 32 * w4 + r32] = (unsigned short)(cvt_pk_bf16(o[tb][r], 0.f) & 0xffffu); }
      if (step < 64) { const int nn = dir ? n - 1 : n + 1; GLA_LOAD(nn); }
#pragma unroll
      for (int kb = 0; kb < 4; ++kb)
#pragma unroll
        for (int g4 = 0; g4 < 4; ++g4) { const f32x4 dc = *(const f32x4*)(L + V_DEC + (32 * kb + 8 * g4 + 4 * hi) * 4);
          S[kb][4 * g4 + 0] *= dc[0]; S[kb][4 * g4 + 1] *= dc[1]; S[kb][4 * g4 + 2] *= dc[2]; S[kb][4 * g4 + 3] *= dc[3]; }
      { const s16x4 l0 = tr_read<0 * 4096>(vbV), h0 = tr_read<0 * 4096 + 2048>(vbV), l1 = tr_read<1 * 4096>(vbV), h1 = tr_read<1 * 4096 + 2048>(vbV);
        const s16x4 l2 = tr_read<2 * 4096>(vbV), h2 = tr_read<2 * 4096 + 2048>(vbV), l3 = tr_read<3 * 4096>(vbV), h3 = tr_read<3 * 4096 + 2048>(vbV);
        asm volatile("s_waitcnt lgkmcnt(0)" ::: "memory"); GLA_SBAR();
        const bf16x8 vf0 = GLA_PK(l0, h0), vf1 = GLA_PK(l1, h1), vf2 = GLA_PK(l2, h2), vf3 = GLA_PK(l3, h3);
#define GLA_UPD(kb) do { const s16x4 a0 = tr_read<(kb) * 512 + 0 * 4096>(vbK), b0 = tr_read<(kb) * 512 + 0 * 4096 + 2048>(vbK), a1 = tr_read<(kb) * 512 + 1 * 4096>(vbK), b1 = tr_read<(kb) * 512 + 1 * 4096 + 2048>(vbK); \
          const s16x4 a2 = tr_read<(kb) * 512 + 2 * 4096>(vbK), b2 = tr_read<(kb) * 512 + 2 * 4096 + 2048>(vbK), a3 = tr_read<(kb) * 512 + 3 * 4096>(vbK), b3 = tr_read<(kb) * 512 + 3 * 4096 + 2048>(vbK); \
          asm volatile("s_waitcnt lgkmcnt(0)" ::: "memory"); GLA_SBAR(); \
          S[kb] = __builtin_amdgcn_mfma_f32_32x32x16_bf16(GLA_PK(a0, b0), vf0, S[kb], 0, 0, 0); S[kb] = __builtin_amdgcn_mfma_f32_32x32x16_bf16(GLA_PK(a1, b1), vf1, S[kb], 0, 0, 0); \
          S[kb] = __builtin_amdgcn_mfma_f32_32x32x16_bf16(GLA_PK(a2, b2), vf2, S[kb], 0, 0, 0); S[kb] = __builtin_amdgcn_mfma_f32_32x32x16_bf16(GLA_PK(a3, b3), vf3, S[kb], 0, 0, 0); } while (0)
        GLA_UPD(0); GLA_UPD(1); GLA_UPD(2); GLA_UPD(3);
#undef GLA_UPD
      }
      __syncthreads();
      const int t = ct >> 2, q4 = ct & 3; const size_t goff = (seq0 + GLA_ROW(n, t)) * 1024 + cb + 32 * q4;
      u32x2 ow[8];
#pragma unroll
      for (int i = 0; i < 8; ++i) ow[i] = *(const u32x2*)(L + O_KI + t * RS + q4 * 64 + i * 8);
      if (!fin) {
#pragma unroll
        for (int i = 0; i < 4; ++i) *(u32x4*)(Kown + goff + 8 * i) = (u32x4){ow[2 * i].x, ow[2 * i].y, ow[2 * i + 1].x, ow[2 * i + 1].y};
      }
      __syncthreads();
      if (fin) {
        float ov[32]; float ss = 0.f;
#pragma unroll
        for (int i = 0; i < 4; ++i) { const u32x4 pw = *(const u32x4*)(Koth + goff + 8 * i);
          ov[8 * i + 0] = bf_lo(ow[2 * i].x) + bf_lo(pw.x); ov[8 * i + 1] = bf_hi(ow[2 * i].x) + bf_hi(pw.x); ov[8 * i + 2] = bf_lo(ow[2 * i].y) + bf_lo(pw.y); ov[8 * i + 3] = bf_hi(ow[2 * i].y) + bf_hi(pw.y);
          ov[8 * i + 4] = bf_lo(ow[2 * i + 1].x) + bf_lo(pw.z); ov[8 * i + 5] = bf_hi(ow[2 * i + 1].x) + bf_hi(pw.z); ov[8 * i + 6] = bf_lo(ow[2 * i + 1].y) + bf_lo(pw.w); ov[8 * i + 7] = bf_hi(ow[2 * i + 1].y) + bf_hi(pw.w); }
#pragma unroll
        for (int i = 0; i < 32; ++i) ss += ov[i] * ov[i];
        ss += __shfl_xor(ss, 1); ss += __shfl_xor(ss, 2);
        const float rstd = 1.0f / sqrtf(ss * (1.0f / 128.0f) + EPS);
#pragma unroll
        for (int i = 0; i < 4; ++i) { const u32x4 gw = *(const u32x4*)(SGb + goff + 8 * i); const f32x4 n0 = *(const f32x4*)(onorm + cb + 32 * q4 + 8 * i), n1 = *(const f32x4*)(onorm + cb + 32 * q4 + 8 * i + 4);
          u32x4 w; w.x = cvt_pk_bf16(ov[8 * i + 0] * rstd * n0[0] * bf_lo(gw.x), ov[8 * i + 1] * rstd * n0[1] * bf_hi(gw.x)); w.y = cvt_pk_bf16(ov[8 * i + 2] * rstd * n0[2] * bf_lo(gw.y), ov[8 * i + 3] * rstd * n0[3] * bf_hi(gw.y));
                   w.z = cvt_pk_bf16(ov[8 * i + 4] * rstd * n1[0] * bf_lo(gw.z), ov[8 * i + 5] * rstd * n1[1] * bf_hi(gw.z)); w.w = cvt_pk_bf16(ov[8 * i + 6] * rstd * n1[2] * bf_lo(gw.w), ov[8 * i + 7] * rstd * n1[3] * bf_hi(gw.w));
          *(u32x4*)(Qb + goff + 8 * i) = w; }
      }
      __syncthreads();
    }
#undef GLA_ROW
#undef GLA_LOAD
  }
  __syncthreads();
}
#undef GLA_PK
#undef GLA_SBAR
}
constexpr int NPHASE = 16;
#ifndef GLA_SIMPLE
#define GLA_SIMPLE 0
#endif
#ifndef ATTN_SIMPLE
#define ATTN_SIMPLE 0
#endif
#ifndef MK_ONE_LAUNCH
#define MK_ONE_LAUNCH 1
#endif
struct Args { const float* in[19]; float* out; unsigned char* ws; int ph_lo, ph_hi; };
__global__ void __launch_bounds__(NWAVES * 64, 2) fwd(Args args) {
    extern __shared__ __attribute__((aligned(16))) unsigned char lds[];
    Frame F;
    F.lds = (LAS unsigned char*)lds;
    F.MISC = (volatile LAS unsigned*)(F.lds + MISC_OFF);
    F.tid = threadIdx.x; F.lane = F.tid & 63; F.wave = __builtin_amdgcn_readfirstlane(F.tid >> 6);
    F.G = gridDim.x; { const int bx = blockIdx.x; F.vcu = (F.G % 8 == 0) ? (bx % 8) * (F.G / 8) + bx / 8 : bx; }
    unsigned char* ws = args.ws;
    for (int u = F.tid; u < (LDS_BYTES - LDSCTL_OFF) / 4; u += NWAVES * 64) ((LAS unsigned*)(F.lds + LDSCTL_OFF))[u] = 0u;
    __syncthreads();
    const int lo = args.ph_lo, hi = args.ph_hi;
    XcdBarrier bar; bar.bar = (unsigned*)(ws + WS_CTL); bar.x = 0; bar.st = nullptr;
    if (hi - lo > 1) bar = xcd_barrier_post((unsigned*)(ws + WS_CTL), F.MISC + 8);
#ifndef ONLY_PHASE
#define ONLY_PHASE -1
#endif
#define IN(k) (lo <= (k) && (k) < hi && (ONLY_PHASE < 0 || ONLY_PHASE == (k)))
#ifndef DUP_MASK
#define DUP_MASK 0
#endif
#ifndef DUP_GLA
#define DUP_GLA 0
#endif
#define SEAM(k) do { if (IN(k) && IN((k) + 1)) xcd_barrier(bar); } while (0)
    const float* const* in = args.in;
    bf16* hD = (bf16*)args.out;
    bf16* hB = (bf16*)(ws + WS_B0 + (size_t)SLACK * ROWB);
    const pg8::f32x2* rope = (const pg8::f32x2*)(ws + WS_ROPE);
    using pg8::Gemm; using pg8::StaticOrder;
    const int cid = (int)blockIdx.x;

    if (IN(0)) { p0_prologue(F, in, ws, hD); } SEAM(0);
    if (IN(1)) { Gemm g{hD, (const bf16*)(ws + W_IN), 1024, 1024, 1024}; StaticOrder S; S.init(MT, 5, F.G, cid);
        pg8::EpiProj E{(bf16*)(ws + R_CQKV), (float*)(ws + R_SSQ), (bf16*)(ws + R_KROPE), rope};
        pg8::gemm_phase<pg8::EpiProj, StaticOrder, true, true>(F.lds + RING_OFF, g, S, E); } SEAM(1);
    if (IN(2)) {
        { Gemm g{(const bf16*)(ws + R_CQKV), (const bf16*)(ws + W_UQ), 768, 1024, 768}; StaticOrder S; S.init(MT, 6, F.G, cid);
          pg8::EpiQ E{(bf16*)(ws + R_Q), (const float*)(ws + R_SSQ), rope};
          pg8::gemm_phase<pg8::EpiQ, StaticOrder, true, true>(F.lds + RING_OFF, g, S, E); }
        { Gemm g{(const bf16*)(ws + R_CQKV) + 768, (const bf16*)(ws + W_UKV), 256, 1024, 256}; StaticOrder S; S.init(MT, 8, F.G, cid);
          pg8::EpiKV E{(bf16*)(ws + R_KV), (const float*)(ws + R_SSQ)};
          pg8::gemm_phase<pg8::EpiKV, StaticOrder, true, true>(F.lds + RING_OFF, g, S, E); }
    } SEAM(2);
    if (IN(3)) {
#if ATTN_SIMPLE
        attn_simple(F, (const bf16*)(ws + R_Q), (const bf16*)(ws + R_KV), (const bf16*)(ws + R_KROPE), (bf16*)(ws + R_CQKV));
#else
        fa::attn_phase(F.vcu, F.G, (const bf16*)(ws + R_Q), (const bf16*)(ws + R_KV), (const bf16*)(ws + R_KROPE), (bf16*)(ws + R_CQKV), (char*)lds);
#endif
    } SEAM(3);
    if (IN(4)) { Gemm g{(const bf16*)(ws + R_CQKV), (const bf16*)(ws + W_O), 1024, 1024, 1024}; StaticOrder S; S.init(MT, 4, F.G, cid);
        pg8::EpiResidLN<false, false> E{hD, nullptr, nullptr, nullptr, hB, (pg8::f32x2*)(ws + WS_SUM1) + SLACK, nullptr};
        pg8::gemm_phase<pg8::EpiResidLN<false, false>, StaticOrder, true, true>(F.lds + RING_OFF, g, S, E); } SEAM(4);
    if (IN(6)) { Gemm g{hB - 1024, (const bf16*)(ws + W_UP0), 1024, 1024, 1024}; StaticOrder S; S.init(MT_UP, 22, F.G, cid);
        pg8::EpiConvGate E{(bf16*)(ws + R_ACT), in[14], in[15], (const pg8::f32x2*)(ws + WS_SUM1) + SLACK, (const float*)(ws + C1_UP0), (const float*)(ws + C2_UP0)};
        pg8::gemm_phase<pg8::EpiConvGate, StaticOrder, true, true, true>(F.lds + RING_OFF, g, S, E); } SEAM(6);
    if (IN(7)) { Gemm g{(const bf16*)(ws + R_ACT), (const bf16*)(ws + W_DN0), DFF, DFF, DFF}; StaticOrder S; S.init(MT, 4, F.G, cid);
        pg8::EpiResidLN<true, false> E{hB, (const pg8::f32x2*)(ws + WS_SUM1) + SLACK, in[17] + 0 * 1024, in[18] + 0 * 1024, hD, (pg8::f32x2*)(ws + WS_SUM2) + SLACK, nullptr};
        pg8::gemm_phase<pg8::EpiResidLN<true, false>, StaticOrder, true, true>(F.lds + RING_OFF, g, S, E); } SEAM(7);
    if (IN(9)) { Gemm g{hD, (const bf16*)(ws + W_HIN), 1024, 1024, 1024}; StaticOrder S; S.init(MT, 20, F.G, cid);
        pg8::EpiHgIn E{hB, (bf16*)(ws + R_HV), (bf16*)(ws + R_HKF), (bf16*)(ws + R_HKB), (bf16*)(ws + R_HSG), (const float*)(ws + WS_LB), (const pg8::f32x2*)(ws + WS_SUM2) + SLACK, (const float*)(ws + C1_HG), (const float*)(ws + C2_HG)};
        pg8::gemm_phase<pg8::EpiHgIn, StaticOrder, true, true>(F.lds + RING_OFF, g, S, E); } SEAM(9);
    if (IN(10)) {
#if GLA_SIMPLE
        gla_simple(F, hB, (const bf16*)(ws + R_HV), (bf16*)(ws + R_HKF), (const bf16*)(ws + R_HKB), (const bf16*)(ws + R_HSG), in[11]);
#else
        gla::gla_phase(F.vcu, F.G, hB, (const bf16*)(ws + R_HV), (bf16*)(ws + R_HKF), (bf16*)(ws + R_HKB), (const bf16*)(ws + R_HSG), in[11], (char*)lds);
#endif
    } SEAM(10);
    if (IN(11)) {
        { const int gt = (F.vcu * NWAVES + F.wave) * 64 + F.lane, NGT = F.G * NWAVES * 64; GAS v4u* z0 = (GAS v4u*)(ws + R_HSG); GAS v4u* z1 = (GAS v4u*)(ws + R_XB3 + (size_t)M * ROWB);
          for (int i = gt; i < SLACK * (int)ROWB / 16; i += NGT) { z0[i] = (v4u){0u, 0u, 0u, 0u}; z1[i] = (v4u){0u, 0u, 0u, 0u}; } }
        Gemm g{hB, (const bf16*)(ws + W_HO), 1024, 1024, 1024}; StaticOrder S; S.init(MT, 4, F.G, cid);
        pg8::EpiResidLN<true, false> E{hD, (const pg8::f32x2*)(ws + WS_SUM2) + SLACK, in[17] + 1 * 1024, in[18] + 1 * 1024, (bf16*)(ws + R_XB3), (pg8::f32x2*)(ws + WS_SUM3) + SLACK, nullptr};
        pg8::gemm_phase<pg8::EpiResidLN<true, false>, StaticOrder, true, true>(F.lds + RING_OFF, g, S, E); } SEAM(11);
    if (IN(13)) { Gemm g{(const bf16*)(ws + R_XB3) - 1024, (const bf16*)(ws + W_UP1), 1024, 1024, 1024}; StaticOrder S; S.init(MT_UP, 22, F.G, cid);
        pg8::EpiConvGate E{(bf16*)(ws + R_ACT), in[14] + 3 * NUP, in[15] + NUP, (const pg8::f32x2*)(ws + WS_SUM3) + SLACK, (const float*)(ws + C1_UP1), (const float*)(ws + C2_UP1)};
        pg8::gemm_phase<pg8::EpiConvGate, StaticOrder, true, true, true>(F.lds + RING_OFF, g, S, E); } SEAM(13);
    if (IN(14)) { Gemm g{(const bf16*)(ws + R_ACT), (const bf16*)(ws + W_DN1), DFF, DFF, DFF}; StaticOrder S; S.init(MT, 4, F.G, cid);
        pg8::EpiResidLN<true, true> E{(const bf16*)(ws + R_XB3), (const pg8::f32x2*)(ws + WS_SUM3) + SLACK, in[17] + 2 * 1024, in[18] + 2 * 1024, nullptr, nullptr, args.out};
        pg8::gemm_phase<pg8::EpiResidLN<true, true>, StaticOrder, true, true>(F.lds + RING_OFF, g, S, E); } SEAM(14);
    if (IN(15)) { ln_final(F, args.out, in[17] + 3 * 1024, in[18] + 3 * 1024); }
#undef IN
#undef SEAM
}

__global__ void nan_fill(float* o, long n) { const float q = __builtin_nanf(""); for (long i = blockIdx.x * 256L + threadIdx.x; i < n; i += gridDim.x * 256L) o[i] = q; }
extern "C" void kernel_launch(void* const* d_in, const int* in_sizes, int n_in, void* d_out, int out_size, void* d_ws, size_t ws_size, hipStream_t stream) {
    static int grid = 0;
    if (grid == 0) {
        bool ok = (n_in == 19) && in_sizes[0] == 16 * SEQ * 1024 && in_sizes[1] == 4 * SEQ * 1024 && out_size == NB * SEQ * 1024 && ws_size >= WS_END;
        int dev = 0, cus = 0;
        if (ok) ok = hipGetDevice(&dev) == hipSuccess && hipDeviceGetAttribute(&cus, hipDeviceAttributeMultiprocessorCount, dev) == hipSuccess;
        if (ok) ok = hipFuncSetAttribute((const void*)fwd, hipFuncAttributeMaxDynamicSharedMemorySize, LDS_BYTES) == hipSuccess;
        if (!ok) { fprintf(stderr, "kernel_launch: unexpected shapes / workspace (%zu) / device\n", ws_size); grid = -1; }
        else grid = cus;
        (void)hipGetLastError();
    }
    if (grid < 0) { hipLaunchKernelGGL(nan_fill, dim3(1024), dim3(256), 0, stream, (float*)d_out, (long)out_size); return; }
    (void)hipMemsetAsync((char*)d_ws + WS_CTL, 0, CTL_ZERO_BYTES, stream);
    Args a{};
    for (int i = 0; i < 19; ++i) a.in[i] = (const float*)d_in[i];
    a.out = (float*)d_out; a.ws = (unsigned char*)d_ws;
#if MK_ONE_LAUNCH
    a.ph_lo = 0; a.ph_hi = NPHASE;
    hipLaunchKernelGGL(fwd, dim3(grid), dim3(NWAVES * 64), LDS_BYTES, stream, a);
#else
    for (int p = 0; p < NPHASE; ++p) { if (p == 5 || p == 8 || p == 12) continue;
        for (int r = 0; r < 1 + ((DUP_MASK >> p) & 1); ++r) { a.ph_lo = p; a.ph_hi = p + 1; hipLaunchKernelGGL(fwd, dim3(grid), dim3(NWAVES * 64), LDS_BYTES, stream, a); }
        if (p == 10 && DUP_GLA) for (int q = 9; q <= 10; ++q) { a.ph_lo = q; a.ph_hi = q + 1; hipLaunchKernelGGL(fwd, dim3(grid), dim3(NWAVES * 64), LDS_BYTES, stream, a); } }
#endif
}
```

```cpp
#include <hip/hip_runtime.h>
#include <cstdio>
constexpr int NB = 20;
constexpr int LP = 4160;
constexpr int PADR = 48, LTOK = 4112, SEQ = 4096, DM = 1024;
constexpr int M = NB * LP;
constexpr int MT = M / 256;
constexpr int DFF = 2816, NUP = 2 * DFF;
constexpr int NBLK62 = (M + 61) / 62;
constexpr int MT_UP = (NBLK62 + 3) / 4;
constexpr float EPS = 1e-6f, ALPHA = 1.4142135623730951f;
constexpr float SM_C = 0.10206207261596575f * 1.4426950408889634f;
#include <cstdint>
namespace pg8 {
#define PG8_LAS __attribute__((address_space(3)))
typedef unsigned short bf16_t;
typedef short bf16x8 __attribute__((ext_vector_type(8)));
typedef float f32x4 __attribute__((ext_vector_type(4)));
typedef unsigned u32x4 __attribute__((ext_vector_type(4)));
typedef unsigned u32x2 __attribute__((ext_vector_type(2)));
constexpr int BM = 256, BK = 64, HALF = 128, HTB = HALF * BK * 2  , STAGE_BYTES = 8 * HTB, NXCD = 8, WGM = 8;

__host__ __device__ __forceinline__ int lds_byte(int r, int c) { const int st = (r >> 4) * 2 + (c >> 5), rr = r & 15, cc = c & 31, ob = rr * 64 + cc * 2; return st * 1024 + (ob ^ (((ob >> 9) & 1) << 5)); }
__host__ __device__ __forceinline__ void stage_rc(int b, int& R, int& C) { const int st = b / 1024, sb = b % 1024, swz = sb ^ (((sb >> 9) & 1) << 5); R = (st >> 1) * 16 + swz / 64; C = (st & 1) * 32 + (swz % 64) / 2; }
__host__ __device__ __forceinline__ int perm32(int rho) { const int n = rho >> 4, i = rho & 15; return 8 * (i >> 2) + 4 * n + (i & 3); }

struct Unit { int pm, pn; };
struct Gemm { const bf16_t* A; const bf16_t* Bt; int K, lda, ldb; };

struct StaticOrder {
    int nM, nN, nwg, G, c;
    __host__ __device__ void init(int nM_, int nN_, int G_, int c_) { nM = nM_; nN = nN_; nwg = nM * nN; G = G_; c = c_; }
    __host__ __device__ bool next(int i, Unit& u) const {
        const long L = (long)i * G + c; if (L >= nwg) return false;
        int wgid = (int)L; { const int q = nwg / NXCD, r = nwg % NXCD, xcd = wgid % NXCD, off = wgid / NXCD; wgid = (xcd < r ? xcd * (q + 1) : r * (q + 1) + (xcd - r) * q) + off; }
        const int nig = WGM * nN, gid = wgid / nig, fm = gid * WGM, gsz = (nM - fm) < WGM ? (nM - fm) : WGM;
        u.pm = fm + ((wgid % nig) % gsz); u.pn = (wgid % nig) / gsz; return true;
    }
    __device__ __forceinline__ void a_ready(const Unit&) const {}
    __device__ __forceinline__ void done(const Unit&) const {}
};
__device__ __forceinline__ unsigned cvt_pk_bf16(float lo, float hi) { unsigned r; asm volatile("v_cvt_pk_bf16_f32 %0, %1, %2" : "=v"(r) : "v"(lo), "v"(hi)); return r; }
__device__ __forceinline__ float bf_lo(unsigned w) { return __uint_as_float(w << 16); }
__device__ __forceinline__ float bf_hi(unsigned w) { return __uint_as_float(w & 0xffff0000u); }
typedef float f32x2 __attribute__((ext_vector_type(2)));
__device__ __forceinline__ u32x4 pack8(const f32x4 v0, const f32x4 v1) { u32x4 w; w.x = cvt_pk_bf16(v0[0], v0[1]); w.y = cvt_pk_bf16(v0[2], v0[3]); w.z = cvt_pk_bf16(v1[0], v1[1]); w.w = cvt_pk_bf16(v1[2], v1[3]); return w; }
__device__ __forceinline__ void rope8(f32x4& v0, f32x4& v1, const f32x2* tab, int pos, int i0) {
    const f32x2* t = tab + pos * 16 + i0;
    const f32x2 c0 = t[0], c1 = t[1], c2 = t[2], c3 = t[3];
    f32x4 a, b;
    a[0] = v0[0] * c0.x - v0[1] * c0.y; a[1] = v0[0] * c0.y + v0[1] * c0.x;
    a[2] = v0[2] * c1.x - v0[3] * c1.y; a[3] = v0[2] * c1.y + v0[3] * c1.x;
    b[0] = v1[0] * c2.x - v1[1] * c2.y; b[1] = v1[0] * c2.y + v1[1] * c2.x;
    b[2] = v1[2] * c3.x - v1[3] * c3.y; b[3] = v1[2] * c3.y + v1[3] * c3.x;
    v0 = a; v1 = b;
}
__device__ __forceinline__ void glds16(const void* src, PG8_LAS unsigned char* dst_wave_base) { __builtin_amdgcn_global_load_lds((const unsigned*)src, (PG8_LAS unsigned*)dst_wave_base, 16, 0, 0); }
struct EpiProj {
    static constexpr bool PERM = true, AFTER_DRAIN = false, STAGED = false;
    bf16_t* cqkv; float* ssq; bf16_t* krope; const f32x2* rope;
    __device__ __forceinline__ void operator()(const f32x4 (&acc)[2][2][4][2], const Unit& u, int wr, int wc, int fr, int fq, PG8_LAS unsigned char*) const {
        const int row0 = u.pm * BM + wr * 64 + fr;
        if (u.pn < 4) {
            const int col0 = u.pn * BM + wc * 32 + 8 * fq;
#pragma unroll
            for (int ai = 0; ai < 2; ++ai)
#pragma unroll
                for (int m = 0; m < 4; ++m) { const int row = row0 + ai * HALF + m * 16; float s = 0.f;
#pragma unroll
                    for (int bj = 0; bj < 2; ++bj) { const f32x4 v0 = acc[ai][bj][m][0], v1 = acc[ai][bj][m][1];
                        s += (v0[0] * v0[0] + v0[1] * v0[1]) + (v0[2] * v0[2] + v0[3] * v0[3]) + (v1[0] * v1[0] + v1[1] * v1[1]) + (v1[2] * v1[2] + v1[3] * v1[3]);
                        *(u32x4*)(cqkv + (size_t)row * 1024 + col0 + bj * HALF) = pack8(v0, v1); }
                    s += __shfl_xor(s, 16); s += __shfl_xor(s, 32);
                    if (fq == 0) __hip_atomic_fetch_add(ssq + (size_t)row * 2 + (u.pn == 3 ? 1 : 0), s, __ATOMIC_RELAXED, __HIP_MEMORY_SCOPE_AGENT); }
        } else if (wc == 0) {
#pragma unroll
            for (int ai = 0; ai < 2; ++ai)
#pragma unroll
                for (int m = 0; m < 4; ++m) { const int row = row0 + ai * HALF + m * 16; int pos = row % LP - PADR; pos = pos < 0 ? 0 : pos;
                    f32x4 v0 = acc[ai][0][m][0], v1 = acc[ai][0][m][1]; rope8(v0, v1, rope, pos, 4 * fq);
                    *(u32x4*)(krope + (size_t)row * 32 + 8 * fq) = pack8(v0, v1); }
        }
    }
};
struct EpiQ {
    static constexpr bool PERM = true, AFTER_DRAIN = false, STAGED = true;
    bf16_t* Q; const float* ssq; const f32x2* rope;
    __device__ __forceinline__ void stage(PG8_LAS unsigned char* slot, const Unit& u, int tid, int wid) const { asm volatile("" : "+v"(tid)); if (tid < 128) glds16(ssq + ((size_t)u.pm * BM + tid * 2) * 2, slot + wid * 1024); }
    __device__ __forceinline__ void operator()(const f32x4 (&acc)[2][2][4][2], const Unit& u, int wr, int wc, int fr, int fq, PG8_LAS unsigned char* slot) const {
        const int col0 = u.pn * BM + wc * 32 + 8 * fq; const PG8_LAS unsigned char* rb = slot + (wr * 64 + fr) * 8;
#pragma unroll
        for (int ai = 0; ai < 2; ++ai)
#pragma unroll
            for (int m = 0; m < 4; ++m) { const int lr = ai * HALF + wr * 64 + m * 16 + fr, row = u.pm * BM + lr; int pos = row % LP - PADR; pos = pos < 0 ? 0 : pos;
                const float ss = *(const PG8_LAS float*)(rb + (ai * HALF + m * 16) * 8);
                const float rstd = SM_C / sqrtf(ss * (1.0f / 768.0f) + EPS);
#pragma unroll
                for (int bj = 0; bj < 2; ++bj) { const int c = col0 + bj * HALF, d = c % 96; f32x4 v0 = acc[ai][bj][m][0] * rstd, v1 = acc[ai][bj][m][1] * rstd;
                    if (d >= 64) rope8(v0, v1, rope, pos, (d - 64) >> 1);
                    *(u32x4*)(Q + (size_t)row * 1536 + c) = pack8(v0, v1); }
                asm volatile("" ::: "memory"); }
    }
};
struct EpiKV {
    static constexpr bool PERM = true, AFTER_DRAIN = false, STAGED = true;
    bf16_t* KV; const float* ssq;
    __device__ __forceinline__ void stage(PG8_LAS unsigned char* slot, const Unit& u, int tid, int wid) const { asm volatile("" : "+v"(tid)); if (tid < 128) glds16(ssq + ((size_t)u.pm * BM + tid * 2) * 2, slot + wid * 1024); }
    __device__ __forceinline__ void operator()(const f32x4 (&acc)[2][2][4][2], const Unit& u, int wr, int wc, int fr, int fq, PG8_LAS unsigned char* slot) const {
        const int col0 = u.pn * BM + wc * 32 + 8 * fq; const PG8_LAS unsigned char* rb = slot + (wr * 64 + fr) * 8 + 4;
#pragma unroll
        for (int ai = 0; ai < 2; ++ai)
#pragma unroll
            for (int m = 0; m < 4; ++m) { const int lr = ai * HALF + wr * 64 + m * 16 + fr, row = u.pm * BM + lr;
                const float rstd = 1.0f / sqrtf(*(const PG8_LAS float*)(rb + (ai * HALF + m * 16) * 8) * (1.0f / 256.0f) + EPS);
#pragma unroll
                for (int bj = 0; bj < 2; ++bj) *(u32x4*)(KV + (size_t)row * 2048 + col0 + bj * HALF) = pack8(acc[ai][bj][m][0] * rstd, acc[ai][bj][m][1] * rstd); }
    }
};
__device__ __forceinline__ void mean_rstd(const f32x2 sq, float& mean, float& rstd) { mean = sq.x * (1.0f / 1024.0f); rstd = 1.0f / sqrtf(fmaxf(sq.y * (1.0f / 1024.0f) - mean * mean, 0.f) + EPS); }
template <bool BASE_LN, bool OUT_F32> struct EpiResidLN {
    static constexpr bool PERM = false, AFTER_DRAIN = false, STAGED = BASE_LN;
    const bf16_t* hb; const f32x2* SUMp; const float* g; const float* b; bf16_t* xo; f32x2* SUMo; float* of32;
    __device__ __forceinline__ void stage(PG8_LAS unsigned char* slot, const Unit& u, int tid, int wid) const {
        asm volatile("" : "+v"(tid));
        const int c = tid; const void* src = c < 64 ? (const void*)(g + u.pn * BM + c * 4) : c < 128 ? (const void*)(b + u.pn * BM + (c - 64) * 4) : (const void*)(SUMp + u.pm * BM + (c - 128) * 2);
        if (c < 256) glds16(src, slot + wid * 1024);
    }
    __device__ __forceinline__ void operator()(const f32x4 (&acc)[2][2][4][2], const Unit& u, int wr, int wc, int fr, int fq, PG8_LAS unsigned char* slot) const {
        const int row0 = u.pm * BM + wr * 64 + fr, col0 = u.pn * BM + wc * 32 + 4 * fq, lc0 = wc * 32 + 4 * fq;
#pragma unroll
        for (int ai = 0; ai < 2; ++ai)
#pragma unroll
            for (int m = 0; m < 4; ++m) { const int lr = ai * HALF + wr * 64 + m * 16 + fr, row = u.pm * BM + lr; const size_t off = (size_t)row * 1024 + col0; const int sq = row % LP;
                float mean = 0.f, rstd = 0.f; if (BASE_LN) mean_rstd(*(const PG8_LAS f32x2*)(slot + (wr * 64 + fr) * 8 + (2048 + (ai * HALF + m * 16) * 8)), mean, rstd);
                const bool pad = sq < PADR; float s = 0.f, q = 0.f; f32x4 x[2][2];
#pragma unroll
                for (int bj = 0; bj < 2; ++bj)
#pragma unroll
                    for (int n = 0; n < 2; ++n) { const u32x2 hw = *(const u32x2*)(hb + off + bj * HALF + n * 16);
                        f32x4 hv; hv[0] = bf_lo(hw.x); hv[1] = bf_hi(hw.x); hv[2] = bf_lo(hw.y); hv[3] = bf_hi(hw.y);
                        if (BASE_LN) { const f32x4 gv = *(const PG8_LAS f32x4*)(slot + (lc0 + bj * HALF + n * 16) * 4), bv = *(const PG8_LAS f32x4*)(slot + 1024 + (lc0 + bj * HALF + n * 16) * 4);
                            hv = (hv - mean) * rstd * gv + bv; if (pad) hv = (f32x4){0.f, 0.f, 0.f, 0.f}; }
                        const f32x4 xv = hv * ALPHA + acc[ai][bj][m][n]; x[bj][n] = xv;
                        s += (xv[0] + xv[1]) + (xv[2] + xv[3]); q += (xv[0] * xv[0] + xv[1] * xv[1]) + (xv[2] * xv[2] + xv[3] * xv[3]); }
                if (OUT_F32) { if (sq >= 64) { float* orow = of32 + ((size_t)(row / LP) * SEQ + (sq - 64)) * 1024 + col0;
#pragma unroll
                        for (int bj = 0; bj < 2; ++bj)
#pragma unroll
                            for (int n = 0; n < 2; ++n) *(f32x4*)(orow + bj * HALF + n * 16) = x[bj][n]; }
                } else {
#pragma unroll
                    for (int bj = 0; bj < 2; ++bj)
#pragma unroll
                        for (int n = 0; n < 2; ++n) { u32x2 w; w.x = cvt_pk_bf16(x[bj][n][0], x[bj][n][1]); w.y = cvt_pk_bf16(x[bj][n][2], x[bj][n][3]); *(u32x2*)(xo + off + bj * HALF + n * 16) = w; }
                    s += __shfl_xor(s, 16); q += __shfl_xor(q, 16); s += __shfl_xor(s, 32); q += __shfl_xor(q, 32);
                    if (fq == 0) { float* sp = (float*)(SUMo + row); __hip_atomic_fetch_add(sp, s, __ATOMIC_RELAXED, __HIP_MEMORY_SCOPE_AGENT); __hip_atomic_fetch_add(sp + 1, q, __ATOMIC_RELAXED, __HIP_MEMORY_SCOPE_AGENT); } } }
        (void)row0;
    }
};
struct EpiHgIn {
    static constexpr bool PERM = true, AFTER_DRAIN = false, STAGED = true;
    bf16_t* q; bf16_t* v; bf16_t* kf; bf16_t* kb; bf16_t* sg; const float* lb;
    const f32x2* SUM; const float* c1; const float* c2;
    __device__ __forceinline__ void stage(PG8_LAS unsigned char* slot, const Unit& u, int tid, int wid) const {
        asm volatile("" : "+v"(tid));
        const int c = tid, t = u.pn >> 2;
        const void* src = c < 64 ? (const void*)(c1 + u.pn * BM + c * 4) : c < 128 ? (const void*)(c2 + u.pn * BM + (c - 64) * 4)
                        : c < 192 ? (const void*)(lb + ((t == 3) ? 1024 : 0) + (u.pn & 3) * BM + (c - 128) * 4) : (const void*)(SUM + u.pm * BM + (c - 192) * 2);
        if (c < 320) glds16(src, slot + wid * 1024);
    }
    __device__ __forceinline__ void operator()(const f32x4 (&acc)[2][2][4][2], const Unit& u, int wr, int wc, int fr, int fq, PG8_LAS unsigned char* slot) const {
        const int t = u.pn >> 2, col0 = (u.pn & 3) * BM + wc * 32 + 8 * fq, lc0 = wc * 32 + 8 * fq;
        bf16_t* dst = t == 0 ? q : t == 1 ? v : t == 2 ? kf : t == 3 ? kb : sg;
#pragma unroll
        for (int bj = 0; bj < 2; ++bj) { const int c = col0 + bj * HALF, lc = lc0 + bj * HALF;
            f32x4 om0 = {1.f, 1.f, 1.f, 1.f}, om1 = om0;
            if (t == 2 || t == 3) { om0 = 1.0f - *(const PG8_LAS f32x4*)(slot + 2048 + lc * 4); om1 = 1.0f - *(const PG8_LAS f32x4*)(slot + 2048 + lc * 4 + 16); }
            const f32x4 k10 = *(const PG8_LAS f32x4*)(slot + lc * 4), k11 = *(const PG8_LAS f32x4*)(slot + lc * 4 + 16), k20 = *(const PG8_LAS f32x4*)(slot + 1024 + lc * 4), k21 = *(const PG8_LAS f32x4*)(slot + 1024 + lc * 4 + 16);
#pragma unroll
            for (int ai = 0; ai < 2; ++ai)
#pragma unroll
                for (int m = 0; m < 4; ++m) { const int lr = ai * HALF + wr * 64 + m * 16 + fr, row = u.pm * BM + lr; const bool pad = (row % LP) < PADR;
                    float mean, rstd; mean_rstd(*(const PG8_LAS f32x2*)(slot + (wr * 64 + fr) * 8 + (3072 + (ai * HALF + m * 16) * 8)), mean, rstd);
                    f32x4 v0 = (acc[ai][bj][m][0] - k10 * mean) * rstd + k20, v1 = (acc[ai][bj][m][1] - k11 * mean) * rstd + k21;
                    if (pad) { v0 = (f32x4){0.f, 0.f, 0.f, 0.f}; v1 = v0; }
                    if (t == 2 || t == 3) {
#pragma unroll
                        for (int j = 0; j < 4; ++j) { v0[j] = pad ? 0.f : om0[j] * __builtin_amdgcn_rcpf(1.0f + __builtin_amdgcn_exp2f(v0[j] * 1.4426950408889634f));
                                                      v1[j] = pad ? 0.f : om1[j] * __builtin_amdgcn_rcpf(1.0f + __builtin_amdgcn_exp2f(v1[j] * 1.4426950408889634f)); }
                    } else if (t == 4) {
#pragma unroll
                        for (int j = 0; j < 4; ++j) { v0[j] = v0[j] * __builtin_amdgcn_rcpf(1.0f + __builtin_amdgcn_exp2f(v0[j] * -1.4426950408889634f));
                                                      v1[j] = v1[j] * __builtin_amdgcn_rcpf(1.0f + __builtin_amdgcn_exp2f(v1[j] * -1.4426950408889634f)); }
                    }
                    *(u32x4*)(dst + (size_t)row * 1024 + c) = pack8(v0, v1); } }
    }
};
struct EpiConvGate {
    static constexpr bool PERM = true, AFTER_DRAIN = false, STAGED = true;
    bf16_t* act; const float* cw; const float* cb;
    const f32x2* SUM; const float* c1; const float* c2;
    static __device__ __forceinline__ float dpp_mirror(float x) { return __builtin_bit_cast(float, __builtin_amdgcn_update_dpp(0, __builtin_bit_cast(int, x), 0x140, 0xf, 0xf, false)); }
    static __device__ __forceinline__ float dpp_prev(float old, float x) { return __builtin_bit_cast(float, __builtin_amdgcn_update_dpp(__builtin_bit_cast(int, old), __builtin_bit_cast(int, x), 0x111, 0xf, 0xf, false)); }
    static __device__ __forceinline__ float dpp_next(float old, float x) { return __builtin_bit_cast(float, __builtin_amdgcn_update_dpp(__builtin_bit_cast(int, old), __builtin_bit_cast(int, x), 0x101, 0xf, 0xf, false)); }
    __device__ __forceinline__ void stage(PG8_LAS unsigned char* slot, const Unit& u, int tid, int wid) const {
        asm volatile("" : "+v"(tid));
        const int c = tid; const void* src;
        if (c < 384) { const int arr = c >> 5, off = (c & 31) * 4;
            src = arr < 3 ? (const void*)(cw + arr * NUP + 128 * u.pn + off) : arr == 3 ? (const void*)(cb + 128 * u.pn + off) : arr < 7 ? (const void*)(cw + (arr - 4) * NUP + DFF + 128 * u.pn + off)
                : arr == 7 ? (const void*)(cb + DFF + 128 * u.pn + off) : arr == 8 ? (const void*)(c1 + 256 * u.pn + off) : arr == 9 ? (const void*)(c1 + 256 * u.pn + 128 + off)
                : arr == 10 ? (const void*)(c2 + 256 * u.pn + off) : (const void*)(c2 + 256 * u.pn + 128 + off);
        } else { const int i = 2 * (c - 384); src = (const void*)(SUM + (62 * (4 * u.pm + (i >> 6)) - 1 + (i & 63))); }
        glds16(src, slot + wid * 1024);
    }
    __device__ __forceinline__ void operator()(const f32x4 (&acc)[2][2][4][2], const Unit& u, int wr, int wc, int fr, int fq, PG8_LAS unsigned char* slot) const {
        const int cv0 = 128 * u.pn + 32 * wc + 8 * fq;
        float mean[2][4], rstd[2][4];
#pragma unroll
        for (int ai = 0; ai < 2; ++ai)
#pragma unroll
            for (int m = 0; m < 4; ++m) { const int arow = 62 * (4 * u.pm + 2 * ai + wr) - 1 + 16 * m + fr; const bool ok = arow >= 0 && arow < M && (arow % LP) >= PADR;
                mean_rstd(*(const PG8_LAS f32x2*)(slot + (64 * wr + fr) * 8 + (6144 + (128 * ai + 16 * m) * 8)), mean[ai][m], rstd[ai][m]); if (!ok) { rstd[ai][m] = 0.f; mean[ai][m] = 0.f; } }
#pragma unroll
        for (int n = 0; n < 2; ++n) { const int cv = cv0 + 4 * n;
            const int lc = (32 * wc + 8 * fq + 4 * n) * 4;
            const f32x4 k1v = *(const PG8_LAS f32x4*)(slot + 8 * 512 + lc), k1g = *(const PG8_LAS f32x4*)(slot + 9 * 512 + lc), k2v = *(const PG8_LAS f32x4*)(slot + 10 * 512 + lc), k2g = *(const PG8_LAS f32x4*)(slot + 11 * 512 + lc);
            const f32x4 wv0 = *(const PG8_LAS f32x4*)(slot + 0 * 512 + lc), wv1 = *(const PG8_LAS f32x4*)(slot + 1 * 512 + lc), wv2 = *(const PG8_LAS f32x4*)(slot + 2 * 512 + lc), bv = *(const PG8_LAS f32x4*)(slot + 3 * 512 + lc);
            const f32x4 wg0 = *(const PG8_LAS f32x4*)(slot + 4 * 512 + lc), wg1 = *(const PG8_LAS f32x4*)(slot + 5 * 512 + lc), wg2 = *(const PG8_LAS f32x4*)(slot + 6 * 512 + lc), bg = *(const PG8_LAS f32x4*)(slot + 7 * 512 + lc);
#pragma unroll
            for (int ai = 0; ai < 2; ++ai) { const int J = 4 * u.pm + 2 * ai + wr;
                f32x4 o[4];
#pragma unroll
                for (int j = 0; j < 4; ++j) {
                    float uv[4], ug[4], mv[4], mg[4];
#pragma unroll
                    for (int m = 0; m < 4; ++m) { const bool okr = rstd[ai][m] != 0.f; uv[m] = (acc[ai][0][m][n][j] - k1v[j] * mean[ai][m]) * rstd[ai][m] + (okr ? k2v[j] : 0.f); ug[m] = (acc[ai][1][m][n][j] - k1g[j] * mean[ai][m]) * rstd[ai][m] + (okr ? k2g[j] : 0.f);
                                                  mv[m] = dpp_mirror(uv[m]); mg[m] = dpp_mirror(ug[m]); }
#pragma unroll
                    for (int m = 0; m < 4; ++m) {
                        const float pv = dpp_prev(m == 0 ? 0.f : mv[m - 1], uv[m]), nv = dpp_next(m == 3 ? 0.f : mv[m + 1], uv[m]);
                        const float pg = dpp_prev(m == 0 ? 0.f : mg[m - 1], ug[m]), ng = dpp_next(m == 3 ? 0.f : mg[m + 1], ug[m]);
                        const float val = wv0[j] * pv + wv1[j] * uv[m] + wv2[j] * nv + bv[j];
                        const float gat = wg0[j] * pg + wg1[j] * ug[m] + wg2[j] * ng + bg[j];
                        o[m][j] = val * gat * __builtin_amdgcn_rcpf(1.0f + __builtin_amdgcn_exp2f(gat * -1.4426950408889634f)); }
                    asm volatile("" : "+v"(o[0][j]), "+v"(o[1][j]), "+v"(o[2][j]), "+v"(o[3][j])); }
#pragma unroll
                for (int m = 0; m < 4; ++m) { const int R64 = 16 * m + fr; const int rowo = 62 * J - 1 + R64;
                    if (R64 >= 1 && R64 <= 62 && rowo < M) { u32x2 w; w.x = cvt_pk_bf16(o[m][0], o[m][1]); w.y = cvt_pk_bf16(o[m][2], o[m][3]); *(u32x2*)(act + (size_t)rowo * DFF + cv) = w; } }
                asm volatile("" ::: "memory"); } }
    }
};
struct EpiNull {
    static constexpr bool PERM = true, AFTER_DRAIN = false, STAGED = false;
    float* sink;
    __device__ __forceinline__ void operator()(const f32x4 (&acc)[2][2][4][2], const Unit& u, int wr, int wc, int fr, int fq, PG8_LAS unsigned char*) const {
        float s = 0.f;
#pragma unroll
        for (int ai = 0; ai < 2; ++ai)
#pragma unroll
            for (int bj = 0; bj < 2; ++bj)
#pragma unroll
                for (int m = 0; m < 4; ++m)
#pragma unroll
                    for (int n = 0; n < 2; ++n) s += acc[ai][bj][m][n][0] + acc[ai][bj][m][n][1] + acc[ai][bj][m][n][2] + acc[ai][bj][m][n][3];
        if (s == 1.2345e33f) sink[0] = s;
    }
};
template <class Epi, class Sched, bool ALIGN_EPI = false, bool SP2 = false, bool SHIFT = false>
__device__ __forceinline__ void gemm_phase(PG8_LAS unsigned char* lds, const Gemm g, const Sched& S, const Epi& E) {
    const int tid = threadIdx.x, wid = __builtin_amdgcn_readfirstlane(tid >> 6), lane = tid & 63, wr = wid >> 2, wc = wid & 3, fr = lane & 15, fq = lane >> 4;
    const int K = g.K, nt = K / BK;
    unsigned voffA[2], voffB[2];
#pragma unroll
    for (int i = 0; i < 2; ++i) { int R, C; stage_rc(tid * 16 + i * 8192, R, C); const int Rb = Epi::PERM ? ((R & ~31) + perm32(R & 31)) : R;
        const int Ra = SHIFT ? (R - 2 * (R >> 6)) : R; voffA[i] = (unsigned)(Ra * g.lda + C) * 2u; voffB[i] = (unsigned)(Rb * g.ldb + C) * 2u; }
    const size_t kstep = (size_t)(BK * 2);
    const size_t hstepA = (size_t)(SHIFT ? 124 : HALF) * g.lda * 2, hstepB = (size_t)HALF * g.ldb * 2;
    const size_t tstepA = 2 * hstepA, tstepB = 2 * hstepB;
    const unsigned ldsw = (unsigned)wid * 1024u;
    const int aoff = lds_byte(wr * 64 + fr, fq * 8), boff = lds_byte(wc * 32 + fr, fq * 8);
#define PG8_SA(b, h) (((b) * 2 + (h)) * HTB)
#define PG8_SB(b, h) ((4 + (b) * 2 + (h)) * HTB)
#define PG8_STAGE(bufoff, gbase, voff) do { _Pragma("unroll") for (int _i = 0; _i < 2; ++_i) \
        __builtin_amdgcn_global_load_lds((const unsigned*)((const char*)(gbase) + (voff)[_i]), (PG8_LAS unsigned*)(lds + (bufoff) + ldsw + _i * 8192), 16, 0, 0); } while (0)
#define PG8_LDA(dst, b, h) do { _Pragma("unroll") for (int m = 0; m < 4; ++m) _Pragma("unroll") for (int k = 0; k < 2; ++k) dst[m][k] = *(const PG8_LAS bf16x8*)(lds + PG8_SA(b, h) + aoff + m * 2048 + k * 1024); } while (0)
#define PG8_LDB(dst, b, h) do { _Pragma("unroll") for (int n = 0; n < 2; ++n) _Pragma("unroll") for (int k = 0; k < 2; ++k) dst[n][k] = *(const PG8_LAS bf16x8*)(lds + PG8_SB(b, h) + boff + n * 2048 + k * 1024); } while (0)
#define PG8_MMA(ai, bj, At, Bt) do { __builtin_amdgcn_s_setprio(1); _Pragma("unroll") for (int m = 0; m < 4; ++m) _Pragma("unroll") for (int n = 0; n < 2; ++n) _Pragma("unroll") for (int k = 0; k < 2; ++k) \
        acc[ai][bj][m][n] = __builtin_amdgcn_mfma_f32_16x16x32_bf16(Bt[n][k], At[m][k], acc[ai][bj][m][n], 0, 0, 0); __builtin_amdgcn_s_setprio(0); } while (0)
#define PG8_WAIT_V(n) asm volatile("s_waitcnt vmcnt(" #n ")" ::: "memory")
#define PG8_WAIT_L(n) asm volatile("s_waitcnt lgkmcnt(" #n ")" ::: "memory")
#define PG8_BAR __builtin_amdgcn_s_barrier()
#define PG8_SCHED __builtin_amdgcn_sched_barrier(0)
    Unit cur, nxt; int ui = 0;
    if (!S.next(0, cur)) return;
    f32x4 acc[2][2][4][2];
#pragma unroll
    for (int a = 0; a < 2; ++a)
#pragma unroll
        for (int b = 0; b < 2; ++b)
#pragma unroll
            for (int m = 0; m < 4; ++m)
#pragma unroll
                for (int n = 0; n < 2; ++n) acc[a][b][m][n] = (f32x4){0.f, 0.f, 0.f, 0.f};
    bf16x8 At[4][2], B0[2][2], B1[2][2];
    const char* cA = (const char*)g.A + (size_t)cur.pm * tstepA; const char* cB = (const char*)g.Bt + (size_t)cur.pn * tstepB;
    S.a_ready(cur);
    if constexpr (SP2) {
        PG8_STAGE(PG8_SB(0, 0), cB, voffB); PG8_STAGE(PG8_SB(0, 1), cB + hstepB, voffB); PG8_STAGE(PG8_SA(0, 0), cA, voffA); PG8_STAGE(PG8_SA(0, 1), cA + hstepA, voffA);
        if (wr == 1) PG8_BAR;
        PG8_WAIT_V(2); PG8_BAR;
        PG8_STAGE(PG8_SB(1, 0), cB + kstep, voffB); PG8_STAGE(PG8_SA(1, 0), cA + kstep, voffA); PG8_STAGE(PG8_SB(1, 1), cB + hstepB + kstep, voffB);
        PG8_WAIT_V(6); PG8_BAR;
    } else {
        PG8_STAGE(PG8_SB(0, 0), cB, voffB); PG8_STAGE(PG8_SA(0, 0), cA, voffA); PG8_STAGE(PG8_SB(0, 1), cB + hstepB, voffB); PG8_STAGE(PG8_SA(0, 1), cA + hstepA, voffA);
        if (wr == 1) PG8_BAR;
        PG8_WAIT_V(4); PG8_BAR;
        PG8_STAGE(PG8_SB(1, 0), cB + kstep, voffB); PG8_STAGE(PG8_SA(1, 0), cA + kstep, voffA); PG8_STAGE(PG8_SB(1, 1), cB + hstepB + kstep, voffB);
        PG8_WAIT_V(6); PG8_BAR;
    }
    for (;;) {
        if constexpr (Epi::STAGED) E.stage(lds + STAGE_BYTES + (ui & 1) * 8192, cur, tid, wid);
        const bool has_next = S.next(ui + 1, nxt);
        const char* nA = has_next ? (const char*)g.A + (size_t)nxt.pm * tstepA : cA; const char* nB = has_next ? (const char*)g.Bt + (size_t)nxt.pn * tstepB : cB;
        for (int t = 0; t < nt; t += 2) {
            const bool last = (t == nt - 2);
            const char* a1 = cA + (size_t)(t + 1) * kstep;
            const char* a2 = last ? nA : cA + (size_t)(t + 2) * kstep; const char* b2 = last ? nB : cB + (size_t)(t + 2) * kstep;
            const char* a3 = a2 + kstep; const char* b3 = b2 + kstep;
            if (last && has_next) S.a_ready(nxt);
            if constexpr (SP2) {
            PG8_LDB(B0, 0, 0); PG8_LDB(B1, 0, 1); PG8_SCHED; PG8_LDA(At, 0, 0); PG8_STAGE(PG8_SA(1, 1), a1 + hstepA, voffA);
            PG8_WAIT_V(8); PG8_WAIT_L(0); PG8_BAR; PG8_MMA(0, 0, At, B0); PG8_MMA(0, 1, At, B1); PG8_BAR; PG8_SCHED;
            PG8_LDA(At, 0, 1); PG8_STAGE(PG8_SB(0, 0), b2, voffB); PG8_STAGE(PG8_SB(0, 1), b2 + hstepB, voffB); PG8_STAGE(PG8_SA(0, 0), a2, voffA);
            PG8_WAIT_V(8); PG8_WAIT_L(0); PG8_BAR; PG8_MMA(1, 0, At, B0); PG8_MMA(1, 1, At, B1); PG8_BAR; PG8_SCHED;
            PG8_LDB(B0, 1, 0); PG8_LDB(B1, 1, 1); PG8_SCHED; PG8_LDA(At, 1, 0); PG8_STAGE(PG8_SA(0, 1), a2 + hstepA, voffA);
            PG8_WAIT_V(8); PG8_WAIT_L(0); PG8_BAR; PG8_MMA(0, 0, At, B0); PG8_MMA(0, 1, At, B1); PG8_BAR; PG8_SCHED;
            PG8_LDA(At, 1, 1); PG8_STAGE(PG8_SB(1, 0), b3, voffB); PG8_STAGE(PG8_SB(1, 1), b3 + hstepB, voffB); PG8_STAGE(PG8_SA(1, 0), a3, voffA);
            PG8_WAIT_V(8); PG8_WAIT_L(0); PG8_BAR; PG8_MMA(1, 0, At, B0); PG8_MMA(1, 1, At, B1); PG8_BAR; PG8_SCHED;
            } else {
            PG8_LDB(B0, 0, 0); PG8_SCHED; PG8_LDA(At, 0, 0); PG8_STAGE(PG8_SA(1, 1), a1 + hstepA, voffA);
            PG8_WAIT_L(8); PG8_BAR; PG8_WAIT_L(0); PG8_MMA(0, 0, At, B0); PG8_BAR; PG8_SCHED;
            PG8_LDB(B1, 0, 1); PG8_STAGE(PG8_SB(0, 0), b2, voffB);
            PG8_BAR; PG8_WAIT_L(0); PG8_MMA(0, 1, At, B1); PG8_BAR;
            PG8_LDA(At, 0, 1); PG8_STAGE(PG8_SA(0, 0), a2, voffA);
            PG8_BAR; PG8_WAIT_L(0); PG8_MMA(1, 0, At, B0); PG8_BAR; PG8_SCHED;
            PG8_STAGE(PG8_SB(0, 1), b2 + hstepB, voffB);
            PG8_WAIT_V(6); PG8_BAR; PG8_MMA(1, 1, At, B1); PG8_BAR;
            PG8_LDB(B0, 1, 0); PG8_SCHED; PG8_LDA(At, 1, 0); PG8_STAGE(PG8_SA(0, 1), a2 + hstepA, voffA);
            PG8_WAIT_L(8); PG8_BAR; PG8_WAIT_L(0); PG8_MMA(0, 0, At, B0); PG8_BAR; PG8_SCHED;
            PG8_LDB(B1, 1, 1); PG8_STAGE(PG8_SB(1, 0), b3, voffB);
            PG8_BAR; PG8_WAIT_L(0); PG8_MMA(0, 1, At, B1); PG8_BAR;
            PG8_LDA(At, 1, 1); PG8_STAGE(PG8_SA(1, 0), a3, voffA);
            PG8_BAR; PG8_WAIT_L(0); PG8_MMA(1, 0, At, B0); PG8_BAR; PG8_SCHED;
            PG8_STAGE(PG8_SB(1, 1), b3 + hstepB, voffB);
            PG8_WAIT_V(6); PG8_BAR; PG8_MMA(1, 1, At, B1); PG8_BAR;
            }
        }
        if constexpr (ALIGN_EPI) { if (wr == 0) PG8_BAR; }
        if constexpr (!Epi::AFTER_DRAIN) { E(acc, cur, wr, wc, fr, fq, lds + STAGE_BYTES + (ui & 1) * 8192); S.done(cur); }
        if (!has_next) break;
#pragma unroll
        for (int a = 0; a < 2; ++a)
#pragma unroll
            for (int b = 0; b < 2; ++b)
#pragma unroll
                for (int m = 0; m < 4; ++m)
#pragma unroll
                    for (int n = 0; n < 2; ++n) acc[a][b][m][n] = (f32x4){0.f, 0.f, 0.f, 0.f};
        cur = nxt; cA = nA; cB = nB; ++ui;
        if constexpr (ALIGN_EPI) { if (wr == 1) PG8_BAR; }
    }
    PG8_WAIT_V(0);
    if constexpr (!ALIGN_EPI) { if (wr == 0) PG8_BAR; }
    PG8_BAR;
    if constexpr (Epi::AFTER_DRAIN) { E.fused(acc, cur, wr, wc, fr, fq, lds, wid, lane); S.done(cur); }
#undef PG8_SA
#undef PG8_SB
#undef PG8_STAGE
#undef PG8_LDA
#undef PG8_LDB
#undef PG8_MMA
#undef PG8_WAIT_V
#undef PG8_WAIT_L
#undef PG8_BAR
#undef PG8_SCHED
}
}
#define GAS __attribute__((address_space(1)))
#define LAS __attribute__((address_space(3)))
typedef unsigned short bf16;
typedef unsigned v4u __attribute__((ext_vector_type(4)));
typedef unsigned v2u __attribute__((ext_vector_type(2)));
typedef float f32x4 __attribute__((ext_vector_type(4)));
typedef float f32x2 __attribute__((ext_vector_type(2)));
typedef GAS unsigned gu32;
using pg8::cvt_pk_bf16; using pg8::bf_lo; using pg8::bf_hi;

constexpr size_t MiB = 1u << 20;
constexpr size_t WS_CTL = 0, CTL_ZERO_BYTES = 64 * 1024;
constexpr size_t WS_ROPE = 1 * MiB;
constexpr size_t WS_LB = WS_ROPE + 640 * 1024;
constexpr size_t WS_C12 = WS_LB + 16 * 1024;
constexpr size_t C1_UP0 = WS_C12, C2_UP0 = C1_UP0 + 5632 * 4, C1_HG = C2_UP0 + 5632 * 4, C2_HG = C1_HG + 5120 * 4, C1_UP1 = C2_HG + 5120 * 4, C2_UP1 = C1_UP1 + 5632 * 4;
static_assert(C2_UP1 + 5632 * 4 <= 2 * MiB, "small tables");
constexpr size_t WS_W = 2 * MiB;
constexpr size_t W_IN = WS_W, W_UQ = W_IN + 1280ull * 1024 * 2, W_UKV = W_UQ + 1536ull * 768 * 2, W_O = W_UKV + 2048ull * 256 * 2, W_HIN = W_O + 1024ull * 1024 * 2,
                 W_HO = W_HIN + 5120ull * 1024 * 2, W_UP0 = W_HO + 1024ull * 1024 * 2, W_UP1 = W_UP0 + 5632ull * 1024 * 2, W_DN0 = W_UP1 + 5632ull * 1024 * 2, W_DN1 = W_DN0 + 1024ull * 2816 * 2,
                 W_END = W_DN1 + 1024ull * 2816 * 2;
static_assert(W_END <= 55 * MiB, "weights");
constexpr int SLACK = 256;
constexpr size_t ROWB = 2048;
constexpr size_t WS_B0 = 55 * MiB, B0_BYTES = (size_t)(M + 2 * SLACK) * ROWB;
static_assert(B0_BYTES <= 164 * MiB, "B0");
constexpr size_t WS_R = 219 * MiB;
constexpr size_t R_CQKV = WS_R;
constexpr size_t R_Q = R_CQKV + 164 * MiB;
constexpr size_t R_KV = R_Q + 245 * MiB;
constexpr size_t R_KROPE = R_KV + 326 * MiB;
constexpr size_t R_SSQ = R_KROPE + 6 * MiB;
constexpr size_t R_X_L0 = R_Q;
constexpr size_t R_ACT = WS_R;
constexpr size_t R_X_FFN = WS_R + 448 * MiB;
constexpr size_t R_HV = WS_R, R_HKF = WS_R + 163 * MiB, R_HKB = WS_R + 326 * MiB, R_HSG = WS_R + 489 * MiB;
constexpr size_t R_X_HG = WS_R;
constexpr size_t R_XB3 = R_HSG + (size_t)SLACK * ROWB;
constexpr size_t SUM_ROWS = (size_t)M + 2 * SLACK, SUM_BYTES = SUM_ROWS * 8;
constexpr size_t WS_SUM1 = WS_R + 773 * MiB, WS_SUM2 = WS_SUM1 + SUM_BYTES, WS_SUM3 = WS_SUM2 + SUM_BYTES;
constexpr size_t WS_END = 1024 * MiB;
static_assert(SUM_BYTES % 256 == 0 && WS_SUM3 + SUM_BYTES <= WS_END && R_XB3 + (size_t)(M + SLACK) * ROWB <= WS_SUM1 && R_KV + 326 * MiB + 12 * MiB <= WS_SUM1 && R_ACT + 448 * MiB <= R_HSG, "d_ws map 3");
static_assert(R_SSQ + (size_t)M * 16 * 4 <= WS_END && R_X_FFN + (size_t)M * 4096 <= WS_END && R_HSG + (size_t)M * ROWB <= WS_END, "d_ws map");
static_assert((size_t)M * 1536 * 2 + 64 * 3072 <= 245 * MiB && (size_t)M * 4096 + 64 * 4096 <= 326 * MiB && (size_t)M * DFF * 2 <= 448 * MiB && (size_t)M * ROWB <= 163 * MiB, "d_ws map 2");

constexpr int RING_OFF = 0, RING_BYTES = 131072;
constexpr int EPI_OFF = RING_BYTES, EPI_SLOT = 8192;
constexpr int LDSCTL_OFF = 147456, MISC_OFF = LDSCTL_OFF + 320;
constexpr int LDS_BYTES = 148480;
constexpr int NWAVES = 8;

#define RLX_AGENT __ATOMIC_RELAXED, __HIP_MEMORY_SCOPE_AGENT
#define XB_TMO      128
#define XB_XCNT(j)  (256  + 64 * (j))
#define XB_XSUB(j)  (1280 + 64 * (j))
#define XB_XGEN(j)  (2304 + 64 * (j))
#define XB_TOP      3328
#define XB_TOPGEN   3392
#define XCD_BAR_WORDS 3456
#define XB_SPIN_CAP (1u << 18)

__device__ __forceinline__ unsigned xb_ld(unsigned* p)              { return __hip_atomic_load(p, __ATOMIC_RELAXED, __HIP_MEMORY_SCOPE_AGENT); }
__device__ __forceinline__ unsigned xb_add(unsigned* p, unsigned v) { return __hip_atomic_fetch_add(p, v, __ATOMIC_RELAXED, __HIP_MEMORY_SCOPE_AGENT); }
__device__ __forceinline__ unsigned xb_xcc_id() { return (unsigned)__builtin_amdgcn_s_getreg((3 << 11) | 20) & 0xFu; }
#define XB_SPIN(cond, bar) do { unsigned _sp = 0; while (cond) { __builtin_amdgcn_s_sleep(1); \
    if ((++_sp & 255u) == 0u) { if (xb_ld(&(bar)[XB_TMO])) break; if (_sp > XB_SPIN_CAP) { atomicAdd(&(bar)[XB_TMO], 1u); break; } } } } while (0)

struct XcdBarrier {
    unsigned* bar; unsigned x;
    volatile LAS unsigned* st;
};

__device__ __forceinline__ XcdBarrier xcd_barrier_post(unsigned* bar, volatile LAS unsigned* st) {
    XcdBarrier b; b.bar = bar; b.x = xb_xcc_id(); b.st = st;
    if (threadIdx.x == 0) (void)xb_add(&bar[XB_XCNT(b.x)], 1u);
    return b;
}
__device__ __forceinline__ void xcd_barrier_complete(unsigned* bar, unsigned x, unsigned& nloc, unsigned& nx) {
    const unsigned G = gridDim.x * gridDim.y * gridDim.z;
    unsigned sum, cnt, mine, sp = 0u;
    for (;;) {
        sum = 0u; cnt = 0u; mine = 0u;
#pragma unroll
        for (unsigned j = 0; j < 16; ++j) { const unsigned c = xb_ld(&bar[XB_XCNT(j)]); sum += c; cnt += (c > 0u) ? 1u : 0u; mine = (j == x) ? c : mine; }
        if (sum == G) break;
        __builtin_amdgcn_s_sleep(1);
        if ((++sp & 255u) == 0u) { if (xb_ld(&bar[XB_TMO])) break; if (sp > XB_SPIN_CAP) { atomicAdd(&bar[XB_TMO], 1u); break; } }
    }
    nloc = mine > 0u ? mine : 1u; nx = cnt > 0u ? cnt : 1u;
}

__device__ __forceinline__ void xcd_barrier(const XcdBarrier& b) {
    asm volatile("s_waitcnt vmcnt(0)" ::: "memory");
    __syncthreads();
    if (threadIdx.x == 0) {
        unsigned* bar = b.bar;
        __builtin_amdgcn_s_waitcnt(0);
        unsigned nloc = b.st[0], nx = b.st[1];
        if (nloc == 0u) { xcd_barrier_complete(bar, b.x, nloc, nx); b.st[0] = nloc; b.st[1] = nx; }
        const unsigned old = xb_add(&bar[XB_XSUB(b.x)], 1u);
        const unsigned gen = old / nloc;
        if (old + 1u == (gen + 1u) * nloc) {
            __builtin_amdgcn_fence(__ATOMIC_RELEASE, "agent");
            asm volatile("s_waitcnt vmcnt(0)" ::: "memory");
            const unsigned og = xb_add(&bar[XB_TOP], 1u);
            const unsigned tg = og / nx;
            if (og + 1u == (tg + 1u) * nx) xb_add(&bar[XB_TOPGEN], 1u);
            else XB_SPIN(xb_ld(&bar[XB_TOPGEN]) == tg, bar);
            __builtin_amdgcn_fence(__ATOMIC_ACQUIRE, "agent");
            xb_add(&bar[XB_XGEN(b.x)], 1u);
            asm volatile("s_waitcnt vmcnt(0)" ::: "memory");
        } else {
            XB_SPIN(xb_ld(&bar[XB_XGEN(b.x)]) == gen, bar);
            __builtin_amdgcn_fence(__ATOMIC_ACQUIRE, "agent");
            asm volatile("s_waitcnt vmcnt(0)" ::: "memory");
        }
    }
    __syncthreads();
}

struct Frame {
    LAS unsigned char* lds;
    volatile LAS unsigned* MISC;
    int tid, lane, wave;
    int vcu, G;
};
__device__ __forceinline__ float wave_sum(float v) {
#pragma unroll
    for (int o = 1; o < 64; o <<= 1) v += __shfl_xor(v, o);
    return v;
}
__device__ __forceinline__ unsigned f2bf(float f) { unsigned u = __builtin_bit_cast(unsigned, f); return (u + 0x7fffu + ((u >> 16) & 1u)) >> 16; }
__device__ __forceinline__ unsigned pk2(float lo, float hi) { return f2bf(lo) | (f2bf(hi) << 16); }

__device__ __forceinline__ int src_col(int kind, int n) {
    if (kind == 1) { if (n < 1024) return n; if (n >= 1056) return -1; const int e = n - 1024; return 1024 + ((e & 1) ? 16 + (e >> 1) : (e >> 1)); }
    if (kind == 2) { const int hd = n / 96, d = n % 96; if (d < 64) return n; const int e = d - 64; return hd * 96 + 64 + ((e & 1) ? 16 + (e >> 1) : (e >> 1)); }
    if (kind == 3) { const int pn = n >> 8, r = n & 255; return r < 128 ? 128 * pn + r : DFF + 128 * pn + (r - 128); }
    return n;
}
__device__ __forceinline__ void p0_transpose_item(const float* W, int K, int N, bf16* WT, int kind, const float* gain, LAS float* scr, int item, int lane, int NP) {
    const int nblk = NP / 32, kb = item / nblk, nb = item % nblk, k0 = 64 * kb, n0 = 32 * nb;
    const int sc = src_col(kind, n0 + (lane & 31));
#pragma unroll 8
    for (int i = 0; i < 32; ++i) { const int kk = 2 * i + (lane >> 5); float v = sc >= 0 ? W[(size_t)(k0 + kk) * N + sc] : 0.f; if (gain) v *= gain[k0 + kk]; scr[kk * 33 + (lane & 31)] = v; }
    asm volatile("s_waitcnt lgkmcnt(0)" ::: "memory");
    const int c = lane & 7;
#pragma unroll
    for (int j = 0; j < 4; ++j) { const int n = (lane >> 3) + 8 * j; const LAS float* s = scr + (8 * c) * 33 + n;
        v4u o; o.x = pk2(s[0 * 33], s[1 * 33]); o.y = pk2(s[2 * 33], s[3 * 33]); o.z = pk2(s[4 * 33], s[5 * 33]); o.w = pk2(s[6 * 33], s[7 * 33]);
        *(GAS v4u*)(WT + (size_t)(n0 + n) * K + k0 + 8 * c) = o; }
    asm volatile("s_waitcnt lgkmcnt(0)" ::: "memory");
}
__device__ __forceinline__ void wjob(Frame& F, const float* W, bf16* WT, const float* gain, int K, int N, int NP, int kind, int widx, int nwg) {
    LAS float* scr = (LAS float*)(F.lds + RING_OFF + F.wave * 16384);
    const int nitems = (K / 64) * (NP / 32);
    for (int it = widx * NWAVES + F.wave; it < nitems; it += nwg * NWAVES) p0_transpose_item(W, K, N, WT, kind, gain, scr, it, F.lane, NP);
}
__device__ __forceinline__ void c12job(Frame& F, const float* const* in, unsigned char* ws, int which, int widx, int nwg) {
    const float* W = which == 0 ? in[13] : which == 1 ? in[9] : in[13] + (size_t)1024 * NUP; const int N = which == 1 ? 5120 : NUP;
    const float* gn = in[17] + (which == 0 ? 0 : which == 1 ? 1024 : 2048); const float* bs = in[18] + (which == 0 ? 0 : which == 1 ? 1024 : 2048);
    float* c1 = (float*)(ws + (which == 0 ? C1_UP0 : which == 1 ? C1_HG : C1_UP1)); float* c2 = (float*)(ws + (which == 0 ? C2_UP0 : which == 1 ? C2_HG : C2_UP1));
    LAS float* red = (LAS float*)(F.lds + RING_OFF + 12288);
    for (int cb = widx; cb < N / 64; cb += nwg) { const int n = cb * 64 + F.lane; const int sc = which == 1 ? n : src_col(3, n);
        float a1[4] = {0.f, 0.f, 0.f, 0.f}, a2[4] = {0.f, 0.f, 0.f, 0.f};
        for (int k = F.wave * 128; k < F.wave * 128 + 128; k += 4) {
#pragma unroll
            for (int i = 0; i < 4; ++i) { const float w = W[(size_t)(k + i) * N + sc]; a1[i] += __uint_as_float(f2bf(gn[k + i] * w) << 16); a2[i] += bs[k + i] * w; } }
        red[F.wave * 4096 + F.lane * 2] = (a1[0] + a1[1]) + (a1[2] + a1[3]); red[F.wave * 4096 + F.lane * 2 + 1] = (a2[0] + a2[1]) + (a2[2] + a2[3]);
        __syncthreads();
        if (F.wave == 0) { float s1 = 0.f, s2 = 0.f;
#pragma unroll
            for (int w = 0; w < 8; ++w) { s1 += red[w * 4096 + F.lane * 2]; s2 += red[w * 4096 + F.lane * 2 + 1]; }
            c1[n] = s1; c2[n] = s2; }
        __syncthreads(); }
}
__device__ __forceinline__ void tail_jobs_a(Frame& F, const float* const* in, unsigned char* ws, int widx, int nwg) {
    wjob(F, in[9], (bf16*)(ws + W_HIN), in[17] + 1024, 1024, 5120, 5120, 0, widx, nwg);
    wjob(F, in[12], (bf16*)(ws + W_HO), nullptr, 1024, 1024, 1024, 0, widx, nwg);
    c12job(F, in, ws, 1, widx, nwg);
}
__device__ __forceinline__ void tail_jobs_b(Frame& F, const float* const* in, unsigned char* ws, int widx, int nwg) {
    wjob(F, in[13] + (size_t)1024 * NUP, (bf16*)(ws + W_UP1), in[17] + 2048, 1024, NUP, NUP, 3, widx, nwg);
    wjob(F, in[16] + (size_t)DFF * 1024, (bf16*)(ws + W_DN1), nullptr, DFF, 1024, 1024, 0, widx, nwg);
    c12job(F, in, ws, 2, widx, nwg);
}
__device__ __forceinline__ void tail_jobs_0(Frame& F, const float* const* in, unsigned char* ws, int widx, int nwg) {
    wjob(F, in[13], (bf16*)(ws + W_UP0), in[17], 1024, NUP, NUP, 3, widx, nwg);
    wjob(F, in[16], (bf16*)(ws + W_DN0), nullptr, DFF, 1024, 1024, 0, widx, nwg);
    c12job(F, in, ws, 0, widx, nwg);
}
__device__ __forceinline__ void p0_prologue(Frame& F, const float* const* in, unsigned char* ws, bf16* h0) {
    const int gw = F.vcu * NWAVES + F.wave, NGW = F.G * NWAVES;
    wjob(F, in[3], (bf16*)(ws + W_IN), nullptr, 1024, 1056, 1280, 1, F.vcu, F.G);
    wjob(F, in[6], (bf16*)(ws + W_UQ), in[4], 768, 1536, 1536, 2, F.vcu, F.G);
    wjob(F, in[7], (bf16*)(ws + W_UKV), in[5], 256, 2048, 2048, 0, F.vcu, F.G);
    wjob(F, in[8], (bf16*)(ws + W_O), nullptr, 1024, 1024, 1024, 0, F.vcu, F.G);
    for (int row0 = gw; row0 < M; row0 += 4 * NGW) {
        f32x4 v[4][4];
#pragma unroll
        for (int u = 0; u < 4; ++u) { const int row = row0 + u * NGW; const int rc = row < M ? row : M - 1; const int b = rc / LP, s = rc % LP;
            const float* src = s < PADR ? in[2] : s < PADR + 16 ? in[2] + (size_t)(s - PADR) * 1024 : (b < 16 ? in[0] + ((size_t)b * SEQ + (s - 64)) * 1024 : in[1] + ((size_t)(b - 16) * SEQ + (s - 64)) * 1024);
            const GAS f32x4* xr = (const GAS f32x4*)src + F.lane;
#pragma unroll
            for (int j = 0; j < 4; ++j) v[u][j] = xr[64 * j]; }
#pragma unroll
        for (int u = 0; u < 4; ++u) { const int row = row0 + u * NGW; if (row >= M) continue; const int s = row % LP;
            GAS unsigned long long* o8 = (GAS unsigned long long*)(h0 + (size_t)row * 1024) + F.lane;
#pragma unroll
            for (int j = 0; j < 4; ++j) o8[64 * j] = s < PADR ? 0ull : ((unsigned long long)pk2(v[u][j].x, v[u][j].y) | ((unsigned long long)pk2(v[u][j].z, v[u][j].w) << 32)); }
    }
    { const int gt = gw * 64 + F.lane, NGT = NGW * 64; GAS v4u* z0 = (GAS v4u*)(ws + WS_B0); GAS v4u* z1 = (GAS v4u*)(ws + WS_B0 + (size_t)(SLACK + M) * ROWB);
      const int n16 = SLACK * (int)ROWB / 16;
      for (int i = gt; i < n16; i += NGT) { z0[i] = (v4u){0u, 0u, 0u, 0u}; z1[i] = (v4u){0u, 0u, 0u, 0u}; } }
    { const int gt = gw * 64 + F.lane, NGT = NGW * 64; GAS v4u* z = (GAS v4u*)(ws + WS_SUM1);
      for (int i = gt; i < (int)(3 * SUM_BYTES / 16); i += NGT) z[i] = (v4u){0u, 0u, 0u, 0u}; }
    { const int gt = gw * 64 + F.lane, NGT = NGW * 64; GAS v4u* z = (GAS v4u*)(ws + R_SSQ);
      for (int i = gt; i < M * 8 / 16; i += NGT) z[i] = (v4u){0u, 0u, 0u, 0u}; }
    { const int gt = gw * 64 + F.lane, NGT = NGW * 64; f32x2* tab = (f32x2*)(ws + WS_ROPE);
      for (int i = gt; i < LTOK * 16; i += NGT) { const int pos = i >> 4, k = i & 15;
          const float inv = 1.0f / powf(10000.0f, (float)(2 * k) / 32.0f); const float ang = (float)pos * inv;
          f32x2 cs; cs.x = (float)cos((double)ang); cs.y = (float)sin((double)ang); tab[i] = cs; } }
    { const int gt = gw * 64 + F.lane; float* lb = (float*)(ws + WS_LB);
      if (gt < 2048) { const int d = gt >> 10, k = gt & 1023; const float x0 = in[10][(size_t)(d * 2 + 0) * 1024 + k], x1 = in[10][(size_t)(d * 2 + 1) * 1024 + k];
          lb[gt] = 1.0f / (1.0f + expf(x0 - x1)); } }
}

template <bool FINAL> __device__ __forceinline__ void ln_pass(Frame& F, const float* X, const float* gain, const float* bias, bf16* hout, float* out) {
    const int gw = F.vcu * NWAVES + F.wave, NGW = F.G * NWAVES;
    f32x4 g[4], bb[4];
#pragma unroll
    for (int j = 0; j < 4; ++j) { g[j] = ((const f32x4*)gain)[64 * j + F.lane]; bb[j] = ((const f32x4*)bias)[64 * j + F.lane]; }
    for (int row0 = gw; row0 < M; row0 += 4 * NGW) {
        f32x4 v[4][4];
#pragma unroll
        for (int u = 0; u < 4; ++u) { const int row = row0 + u * NGW; const int rc = row < M ? row : M - 1; const GAS f32x4* xr = (const GAS f32x4*)(X + (size_t)rc * 1024) + F.lane;
#pragma unroll
            for (int j = 0; j < 4; ++j) v[u][j] = xr[64 * j]; }
#pragma unroll
        for (int u = 0; u < 4; ++u) { const int row = row0 + u * NGW; if (row >= M) continue;
            const int b = row / LP, s = row % LP;
            if (FINAL) { if (s < 64) continue; }
            else if (s < PADR) { GAS unsigned long long* o8 = (GAS unsigned long long*)(hout + (size_t)row * 1024) + F.lane;
#pragma unroll
                for (int j = 0; j < 4; ++j) o8[64 * j] = 0ull;
                continue; }
            float sm = 0.f;
#pragma unroll
            for (int j = 0; j < 4; ++j) sm += (v[u][j].x + v[u][j].y) + (v[u][j].z + v[u][j].w);
            const float mean = wave_sum(sm) * (1.f / 1024.f); float s2 = 0.f;
#pragma unroll
            for (int j = 0; j < 4; ++j) { v[u][j] = v[u][j] - mean; s2 += (v[u][j].x * v[u][j].x + v[u][j].y * v[u][j].y) + (v[u][j].z * v[u][j].z + v[u][j].w * v[u][j].w); }
            const float rstd = 1.f / sqrtf(wave_sum(s2) * (1.f / 1024.f) + EPS);
            if (FINAL) { GAS f32x4* o = (GAS f32x4*)(out + ((size_t)b * SEQ + (s - 64)) * 1024) + F.lane;
#pragma unroll
                for (int j = 0; j < 4; ++j) o[64 * j] = v[u][j] * rstd * g[j] + bb[j];
            } else { GAS unsigned long long* o8 = (GAS unsigned long long*)(hout + (size_t)row * 1024) + F.lane;
#pragma unroll
                for (int j = 0; j < 4; ++j) { const f32x4 y = v[u][j] * rstd * g[j] + bb[j]; o8[64 * j] = (unsigned long long)cvt_pk_bf16(y.x, y.y) | ((unsigned long long)cvt_pk_bf16(y.z, y.w) << 32); } }
        }
    }
}

__device__ __forceinline__ void ln_final(Frame& F, float* out, const float* gain, const float* bias) {
    const int gw = F.vcu * NWAVES + F.wave, NGW = F.G * NWAVES; constexpr int NR = NB * SEQ;
    f32x4 g[4], bb[4];
#pragma unroll
    for (int j = 0; j < 4; ++j) { g[j] = ((const f32x4*)gain)[64 * j + F.lane]; bb[j] = ((const f32x4*)bias)[64 * j + F.lane]; }
    for (int row0 = gw; row0 < NR; row0 += 4 * NGW) {
        f32x4 v[4][4];
#pragma unroll
        for (int u = 0; u < 4; ++u) { const int row = row0 + u * NGW; const int rc = row < NR ? row : NR - 1; const GAS f32x4* xr = (const GAS f32x4*)(out + (size_t)rc * 1024) + F.lane;
#pragma unroll
            for (int j = 0; j < 4; ++j) v[u][j] = xr[64 * j]; }
#pragma unroll
        for (int u = 0; u < 4; ++u) { const int row = row0 + u * NGW; if (row >= NR) continue;
            float sm = 0.f;
#pragma unroll
            for (int j = 0; j < 4; ++j) sm += (v[u][j].x + v[u][j].y) + (v[u][j].z + v[u][j].w);
            const float mean = wave_sum(sm) * (1.f / 1024.f); float s2 = 0.f;
#pragma unroll
            for (int j = 0; j < 4; ++j) { v[u][j] = v[u][j] - mean; s2 += (v[u][j].x * v[u][j].x + v[u][j].y * v[u][j].y) + (v[u][j].z * v[u][j].z + v[u][j].w * v[u][j].w); }
            const float rstd = 1.f / sqrtf(wave_sum(s2) * (1.f / 1024.f) + EPS);
            GAS f32x4* o = (GAS f32x4*)(out + (size_t)row * 1024) + F.lane;
#pragma unroll
            for (int j = 0; j < 4; ++j) o[64 * j] = v[u][j] * rstd * g[j] + bb[j]; }
    }
}
__device__ __forceinline__ void attn_simple(Frame& F, const bf16* Q, const bf16* KV, const bf16* KR, bf16* O) {
    LAS float* Ks = (LAS float*)(F.lds);
    LAS float* Vs = (LAS float*)(F.lds + 64 * 96 * 4);
    constexpr int NQC = 17;
    const int hf = F.tid & 1;
    for (int u = F.vcu; u < NB * 16 * NQC; u += F.G) {
        const int bh = u / NQC, qc = u % NQC, b = bh >> 4, h = bh & 15;
        const int sq = qc * 256 + (F.tid >> 1); const bool vq = sq < LP; const size_t rowq = (size_t)b * LP + (vq ? sq : LP - 1);
        float q[48];
#pragma unroll
        for (int c = 0; c < 6; ++c) { const v4u w = *(const GAS v4u*)(Q + rowq * 1536 + h * 96 + hf * 48 + c * 8);
            q[c * 8 + 0] = bf_lo(w.x); q[c * 8 + 1] = bf_hi(w.x); q[c * 8 + 2] = bf_lo(w.y); q[c * 8 + 3] = bf_hi(w.y);
            q[c * 8 + 4] = bf_lo(w.z); q[c * 8 + 5] = bf_hi(w.z); q[c * 8 + 6] = bf_lo(w.w); q[c * 8 + 7] = bf_hi(w.w); }
        float o[32];
#pragma unroll
        for (int d = 0; d < 32; ++d) o[d] = 0.f;
        float mx = -1e30f, l = 0.f;
        for (int kt = 0; kt < 65; ++kt) {
            __syncthreads();
            for (int idx = F.tid; idx < 64 * 12; idx += 512) { const int j = idx / 12, c = idx % 12; int sk = PADR + kt * 64 + j; sk = sk < LP ? sk : LP - 1; const size_t rk = (size_t)b * LP + sk;
                const v4u w = c < 8 ? *(const GAS v4u*)(KV + rk * 2048 + h * 128 + c * 8) : *(const GAS v4u*)(KR + rk * 32 + (c - 8) * 8);
                LAS float* d = Ks + j * 96 + c * 8; d[0] = bf_lo(w.x); d[1] = bf_hi(w.x); d[2] = bf_lo(w.y); d[3] = bf_hi(w.y); d[4] = bf_lo(w.z); d[5] = bf_hi(w.z); d[6] = bf_lo(w.w); d[7] = bf_hi(w.w); }
            { const int j = F.tid >> 3, c = F.tid & 7; int sk = PADR + kt * 64 + j; sk = sk < LP ? sk : LP - 1; const size_t rk = (size_t)b * LP + sk;
                const v4u w = *(const GAS v4u*)(KV + rk * 2048 + h * 128 + 64 + c * 8);
                LAS float* d = Vs + j * 64 + c * 8; d[0] = bf_lo(w.x); d[1] = bf_hi(w.x); d[2] = bf_lo(w.y); d[3] = bf_hi(w.y); d[4] = bf_lo(w.z); d[5] = bf_hi(w.z); d[6] = bf_lo(w.w); d[7] = bf_hi(w.w); }
            __syncthreads();
            const int nk = (LTOK - kt * 64) < 64 ? (LTOK - kt * 64) : 64;
#pragma unroll 1
            for (int jj = 0; jj < nk; ++jj) {
                const LAS f32x4* kr = (const LAS f32x4*)(Ks + jj * 96 + hf * 48); float a0 = 0.f, a1 = 0.f;
#pragma unroll
                for (int c = 0; c < 12; c += 2) { const f32x4 k0 = kr[c], k1 = kr[c + 1];
                    a0 += q[4 * c] * k0.x + q[4 * c + 1] * k0.y + q[4 * c + 2] * k0.z + q[4 * c + 3] * k0.w;
                    a1 += q[4 * c + 4] * k1.x + q[4 * c + 5] * k1.y + q[4 * c + 6] * k1.z + q[4 * c + 7] * k1.w; }
                float sc = a0 + a1; sc += __shfl_xor(sc, 1);
                const float mn = fmaxf(mx, sc);
                const float al = __builtin_amdgcn_exp2f(mx - mn), p = __builtin_amdgcn_exp2f(sc - mn); mx = mn; l = l * al + p;
                const LAS f32x4* vr = (const LAS f32x4*)(Vs + jj * 64 + hf * 32);
#pragma unroll
                for (int c = 0; c < 8; ++c) { const f32x4 vv = vr[c]; o[4 * c] = fmaf(p, vv.x, o[4 * c] * al); o[4 * c + 1] = fmaf(p, vv.y, o[4 * c + 1] * al); o[4 * c + 2] = fmaf(p, vv.z, o[4 * c + 2] * al); o[4 * c + 3] = fmaf(p, vv.w, o[4 * c + 3] * al); }
            }
        }
        if (vq) { const float il = 1.0f / l;
#pragma unroll
            for (int c = 0; c < 4; ++c) { v4u w; w.x = cvt_pk_bf16(o[8 * c] * il, o[8 * c + 1] * il); w.y = cvt_pk_bf16(o[8 * c + 2] * il, o[8 * c + 3] * il); w.z = cvt_pk_bf16(o[8 * c + 4] * il, o[8 * c + 5] * il); w.w = cvt_pk_bf16(o[8 * c + 6] * il, o[8 * c + 7] * il);
                *(GAS v4u*)(O + rowq * 1024 + h * 64 + hf * 32 + c * 8) = w; } }
    }
    __syncthreads();
}

__device__ __forceinline__ void gla_simple(Frame& F, bf16* Qb, const bf16* Vb, bf16* KFb, const bf16* KBb, const bf16* SGb, const float* onorm) {
    LAS float* tq = (LAS float*)(F.lds);
    LAS float* tk = (LAS float*)(F.lds + 16384);
    LAS float* tv = (LAS float*)(F.lds + 32768);
    LAS float* pr = (LAS float*)(F.lds + 49152);
    const int j = F.tid & 127, kq = F.tid >> 7;
    for (int it = F.vcu; it < NB * 8; it += F.G) {
        const int b = it >> 3, h = it & 7; const size_t cbase = (size_t)h * 128;
        for (int dir = 0; dir < 2; ++dir) {
            float S[32];
#pragma unroll
            for (int k = 0; k < 32; ++k) S[k] = 0.f;
            const bf16* Kg = dir == 0 ? KFb : KBb;
            for (int tile = 0; tile < (LTOK + 31) / 32; ++tile) {
                __syncthreads();
                { const int i = F.tid >> 4, c8 = (F.tid & 15) * 8; const int tt = tile * 32 + i; const bool vt = tt < LTOK; const int tok = dir == 0 ? tt : LTOK - 1 - tt;
                  const size_t off = ((size_t)b * LP + PADR + (vt ? tok : 0)) * 1024 + cbase + c8;
                  v4u wq = *(const GAS v4u*)(Qb + off), wk = *(const GAS v4u*)(Kg + off), wv = *(const GAS v4u*)(Vb + off);
                  if (!vt) { wq = (v4u){0u, 0u, 0u, 0u}; wk = wq; wv = wq; }
                  LAS float* dq = tq + i * 128 + c8; LAS float* dk = tk + i * 128 + c8; LAS float* dv = tv + i * 128 + c8;
                  dq[0] = bf_lo(wq.x); dq[1] = bf_hi(wq.x); dq[2] = bf_lo(wq.y); dq[3] = bf_hi(wq.y); dq[4] = bf_lo(wq.z); dq[5] = bf_hi(wq.z); dq[6] = bf_lo(wq.w); dq[7] = bf_hi(wq.w);
                  dk[0] = bf_lo(wk.x); dk[1] = bf_hi(wk.x); dk[2] = bf_lo(wk.y); dk[3] = bf_hi(wk.y); dk[4] = bf_lo(wk.z); dk[5] = bf_hi(wk.z); dk[6] = bf_lo(wk.w); dk[7] = bf_hi(wk.w);
                  dv[0] = bf_lo(wv.x); dv[1] = bf_hi(wv.x); dv[2] = bf_lo(wv.y); dv[3] = bf_hi(wv.y); dv[4] = bf_lo(wv.z); dv[5] = bf_hi(wv.z); dv[6] = bf_lo(wv.w); dv[7] = bf_hi(wv.w); }
                __syncthreads();
                for (int i = 0; i < 32; ++i) {
                    const float vj = tv[i * 128 + j]; float part = 0.f;
                    const LAS f32x4* kr = (const LAS f32x4*)(tk + i * 128 + kq * 32); const LAS f32x4* qr = (const LAS f32x4*)(tq + i * 128 + kq * 32);
#pragma unroll
                    for (int c = 0; c < 8; ++c) { const f32x4 kk = kr[c], qq = qr[c];
                        S[4 * c] = fmaf(kk.x, vj - S[4 * c], S[4 * c]); part = fmaf(S[4 * c], qq.x, part);
                        S[4 * c + 1] = fmaf(kk.y, vj - S[4 * c + 1], S[4 * c + 1]); part = fmaf(S[4 * c + 1], qq.y, part);
                        S[4 * c + 2] = fmaf(kk.z, vj - S[4 * c + 2], S[4 * c + 2]); part = fmaf(S[4 * c + 2], qq.z, part);
                        S[4 * c + 3] = fmaf(kk.w, vj - S[4 * c + 3], S[4 * c + 3]); part = fmaf(S[4 * c + 3], qq.w, part); }
                    pr[(i * 4 + kq) * 128 + j] = part;
                }
                __syncthreads();
#pragma unroll
                for (int ii = 0; ii < 4; ++ii) { const int i = F.wave * 4 + ii; const int tt = tile * 32 + i; const bool vt = tt < LTOK; const int tok = dir == 0 ? tt : LTOK - 1 - tt;
                    const int c = 2 * F.lane;
                    float o0 = pr[(i * 4 + 0) * 128 + c] + pr[(i * 4 + 1) * 128 + c] + pr[(i * 4 + 2) * 128 + c] + pr[(i * 4 + 3) * 128 + c];
                    float o1 = pr[(i * 4 + 0) * 128 + c + 1] + pr[(i * 4 + 1) * 128 + c + 1] + pr[(i * 4 + 2) * 128 + c + 1] + pr[(i * 4 + 3) * 128 + c + 1];
                    const size_t off = ((size_t)b * LP + PADR + (vt ? tok : 0)) * 1024 + cbase + c;
                    if (dir == 0) { if (vt) *(GAS unsigned*)(KFb + off) = cvt_pk_bf16(o0, o1); }
                    else { const unsigned wf = *(const GAS unsigned*)(KFb + off); o0 += bf_lo(wf); o1 += bf_hi(wf);
                        const float ss = wave_sum(o0 * o0 + o1 * o1); const float rstd = 1.0f / sqrtf(ss * (1.0f / 128.0f) + EPS);
                        const unsigned wg = *(const GAS unsigned*)(SGb + off); const f32x2 gn = *(const f32x2*)(onorm + cbase + c);
                        if (vt) *(GAS unsigned*)(Qb + off) = cvt_pk_bf16(o0 * rstd * gn.x * bf_lo(wg), o1 * rstd * gn.y * bf_hi(wg)); } }
            }
            __syncthreads();
        }
    }
    __syncthreads();
}
namespace fa {
using bf16x8 = __attribute__((ext_vector_type(8))) short;
using s16x4  = __attribute__((ext_vector_type(4))) short;
using f32x16 = __attribute__((ext_vector_type(16))) float;
using u32x4  = __attribute__((ext_vector_type(4))) unsigned;
constexpr int KROW = 208;
constexpr int SHM_V = 64 * 64 * 2, SHM_K = 64 * KROW;
constexpr int OFF_V = 0, OFF_K = 2 * SHM_V, OFF_WS = OFF_K + 2 * SHM_K, OFF_STG = OFF_WS + 8 * 256, LDS_TOTAL = OFF_STG + 8 * 4096;
constexpr int NT = 65, NQC = 17;
#define FA_SBAR() __builtin_amdgcn_sched_barrier(0)
__device__ __forceinline__ int crow(int r, int hi) { return (r & 3) + 8 * (r >> 2) + 4 * hi; }
constexpr float THRL = 11.5f;
__device__ __forceinline__ void partialSM(f32x16& p0, f32x16& p1, float& mhat, f32x16& negm, float& alpha, bool first) {
  float a = fmaxf(fmaxf(p0[0], p0[1]), p1[0]), b = fmaxf(fmaxf(p0[2], p0[3]), p1[1]); a = fmaxf(fmaxf(a, p1[2]), p1[3]);
#pragma unroll
  for (int r = 4; r < 16; r += 4) { a = fmaxf(fmaxf(a, p0[r]), p0[r + 1]); b = fmaxf(fmaxf(b, p0[r + 2]), p0[r + 3]); a = fmaxf(fmaxf(a, p1[r]), p1[r + 1]); b = fmaxf(fmaxf(b, p1[r + 2]), p1[r + 3]); }
  float rm = fmaxf(a, b);
  { auto rr = __builtin_amdgcn_permlane32_swap(__float_as_uint(rm), __float_as_uint(rm), false, false);
    rm = fmaxf(__uint_as_float(rr[0]), __uint_as_float(rr[1])); }
  alpha = 1.f;
  if (first || __builtin_expect(__any(rm > THRL), 0)) { const float dl = first ? rm : fmaxf(rm, 0.f); mhat += dl;
#pragma unroll
    for (int r = 0; r < 16; ++r) { p0[r] -= dl; p1[r] -= dl; }
#pragma unroll
    for (int r = 0; r < 16; ++r) negm[r] = -mhat;
    asm volatile("" : "+v"(negm));
    alpha = __builtin_amdgcn_exp2f(-dl); }
#pragma unroll
  for (int r = 0; r < 16; ++r) p0[r] = __builtin_amdgcn_exp2f(p0[r]);
}
__device__ __forceinline__ void finishSM(f32x16& p0, f32x16& p1, float alpha, float& l_reg, bf16x8& pa0, bf16x8& pa1, bf16x8& pa2, bf16x8& pa3) {
#pragma unroll
  for (int r = 0; r < 16; ++r) p1[r] = __builtin_amdgcn_exp2f(p1[r]);
  float ps = 0;
#pragma unroll
  for (int r = 0; r < 16; ++r) ps += p0[r];
#pragma unroll
  for (int r = 0; r < 16; ++r) ps += p1[r];
  { auto rr = __builtin_amdgcn_permlane32_swap(__float_as_uint(ps), __float_as_uint(ps), false, false);
    ps = __uint_as_float(rr[0]) + __uint_as_float(rr[1]); }
  l_reg = l_reg * alpha + ps;
#define FA_PK4(P, BASE, OUT) do { unsigned a0 = cvt_pk_bf16(P[BASE + 0], P[BASE + 1]), a1 = cvt_pk_bf16(P[BASE + 2], P[BASE + 3]);   \
    unsigned b0 = cvt_pk_bf16(P[BASE + 4], P[BASE + 5]), b1 = cvt_pk_bf16(P[BASE + 6], P[BASE + 7]);                              \
    auto r0 = __builtin_amdgcn_permlane32_swap(a0, b0, false, false); auto r1 = __builtin_amdgcn_permlane32_swap(a1, b1, false, false); \
    u32x4 w = {r0[0], r1[0], r0[1], r1[1]}; OUT = *reinterpret_cast<bf16x8*>(&w); } while (0)
  FA_PK4(p0, 0, pa0); FA_PK4(p0, 8, pa1); FA_PK4(p1, 0, pa2); FA_PK4(p1, 8, pa3);
#undef FA_PK4
}
__device__ __forceinline__ void qkt(f32x16& p0, f32x16& p1, const char* Ks, const bf16x8* qr, const f32x16& negm, int r32, int hi) {
#pragma unroll
  for (int d0 = 0; d0 < 6; ++d0) { const int cb = (d0 * 16 + hi * 8) * 2;
    const bf16x8 b0 = *reinterpret_cast<const bf16x8*>(Ks + r32 * KROW + cb);
    const bf16x8 b1 = *reinterpret_cast<const bf16x8*>(Ks + (32 + r32) * KROW + cb);
    if (d0 == 0) { p0 = __builtin_amdgcn_mfma_f32_32x32x16_bf16(b0, qr[0], negm, 0, 0, 0); p1 = __builtin_amdgcn_mfma_f32_32x32x16_bf16(b1, qr[0], negm, 0, 0, 0); }
    else { p0 = __builtin_amdgcn_mfma_f32_32x32x16_bf16(b0, qr[d0], p0, 0, 0, 0); p1 = __builtin_amdgcn_mfma_f32_32x32x16_bf16(b1, qr[d0], p1, 0, 0, 0); } }
}
__device__ __forceinline__ int v_st(int k, int c) { const int kk = (k & ~0xC) | ((k & 4) << 1) | ((k & 8) >> 1); return ((kk >> 3) * 2 + (c >> 5)) * 512 + ((kk & 7) * 32 + (c & 31)) * 2; }
__device__ __forceinline__ int v_rd_base(int lane) { return ((lane & 3) << 3) | (((lane >> 2) & 3) << 6) | (((lane >> 4) & 1) << 5) | (((lane >> 5) & 1) << 8); }
constexpr int v_rd_off(int d0, int ks, int half) { return d0 * 512 + ks * 2048 + half * 1024; }
template <int OFF> __device__ __forceinline__ s16x4 tr_read(int vb) {
  s16x4 r; asm volatile("ds_read_b64_tr_b16 %0, %1 offset:%2" : "=&v"(r) : "v"(vb), "i"(OFF) : "memory"); return r;
}
template <int D0> __device__ __forceinline__ void pv_one(f32x16& od, int vb, bf16x8 pa0, bf16x8 pa1, bf16x8 pa2, bf16x8 pa3) {
  const s16x4 l0 = tr_read<v_rd_off(D0, 0, 0)>(vb), h0 = tr_read<v_rd_off(D0, 0, 1)>(vb), l1 = tr_read<v_rd_off(D0, 1, 0)>(vb), h1 = tr_read<v_rd_off(D0, 1, 1)>(vb);
  const s16x4 l2 = tr_read<v_rd_off(D0, 2, 0)>(vb), h2 = tr_read<v_rd_off(D0, 2, 1)>(vb), l3 = tr_read<v_rd_off(D0, 3, 0)>(vb), h3 = tr_read<v_rd_off(D0, 3, 1)>(vb);
  asm volatile("s_waitcnt lgkmcnt(0)" ::: "memory"); FA_SBAR();
#define FA_PK(L, H) (bf16x8){L[0], L[1], L[2], L[3], H[0], H[1], H[2], H[3]}
  od = __builtin_amdgcn_mfma_f32_32x32x16_bf16(pa0, FA_PK(l0, h0), od, 0, 0, 0);
  od = __builtin_amdgcn_mfma_f32_32x32x16_bf16(pa1, FA_PK(l1, h1), od, 0, 0, 0);
  od = __builtin_amdgcn_mfma_f32_32x32x16_bf16(pa2, FA_PK(l2, h2), od, 0, 0, 0);
  od = __builtin_amdgcn_mfma_f32_32x32x16_bf16(pa3, FA_PK(l3, h3), od, 0, 0, 0);
#undef FA_PK
}
__device__ __forceinline__ void pv_d0(f32x16* o, int vb, bf16x8 pa0, bf16x8 pa1, bf16x8 pa2, bf16x8 pa3) {
  pv_one<0>(o[0], vb, pa0, pa1, pa2, pa3); pv_one<1>(o[1], vb, pa0, pa1, pa2, pa3);
}
__device__ __forceinline__ void attn_unit(int b, int h, int q0, const bf16* __restrict__ Q, const bf16* __restrict__ KV, const bf16* __restrict__ KR, bf16* __restrict__ O, char* lds) {
  const int tid = threadIdx.x, wid = tid >> 6, lane = tid & 63, r32 = lane & 31, hi = lane >> 5;
  char* V_lds = lds + OFF_V; char* K_lds = lds + OFF_K;
  float* ws = (float*)(lds + OFF_WS) + wid * 64; float* li_l = ws; float* al_l = ws + 32;
  float mhat = 0.f, l_reg = 0; f32x16 o[2] = {}; bf16x8 qr[6]; f32x16 negm = f32x16{}; asm volatile("" : "+v"(negm));
  const size_t seq0 = (size_t)b * LP;
  { int sq = q0 + wid * 32 + r32; sq = sq < LP ? sq : LP - 1;
    const bf16* Qw = Q + (seq0 + sq) * 1536 + h * 96 + hi * 8;
#pragma unroll
    for (int d0 = 0; d0 < 6; ++d0) qr[d0] = *reinterpret_cast<const bf16x8*>(Qw + d0 * 16); }
  const int sr = tid >> 3, sc = (tid & 7) * 8, rr = (tid >> 2) & 63, rc = (tid & 3) * 8; const bool hasr = tid < 256;
  const int vst = v_st(sr, sc), kst = sr * KROW + sc * 2, rst = rr * KROW + 128 + rc * 2;
  const bf16* Kn = KV + seq0 * 2048 + h * 128 + (size_t)sr * 2048 + sc; const bf16* Vn = Kn + 64; const bf16* Rn = KR + seq0 * 32 + (size_t)rr * 32 + rc;
  const int vb0 = (int)(uintptr_t)V_lds + v_rd_base(lane);
  struct { bf16x8 vs, ks, rs; } sr_[2];
#define FA_SLOAD(i, k0) do { sr_[i].vs = *reinterpret_cast<const bf16x8*>(Vn + (size_t)(k0) * 2048); sr_[i].ks = *reinterpret_cast<const bf16x8*>(Kn + (size_t)(k0) * 2048); \
    if (hasr) sr_[i].rs = *reinterpret_cast<const bf16x8*>(Rn + (size_t)(k0) * 32); } while (0)
#define FA_SWRITE(bf, i) do { *(bf16x8*)(V_lds + (bf) * SHM_V + vst) = sr_[i].vs; *(bf16x8*)(K_lds + (bf) * SHM_K + kst) = sr_[i].ks; \
    if (hasr) *(bf16x8*)(K_lds + (bf) * SHM_K + rst) = sr_[i].rs; } while (0)
#define FA_SWAIT() asm volatile("s_waitcnt vmcnt(3)" ::: "memory")
#define FA_RESC(a) do { if (__any((a) < 1.f)) { if (hi == 0) al_l[r32] = (a); asm volatile("s_waitcnt lgkmcnt(0)" ::: "memory"); \
    _Pragma("unroll") for (int d = 0; d < 2; ++d) _Pragma("unroll") for (int r = 0; r < 16; ++r) o[d][r] *= al_l[crow(r, hi)]; } } while (0)
  f32x16 pA0, pA1, pB0, pB1; float alA, alB; bf16x8 pa0, pa1, pa2, pa3;
  constexpr int SE = 0, SO = 1;
  const bool act = q0 + wid * 32 < LP;
  if (!act) {
    __syncthreads();
    FA_SLOAD(SE, 0); asm volatile("s_waitcnt vmcnt(0)" ::: "memory"); FA_SWRITE(0, SE); __syncthreads();
    FA_SLOAD(SO, 64); FA_SLOAD(SE, 128);
    FA_SWAIT(); FA_SWRITE(1, SO); __syncthreads();
    for (int j = 1; j + 1 < NT; j += 2) {
      if (j + 2 < NT) FA_SLOAD(SO, (j + 2) * 64);
      __syncthreads(); FA_SWAIT(); FA_SWRITE(0, SE); __syncthreads();
      if (j + 3 < NT) FA_SLOAD(SE, (j + 3) * 64);
      __syncthreads(); FA_SWAIT(); if (j + 2 < NT) FA_SWRITE(1, SO); __syncthreads();
    }
    return;
  }
  __syncthreads();
  FA_SLOAD(SE, 0); asm volatile("s_waitcnt vmcnt(0)" ::: "memory"); FA_SWRITE(0, SE); __syncthreads();
  qkt(pA0, pA1, K_lds, qr, negm, r32, hi);
  { const float NEG = -INFINITY;
#pragma unroll
    for (int r = 0; r < 16; ++r) pA0[r] = NEG;
#pragma unroll
    for (int r = 0; r < 8; ++r) pA1[r] = NEG; }
  partialSM(pA0, pA1, mhat, negm, alA, true);
  FA_SLOAD(SO, 64); FA_SLOAD(SE, 128);
  FA_SWAIT(); FA_SWRITE(1, SO); __syncthreads();
  for (int j = 1; j + 1 < NT; j += 2) {
    FA_SBAR(); qkt(pB0, pB1, K_lds + SHM_K, qr, negm, r32, hi);
    finishSM(pA0, pA1, alA, l_reg, pa0, pa1, pa2, pa3); FA_SBAR();
    if (j + 2 < NT) FA_SLOAD(SO, (j + 2) * 64); FA_SBAR();
    pv_d0(o, vb0, pa0, pa1, pa2, pa3); partialSM(pB0, pB1, mhat, negm, alB, false);
    __syncthreads(); FA_SWAIT(); FA_SWRITE(0, SE);
    FA_RESC(alB); __syncthreads();
    FA_SBAR(); qkt(pA0, pA1, K_lds, qr, negm, r32, hi);
    finishSM(pB0, pB1, alB, l_reg, pa0, pa1, pa2, pa3); FA_SBAR();
    if (j + 3 < NT) FA_SLOAD(SE, (j + 3) * 64); FA_SBAR();
    pv_d0(o, vb0 + SHM_V, pa0, pa1, pa2, pa3); partialSM(pA0, pA1, mhat, negm, alA, false);
    __syncthreads(); FA_SWAIT(); if (j + 2 < NT) FA_SWRITE(1, SO);
    FA_RESC(alA); __syncthreads();
  }
  finishSM(pA0, pA1, alA, l_reg, pa0, pa1, pa2, pa3); FA_SBAR();
  pv_d0(o, vb0, pa0, pa1, pa2, pa3);
  if (hi == 0) li_l[r32] = l_reg; asm volatile("s_waitcnt lgkmcnt(0)" ::: "memory");
  float rli[16];
#pragma unroll
  for (int r = 0; r < 16; ++r) rli[r] = __builtin_amdgcn_rcpf(li_l[crow(r, hi)]);
  { unsigned short* stg = (unsigned short*)(lds + OFF_STG) + wid * 2048;
#pragma unroll
    for (int r = 0; r < 16; ++r) { const int orow = crow(r, hi);
#pragma unroll
      for (int d0 = 0; d0 < 2; ++d0) stg[orow * 64 + d0 * 32 + r32] = (unsigned short)(cvt_pk_bf16(o[d0][r] * rli[r], 0.f) & 0xffffu); }
    asm volatile("s_waitcnt lgkmcnt(0)" ::: "memory");
#pragma unroll
    for (int i = 0; i < 4; ++i) { const int row = i * 8 + (lane >> 3), ch = lane & 7; const int sq = q0 + wid * 32 + row; const u32x4 v = *(const u32x4*)(stg + row * 64 + ch * 8);
      if (sq < LP) *(u32x4*)(O + (seq0 + sq) * 1024 + h * 64 + ch * 8) = v; } }
#undef FA_SLOAD
#undef FA_SWRITE
#undef FA_SWAIT
#undef FA_RESC
}
__device__ __forceinline__ void attn_phase(int vcu, int G, const bf16* Q, const bf16* KV, const bf16* KR, bf16* O, char* lds) {
  for (int u = vcu; u < NB * 16 * NQC; u += G) { const int bh = u / NQC, qc = u % NQC; attn_unit(bh >> 4, bh & 15, qc * 256, Q, KV, KR, O, lds); }
  __syncthreads();
}
}
namespace fa2 {
using namespace fa;
constexpr int SLOT = SHM_K + SHM_V;
constexpr int R_WS = 4 * SLOT, R_STG = R_WS + 8 * 256, R_TOTAL = R_STG + 8 * 4096;
static_assert(R_TOTAL <= 131072, "attention LDS");
struct VFr { s16x4 l[2][4], h[2][4]; };
__device__ __forceinline__ void pv_issue(VFr& f, int vb) {
  f.l[0][0] = tr_read<v_rd_off(0, 0, 0)>(vb); f.h[0][0] = tr_read<v_rd_off(0, 0, 1)>(vb); f.l[0][1] = tr_read<v_rd_off(0, 1, 0)>(vb); f.h[0][1] = tr_read<v_rd_off(0, 1, 1)>(vb);
  f.l[0][2] = tr_read<v_rd_off(0, 2, 0)>(vb); f.h[0][2] = tr_read<v_rd_off(0, 2, 1)>(vb); f.l[0][3] = tr_read<v_rd_off(0, 3, 0)>(vb); f.h[0][3] = tr_read<v_rd_off(0, 3, 1)>(vb);
  f.l[1][0] = tr_read<v_rd_off(1, 0, 0)>(vb); f.h[1][0] = tr_read<v_rd_off(1, 0, 1)>(vb); f.l[1][1] = tr_read<v_rd_off(1, 1, 0)>(vb); f.h[1][1] = tr_read<v_rd_off(1, 1, 1)>(vb);
  f.l[1][2] = tr_read<v_rd_off(1, 2, 0)>(vb); f.h[1][2] = tr_read<v_rd_off(1, 2, 1)>(vb); f.l[1][3] = tr_read<v_rd_off(1, 3, 0)>(vb); f.h[1][3] = tr_read<v_rd_off(1, 3, 1)>(vb);
}
__device__ __forceinline__ void pv_mma(f32x16* o, const VFr& f, bf16x8 pa0, bf16x8 pa1, bf16x8 pa2, bf16x8 pa3) {
  asm volatile("s_waitcnt lgkmcnt(0)" ::: "memory"); FA_SBAR();
#define FA2_PK(L, H) (bf16x8){L[0], L[1], L[2], L[3], H[0], H[1], H[2], H[3]}
#pragma unroll
  for (int d = 0; d < 2; ++d) {
    o[d] = __builtin_amdgcn_mfma_f32_32x32x16_bf16(pa0, FA2_PK(f.l[d][0], f.h[d][0]), o[d], 0, 0, 0);
    o[d] = __builtin_amdgcn_mfma_f32_32x32x16_bf16(pa1, FA2_PK(f.l[d][1], f.h[d][1]), o[d], 0, 0, 0);
    o[d] = __builtin_amdgcn_mfma_f32_32x32x16_bf16(pa2, FA2_PK(f.l[d][2], f.h[d][2]), o[d], 0, 0, 0);
    o[d] = __builtin_amdgcn_mfma_f32_32x32x16_bf16(pa3, FA2_PK(f.l[d][3], f.h[d][3]), o[d], 0, 0, 0); }
#undef FA2_PK
}
__device__ __forceinline__ void attn_unit(int b, int h, int q0, const bf16* __restrict__ Q, const bf16* __restrict__ KV, const bf16* __restrict__ KR, bf16* __restrict__ O, char* lds) {
  const int tid = threadIdx.x, wid = __builtin_amdgcn_readfirstlane(tid >> 6), lane = tid & 63, r32 = lane & 31, hi = lane >> 5;
  float* ws = (float*)(lds + R_WS) + wid * 64; float* li_l = ws; float* al_l = ws + 32;
  float mhat = 0.f, l_reg = 0; f32x16 o[2] = {}; bf16x8 qr[6]; f32x16 negm = f32x16{}; asm volatile("" : "+v"(negm));
  const size_t seq0 = (size_t)b * LP;
  const char* sp[3]; unsigned stp[3];
#pragma unroll
  for (int k = 0; k < 3; ++k) { const int c = (wid + 8 * k) * 64 + lane;
    if (c < 832) { const int row = c / 13, cc = c % 13;
      if (cc >= 8 && cc < 12) { sp[k] = (const char*)(KR + (seq0 + row) * 32 + (cc - 8) * 8); stp[k] = 64 * 32 * 2; }
      else { sp[k] = (const char*)(KV + (seq0 + row) * 2048 + h * 128 + (cc < 8 ? cc : 0) * 8); stp[k] = 64 * 2048 * 2; }
    } else { const int p = (c - 832) & 511, kk = ((p >> 6) << 3) | ((p & 31) >> 2), key = (kk & ~0xC) | ((kk & 4) << 1) | ((kk & 8) >> 1), col = ((p >> 5) & 1) * 32 + (p & 3) * 8;
      sp[k] = (const char*)(KV + (seq0 + key) * 2048 + h * 128 + 64 + col); stp[k] = 64 * 2048 * 2; } }
  const bool third = wid < 5;
#define FA2_DMA(t, slot) do { const unsigned t_ = (unsigned)(t); \
    __builtin_amdgcn_global_load_lds((const unsigned*)(sp[0] + (size_t)t_ * stp[0]), (__attribute__((address_space(3))) unsigned*)(lds + (slot) * SLOT + wid * 1024), 16, 0, 0); \
    __builtin_amdgcn_global_load_lds((const unsigned*)(sp[1] + (size_t)t_ * stp[1]), (__attribute__((address_space(3))) unsigned*)(lds + (slot) * SLOT + (wid + 8) * 1024), 16, 0, 0); \
    if (third) __builtin_amdgcn_global_load_lds((const unsigned*)(sp[2] + (size_t)t_ * stp[2]), (__attribute__((address_space(3))) unsigned*)(lds + (slot) * SLOT + (wid + 16) * 1024), 16, 0, 0); } while (0)
#define FA2_RESC(a) do { if (__any((a) < 1.f)) { if (hi == 0) al_l[r32] = (a); asm volatile("s_waitcnt lgkmcnt(0)" ::: "memory"); \
    _Pragma("unroll") for (int d = 0; d < 2; ++d) _Pragma("unroll") for (int r = 0; r < 16; ++r) o[d][r] *= al_l[crow(r, hi)]; } } while (0)
  const bool act = q0 + wid * 32 < LP;
  __syncthreads();
  FA2_DMA(0, 0); FA2_DMA(1, 1);
  { int sq = q0 + wid * 32 + r32; sq = sq < LP ? sq : LP - 1;
    const bf16* Qw = Q + (seq0 + sq) * 1536 + h * 96 + hi * 8;
#pragma unroll
    for (int d0 = 0; d0 < 6; ++d0) qr[d0] = *reinterpret_cast<const bf16x8*>(Qw + d0 * 16); }
  __syncthreads();
  if (!act) {
    FA2_DMA(2, 2); __syncthreads();
    for (int i = 0; i < 16; ++i) { const int j = 4 * i + 1;
      if (j + 2 < NT) FA2_DMA(j + 2, 3); __syncthreads(); if (j + 3 < NT) FA2_DMA(j + 3, 0); __syncthreads(); if (j + 4 < NT) FA2_DMA(j + 4, 1); __syncthreads(); if (j + 5 < NT) FA2_DMA(j + 5, 2); __syncthreads(); }
    return; }
  const int vb0 = (int)(uintptr_t)lds + SHM_K + v_rd_base(lane);
  f32x16 pA0, pA1, pB0, pB1; float alA, alB; bf16x8 pa0, pa1, pa2, pa3;
  FA2_DMA(2, 2);
  qkt(pA0, pA1, lds, qr, negm, r32, hi);
  { const float NEG = -INFINITY;
#pragma unroll
    for (int r = 0; r < 16; ++r) pA0[r] = NEG;
#pragma unroll
    for (int r = 0; r < 8; ++r) pA1[r] = NEG; }
  partialSM(pA0, pA1, mhat, negm, alA, true);
  __syncthreads();
#define FA2_SEG(j, PC0, PC1, ALC, PP0, PP1, ALP, KS, VS, DS) do { if ((j) + 2 < NT) FA2_DMA((j) + 2, DS); \
    FA_SBAR(); qkt(PC0, PC1, lds + (KS) * SLOT, qr, negm, r32, hi); FA_SBAR(); \
    { VFr vf_; pv_issue(vf_, vb0 + (VS) * SLOT); FA_SBAR(); finishSM(PP0, PP1, ALP, l_reg, pa0, pa1, pa2, pa3); FA_SBAR(); \
      pv_mma(o, vf_, pa0, pa1, pa2, pa3); } partialSM(PC0, PC1, mhat, negm, ALC, false); \
    FA2_RESC(ALC); __syncthreads(); } while (0)
  for (int j = 1; j + 1 < NT; j += 2) {
    FA2_SEG(j,     pB0, pB1, alB, pA0, pA1, alA, j & 3, (j - 1) & 3, (j + 2) & 3);
    FA2_SEG(j + 1, pA0, pA1, alA, pB0, pB1, alB, (j + 1) & 3, j & 3, (j + 3) & 3);
  }
  finishSM(pA0, pA1, alA, l_reg, pa0, pa1, pa2, pa3); FA_SBAR();
  pv_d0(o, vb0, pa0, pa1, pa2, pa3);
  if (hi == 0) li_l[r32] = l_reg; asm volatile("s_waitcnt lgkmcnt(0)" ::: "memory");
  float rli[16];
#pragma unroll
  for (int r = 0; r < 16; ++r) rli[r] = __builtin_amdgcn_rcpf(li_l[crow(r, hi)]);
  { unsigned short* stg = (unsigned short*)(lds + R_STG) + wid * 2048;
#pragma unroll
    for (int r = 0; r < 16; ++r) { const int orow = crow(r, hi);
#pragma unroll
      for (int d0 = 0; d0 < 2; ++d0) stg[orow * 64 + d0 * 32 + r32] = (unsigned short)(cvt_pk_bf16(o[d0][r] * rli[r], 0.f) & 0xffffu); }
    asm volatile("s_waitcnt lgkmcnt(0)" ::: "memory");
#pragma unroll
    for (int i = 0; i < 4; ++i) { const int row = i * 8 + (lane >> 3), ch = lane & 7; const int sq = q0 + wid * 32 + row; const u32x4 v = *(const u32x4*)(stg + row * 64 + ch * 8);
      if (sq < LP) *(u32x4*)(O + (seq0 + sq) * 1024 + h * 64 + ch * 8) = v; } }
#undef FA2_DMA
#undef FA2_RESC
#undef FA2_SEG
}
__device__ __forceinline__ void attn_phase(int vcu, int G, const bf16* Q, const bf16* KV, const bf16* KR, bf16* O, char* lds) {
  for (int u = vcu; u < NB * 16 * NQC; u += G) { const int bh = u / NQC, qc = u % NQC; attn_unit(bh >> 4, bh & 15, qc * 256, Q, KV, KR, O, lds); }
  __syncthreads();
}
#undef FA_SBAR
}
namespace gla {
using bf16x8 = __attribute__((ext_vector_type(8))) short;
using s16x4  = __attribute__((ext_vector_type(4))) short;
using f32x16 = __attribute__((ext_vector_type(16))) float;
using u32x4  = __attribute__((ext_vector_type(4))) unsigned;
using u32x2  = __attribute__((ext_vector_type(2))) unsigned;
constexpr int RS = 264;
constexpr int O_QI = 0, O_KI = 64 * RS, O_KD = 2 * 64 * RS, O_VV = O_KD + 16384, O_VEC = O_VV + 16384;
constexpr int V_DEC = O_VEC, V_EREF = O_VEC + 512, V_TOT = O_VEC + 1024, V_F2 = O_VEC + 1024 + 2048;
constexpr int CH_BYTES = O_VEC + 3584;
static_assert(CH_BYTES % 16 == 0 && 2 * CH_BYTES <= 146432, "gla LDS");
#define GLA_SBAR() __builtin_amdgcn_sched_barrier(0)
__device__ __forceinline__ int crow(int r, int hi) { return (r & 3) + 8 * (r >> 2) + 4 * hi; }
__device__ __forceinline__ int v_st4(int k, int c) { const int kk = (k & ~0xC) | ((k & 4) << 1) | ((k & 8) >> 1); return ((kk >> 3) * 4 + (c >> 5)) * 512 + ((kk & 7) * 32 + (c & 31)) * 2; }
__device__ __forceinline__ int v_rd_base(int lane) { return ((lane & 3) << 3) | (((lane >> 2) & 3) << 6) | (((lane >> 4) & 1) << 5) | (((lane >> 5) & 1) << 8); }
template <int OFF> __device__ __forceinline__ s16x4 tr_read(int vb) {
  s16x4 r; asm volatile("ds_read_b64_tr_b16 %0, %1 offset:%2" : "=&v"(r) : "v"(vb), "i"(OFF) : "memory"); return r;
}
__device__ __forceinline__ bf16x8 nat_frag(const char* img, int row, int ks, int hi) {
  const u32x2 a = *(const u32x2*)(img + row * RS + (16 * ks + 4 * hi) * 2), b = *(const u32x2*)(img + row * RS + (16 * ks + 8 + 4 * hi) * 2);
  u32x4 w = {a.x, a.y, b.x, b.y}; return *reinterpret_cast<bf16x8*>(&w);
}
__device__ __forceinline__ bf16x8 pk4(const f32x16& P, int BASE_IS_8) {
  const int B = BASE_IS_8 ? 8 : 0;
  const unsigned a0 = cvt_pk_bf16(P[B + 0], P[B + 1]), a1 = cvt_pk_bf16(P[B + 2], P[B + 3]), b0 = cvt_pk_bf16(P[B + 4], P[B + 5]), b1 = cvt_pk_bf16(P[B + 6], P[B + 7]);
  auto r0 = __builtin_amdgcn_permlane32_swap(a0, b0, false, false); auto r1 = __builtin_amdgcn_permlane32_swap(a1, b1, false, false);
  u32x4 w = {r0[0], r1[0], r0[1], r1[1]}; return *reinterpret_cast<bf16x8*>(&w);
}
#define GLA_PK(L, H) (bf16x8){L[0], L[1], L[2], L[3], H[0], H[1], H[2], H[3]}
__device__ __forceinline__ void gla_phase(int vcu, int G, bf16* Qb, const bf16* Vb, bf16* KFb, bf16* KBb, const bf16* SGb, const float* onorm, char* lds) {
  const int tid = threadIdx.x, wid = __builtin_amdgcn_readfirstlane(tid >> 6), lane = tid & 63, r32 = lane & 31, hi = lane >> 5;
  const int dir = wid >> 2, w4 = wid & 3, ct = tid & 255, kp = ct & 63;
  char* L = lds + dir * CH_BYTES;
  const int lbase = (int)(uintptr_t)L;
  const int vbV = lbase + O_VV + v_rd_base(lane) + w4 * 512, vbK = lbase + O_KD + v_rd_base(lane);
  bf16* Kown = dir ? KBb : KFb; const bf16* Koth = dir ? KFb : KBb;
  for (int it = vcu; it < NB * 8; it += G) {
    const int b = it >> 3, h = it & 7, cb = h * 128; const size_t seq0 = (size_t)b * LP;
    f32x16 S[4];
#pragma unroll
    for (int kb = 0; kb < 4; ++kb) S[kb] = f32x16{};
    unsigned pq[16], pk[16]; bf16x8 pvv[4];
#define GLA_ROW(n, tl) ((n) * 64 + (dir ? 63 - (tl) : (tl)))
#define GLA_LOAD(n) do { _Pragma("unroll") for (int i = 0; i < 16; ++i) { const size_t off = (seq0 + GLA_ROW(n, 16 * w4 + i)) * 1024 + cb + 2 * kp; \
        pq[i] = *(const unsigned*)(Qb + off); pk[i] = *(const unsigned*)(Kown + off); } \
      _Pragma("unroll") for (int i = 0; i < 4; ++i) { const int id = ct + 256 * i; pvv[i] = *(const bf16x8*)(Vb + (seq0 + GLA_ROW(n, id >> 4)) * 1024 + cb + (id & 15) * 8); } } while (0)
    GLA_LOAD(dir ? 64 : 0);
    for (int step = 0; step < 65; ++step) {
      const int n = dir ? 64 - step : step;
      const bool fin = dir ? (step >= 32) : (step >= 33);
      int lane_o = lane; asm volatile("" : "+v"(lane_o));
      const int r32 = lane_o & 31, hi = lane_o >> 5, kp = lane_o, ct = (w4 << 6) | lane_o;
      const int vbV = lbase + O_VV + v_rd_base(lane_o) + w4 * 512, vbK = lbase + O_KD + v_rd_base(lane_o);
      { float run0 = 1.f, run1 = 1.f, f20 = 1.f, f21 = 1.f;
#pragma unroll
        for (int i = 0; i < 16; ++i) { run0 *= 1.0f - bf_lo(pk[i]); run1 *= 1.0f - bf_hi(pk[i]); if (i == 0) { f20 = run0; f21 = run1; } }
        *(f32x2*)(L + V_TOT + (w4 * 128 + 2 * kp) * 4) = (f32x2){run0, run1};
        if (w4 == 2) *(f32x2*)(L + V_F2 + (2 * kp) * 4) = (f32x2){f20, f21}; }
      __syncthreads();
      { const f32x2 t0 = *(const f32x2*)(L + V_TOT + (0 * 128 + 2 * kp) * 4), t1 = *(const f32x2*)(L + V_TOT + (1 * 128 + 2 * kp) * 4), t2 = *(const f32x2*)(L + V_TOT + (2 * 128 + 2 * kp) * 4),
                    t3 = *(const f32x2*)(L + V_TOT + (3 * 128 + 2 * kp) * 4), f2 = *(const f32x2*)(L + V_F2 + (2 * kp) * 4);
        const f32x2 pre = w4 == 0 ? (f32x2){1.f, 1.f} : w4 == 1 ? t0 : w4 == 2 ? t0 * t1 : t0 * t1 * t2;
        const f32x2 pref = t0 * t1 * f2, plast = (t0 * t1) * (t2 * t3);
        const float ir0 = __builtin_amdgcn_rcpf(pref.x), ir1 = __builtin_amdgcn_rcpf(pref.y);
        const float c30 = plast.x * ir0, c31 = plast.y * ir1;
        float run0 = pre.x, run1 = pre.y;
#pragma unroll
        for (int i = 0; i < 16; ++i) { const int t = 16 * w4 + i;
          const float kg0 = bf_lo(pk[i]), kg1 = bf_hi(pk[i]);
          run0 *= 1.0f - kg0; run1 *= 1.0f - kg1;
          const float ki0 = kg0 * pref.x * __builtin_amdgcn_rcpf(run0), ki1 = kg1 * pref.y * __builtin_amdgcn_rcpf(run1);
          *(unsigned*)(L + O_QI + t * RS + 4 * kp) = cvt_pk_bf16(bf_lo(pq[i]) * run0 * ir0, bf_hi(pq[i]) * run1 * ir1);
          *(unsigned*)(L + O_KI + t * RS + 4 * kp) = cvt_pk_bf16(ki0, ki1);
          *(unsigned*)(L + O_KD + v_st4(t, 2 * kp)) = cvt_pk_bf16(ki0 * c30, ki1 * c31); }
        if (w4 == 0) { *(f32x2*)(L + V_DEC + (2 * kp) * 4) = plast; *(f32x2*)(L + V_EREF + (2 * kp) * 4) = pref; }
#pragma unroll
        for (int i = 0; i < 4; ++i) { const int id = ct + 256 * i; *(bf16x8*)(L + O_VV + v_st4(id >> 4, (id & 15) * 8)) = pvv[i]; } }
      __syncthreads();
      f32x16 o[2]; o[0] = f32x16{}; o[1] = f32x16{};
      { bf16x8 Sb[8];
#pragma unroll
        for (int kb = 0; kb < 4; ++kb)
#pragma unroll
          for (int s = 0; s < 2; ++s) { const f32x4 e0 = *(const f32x4*)(L + V_EREF + (32 * kb + 16 * s + 4 * hi) * 4), e1 = *(const f32x4*)(L + V_EREF + (32 * kb + 16 * s + 8 + 4 * hi) * 4);
            u32x4 w; w.x = cvt_pk_bf16(S[kb][8 * s + 0] * e0[0], S[kb][8 * s + 1] * e0[1]); w.y = cvt_pk_bf16(S[kb][8 * s + 2] * e0[2], S[kb][8 * s + 3] * e0[3]);
                     w.z = cvt_pk_bf16(S[kb][8 * s + 4] * e1[0], S[kb][8 * s + 5] * e1[1]); w.w = cvt_pk_bf16(S[kb][8 * s + 6] * e1[2], S[kb][8 * s + 7] * e1[3]);
            Sb[2 * kb + s] = *reinterpret_cast<bf16x8*>(&w); }
#pragma unroll
        for (int tb = 0; tb < 2; ++tb)
#pragma unroll
          for (int ks = 0; ks < 8; ++ks) { o[tb] = __builtin_amdgcn_mfma_f32_32x32x16_bf16(nat_frag(L + O_QI, 32 * tb + r32, ks, hi), Sb[ks], o[tb], 0, 0, 0);
                                           if ((ks & 3) == 3) asm volatile("" ::: "memory"); } }
      { f32x16 a0 = f32x16{};
#pragma unroll
        for (int ks = 0; ks < 8; ++ks) { a0 = __builtin_amdgcn_mfma_f32_32x32x16_bf16(nat_frag(L + O_KI, r32, ks, hi), nat_frag(L + O_QI, r32, ks, hi), a0, 0, 0, 0);
                                         if ((ks & 3) == 3) asm volatile("" ::: "memory"); }
#pragma unroll
        for (int r = 0; r < 16; ++r) a0[r] = crow(r, hi) > r32 ? 0.f : a0[r];
        const bf16x8 pa0 = pk4(a0, 0), pa1 = pk4(a0, 1);
        const s16x4 l0 = tr_read<0 * 4096>(vbV), h0 = tr_read<0 * 4096 + 2048>(vbV), l1 = tr_read<1 * 4096>(vbV), h1 = tr_read<1 * 4096 + 2048>(vbV);
        asm volatile("s_waitcnt lgkmcnt(0)" ::: "memory"); GLA_SBAR();
        o[0] = __builtin_amdgcn_mfma_f32_32x32x16_bf16(pa0, GLA_PK(l0, h0), o[0], 0, 0, 0);
        o[0] = __builtin_amdgcn_mfma_f32_32x32x16_bf16(pa1, GLA_PK(l1, h1), o[0], 0, 0, 0); }
      { f32x16 a0 = f32x16{}, a1 = f32x16{};
#pragma unroll
        for (int ks = 0; ks < 8; ++ks) { const bf16x8 qf = nat_frag(L + O_QI, 32 + r32, ks, hi);
                                         a0 = __builtin_amdgcn_mfma_f32_32x32x16_bf16(nat_frag(L + O_KI, r32, ks, hi), qf, a0, 0, 0, 0);
                                         a1 = __builtin_amdgcn_mfma_f32_32x32x16_bf16(nat_frag(L + O_KI, 32 + r32, ks, hi), qf, a1, 0, 0, 0);
                                         if (ks & 1) asm volatile("" ::: "memory"); }
#pragma unroll
        for (int r = 0; r < 16; ++r) a1[r] = crow(r, hi) > r32 ? 0.f : a1[r];
        const bf16x8 pa0 = pk4(a0, 0), pa1 = pk4(a0, 1), pa2 = pk4(a1, 0), pa3 = pk4(a1, 1);
        const s16x4 l0 = tr_read<0 * 4096>(vbV), h0 = tr_read<0 * 4096 + 2048>(vbV), l1 = tr_read<1 * 4096>(vbV), h1 = tr_read<1 * 4096 + 2048>(vbV);
        const s16x4 l2 = tr_read<2 * 4096>(vbV), h2 = tr_read<2 * 4096 + 2048>(vbV), l3 = tr_read<3 * 4096>(vbV), h3 = tr_read<3 * 4096 + 2048>(vbV);
        asm volatile("s_waitcnt lgkmcnt(0)" ::: "memory"); GLA_SBAR();
        o[1] = __builtin_amdgcn_mfma_f32_32x32x16_bf16(pa0, GLA_PK(l0, h0), o[1], 0, 0, 0);
        o[1] = __builtin_amdgcn_mfma_f32_32x32x16_bf16(pa1, GLA_PK(l1, h1), o[1], 0, 0, 0);
        o[1] = __builtin_amdgcn_mfma_f32_32x32x16_bf16(pa2, GLA_PK(l2, h2), o[1], 0, 0, 0);
        o[1] = __builtin_amdgcn_mfma_f32_32x32x16_bf16(pa3, GLA_PK(l3, h3), o[1], 0, 0, 0); }
      __syncthreads();
      { unsigned short* ot = (unsigned short*)(L + O_KI);
#pragma unroll
        for (int tb = 0; tb < 2; ++tb)
#pragma unroll
          for (int r = 0; r < 16; ++r) ot[(32 * tb + crow(r, hi)) * (RS / 2) + 32 * w4 + r32] = (unsigned short)(cvt_pk_bf16(o[tb][r], 0.f) & 0xffffu); }
      if (step < 64) { const int nn = dir ? n - 1 : n + 1; GLA_LOAD(nn); }
#pragma unroll
      for (int kb = 0; kb < 4; ++kb)
#pragma unroll
        for (int g4 = 0; g4 < 4; ++g4) { const f32x4 dc = *(const f32x4*)(L + V_DEC + (32 * kb + 8 * g4 + 4 * hi) * 4);
          S[kb][4 * g4 + 0] *= dc[0]; S[kb][4 * g4 + 1] *= dc[1]; S[kb][4 * g4 + 2] *= dc[2]; S[kb][4 * g4 + 3] *= dc[3]; }
      { const s16x4 l0 = tr_read<0 * 4096>(vbV), h0 = tr_read<0 * 4096 + 2048>(vbV), l1 = tr_read<1 * 4096>(vbV), h1 = tr_read<1 * 4096 + 2048>(vbV);
        const s16x4 l2 = tr_read<2 * 4096>(vbV), h2 = tr_read<2 * 4096 + 2048>(vbV), l3 = tr_read<3 * 4096>(vbV), h3 = tr_read<3 * 4096 + 2048>(vbV);
        asm volatile("s_waitcnt lgkmcnt(0)" ::: "memory"); GLA_SBAR();
        const bf16x8 vf0 = GLA_PK(l0, h0), vf1 = GLA_PK(l1, h1), vf2 = GLA_PK(l2, h2), vf3 = GLA_PK(l3, h3);
#define GLA_UPD(kb) do { const s16x4 a0 = tr_read<(kb) * 512 + 0 * 4096>(vbK), b0 = tr_read<(kb) * 512 + 0 * 4096 + 2048>(vbK), a1 = tr_read<(kb) * 512 + 1 * 4096>(vbK), b1 = tr_read<(kb) * 512 + 1 * 4096 + 2048>(vbK); \
          const s16x4 a2 = tr_read<(kb) * 512 + 2 * 4096>(vbK), b2 = tr_read<(kb) * 512 + 2 * 4096 + 2048>(vbK), a3 = tr_read<(kb) * 512 + 3 * 4096>(vbK), b3 = tr_read<(kb) * 512 + 3 * 4096 + 2048>(vbK); \
          asm volatile("s_waitcnt lgkmcnt(0)" ::: "memory"); GLA_SBAR(); \
          S[kb] = __builtin_amdgcn_mfma_f32_32x32x16_bf16(GLA_PK(a0, b0), vf0, S[kb], 0, 0, 0); S[kb] = __builtin_amdgcn_mfma_f32_32x32x16_bf16(GLA_PK(a1, b1), vf1, S[kb], 0, 0, 0); \
          S[kb] = __builtin_amdgcn_mfma_f32_32x32x16_bf16(GLA_PK(a2, b2), vf2, S[kb], 0, 0, 0); S[kb] = __builtin_amdgcn_mfma_f32_32x32x16_bf16(GLA_PK(a3, b3), vf3, S[kb], 0, 0, 0); } while (0)
        GLA_UPD(0); GLA_UPD(1); GLA_UPD(2); GLA_UPD(3);
#undef GLA_UPD
      }
      __syncthreads();
      const int t = ct >> 2, q4 = ct & 3; const size_t goff = (seq0 + GLA_ROW(n, t)) * 1024 + cb + 32 * q4;
      u32x2 ow[8];
#pragma unroll
      for (int i = 0; i < 8; ++i) ow[i] = *(const u32x2*)(L + O_KI + t * RS + q4 * 64 + i * 8);
      if (!fin) {
#pragma unroll
        for (int i = 0; i < 4; ++i) *(u32x4*)(Kown + goff + 8 * i) = (u32x4){ow[2 * i].x, ow[2 * i].y, ow[2 * i + 1].x, ow[2 * i + 1].y};
      }
      __syncthreads();
      if (fin) {
        float ov[32]; float ss = 0.f;
#pragma unroll
        for (int i = 0; i < 4; ++i) { const u32x4 pw = *(const u32x4*)(Koth + goff + 8 * i);
          ov[8 * i + 0] = bf_lo(ow[2 * i].x) + bf_lo(pw.x); ov[8 * i + 1] = bf_hi(ow[2 * i].x) + bf_hi(pw.x); ov[8 * i + 2] = bf_lo(ow[2 * i].y) + bf_lo(pw.y); ov[8 * i + 3] = bf_hi(ow[2 * i].y) + bf_hi(pw.y);
          ov[8 * i + 4] = bf_lo(ow[2 * i + 1].x) + bf_lo(pw.z); ov[8 * i + 5] = bf_hi(ow[2 * i + 1].x) + bf_hi(pw.z); ov[8 * i + 6] = bf_lo(ow[2 * i + 1].y) + bf_lo(pw.w); ov[8 * i + 7] = bf_hi(ow[2 * i + 1].y) + bf_hi(pw.w); }
#pragma unroll
        for (int i = 0; i < 32; ++i) ss += ov[i] * ov[i];
        ss += __shfl_xor(ss, 1); ss += __shfl_xor(ss, 2);
        const float rstd = 1.0f / sqrtf(ss * (1.0f / 128.0f) + EPS);
#pragma unroll
        for (int i = 0; i < 4; ++i) { const u32x4 gw = *(const u32x4*)(SGb + goff + 8 * i); const f32x4 n0 = *(const f32x4*)(onorm + cb + 32 * q4 + 8 * i), n1 = *(const f32x4*)(onorm + cb + 32 * q4 + 8 * i + 4);
          u32x4 w; w.x = cvt_pk_bf16(ov[8 * i + 0] * rstd * n0[0] * bf_lo(gw.x), ov[8 * i + 1] * rstd * n0[1] * bf_hi(gw.x)); w.y = cvt_pk_bf16(ov[8 * i + 2] * rstd * n0[2] * bf_lo(gw.y), ov[8 * i + 3] * rstd * n0[3] * bf_hi(gw.y));
                   w.z = cvt_pk_bf16(ov[8 * i + 4] * rstd * n1[0] * bf_lo(gw.z), ov[8 * i + 5] * rstd * n1[1] * bf_hi(gw.z)); w.w = cvt_pk_bf16(ov[8 * i + 6] * rstd * n1[2] * bf_lo(gw.w), ov[8 * i + 7] * rstd * n1[3] * bf_hi(gw.w));
          *(u32x4*)(Qb + goff + 8 * i) = w; }
      }
      __syncthreads();
    }
#undef GLA_ROW
#undef GLA_LOAD
  }
  __syncthreads();
}
#undef GLA_PK
#undef GLA_SBAR
}
constexpr int NPHASE = 16;
#ifndef GLA_SIMPLE
#define GLA_SIMPLE 0
#endif
#ifndef ATTN_SIMPLE
#define ATTN_SIMPLE 0
#endif
#ifndef MK_ONE_LAUNCH
#define MK_ONE_LAUNCH 1
#endif
struct Args { const float* in[19]; float* out; unsigned char* ws; int ph_lo, ph_hi; };
__global__ void __launch_bounds__(NWAVES * 64, 2) fwd(Args args) {
    extern __shared__ __attribute__((aligned(16))) unsigned char lds[];
    Frame F;
    F.lds = (LAS unsigned char*)lds;
    F.MISC = (volatile LAS unsigned*)(F.lds + MISC_OFF);
    F.tid = threadIdx.x; F.lane = F.tid & 63; F.wave = __builtin_amdgcn_readfirstlane(F.tid >> 6);
    F.G = gridDim.x; { const int bx = blockIdx.x; F.vcu = (F.G % 8 == 0) ? (bx % 8) * (F.G / 8) + bx / 8 : bx; }
    unsigned char* ws = args.ws;
    for (int u = F.tid; u < (LDS_BYTES - LDSCTL_OFF) / 4; u += NWAVES * 64) ((LAS unsigned*)(F.lds + LDSCTL_OFF))[u] = 0u;
    __syncthreads();
    const int lo = args.ph_lo, hi = args.ph_hi;
    XcdBarrier bar; bar.bar = (unsigned*)(ws + WS_CTL); bar.x = 0; bar.st = nullptr;
    if (hi - lo > 1) bar = xcd_barrier_post((unsigned*)(ws + WS_CTL), F.MISC + 8);
#ifndef ONLY_PHASE
#define ONLY_PHASE -1
#endif
#define IN(k) (lo <= (k) && (k) < hi && (ONLY_PHASE < 0 || ONLY_PHASE == (k)))
#ifndef DUP_MASK
#define DUP_MASK 0
#endif
#ifndef PROBE_NULL_GEMM
#define PROBE_NULL_GEMM 0
#endif
#ifndef DUP_GLA
#define DUP_GLA 0
#endif
#define SEAM(k) do { if (IN(k) && IN((k) + 1)) xcd_barrier(bar); } while (0)
    const float* const* in = args.in;
    bf16* hD = (bf16*)args.out;
    bf16* hB = (bf16*)(ws + WS_B0 + (size_t)SLACK * ROWB);
    const pg8::f32x2* rope = (const pg8::f32x2*)(ws + WS_ROPE);
    using pg8::Gemm; using pg8::StaticOrder;
    const int cid = (int)blockIdx.x;

    if (IN(0)) { p0_prologue(F, in, ws, hD); } SEAM(0);
    if (IN(1)) { Gemm g{hD, (const bf16*)(ws + W_IN), 1024, 1024, 1024}; StaticOrder S; S.init(MT, 5, F.G, cid);
        pg8::EpiProj E{(bf16*)(ws + R_CQKV), (float*)(ws + R_SSQ), (bf16*)(ws + R_KROPE), rope};
        pg8::gemm_phase<pg8::EpiProj, StaticOrder, true, true>(F.lds + RING_OFF, g, S, E); } SEAM(1);
    if (IN(2)) {
        { Gemm g{(const bf16*)(ws + R_CQKV), (const bf16*)(ws + W_UQ), 768, 1024, 768}; StaticOrder S; S.init(MT, 6, F.G, cid);
          pg8::EpiQ E{(bf16*)(ws + R_Q), (const float*)(ws + R_SSQ), rope};
          pg8::gemm_phase<pg8::EpiQ, StaticOrder, true, true>(F.lds + RING_OFF, g, S, E); }
        { Gemm g{(const bf16*)(ws + R_CQKV) + 768, (const bf16*)(ws + W_UKV), 256, 1024, 256}; StaticOrder S; S.init(MT, 8, F.G, cid);
          pg8::EpiKV E{(bf16*)(ws + R_KV), (const float*)(ws + R_SSQ)};
          pg8::gemm_phase<pg8::EpiKV, StaticOrder, true, true>(F.lds + RING_OFF, g, S, E); }
    } SEAM(2);
    if (IN(3)) {
#if ATTN_SIMPLE
        attn_simple(F, (const bf16*)(ws + R_Q), (const bf16*)(ws + R_KV), (const bf16*)(ws + R_KROPE), (bf16*)(ws + R_CQKV));
#else
        fa2::attn_phase(F.vcu, F.G, (const bf16*)(ws + R_Q), (const bf16*)(ws + R_KV), (const bf16*)(ws + R_KROPE), (bf16*)(ws + R_CQKV), (char*)lds);
#endif
        { const int nlast = (NB * 16 * fa::NQC) % F.G; if (F.vcu >= nlast) tail_jobs_0(F, in, ws, F.vcu - nlast, F.G - nlast); }
    } SEAM(3);
    if (IN(4)) { Gemm g{(const bf16*)(ws + R_CQKV), (const bf16*)(ws + W_O), 1024, 1024, 1024}; StaticOrder S; S.init(MT, 4, F.G, cid);
        pg8::EpiResidLN<false, false> E{hD, nullptr, nullptr, nullptr, hB, (pg8::f32x2*)(ws + WS_SUM1) + SLACK, nullptr};
        pg8::gemm_phase<pg8::EpiResidLN<false, false>, StaticOrder, true, true>(F.lds + RING_OFF, g, S, E);
        { const int nfull = (MT * 4) % F.G; if (cid >= nfull) tail_jobs_a(F, in, ws, cid - nfull, F.G - nfull); } } SEAM(4);
#if PROBE_NULL_GEMM
    if (IN(5)) { Gemm g{hD, (const bf16*)(ws + W_HIN), 1024, 1024, 1024}; StaticOrder S; S.init(MT, 20, F.G, cid);
        pg8::EpiNull E{(float*)(ws + WS_CTL + 32768)};
        pg8::gemm_phase<pg8::EpiNull, StaticOrder, true, true>(F.lds + RING_OFF, g, S, E); }
#endif
    if (IN(6)) { Gemm g{hB - 1024, (const bf16*)(ws + W_UP0), 1024, 1024, 1024}; StaticOrder S; S.init(MT_UP, 22, F.G, cid);
        pg8::EpiConvGate E{(bf16*)(ws + R_ACT), in[14], in[15], (const pg8::f32x2*)(ws + WS_SUM1) + SLACK, (const float*)(ws + C1_UP0), (const float*)(ws + C2_UP0)};
        pg8::gemm_phase<pg8::EpiConvGate, StaticOrder, true, true, true>(F.lds + RING_OFF, g, S, E); } SEAM(6);
    if (IN(7)) { Gemm g{(const bf16*)(ws + R_ACT), (const bf16*)(ws + W_DN0), DFF, DFF, DFF}; StaticOrder S; S.init(MT, 4, F.G, cid);
        pg8::EpiResidLN<true, false> E{hB, (const pg8::f32x2*)(ws + WS_SUM1) + SLACK, in[17] + 0 * 1024, in[18] + 0 * 1024, hD, (pg8::f32x2*)(ws + WS_SUM2) + SLACK, nullptr};
        pg8::gemm_phase<pg8::EpiResidLN<true, false>, StaticOrder, true, true>(F.lds + RING_OFF, g, S, E);
        { const int nfull = (MT * 4) % F.G; if (cid >= nfull) tail_jobs_b(F, in, ws, cid - nfull, F.G - nfull); } } SEAM(7);
    if (IN(9)) { Gemm g{hD, (const bf16*)(ws + W_HIN), 1024, 1024, 1024}; StaticOrder S; S.init(MT, 20, F.G, cid);
        pg8::EpiHgIn E{hB, (bf16*)(ws + R_HV), (bf16*)(ws + R_HKF), (bf16*)(ws + R_HKB), (bf16*)(ws + R_HSG), (const float*)(ws + WS_LB), (const pg8::f32x2*)(ws + WS_SUM2) + SLACK, (const float*)(ws + C1_HG), (const float*)(ws + C2_HG)};
        pg8::gemm_phase<pg8::EpiHgIn, StaticOrder, true, true>(F.lds + RING_OFF, g, S, E); } SEAM(9);
    if (IN(10)) {
#if GLA_SIMPLE
        gla_simple(F, hB, (const bf16*)(ws + R_HV), (bf16*)(ws + R_HKF), (const bf16*)(ws + R_HKB), (const bf16*)(ws + R_HSG), in[11]);
#else
        gla::gla_phase(F.vcu, F.G, hB, (const bf16*)(ws + R_HV), (bf16*)(ws + R_HKF), (bf16*)(ws + R_HKB), (const bf16*)(ws + R_HSG), in[11], (char*)lds);
#endif
    } SEAM(10);
    if (IN(11)) {
        { const int gt = (F.vcu * NWAVES + F.wave) * 64 + F.lane, NGT = F.G * NWAVES * 64; GAS v4u* z0 = (GAS v4u*)(ws + R_HSG); GAS v4u* z1 = (GAS v4u*)(ws + R_XB3 + (size_t)M * ROWB);
          for (int i = gt; i < SLACK * (int)ROWB / 16; i += NGT) { z0[i] = (v4u){0u, 0u, 0u, 0u}; z1[i] = (v4u){0u, 0u, 0u, 0u}; } }
        Gemm g{hB, (const bf16*)(ws + W_HO), 1024, 1024, 1024}; StaticOrder S; S.init(MT, 4, F.G, cid);
        pg8::EpiResidLN<true, false> E{hD, (const pg8::f32x2*)(ws + WS_SUM2) + SLACK, in[17] + 1 * 1024, in[18] + 1 * 1024, (bf16*)(ws + R_XB3), (pg8::f32x2*)(ws + WS_SUM3) + SLACK, nullptr};
        pg8::gemm_phase<pg8::EpiResidLN<true, false>, StaticOrder, true, true>(F.lds + RING_OFF, g, S, E); } SEAM(11);
    if (IN(13)) { Gemm g{(const bf16*)(ws + R_XB3) - 1024, (const bf16*)(ws + W_UP1), 1024, 1024, 1024}; StaticOrder S; S.init(MT_UP, 22, F.G, cid);
        pg8::EpiConvGate E{(bf16*)(ws + R_ACT), in[14] + 3 * NUP, in[15] + NUP, (const pg8::f32x2*)(ws + WS_SUM3) + SLACK, (const float*)(ws + C1_UP1), (const float*)(ws + C2_UP1)};
        pg8::gemm_phase<pg8::EpiConvGate, StaticOrder, true, true, true>(F.lds + RING_OFF, g, S, E); } SEAM(13);
    if (IN(14)) { Gemm g{(const bf16*)(ws + R_ACT), (const bf16*)(ws + W_DN1), DFF, DFF, DFF}; StaticOrder S; S.init(MT, 4, F.G, cid);
        pg8::EpiResidLN<true, true> E{(const bf16*)(ws + R_XB3), (const pg8::f32x2*)(ws + WS_SUM3) + SLACK, in[17] + 2 * 1024, in[18] + 2 * 1024, nullptr, nullptr, args.out};
        pg8::gemm_phase<pg8::EpiResidLN<true, true>, StaticOrder, true, true>(F.lds + RING_OFF, g, S, E); } SEAM(14);
    if (IN(15)) { ln_final(F, args.out, in[17] + 3 * 1024, in[18] + 3 * 1024); }
#undef IN
#undef SEAM
}

__global__ void nan_fill(float* o, long n) { const float q = __builtin_nanf(""); for (long i = blockIdx.x * 256L + threadIdx.x; i < n; i += gridDim.x * 256L) o[i] = q; }
extern "C" void kernel_launch(void* const* d_in, const int* in_sizes, int n_in, void* d_out, int out_size, void* d_ws, size_t ws_size, hipStream_t stream) {
    static int grid = 0;
    if (grid == 0) {
        bool ok = (n_in == 19) && in_sizes[0] == 16 * SEQ * 1024 && in_sizes[1] == 4 * SEQ * 1024 && out_size == NB * SEQ * 1024 && ws_size >= WS_END;
        int dev = 0, cus = 0;
        if (ok) ok = hipGetDevice(&dev) == hipSuccess && hipDeviceGetAttribute(&cus, hipDeviceAttributeMultiprocessorCount, dev) == hipSuccess;
        if (ok) ok = hipFuncSetAttribute((const void*)fwd, hipFuncAttributeMaxDynamicSharedMemorySize, LDS_BYTES) == hipSuccess;
        if (!ok) { fprintf(stderr, "kernel_launch: unexpected shapes / workspace (%zu) / device\n", ws_size); grid = -1; }
        else grid = cus;
        (void)hipGetLastError();
    }
    if (grid < 0) { hipLaunchKernelGGL(nan_fill, dim3(1024), dim3(256), 0, stream, (float*)d_out, (long)out_size); return; }
    (void)hipMemsetAsync((char*)d_ws + WS_CTL, 0, CTL_ZERO_BYTES, stream);
    Args a{};
    for (int i = 0; i < 19; ++i) a.in[i] = (const float*)d_in[i];
    a.out = (float*)d_out; a.ws = (unsigned char*)d_ws;
#if MK_ONE_LAUNCH
    a.ph_lo = 0; a.ph_hi = NPHASE;
    hipLaunchKernelGGL(fwd, dim3(grid), dim3(NWAVES * 64), LDS_BYTES, stream, a);
#else
    for (int p = 0; p < NPHASE; ++p) { if ((p == 5 && !PROBE_NULL_GEMM) || p == 8 || p == 12) continue;
        for (int r = 0; r < 1 + ((DUP_MASK >> p) & 1); ++r) { a.ph_lo = p; a.ph_hi = p + 1; hipLaunchKernelGGL(fwd, dim3(grid), dim3(NWAVES * 64), LDS_BYTES, stream, a); }
        if (p == 10 && DUP_GLA) for (int q = 9; q <= 10; ++q) { a.ph_lo = q; a.ph_hi = q + 1; hipLaunchKernelGGL(fwd, dim3(grid), dim3(NWAVES * 64), LDS_BYTES, stream, a); } }
#endif
}
```

```cpp
#include <hip/hip_runtime.h>
#include <cstdio>
constexpr int NB = 20;
constexpr int LP = 4160;
constexpr int PADR = 48, LTOK = 4112, SEQ = 4096, DM = 1024;
constexpr int M = NB * LP;
constexpr int MT = M / 256;
constexpr int DFF = 2816, NUP = 2 * DFF;
constexpr int NBLK62 = (M + 61) / 62;
constexpr int MT_UP = (NBLK62 + 3) / 4;
constexpr float EPS = 1e-6f, ALPHA = 1.4142135623730951f;
constexpr float SM_C = 0.10206207261596575f * 1.4426950408889634f;
#include <cstdint>
namespace pg8 {
#define PG8_LAS __attribute__((address_space(3)))
typedef unsigned short bf16_t;
typedef short bf16x8 __attribute__((ext_vector_type(8)));
typedef float f32x4 __attribute__((ext_vector_type(4)));
typedef unsigned u32x4 __attribute__((ext_vector_type(4)));
typedef unsigned u32x2 __attribute__((ext_vector_type(2)));
constexpr int BM = 256, BK = 64, HALF = 128, HTB = HALF * BK * 2  , STAGE_BYTES = 8 * HTB, NXCD = 8, WGM = 8;

__host__ __device__ __forceinline__ int lds_byte(int r, int c) { const int st = (r >> 4) * 2 + (c >> 5), rr = r & 15, cc = c & 31, ob = rr * 64 + cc * 2; return st * 1024 + (ob ^ (((ob >> 9) & 1) << 5)); }
__host__ __device__ __forceinline__ void stage_rc(int b, int& R, int& C) { const int st = b / 1024, sb = b % 1024, swz = sb ^ (((sb >> 9) & 1) << 5); R = (st >> 1) * 16 + swz / 64; C = (st & 1) * 32 + (swz % 64) / 2; }
__host__ __device__ __forceinline__ int perm32(int rho) { const int n = rho >> 4, i = rho & 15; return 8 * (i >> 2) + 4 * n + (i & 3); }

struct Unit { int pm, pn; };
struct Gemm { const bf16_t* A; const bf16_t* Bt; int K, lda, ldb; };

struct StaticOrder {
    int nM, nN, nwg, G, c;
    __host__ __device__ void init(int nM_, int nN_, int G_, int c_) { nM = nM_; nN = nN_; nwg = nM * nN; G = G_; c = c_; }
    __host__ __device__ bool next(int i, Unit& u) const {
        const long L = (long)i * G + c; if (L >= nwg) return false;
        int wgid = (int)L; { const int q = nwg / NXCD, r = nwg % NXCD, xcd = wgid % NXCD, off = wgid / NXCD; wgid = (xcd < r ? xcd * (q + 1) : r * (q + 1) + (xcd - r) * q) + off; }
        const int nig = WGM * nN, gid = wgid / nig, fm = gid * WGM, gsz = (nM - fm) < WGM ? (nM - fm) : WGM;
        u.pm = fm + ((wgid % nig) % gsz); u.pn = (wgid % nig) / gsz; return true;
    }
    __device__ __forceinline__ void a_ready(const Unit&) const {}
    __device__ __forceinline__ void done(const Unit&) const {}
};
__device__ __forceinline__ unsigned cvt_pk_bf16(float lo, float hi) { unsigned r; asm volatile("v_cvt_pk_bf16_f32 %0, %1, %2" : "=v"(r) : "v"(lo), "v"(hi)); return r; }
__device__ __forceinline__ float bf_lo(unsigned w) { return __uint_as_float(w << 16); }
__device__ __forceinline__ float bf_hi(unsigned w) { return __uint_as_float(w & 0xffff0000u); }
typedef float f32x2 __attribute__((ext_vector_type(2)));
__device__ __forceinline__ u32x4 pack8(const f32x4 v0, const f32x4 v1) { u32x4 w; w.x = cvt_pk_bf16(v0[0], v0[1]); w.y = cvt_pk_bf16(v0[2], v0[3]); w.z = cvt_pk_bf16(v1[0], v1[1]); w.w = cvt_pk_bf16(v1[2], v1[3]); return w; }
__device__ __forceinline__ void rope8(f32x4& v0, f32x4& v1, const f32x2* tab, int pos, int i0) {
    const f32x2* t = tab + pos * 16 + i0;
    const f32x2 c0 = t[0], c1 = t[1], c2 = t[2], c3 = t[3];
    f32x4 a, b;
    a[0] = v0[0] * c0.x - v0[1] * c0.y; a[1] = v0[0] * c0.y + v0[1] * c0.x;
    a[2] = v0[2] * c1.x - v0[3] * c1.y; a[3] = v0[2] * c1.y + v0[3] * c1.x;
    b[0] = v1[0] * c2.x - v1[1] * c2.y; b[1] = v1[0] * c2.y + v1[1] * c2.x;
    b[2] = v1[2] * c3.x - v1[3] * c3.y; b[3] = v1[2] * c3.y + v1[3] * c3.x;
    v0 = a; v1 = b;
}
__device__ __forceinline__ void glds16(const void* src, PG8_LAS unsigned char* dst_wave_base) { __builtin_amdgcn_global_load_lds((const unsigned*)src, (PG8_LAS unsigned*)dst_wave_base, 16, 0, 0); }
struct EpiProj {
    static constexpr bool PERM = true, AFTER_DRAIN = false, STAGED = false;
    bf16_t* cqkv; float* ssq; bf16_t* krope; const f32x2* rope;
    __device__ __forceinline__ void operator()(const f32x4 (&acc)[2][2][4][2], const Unit& u, int wr, int wc, int fr, int fq, PG8_LAS unsigned char*) const {
        const int row0 = u.pm * BM + wr * 64 + fr;
        if (u.pn < 4) {
            const int col0 = u.pn * BM + wc * 32 + 8 * fq;
#pragma unroll
            for (int ai = 0; ai < 2; ++ai)
#pragma unroll
                for (int m = 0; m < 4; ++m) { const int row = row0 + ai * HALF + m * 16; float s = 0.f;
#pragma unroll
                    for (int bj = 0; bj < 2; ++bj) { const f32x4 v0 = acc[ai][bj][m][0], v1 = acc[ai][bj][m][1];
                        s += (v0[0] * v0[0] + v0[1] * v0[1]) + (v0[2] * v0[2] + v0[3] * v0[3]) + (v1[0] * v1[0] + v1[1] * v1[1]) + (v1[2] * v1[2] + v1[3] * v1[3]);
                        *(u32x4*)(cqkv + (size_t)row * 1024 + col0 + bj * HALF) = pack8(v0, v1); }
                    s += __shfl_xor(s, 16); s += __shfl_xor(s, 32);
                    if (fq == 0) __hip_atomic_fetch_add((unsigned*)ssq + (size_t)row * 2 + (u.pn == 3 ? 1 : 0), __float2uint_rn(s * 4096.0f), __ATOMIC_RELAXED, __HIP_MEMORY_SCOPE_AGENT); }
        } else if (wc == 0) {
#pragma unroll
            for (int ai = 0; ai < 2; ++ai)
#pragma unroll
                for (int m = 0; m < 4; ++m) { const int row = row0 + ai * HALF + m * 16; int pos = row % LP - PADR; pos = pos < 0 ? 0 : pos;
                    f32x4 v0 = acc[ai][0][m][0], v1 = acc[ai][0][m][1]; rope8(v0, v1, rope, pos, 4 * fq);
                    *(u32x4*)(krope + (size_t)row * 32 + 8 * fq) = pack8(v0, v1); }
        }
    }
};
struct EpiQ {
    static constexpr bool PERM = true, AFTER_DRAIN = false, STAGED = true;
    bf16_t* Q; const float* ssq; const f32x2* rope;
    __device__ __forceinline__ void stage(PG8_LAS unsigned char* slot, const Unit& u, int tid, int wid) const { asm volatile("" : "+v"(tid)); if (tid < 128) glds16(ssq + ((size_t)u.pm * BM + tid * 2) * 2, slot + wid * 1024); }
    __device__ __forceinline__ void operator()(const f32x4 (&acc)[2][2][4][2], const Unit& u, int wr, int wc, int fr, int fq, PG8_LAS unsigned char* slot) const {
        const int col0 = u.pn * BM + wc * 32 + 8 * fq; const PG8_LAS unsigned char* rb = slot + (wr * 64 + fr) * 8;
#pragma unroll
        for (int ai = 0; ai < 2; ++ai)
#pragma unroll
            for (int m = 0; m < 4; ++m) { const int lr = ai * HALF + wr * 64 + m * 16 + fr, row = u.pm * BM + lr; int pos = row % LP - PADR; pos = pos < 0 ? 0 : pos;
                const float ss = (float)*(const PG8_LAS unsigned*)(rb + (ai * HALF + m * 16) * 8) * (1.0f / 4096.0f);
                const float rstd = SM_C / sqrtf(ss * (1.0f / 768.0f) + EPS);
#pragma unroll
                for (int bj = 0; bj < 2; ++bj) { const int c = col0 + bj * HALF, d = c % 96; f32x4 v0 = acc[ai][bj][m][0] * rstd, v1 = acc[ai][bj][m][1] * rstd;
                    if (d >= 64) rope8(v0, v1, rope, pos, (d - 64) >> 1);
                    *(u32x4*)(Q + (size_t)row * 1536 + c) = pack8(v0, v1); }
                asm volatile("" ::: "memory"); }
    }
};
struct EpiKV {
    static constexpr bool PERM = true, AFTER_DRAIN = false, STAGED = true;
    bf16_t* KV; const float* ssq;
    __device__ __forceinline__ void stage(PG8_LAS unsigned char* slot, const Unit& u, int tid, int wid) const { asm volatile("" : "+v"(tid)); if (tid < 128) glds16(ssq + ((size_t)u.pm * BM + tid * 2) * 2, slot + wid * 1024); }
    __device__ __forceinline__ void operator()(const f32x4 (&acc)[2][2][4][2], const Unit& u, int wr, int wc, int fr, int fq, PG8_LAS unsigned char* slot) const {
        const int col0 = u.pn * BM + wc * 32 + 8 * fq; const PG8_LAS unsigned char* rb = slot + (wr * 64 + fr) * 8 + 4;
#pragma unroll
        for (int ai = 0; ai < 2; ++ai)
#pragma unroll
            for (int m = 0; m < 4; ++m) { const int lr = ai * HALF + wr * 64 + m * 16 + fr, row = u.pm * BM + lr;
                const float rstd = 1.0f / sqrtf((float)*(const PG8_LAS unsigned*)(rb + (ai * HALF + m * 16) * 8) * (1.0f / (4096.0f * 256.0f)) + EPS);
#pragma unroll
                for (int bj = 0; bj < 2; ++bj) *(u32x4*)(KV + (size_t)row * 2048 + col0 + bj * HALF) = pack8(acc[ai][bj][m][0] * rstd, acc[ai][bj][m][1] * rstd); }
    }
};
__device__ __forceinline__ void mean_rstd(const u32x2 raw, float& mean, float& rstd) {
    mean = (float)(int)raw.x * (1.0f / (4096.0f * 1024.0f)); rstd = 1.0f / sqrtf(fmaxf((float)raw.y * (1.0f / (32768.0f * 1024.0f)) - mean * mean, 0.f) + EPS);
}
template <bool BASE_LN, bool OUT_F32> struct EpiResidLN {
    static constexpr bool PERM = false, AFTER_DRAIN = false, STAGED = BASE_LN;
    const bf16_t* hb; const f32x2* SUMp; const float* g; const float* b; bf16_t* xo; f32x2* SUMo; float* of32;
    __device__ __forceinline__ void stage(PG8_LAS unsigned char* slot, const Unit& u, int tid, int wid) const {
        asm volatile("" : "+v"(tid));
        const int c = tid; const void* src = c < 64 ? (const void*)(g + u.pn * BM + c * 4) : c < 128 ? (const void*)(b + u.pn * BM + (c - 64) * 4) : (const void*)(SUMp + u.pm * BM + (c - 128) * 2);
        if (c < 256) glds16(src, slot + wid * 1024);
    }
    __device__ __forceinline__ void operator()(const f32x4 (&acc)[2][2][4][2], const Unit& u, int wr, int wc, int fr, int fq, PG8_LAS unsigned char* slot) const {
        const int row0 = u.pm * BM + wr * 64 + fr, col0 = u.pn * BM + wc * 32 + 4 * fq, lc0 = wc * 32 + 4 * fq;
#pragma unroll
        for (int ai = 0; ai < 2; ++ai)
#pragma unroll
            for (int m = 0; m < 4; ++m) { const int lr = ai * HALF + wr * 64 + m * 16 + fr, row = u.pm * BM + lr; const size_t off = (size_t)row * 1024 + col0; const int sq = row % LP;
                float mean = 0.f, rstd = 0.f; if (BASE_LN) mean_rstd(*(const PG8_LAS u32x2*)(slot + (wr * 64 + fr) * 8 + (2048 + (ai * HALF + m * 16) * 8)), mean, rstd);
                const bool pad = sq < PADR; float s = 0.f, q = 0.f; f32x4 x[2][2];
#pragma unroll
                for (int bj = 0; bj < 2; ++bj)
#pragma unroll
                    for (int n = 0; n < 2; ++n) { const u32x2 hw = *(const u32x2*)(hb + off + bj * HALF + n * 16);
                        f32x4 hv; hv[0] = bf_lo(hw.x); hv[1] = bf_hi(hw.x); hv[2] = bf_lo(hw.y); hv[3] = bf_hi(hw.y);
                        if (BASE_LN) { const f32x4 gv = *(const PG8_LAS f32x4*)(slot + (lc0 + bj * HALF + n * 16) * 4), bv = *(const PG8_LAS f32x4*)(slot + 1024 + (lc0 + bj * HALF + n * 16) * 4);
                            hv = (hv - mean) * rstd * gv + bv; if (pad) hv = (f32x4){0.f, 0.f, 0.f, 0.f}; }
                        const f32x4 xv = hv * ALPHA + acc[ai][bj][m][n]; x[bj][n] = xv;
                        s += (xv[0] + xv[1]) + (xv[2] + xv[3]); q += (xv[0] * xv[0] + xv[1] * xv[1]) + (xv[2] * xv[2] + xv[3] * xv[3]); }
                if (OUT_F32) { if (sq >= 64) { float* orow = of32 + ((size_t)(row / LP) * SEQ + (sq - 64)) * 1024 + col0;
#pragma unroll
                        for (int bj = 0; bj < 2; ++bj)
#pragma unroll
                            for (int n = 0; n < 2; ++n) *(f32x4*)(orow + bj * HALF + n * 16) = x[bj][n]; }
                } else {
#pragma unroll
                    for (int bj = 0; bj < 2; ++bj)
#pragma unroll
                        for (int n = 0; n < 2; ++n) { u32x2 w; w.x = cvt_pk_bf16(x[bj][n][0], x[bj][n][1]); w.y = cvt_pk_bf16(x[bj][n][2], x[bj][n][3]); *(u32x2*)(xo + off + bj * HALF + n * 16) = w; }
                    s += __shfl_xor(s, 16); q += __shfl_xor(q, 16); s += __shfl_xor(s, 32); q += __shfl_xor(q, 32);
                    if (fq == 0) { unsigned* sp = (unsigned*)(SUMo + row); __hip_atomic_fetch_add(sp, (unsigned)__float2int_rn(s * 4096.0f), __ATOMIC_RELAXED, __HIP_MEMORY_SCOPE_AGENT); __hip_atomic_fetch_add(sp + 1, __float2uint_rn(q * 32768.0f), __ATOMIC_RELAXED, __HIP_MEMORY_SCOPE_AGENT); } } }
        (void)row0;
    }
};
struct EpiHgIn {
    static constexpr bool PERM = true, AFTER_DRAIN = false, STAGED = true;
    bf16_t* q; bf16_t* v; bf16_t* kf; bf16_t* kb; bf16_t* sg; const float* lb;
    const f32x2* SUM; const float* c1; const float* c2;
    __device__ __forceinline__ void stage(PG8_LAS unsigned char* slot, const Unit& u, int tid, int wid) const {
        asm volatile("" : "+v"(tid));
        const int c = tid, t = u.pn >> 2;
        const void* src = c < 64 ? (const void*)(c1 + u.pn * BM + c * 4) : c < 128 ? (const void*)(c2 + u.pn * BM + (c - 64) * 4)
                        : c < 192 ? (const void*)(lb + ((t == 3) ? 1024 : 0) + (u.pn & 3) * BM + (c - 128) * 4) : (const void*)(SUM + u.pm * BM + (c - 192) * 2);
        if (c < 320) glds16(src, slot + wid * 1024);
    }
    __device__ __forceinline__ void operator()(const f32x4 (&acc)[2][2][4][2], const Unit& u, int wr, int wc, int fr, int fq, PG8_LAS unsigned char* slot) const {
        const int t = u.pn >> 2, col0 = (u.pn & 3) * BM + wc * 32 + 8 * fq, lc0 = wc * 32 + 8 * fq;
        bf16_t* dst = t == 0 ? q : t == 1 ? v : t == 2 ? kf : t == 3 ? kb : sg;
#pragma unroll
        for (int bj = 0; bj < 2; ++bj) { const int c = col0 + bj * HALF, lc = lc0 + bj * HALF;
            f32x4 om0 = {1.f, 1.f, 1.f, 1.f}, om1 = om0;
            if (t == 2 || t == 3) { om0 = 1.0f - *(const PG8_LAS f32x4*)(slot + 2048 + lc * 4); om1 = 1.0f - *(const PG8_LAS f32x4*)(slot + 2048 + lc * 4 + 16); }
            const f32x4 k10 = *(const PG8_LAS f32x4*)(slot + lc * 4), k11 = *(const PG8_LAS f32x4*)(slot + lc * 4 + 16), k20 = *(const PG8_LAS f32x4*)(slot + 1024 + lc * 4), k21 = *(const PG8_LAS f32x4*)(slot + 1024 + lc * 4 + 16);
#pragma unroll
            for (int ai = 0; ai < 2; ++ai)
#pragma unroll
                for (int m = 0; m < 4; ++m) { const int lr = ai * HALF + wr * 64 + m * 16 + fr, row = u.pm * BM + lr; const bool pad = (row % LP) < PADR;
                    float mean, rstd; mean_rstd(*(const PG8_LAS u32x2*)(slot + (wr * 64 + fr) * 8 + (3072 + (ai * HALF + m * 16) * 8)), mean, rstd);
                    f32x4 v0 = (acc[ai][bj][m][0] - k10 * mean) * rstd + k20, v1 = (acc[ai][bj][m][1] - k11 * mean) * rstd + k21;
                    if (pad) { v0 = (f32x4){0.f, 0.f, 0.f, 0.f}; v1 = v0; }
                    if (t == 2 || t == 3) {
#pragma unroll
                        for (int j = 0; j < 4; ++j) { v0[j] = pad ? 0.f : om0[j] * __builtin_amdgcn_rcpf(1.0f + __builtin_amdgcn_exp2f(v0[j] * 1.4426950408889634f));
                                                      v1[j] = pad ? 0.f : om1[j] * __builtin_amdgcn_rcpf(1.0f + __builtin_amdgcn_exp2f(v1[j] * 1.4426950408889634f)); }
                    } else if (t == 4) {
#pragma unroll
                        for (int j = 0; j < 4; ++j) { v0[j] = v0[j] * __builtin_amdgcn_rcpf(1.0f + __builtin_amdgcn_exp2f(v0[j] * -1.4426950408889634f));
                                                      v1[j] = v1[j] * __builtin_amdgcn_rcpf(1.0f + __builtin_amdgcn_exp2f(v1[j] * -1.4426950408889634f)); }
                    }
                    *(u32x4*)(dst + (size_t)row * 1024 + c) = pack8(v0, v1); } }
    }
};
struct EpiConvGate {
    static constexpr bool PERM = true, AFTER_DRAIN = false, STAGED = true;
    bf16_t* act; const float* cw; const float* cb;
    const f32x2* SUM; const float* c1; const float* c2;
    static __device__ __forceinline__ float dpp_mirror(float x) { return __builtin_bit_cast(float, __builtin_amdgcn_update_dpp(0, __builtin_bit_cast(int, x), 0x140, 0xf, 0xf, false)); }
    static __device__ __forceinline__ float dpp_prev(float old, float x) { return __builtin_bit_cast(float, __builtin_amdgcn_update_dpp(__builtin_bit_cast(int, old), __builtin_bit_cast(int, x), 0x111, 0xf, 0xf, false)); }
    static __device__ __forceinline__ float dpp_next(float old, float x) { return __builtin_bit_cast(float, __builtin_amdgcn_update_dpp(__builtin_bit_cast(int, old), __builtin_bit_cast(int, x), 0x101, 0xf, 0xf, false)); }
    __device__ __forceinline__ void stage(PG8_LAS unsigned char* slot, const Unit& u, int tid, int wid) const {
        asm volatile("" : "+v"(tid));
        const int c = tid; const void* src;
        if (c < 384) { const int arr = c >> 5, off = (c & 31) * 4;
            src = arr < 3 ? (const void*)(cw + arr * NUP + 128 * u.pn + off) : arr == 3 ? (const void*)(cb + 128 * u.pn + off) : arr < 7 ? (const void*)(cw + (arr - 4) * NUP + DFF + 128 * u.pn + off)
                : arr == 7 ? (const void*)(cb + DFF + 128 * u.pn + off) : arr == 8 ? (const void*)(c1 + 256 * u.pn + off) : arr == 9 ? (const void*)(c1 + 256 * u.pn + 128 + off)
                : arr == 10 ? (const void*)(c2 + 256 * u.pn + off) : (const void*)(c2 + 256 * u.pn + 128 + off);
        } else { const int i = 2 * (c - 384); src = (const void*)(SUM + (62 * (4 * u.pm + (i >> 6)) - 1 + (i & 63))); }
        glds16(src, slot + wid * 1024);
    }
    __device__ __forceinline__ void operator()(const f32x4 (&acc)[2][2][4][2], const Unit& u, int wr, int wc, int fr, int fq, PG8_LAS unsigned char* slot) const {
        const int cv0 = 128 * u.pn + 32 * wc + 8 * fq;
        float mean[2][4], rstd[2][4];
#pragma unroll
        for (int ai = 0; ai < 2; ++ai)
#pragma unroll
            for (int m = 0; m < 4; ++m) { const int arow = 62 * (4 * u.pm + 2 * ai + wr) - 1 + 16 * m + fr; const bool ok = arow >= 0 && arow < M && (arow % LP) >= PADR;
                mean_rstd(*(const PG8_LAS u32x2*)(slot + (64 * wr + fr) * 8 + (6144 + (128 * ai + 16 * m) * 8)), mean[ai][m], rstd[ai][m]); if (!ok) { rstd[ai][m] = 0.f; mean[ai][m] = 0.f; } }
#pragma unroll
        for (int n = 0; n < 2; ++n) { const int cv = cv0 + 4 * n;
            const int lc = (32 * wc + 8 * fq + 4 * n) * 4;
            const f32x4 k1v = *(const PG8_LAS f32x4*)(slot + 8 * 512 + lc), k1g = *(const PG8_LAS f32x4*)(slot + 9 * 512 + lc), k2v = *(const PG8_LAS f32x4*)(slot + 10 * 512 + lc), k2g = *(const PG8_LAS f32x4*)(slot + 11 * 512 + lc);
            const f32x4 wv0 = *(const PG8_LAS f32x4*)(slot + 0 * 512 + lc), wv1 = *(const PG8_LAS f32x4*)(slot + 1 * 512 + lc), wv2 = *(const PG8_LAS f32x4*)(slot + 2 * 512 + lc), bv = *(const PG8_LAS f32x4*)(slot + 3 * 512 + lc);
            const f32x4 wg0 = *(const PG8_LAS f32x4*)(slot + 4 * 512 + lc), wg1 = *(const PG8_LAS f32x4*)(slot + 5 * 512 + lc), wg2 = *(const PG8_LAS f32x4*)(slot + 6 * 512 + lc), bg = *(const PG8_LAS f32x4*)(slot + 7 * 512 + lc);
#pragma unroll
            for (int ai = 0; ai < 2; ++ai) { const int J = 4 * u.pm + 2 * ai + wr;
                f32x4 o[4];
#pragma unroll
                for (int j = 0; j < 4; ++j) {
                    float uv[4], ug[4], mv[4], mg[4];
#pragma unroll
                    for (int m = 0; m < 4; ++m) { const bool okr = rstd[ai][m] != 0.f; uv[m] = (acc[ai][0][m][n][j] - k1v[j] * mean[ai][m]) * rstd[ai][m] + (okr ? k2v[j] : 0.f); ug[m] = (acc[ai][1][m][n][j] - k1g[j] * mean[ai][m]) * rstd[ai][m] + (okr ? k2g[j] : 0.f);
                                                  mv[m] = dpp_mirror(uv[m]); mg[m] = dpp_mirror(ug[m]); }
#pragma unroll
                    for (int m = 0; m < 4; ++m) {
                        const float pv = dpp_prev(m == 0 ? 0.f : mv[m - 1], uv[m]), nv = dpp_next(m == 3 ? 0.f : mv[m + 1], uv[m]);
                        const float pg = dpp_prev(m == 0 ? 0.f : mg[m - 1], ug[m]), ng = dpp_next(m == 3 ? 0.f : mg[m + 1], ug[m]);
                        const float val = wv0[j] * pv + wv1[j] * uv[m] + wv2[j] * nv + bv[j];
                        const float gat = wg0[j] * pg + wg1[j] * ug[m] + wg2[j] * ng + bg[j];
                        o[m][j] = val * gat * __builtin_amdgcn_rcpf(1.0f + __builtin_amdgcn_exp2f(gat * -1.4426950408889634f)); }
                    asm volatile("" : "+v"(o[0][j]), "+v"(o[1][j]), "+v"(o[2][j]), "+v"(o[3][j])); }
#pragma unroll
                for (int m = 0; m < 4; ++m) { const int R64 = 16 * m + fr; const int rowo = 62 * J - 1 + R64;
                    if (R64 >= 1 && R64 <= 62 && rowo < M) { u32x2 w; w.x = cvt_pk_bf16(o[m][0], o[m][1]); w.y = cvt_pk_bf16(o[m][2], o[m][3]); *(u32x2*)(act + (size_t)rowo * DFF + cv) = w; } }
                asm volatile("" ::: "memory"); } }
    }
};
struct EpiNull {
    static constexpr bool PERM = true, AFTER_DRAIN = false, STAGED = false;
    float* sink;
    __device__ __forceinline__ void operator()(const f32x4 (&acc)[2][2][4][2], const Unit& u, int wr, int wc, int fr, int fq, PG8_LAS unsigned char*) const {
        float s = 0.f;
#pragma unroll
        for (int ai = 0; ai < 2; ++ai)
#pragma unroll
            for (int bj = 0; bj < 2; ++bj)
#pragma unroll
                for (int m = 0; m < 4; ++m)
#pragma unroll
                    for (int n = 0; n < 2; ++n) s += acc[ai][bj][m][n][0] + acc[ai][bj][m][n][1] + acc[ai][bj][m][n][2] + acc[ai][bj][m][n][3];
        if (s == 1.2345e33f) sink[0] = s;
    }
};
template <class Epi, class Sched, bool ALIGN_EPI = false, bool SP2 = false, bool SHIFT = false>
__device__ __forceinline__ void gemm_phase(PG8_LAS unsigned char* lds, const Gemm g, const Sched& S, const Epi& E) {
    const int tid = threadIdx.x, wid = __builtin_amdgcn_readfirstlane(tid >> 6), lane = tid & 63, wr = wid >> 2, wc = wid & 3, fr = lane & 15, fq = lane >> 4;
    const int K = g.K, nt = K / BK;
    unsigned voffA[2], voffB[2];
#pragma unroll
    for (int i = 0; i < 2; ++i) { int R, C; stage_rc(tid * 16 + i * 8192, R, C); const int Rb = Epi::PERM ? ((R & ~31) + perm32(R & 31)) : R;
        const int Ra = SHIFT ? (R - 2 * (R >> 6)) : R; voffA[i] = (unsigned)(Ra * g.lda + C) * 2u; voffB[i] = (unsigned)(Rb * g.ldb + C) * 2u; }
    const size_t kstep = (size_t)(BK * 2);
    const size_t hstepA = (size_t)(SHIFT ? 124 : HALF) * g.lda * 2, hstepB = (size_t)HALF * g.ldb * 2;
    const size_t tstepA = 2 * hstepA, tstepB = 2 * hstepB;
    const unsigned ldsw = (unsigned)wid * 1024u;
    const int aoff = lds_byte(wr * 64 + fr, fq * 8), boff = lds_byte(wc * 32 + fr, fq * 8);
#define PG8_SA(b, h) (((b) * 2 + (h)) * HTB)
#define PG8_SB(b, h) ((4 + (b) * 2 + (h)) * HTB)
#define PG8_STAGE(bufoff, gbase, voff) do { _Pragma("unroll") for (int _i = 0; _i < 2; ++_i) \
        __builtin_amdgcn_global_load_lds((const unsigned*)((const char*)(gbase) + (voff)[_i]), (PG8_LAS unsigned*)(lds + (bufoff) + ldsw + _i * 8192), 16, 0, 0); } while (0)
#define PG8_LDA(dst, b, h) do { _Pragma("unroll") for (int m = 0; m < 4; ++m) _Pragma("unroll") for (int k = 0; k < 2; ++k) dst[m][k] = *(const PG8_LAS bf16x8*)(lds + PG8_SA(b, h) + aoff + m * 2048 + k * 1024); } while (0)
#define PG8_LDB(dst, b, h) do { _Pragma("unroll") for (int n = 0; n < 2; ++n) _Pragma("unroll") for (int k = 0; k < 2; ++k) dst[n][k] = *(const PG8_LAS bf16x8*)(lds + PG8_SB(b, h) + boff + n * 2048 + k * 1024); } while (0)
#define PG8_MMA(ai, bj, At, Bt) do { __builtin_amdgcn_s_setprio(1); _Pragma("unroll") for (int m = 0; m < 4; ++m) _Pragma("unroll") for (int n = 0; n < 2; ++n) _Pragma("unroll") for (int k = 0; k < 2; ++k) \
        acc[ai][bj][m][n] = __builtin_amdgcn_mfma_f32_16x16x32_bf16(Bt[n][k], At[m][k], acc[ai][bj][m][n], 0, 0, 0); __builtin_amdgcn_s_setprio(0); } while (0)
#define PG8_WAIT_V(n) asm volatile("s_waitcnt vmcnt(" #n ")" ::: "memory")
#define PG8_WAIT_L(n) asm volatile("s_waitcnt lgkmcnt(" #n ")" ::: "memory")
#define PG8_BAR __builtin_amdgcn_s_barrier()
#define PG8_SCHED __builtin_amdgcn_sched_barrier(0)
    Unit cur, nxt; int ui = 0;
    if (!S.next(0, cur)) return;
    f32x4 acc[2][2][4][2];
#pragma unroll
    for (int a = 0; a < 2; ++a)
#pragma unroll
        for (int b = 0; b < 2; ++b)
#pragma unroll
            for (int m = 0; m < 4; ++m)
#pragma unroll
                for (int n = 0; n < 2; ++n) acc[a][b][m][n] = (f32x4){0.f, 0.f, 0.f, 0.f};
    bf16x8 At[4][2], B0[2][2], B1[2][2];
    const char* cA = (const char*)g.A + (size_t)cur.pm * tstepA; const char* cB = (const char*)g.Bt + (size_t)cur.pn * tstepB;
    S.a_ready(cur);
    if constexpr (SP2) {
        PG8_STAGE(PG8_SB(0, 0), cB, voffB); PG8_STAGE(PG8_SB(0, 1), cB + hstepB, voffB); PG8_STAGE(PG8_SA(0, 0), cA, voffA); PG8_STAGE(PG8_SA(0, 1), cA + hstepA, voffA);
        if (wr == 1) PG8_BAR;
        PG8_WAIT_V(2); PG8_BAR;
        PG8_STAGE(PG8_SB(1, 0), cB + kstep, voffB); PG8_STAGE(PG8_SA(1, 0), cA + kstep, voffA); PG8_STAGE(PG8_SB(1, 1), cB + hstepB + kstep, voffB);
        PG8_WAIT_V(6); PG8_BAR;
    } else {
        PG8_STAGE(PG8_SB(0, 0), cB, voffB); PG8_STAGE(PG8_SA(0, 0), cA, voffA); PG8_STAGE(PG8_SB(0, 1), cB + hstepB, voffB); PG8_STAGE(PG8_SA(0, 1), cA + hstepA, voffA);
        if (wr == 1) PG8_BAR;
        PG8_WAIT_V(4); PG8_BAR;
        PG8_STAGE(PG8_SB(1, 0), cB + kstep, voffB); PG8_STAGE(PG8_SA(1, 0), cA + kstep, voffA); PG8_STAGE(PG8_SB(1, 1), cB + hstepB + kstep, voffB);
        PG8_WAIT_V(6); PG8_BAR;
    }
    for (;;) {
        if constexpr (Epi::STAGED) E.stage(lds + STAGE_BYTES + (ui & 1) * 8192, cur, tid, wid);
        const bool has_next = S.next(ui + 1, nxt);
        const char* nA = has_next ? (const char*)g.A + (size_t)nxt.pm * tstepA : cA; const char* nB = has_next ? (const char*)g.Bt + (size_t)nxt.pn * tstepB : cB;
        for (int t = 0; t < nt; t += 2) {
            const bool last = (t == nt - 2);
            const char* a1 = cA + (size_t)(t + 1) * kstep;
            const char* a2 = last ? nA : cA + (size_t)(t + 2) * kstep; const char* b2 = last ? nB : cB + (size_t)(t + 2) * kstep;
            const char* a3 = a2 + kstep; const char* b3 = b2 + kstep;
            if (last && has_next) S.a_ready(nxt);
            if constexpr (SP2) {
            PG8_LDB(B0, 0, 0); PG8_LDB(B1, 0, 1); PG8_SCHED; PG8_LDA(At, 0, 0); PG8_STAGE(PG8_SA(1, 1), a1 + hstepA, voffA);
            PG8_WAIT_V(8); PG8_WAIT_L(0); PG8_BAR; PG8_MMA(0, 0, At, B0); PG8_MMA(0, 1, At, B1); PG8_BAR; PG8_SCHED;
            PG8_LDA(At, 0, 1); PG8_STAGE(PG8_SB(0, 0), b2, voffB); PG8_STAGE(PG8_SB(0, 1), b2 + hstepB, voffB); PG8_STAGE(PG8_SA(0, 0), a2, voffA);
            PG8_WAIT_V(8); PG8_WAIT_L(0); PG8_BAR; PG8_MMA(1, 0, At, B0); PG8_MMA(1, 1, At, B1); PG8_BAR; PG8_SCHED;
            PG8_LDB(B0, 1, 0); PG8_LDB(B1, 1, 1); PG8_SCHED; PG8_LDA(At, 1, 0); PG8_STAGE(PG8_SA(0, 1), a2 + hstepA, voffA);
            PG8_WAIT_V(8); PG8_WAIT_L(0); PG8_BAR; PG8_MMA(0, 0, At, B0); PG8_MMA(0, 1, At, B1); PG8_BAR; PG8_SCHED;
            PG8_LDA(At, 1, 1); PG8_STAGE(PG8_SB(1, 0), b3, voffB); PG8_STAGE(PG8_SB(1, 1), b3 + hstepB, voffB); PG8_STAGE(PG8_SA(1, 0), a3, voffA);
            PG8_WAIT_V(8); PG8_WAIT_L(0); PG8_BAR; PG8_MMA(1, 0, At, B0); PG8_MMA(1, 1, At, B1); PG8_BAR; PG8_SCHED;
            } else {
            PG8_LDB(B0, 0, 0); PG8_SCHED; PG8_LDA(At, 0, 0); PG8_STAGE(PG8_SA(1, 1), a1 + hstepA, voffA);
            PG8_WAIT_L(8); PG8_BAR; PG8_WAIT_L(0); PG8_MMA(0, 0, At, B0); PG8_BAR; PG8_SCHED;
            PG8_LDB(B1, 0, 1); PG8_STAGE(PG8_SB(0, 0), b2, voffB);
            PG8_BAR; PG8_WAIT_L(0); PG8_MMA(0, 1, At, B1); PG8_BAR;
            PG8_LDA(At, 0, 1); PG8_STAGE(PG8_SA(0, 0), a2, voffA);
            PG8_BAR; PG8_WAIT_L(0); PG8_MMA(1, 0, At, B0); PG8_BAR; PG8_SCHED;
            PG8_STAGE(PG8_SB(0, 1), b2 + hstepB, voffB);
            PG8_WAIT_V(6); PG8_BAR; PG8_MMA(1, 1, At, B1); PG8_BAR;
            PG8_LDB(B0, 1, 0); PG8_SCHED; PG8_LDA(At, 1, 0); PG8_STAGE(PG8_SA(0, 1), a2 + hstepA, voffA);
            PG8_WAIT_L(8); PG8_BAR; PG8_WAIT_L(0); PG8_MMA(0, 0, At, B0); PG8_BAR; PG8_SCHED;
            PG8_LDB(B1, 1, 1); PG8_STAGE(PG8_SB(1, 0), b3, voffB);
            PG8_BAR; PG8_WAIT_L(0); PG8_MMA(0, 1, At, B1); PG8_BAR;
            PG8_LDA(At, 1, 1); PG8_STAGE(PG8_SA(1, 0), a3, voffA);
            PG8_BAR; PG8_WAIT_L(0); PG8_MMA(1, 0, At, B0); PG8_BAR; PG8_SCHED;
            PG8_STAGE(PG8_SB(1, 1), b3 + hstepB, voffB);
            PG8_WAIT_V(6); PG8_BAR; PG8_MMA(1, 1, At, B1); PG8_BAR;
            }
        }
        if constexpr (ALIGN_EPI) { if (wr == 0) PG8_BAR; }
        if constexpr (!Epi::AFTER_DRAIN) { E(acc, cur, wr, wc, fr, fq, lds + STAGE_BYTES + (ui & 1) * 8192); S.done(cur); }
        if (!has_next) break;
#pragma unroll
        for (int a = 0; a < 2; ++a)
#pragma unroll
            for (int b = 0; b < 2; ++b)
#pragma unroll
                for (int m = 0; m < 4; ++m)
#pragma unroll
                    for (int n = 0; n < 2; ++n) acc[a][b][m][n] = (f32x4){0.f, 0.f, 0.f, 0.f};
        cur = nxt; cA = nA; cB = nB; ++ui;
        if constexpr (ALIGN_EPI) { if (wr == 1) PG8_BAR; }
    }
    PG8_WAIT_V(0);
    if constexpr (!ALIGN_EPI) { if (wr == 0) PG8_BAR; }
    PG8_BAR;
    if constexpr (Epi::AFTER_DRAIN) { E.fused(acc, cur, wr, wc, fr, fq, lds, wid, lane); S.done(cur); }
#undef PG8_SA
#undef PG8_SB
#undef PG8_STAGE
#undef PG8_LDA
#undef PG8_LDB
#undef PG8_MMA
#undef PG8_WAIT_V
#undef PG8_WAIT_L
#undef PG8_BAR
#undef PG8_SCHED
}
}
#define GAS __attribute__((address_space(1)))
#define LAS __attribute__((address_space(3)))
typedef unsigned short bf16;
typedef unsigned v4u __attribute__((ext_vector_type(4)));
typedef unsigned v2u __attribute__((ext_vector_type(2)));
typedef float f32x4 __attribute__((ext_vector_type(4)));
typedef float f32x2 __attribute__((ext_vector_type(2)));
typedef GAS unsigned gu32;
using pg8::cvt_pk_bf16; using pg8::bf_lo; using pg8::bf_hi;

constexpr size_t MiB = 1u << 20;
constexpr size_t WS_CTL = 0, CTL_ZERO_BYTES = 64 * 1024;
constexpr size_t WS_ROPE = 1 * MiB;
constexpr size_t WS_LB = WS_ROPE + 640 * 1024;
constexpr size_t WS_C12 = WS_LB + 16 * 1024;
constexpr size_t C1_UP0 = WS_C12, C2_UP0 = C1_UP0 + 5632 * 4, C1_HG = C2_UP0 + 5632 * 4, C2_HG = C1_HG + 5120 * 4, C1_UP1 = C2_HG + 5120 * 4, C2_UP1 = C1_UP1 + 5632 * 4;
static_assert(C2_UP1 + 5632 * 4 <= 2 * MiB, "small tables");
constexpr size_t WS_W = 2 * MiB;
constexpr size_t W_IN = WS_W, W_UQ = W_IN + 1280ull * 1024 * 2, W_UKV = W_UQ + 1536ull * 768 * 2, W_O = W_UKV + 2048ull * 256 * 2, W_HIN = W_O + 1024ull * 1024 * 2,
                 W_HO = W_HIN + 5120ull * 1024 * 2, W_UP0 = W_HO + 1024ull * 1024 * 2, W_UP1 = W_UP0 + 5632ull * 1024 * 2, W_DN0 = W_UP1 + 5632ull * 1024 * 2, W_DN1 = W_DN0 + 1024ull * 2816 * 2,
                 W_END = W_DN1 + 1024ull * 2816 * 2;
static_assert(W_END <= 55 * MiB, "weights");
constexpr int SLACK = 256;
constexpr size_t ROWB = 2048;
constexpr size_t WS_B0 = 55 * MiB, B0_BYTES = (size_t)(M + 2 * SLACK) * ROWB;
static_assert(B0_BYTES <= 164 * MiB, "B0");
constexpr size_t WS_R = 219 * MiB;
constexpr size_t R_CQKV = WS_R;
constexpr size_t R_Q = R_CQKV + 164 * MiB;
constexpr size_t R_KV = R_Q + 245 * MiB;
constexpr size_t R_KROPE = R_KV + 326 * MiB;
constexpr size_t R_SSQ = R_KROPE + 6 * MiB;
constexpr size_t R_X_L0 = R_Q;
constexpr size_t R_ACT = WS_R;
constexpr size_t R_X_FFN = WS_R + 448 * MiB;
constexpr size_t R_HV = WS_R, R_HKF = WS_R + 163 * MiB, R_HKB = WS_R + 326 * MiB, R_HSG = WS_R + 489 * MiB;
constexpr size_t R_X_HG = WS_R;
constexpr size_t R_XB3 = R_HSG + (size_t)SLACK * ROWB;
constexpr size_t SUM_ROWS = (size_t)M + 2 * SLACK, SUM_BYTES = SUM_ROWS * 8;
constexpr size_t WS_SUM1 = WS_R + 773 * MiB, WS_SUM2 = WS_SUM1 + SUM_BYTES, WS_SUM3 = WS_SUM2 + SUM_BYTES, WS_SUM4 = WS_SUM3 + SUM_BYTES;
constexpr size_t WS_END = 1024 * MiB;
static_assert(SUM_BYTES % 256 == 0 && WS_SUM4 + SUM_BYTES <= WS_END && R_XB3 + (size_t)(M + SLACK) * ROWB <= WS_SUM1 && R_KV + 326 * MiB + 12 * MiB <= WS_SUM1 && R_ACT + 448 * MiB <= R_HSG, "d_ws map 3");
static_assert(R_SSQ + (size_t)M * 16 * 4 <= WS_END && R_X_FFN + (size_t)M * 4096 <= WS_END && R_HSG + (size_t)M * ROWB <= WS_END, "d_ws map");
static_assert((size_t)M * 1536 * 2 + 64 * 3072 <= 245 * MiB && (size_t)M * 4096 + 64 * 4096 <= 326 * MiB && (size_t)M * DFF * 2 <= 448 * MiB && (size_t)M * ROWB <= 163 * MiB, "d_ws map 2");

constexpr int RING_OFF = 0, RING_BYTES = 131072;
constexpr int EPI_OFF = RING_BYTES, EPI_SLOT = 8192;
constexpr int LDSCTL_OFF = 147456, MISC_OFF = LDSCTL_OFF + 320;
constexpr int LDS_BYTES = 148480;
constexpr int NWAVES = 8;

#define RLX_AGENT __ATOMIC_RELAXED, __HIP_MEMORY_SCOPE_AGENT
#define XB_TMO      128
#define XB_XCNT(j)  (256  + 64 * (j))
#define XB_XSUB(j)  (1280 + 64 * (j))
#define XB_XGEN(j)  (2304 + 64 * (j))
#define XB_TOP      3328
#define XB_TOPGEN   3392
#define XCD_BAR_WORDS 3456
#define XB_SPIN_CAP (1u << 18)

__device__ __forceinline__ unsigned xb_ld(unsigned* p)              { return __hip_atomic_load(p, __ATOMIC_RELAXED, __HIP_MEMORY_SCOPE_AGENT); }
__device__ __forceinline__ unsigned xb_add(unsigned* p, unsigned v) { return __hip_atomic_fetch_add(p, v, __ATOMIC_RELAXED, __HIP_MEMORY_SCOPE_AGENT); }
__device__ __forceinline__ unsigned xb_xcc_id() { return (unsigned)__builtin_amdgcn_s_getreg((3 << 11) | 20) & 0xFu; }
#define XB_SPIN(cond, bar) do { unsigned _sp = 0; while (cond) { __builtin_amdgcn_s_sleep(1); \
    if ((++_sp & 255u) == 0u) { if (xb_ld(&(bar)[XB_TMO])) break; if (_sp > XB_SPIN_CAP) { atomicAdd(&(bar)[XB_TMO], 1u); break; } } } } while (0)

struct XcdBarrier {
    unsigned* bar; unsigned x;
    volatile LAS unsigned* st;
};

__device__ __forceinline__ XcdBarrier xcd_barrier_post(unsigned* bar, volatile LAS unsigned* st) {
    XcdBarrier b; b.bar = bar; b.x = xb_xcc_id(); b.st = st;
    if (threadIdx.x == 0) (void)xb_add(&bar[XB_XCNT(b.x)], 1u);
    return b;
}
__device__ __forceinline__ void xcd_barrier_complete(unsigned* bar, unsigned x, unsigned& nloc, unsigned& nx) {
    const unsigned G = gridDim.x * gridDim.y * gridDim.z;
    unsigned sum, cnt, mine, sp = 0u;
    for (;;) {
        sum = 0u; cnt = 0u; mine = 0u;
#pragma unroll
        for (unsigned j = 0; j < 16; ++j) { const unsigned c = xb_ld(&bar[XB_XCNT(j)]); sum += c; cnt += (c > 0u) ? 1u : 0u; mine = (j == x) ? c : mine; }
        if (sum == G) break;
        __builtin_amdgcn_s_sleep(1);
        if ((++sp & 255u) == 0u) { if (xb_ld(&bar[XB_TMO])) break; if (sp > XB_SPIN_CAP) { atomicAdd(&bar[XB_TMO], 1u); break; } }
    }
    nloc = mine > 0u ? mine : 1u; nx = cnt > 0u ? cnt : 1u;
}

__device__ __forceinline__ void xcd_barrier(const XcdBarrier& b) {
    asm volatile("s_waitcnt vmcnt(0)" ::: "memory");
    __syncthreads();
    if (threadIdx.x == 0) {
        unsigned* bar = b.bar;
        __builtin_amdgcn_s_waitcnt(0);
        unsigned nloc = b.st[0], nx = b.st[1];
        if (nloc == 0u) { xcd_barrier_complete(bar, b.x, nloc, nx); b.st[0] = nloc; b.st[1] = nx; }
        const unsigned old = xb_add(&bar[XB_XSUB(b.x)], 1u);
        const unsigned gen = old / nloc;
        if (old + 1u == (gen + 1u) * nloc) {
            __builtin_amdgcn_fence(__ATOMIC_RELEASE, "agent");
            asm volatile("s_waitcnt vmcnt(0)" ::: "memory");
            const unsigned og = xb_add(&bar[XB_TOP], 1u);
            const unsigned tg = og / nx;
            if (og + 1u == (tg + 1u) * nx) xb_add(&bar[XB_TOPGEN], 1u);
            else XB_SPIN(xb_ld(&bar[XB_TOPGEN]) == tg, bar);
            __builtin_amdgcn_fence(__ATOMIC_ACQUIRE, "agent");
            xb_add(&bar[XB_XGEN(b.x)], 1u);
            asm volatile("s_waitcnt vmcnt(0)" ::: "memory");
        } else {
            XB_SPIN(xb_ld(&bar[XB_XGEN(b.x)]) == gen, bar);
            __builtin_amdgcn_fence(__ATOMIC_ACQUIRE, "agent");
            asm volatile("s_waitcnt vmcnt(0)" ::: "memory");
        }
    }
    __syncthreads();
}

struct Frame {
    LAS unsigned char* lds;
    volatile LAS unsigned* MISC;
    int tid, lane, wave;
    int vcu, G;
};
__device__ __forceinline__ float wave_sum(float v) {
#pragma unroll
    for (int o = 1; o < 64; o <<= 1) v += __shfl_xor(v, o);
    return v;
}
__device__ __forceinline__ unsigned f2bf(float f) { unsigned u = __builtin_bit_cast(unsigned, f); return (u + 0x7fffu + ((u >> 16) & 1u)) >> 16; }
__device__ __forceinline__ unsigned pk2(float lo, float hi) { return f2bf(lo) | (f2bf(hi) << 16); }

__device__ __forceinline__ int src_col(int kind, int n) {
    if (kind == 1) { if (n < 1024) return n; if (n >= 1056) return -1; const int e = n - 1024; return 1024 + ((e & 1) ? 16 + (e >> 1) : (e >> 1)); }
    if (kind == 2) { const int hd = n / 96, d = n % 96; if (d < 64) return n; const int e = d - 64; return hd * 96 + 64 + ((e & 1) ? 16 + (e >> 1) : (e >> 1)); }
    if (kind == 3) { const int pn = n >> 8, r = n & 255; return r < 128 ? 128 * pn + r : DFF + 128 * pn + (r - 128); }
    return n;
}
__device__ __forceinline__ void p0_transpose_item(const float* W, int K, int N, bf16* WT, int kind, const float* gain, LAS float* scr, int item, int lane, int NP) {
    const int nblk = NP / 32, kb = item / nblk, nb = item % nblk, k0 = 64 * kb, n0 = 32 * nb;
    const int sc = src_col(kind, n0 + (lane & 31));
#pragma unroll 8
    for (int i = 0; i < 32; ++i) { const int kk = 2 * i + (lane >> 5); float v = sc >= 0 ? W[(size_t)(k0 + kk) * N + sc] : 0.f; if (gain) v *= gain[k0 + kk]; scr[kk * 33 + (lane & 31)] = v; }
    asm volatile("s_waitcnt lgkmcnt(0)" ::: "memory");
    const int c = lane & 7;
#pragma unroll
    for (int j = 0; j < 4; ++j) { const int n = (lane >> 3) + 8 * j; const LAS float* s = scr + (8 * c) * 33 + n;
        v4u o; o.x = pk2(s[0 * 33], s[1 * 33]); o.y = pk2(s[2 * 33], s[3 * 33]); o.z = pk2(s[4 * 33], s[5 * 33]); o.w = pk2(s[6 * 33], s[7 * 33]);
        *(GAS v4u*)(WT + (size_t)(n0 + n) * K + k0 + 8 * c) = o; }
    asm volatile("s_waitcnt lgkmcnt(0)" ::: "memory");
}
__device__ __forceinline__ void wjob(Frame& F, const float* W, bf16* WT, const float* gain, int K, int N, int NP, int kind, int widx, int nwg) {
    LAS float* scr = (LAS float*)(F.lds + RING_OFF + F.wave * 16384);
    const int nitems = (K / 64) * (NP / 32);
    for (int it = widx * NWAVES + F.wave; it < nitems; it += nwg * NWAVES) p0_transpose_item(W, K, N, WT, kind, gain, scr, it, F.lane, NP);
}
__device__ __forceinline__ void c12job(Frame& F, const float* const* in, unsigned char* ws, int which, int widx, int nwg) {
    const float* W = which == 0 ? in[13] : which == 1 ? in[9] : in[13] + (size_t)1024 * NUP; const int N = which == 1 ? 5120 : NUP;
    const float* gn = in[17] + (which == 0 ? 0 : which == 1 ? 1024 : 2048); const float* bs = in[18] + (which == 0 ? 0 : which == 1 ? 1024 : 2048);
    float* c1 = (float*)(ws + (which == 0 ? C1_UP0 : which == 1 ? C1_HG : C1_UP1)); float* c2 = (float*)(ws + (which == 0 ? C2_UP0 : which == 1 ? C2_HG : C2_UP1));
    LAS float* red = (LAS float*)(F.lds + RING_OFF + 12288);
    for (int cb = widx; cb < N / 64; cb += nwg) { const int n = cb * 64 + F.lane; const int sc = which == 1 ? n : src_col(3, n);
        float a1[4] = {0.f, 0.f, 0.f, 0.f}, a2[4] = {0.f, 0.f, 0.f, 0.f};
        for (int k = F.wave * 128; k < F.wave * 128 + 128; k += 4) {
#pragma unroll
            for (int i = 0; i < 4; ++i) { const float w = W[(size_t)(k + i) * N + sc]; a1[i] += __uint_as_float(f2bf(gn[k + i] * w) << 16); a2[i] += bs[k + i] * w; } }
        red[F.wave * 4096 + F.lane * 2] = (a1[0] + a1[1]) + (a1[2] + a1[3]); red[F.wave * 4096 + F.lane * 2 + 1] = (a2[0] + a2[1]) + (a2[2] + a2[3]);
        __syncthreads();
        if (F.wave == 0) { float s1 = 0.f, s2 = 0.f;
#pragma unroll
            for (int w = 0; w < 8; ++w) { s1 += red[w * 4096 + F.lane * 2]; s2 += red[w * 4096 + F.lane * 2 + 1]; }
            c1[n] = s1; c2[n] = s2; }
        __syncthreads(); }
}
__device__ __forceinline__ void tail_jobs_a(Frame& F, const float* const* in, unsigned char* ws, int widx, int nwg) {
    wjob(F, in[9], (bf16*)(ws + W_HIN), in[17] + 1024, 1024, 5120, 5120, 0, widx, nwg);
    wjob(F, in[12], (bf16*)(ws + W_HO), nullptr, 1024, 1024, 1024, 0, widx, nwg);
    c12job(F, in, ws, 1, widx, nwg);
}
__device__ __forceinline__ void tail_jobs_b(Frame& F, const float* const* in, unsigned char* ws, int widx, int nwg) {
    wjob(F, in[13] + (size_t)1024 * NUP, (bf16*)(ws + W_UP1), in[17] + 2048, 1024, NUP, NUP, 3, widx, nwg);
    wjob(F, in[16] + (size_t)DFF * 1024, (bf16*)(ws + W_DN1), nullptr, DFF, 1024, 1024, 0, widx, nwg);
    c12job(F, in, ws, 2, widx, nwg);
}
__device__ __forceinline__ void tail_jobs_0(Frame& F, const float* const* in, unsigned char* ws, int widx, int nwg) {
    wjob(F, in[13], (bf16*)(ws + W_UP0), in[17], 1024, NUP, NUP, 3, widx, nwg);
    wjob(F, in[16], (bf16*)(ws + W_DN0), nullptr, DFF, 1024, 1024, 0, widx, nwg);
    c12job(F, in, ws, 0, widx, nwg);
}
__device__ __forceinline__ void p0_prologue(Frame& F, const float* const* in, unsigned char* ws, bf16* h0) {
    const int gw = F.vcu * NWAVES + F.wave, NGW = F.G * NWAVES;
    wjob(F, in[3], (bf16*)(ws + W_IN), nullptr, 1024, 1056, 1280, 1, F.vcu, F.G);
    wjob(F, in[6], (bf16*)(ws + W_UQ), in[4], 768, 1536, 1536, 2, F.vcu, F.G);
    wjob(F, in[7], (bf16*)(ws + W_UKV), in[5], 256, 2048, 2048, 0, F.vcu, F.G);
    wjob(F, in[8], (bf16*)(ws + W_O), nullptr, 1024, 1024, 1024, 0, F.vcu, F.G);
    for (int row0 = gw; row0 < M; row0 += 4 * NGW) {
        f32x4 v[4][4];
#pragma unroll
        for (int u = 0; u < 4; ++u) { const int row = row0 + u * NGW; const int rc = row < M ? row : M - 1; const int b = rc / LP, s = rc % LP;
            const float* src = s < PADR ? in[2] : s < PADR + 16 ? in[2] + (size_t)(s - PADR) * 1024 : (b < 16 ? in[0] + ((size_t)b * SEQ + (s - 64)) * 1024 : in[1] + ((size_t)(b - 16) * SEQ + (s - 64)) * 1024);
            const GAS f32x4* xr = (const GAS f32x4*)src + F.lane;
#pragma unroll
            for (int j = 0; j < 4; ++j) v[u][j] = xr[64 * j]; }
#pragma unroll
        for (int u = 0; u < 4; ++u) { const int row = row0 + u * NGW; if (row >= M) continue; const int s = row % LP;
            GAS unsigned long long* o8 = (GAS unsigned long long*)(h0 + (size_t)row * 1024) + F.lane;
#pragma unroll
            for (int j = 0; j < 4; ++j) o8[64 * j] = s < PADR ? 0ull : ((unsigned long long)pk2(v[u][j].x, v[u][j].y) | ((unsigned long long)pk2(v[u][j].z, v[u][j].w) << 32)); }
    }
    { const int gt = gw * 64 + F.lane, NGT = NGW * 64; GAS v4u* z0 = (GAS v4u*)(ws + WS_B0); GAS v4u* z1 = (GAS v4u*)(ws + WS_B0 + (size_t)(SLACK + M) * ROWB);
      const int n16 = SLACK * (int)ROWB / 16;
      for (int i = gt; i < n16; i += NGT) { z0[i] = (v4u){0u, 0u, 0u, 0u}; z1[i] = (v4u){0u, 0u, 0u, 0u}; } }
    { const int gt = gw * 64 + F.lane, NGT = NGW * 64; GAS v4u* z = (GAS v4u*)(ws + WS_SUM1);
      for (int i = gt; i < (int)(4 * SUM_BYTES / 16); i += NGT) z[i] = (v4u){0u, 0u, 0u, 0u}; }
    { const int gt = gw * 64 + F.lane, NGT = NGW * 64; GAS v4u* z = (GAS v4u*)(ws + R_SSQ);
      for (int i = gt; i < M * 8 / 16; i += NGT) z[i] = (v4u){0u, 0u, 0u, 0u}; }
    { const int gt = gw * 64 + F.lane, NGT = NGW * 64; f32x2* tab = (f32x2*)(ws + WS_ROPE);
      for (int i = gt; i < LTOK * 16; i += NGT) { const int pos = i >> 4, k = i & 15;
          const float inv = 1.0f / powf(10000.0f, (float)(2 * k) / 32.0f); const float ang = (float)pos * inv;
          f32x2 cs; cs.x = (float)cos((double)ang); cs.y = (float)sin((double)ang); tab[i] = cs; } }
    { const int gt = gw * 64 + F.lane; float* lb = (float*)(ws + WS_LB);
      if (gt < 2048) { const int d = gt >> 10, k = gt & 1023; const float x0 = in[10][(size_t)(d * 2 + 0) * 1024 + k], x1 = in[10][(size_t)(d * 2 + 1) * 1024 + k];
          lb[gt] = 1.0f / (1.0f + expf(x0 - x1)); } }
}

template <bool FINAL> __device__ __forceinline__ void ln_pass(Frame& F, const float* X, const float* gain, const float* bias, bf16* hout, float* out) {
    const int gw = F.vcu * NWAVES + F.wave, NGW = F.G * NWAVES;
    f32x4 g[4], bb[4];
#pragma unroll
    for (int j = 0; j < 4; ++j) { g[j] = ((const f32x4*)gain)[64 * j + F.lane]; bb[j] = ((const f32x4*)bias)[64 * j + F.lane]; }
    for (int row0 = gw; row0 < M; row0 += 4 * NGW) {
        f32x4 v[4][4];
#pragma unroll
        for (int u = 0; u < 4; ++u) { const int row = row0 + u * NGW; const int rc = row < M ? row : M - 1; const GAS f32x4* xr = (const GAS f32x4*)(X + (size_t)rc * 1024) + F.lane;
#pragma unroll
            for (int j = 0; j < 4; ++j) v[u][j] = xr[64 * j]; }
#pragma unroll
        for (int u = 0; u < 4; ++u) { const int row = row0 + u * NGW; if (row >= M) continue;
            const int b = row / LP, s = row % LP;
            if (FINAL) { if (s < 64) continue; }
            else if (s < PADR) { GAS unsigned long long* o8 = (GAS unsigned long long*)(hout + (size_t)row * 1024) + F.lane;
#pragma unroll
                for (int j = 0; j < 4; ++j) o8[64 * j] = 0ull;
                continue; }
            float sm = 0.f;
#pragma unroll
            for (int j = 0; j < 4; ++j) sm += (v[u][j].x + v[u][j].y) + (v[u][j].z + v[u][j].w);
            const float mean = wave_sum(sm) * (1.f / 1024.f); float s2 = 0.f;
#pragma unroll
            for (int j = 0; j < 4; ++j) { v[u][j] = v[u][j] - mean; s2 += (v[u][j].x * v[u][j].x + v[u][j].y * v[u][j].y) + (v[u][j].z * v[u][j].z + v[u][j].w * v[u][j].w); }
            const float rstd = 1.f / sqrtf(wave_sum(s2) * (1.f / 1024.f) + EPS);
            if (FINAL) { GAS f32x4* o = (GAS f32x4*)(out + ((size_t)b * SEQ + (s - 64)) * 1024) + F.lane;
#pragma unroll
                for (int j = 0; j < 4; ++j) o[64 * j] = v[u][j] * rstd * g[j] + bb[j];
            } else { GAS unsigned long long* o8 = (GAS unsigned long long*)(hout + (size_t)row * 1024) + F.lane;
#pragma unroll
                for (int j = 0; j < 4; ++j) { const f32x4 y = v[u][j] * rstd * g[j] + bb[j]; o8[64 * j] = (unsigned long long)cvt_pk_bf16(y.x, y.y) | ((unsigned long long)cvt_pk_bf16(y.z, y.w) << 32); } }
        }
    }
}

__device__ __forceinline__ void ln_final(Frame& F, const bf16* xb, const f32x2* SUM, float* out, const float* gain, const float* bias) {
    const int gw = F.vcu * NWAVES + F.wave, NGW = F.G * NWAVES; constexpr int NR = NB * SEQ;
    f32x4 g[4], bb[4];
#pragma unroll
    for (int j = 0; j < 4; ++j) { g[j] = ((const f32x4*)gain)[64 * j + F.lane]; bb[j] = ((const f32x4*)bias)[64 * j + F.lane]; }
    for (int row0 = gw; row0 < NR; row0 += 4 * NGW) {
        v2u v[4][4]; pg8::u32x2 sq[4];
#pragma unroll
        for (int u = 0; u < 4; ++u) { const int orow = row0 + u * NGW; const int rc = orow < NR ? orow : NR - 1; const size_t row = (size_t)(rc / SEQ) * LP + 64 + rc % SEQ;
            const GAS v2u* xr = (const GAS v2u*)(xb + row * 1024) + F.lane; sq[u] = *(const pg8::u32x2*)(SUM + row);
#pragma unroll
            for (int j = 0; j < 4; ++j) v[u][j] = xr[64 * j]; }
#pragma unroll
        for (int u = 0; u < 4; ++u) { const int orow = row0 + u * NGW; if (orow >= NR) continue;
            float mean, rstd; pg8::mean_rstd(sq[u], mean, rstd);
            GAS f32x4* o = (GAS f32x4*)(out + (size_t)orow * 1024) + F.lane;
#pragma unroll
            for (int j = 0; j < 4; ++j) { f32x4 x; x[0] = bf_lo(v[u][j].x); x[1] = bf_hi(v[u][j].x); x[2] = bf_lo(v[u][j].y); x[3] = bf_hi(v[u][j].y); o[64 * j] = (x - mean) * rstd * g[j] + bb[j]; } }
    }
}
__device__ __forceinline__ void attn_simple(Frame& F, const bf16* Q, const bf16* KV, const bf16* KR, bf16* O) {
    LAS float* Ks = (LAS float*)(F.lds);
    LAS float* Vs = (LAS float*)(F.lds + 64 * 96 * 4);
    constexpr int NQC = 17;
    const int hf = F.tid & 1;
    for (int u = F.vcu; u < NB * 16 * NQC; u += F.G) {
        const int bh = u / NQC, qc = u % NQC, b = bh >> 4, h = bh & 15;
        const int sq = qc * 256 + (F.tid >> 1); const bool vq = sq < LP; const size_t rowq = (size_t)b * LP + (vq ? sq : LP - 1);
        float q[48];
#pragma unroll
        for (int c = 0; c < 6; ++c) { const v4u w = *(const GAS v4u*)(Q + rowq * 1536 + h * 96 + hf * 48 + c * 8);
            q[c * 8 + 0] = bf_lo(w.x); q[c * 8 + 1] = bf_hi(w.x); q[c * 8 + 2] = bf_lo(w.y); q[c * 8 + 3] = bf_hi(w.y);
            q[c * 8 + 4] = bf_lo(w.z); q[c * 8 + 5] = bf_hi(w.z); q[c * 8 + 6] = bf_lo(w.w); q[c * 8 + 7] = bf_hi(w.w); }
        float o[32];
#pragma unroll
        for (int d = 0; d < 32; ++d) o[d] = 0.f;
        float mx = -1e30f, l = 0.f;
        for (int kt = 0; kt < 65; ++kt) {
            __syncthreads();
            for (int idx = F.tid; idx < 64 * 12; idx += 512) { const int j = idx / 12, c = idx % 12; int sk = PADR + kt * 64 + j; sk = sk < LP ? sk : LP - 1; const size_t rk = (size_t)b * LP + sk;
                const v4u w = c < 8 ? *(const GAS v4u*)(KV + rk * 2048 + h * 128 + c * 8) : *(const GAS v4u*)(KR + rk * 32 + (c - 8) * 8);
                LAS float* d = Ks + j * 96 + c * 8; d[0] = bf_lo(w.x); d[1] = bf_hi(w.x); d[2] = bf_lo(w.y); d[3] = bf_hi(w.y); d[4] = bf_lo(w.z); d[5] = bf_hi(w.z); d[6] = bf_lo(w.w); d[7] = bf_hi(w.w); }
            { const int j = F.tid >> 3, c = F.tid & 7; int sk = PADR + kt * 64 + j; sk = sk < LP ? sk : LP - 1; const size_t rk = (size_t)b * LP + sk;
                const v4u w = *(const GAS v4u*)(KV + rk * 2048 + h * 128 + 64 + c * 8);
                LAS float* d = Vs + j * 64 + c * 8; d[0] = bf_lo(w.x); d[1] = bf_hi(w.x); d[2] = bf_lo(w.y); d[3] = bf_hi(w.y); d[4] = bf_lo(w.z); d[5] = bf_hi(w.z); d[6] = bf_lo(w.w); d[7] = bf_hi(w.w); }
            __syncthreads();
            const int nk = (LTOK - kt * 64) < 64 ? (LTOK - kt * 64) : 64;
#pragma unroll 1
            for (int jj = 0; jj < nk; ++jj) {
                const LAS f32x4* kr = (const LAS f32x4*)(Ks + jj * 96 + hf * 48); float a0 = 0.f, a1 = 0.f;
#pragma unroll
                for (int c = 0; c < 12; c += 2) { const f32x4 k0 = kr[c], k1 = kr[c + 1];
                    a0 += q[4 * c] * k0.x + q[4 * c + 1] * k0.y + q[4 * c + 2] * k0.z + q[4 * c + 3] * k0.w;
                    a1 += q[4 * c + 4] * k1.x + q[4 * c + 5] * k1.y + q[4 * c + 6] * k1.z + q[4 * c + 7] * k1.w; }
                float sc = a0 + a1; sc += __shfl_xor(sc, 1);
                const float mn = fmaxf(mx, sc);
                const float al = __builtin_amdgcn_exp2f(mx - mn), p = __builtin_amdgcn_exp2f(sc - mn); mx = mn; l = l * al + p;
                const LAS f32x4* vr = (const LAS f32x4*)(Vs + jj * 64 + hf * 32);
#pragma unroll
                for (int c = 0; c < 8; ++c) { const f32x4 vv = vr[c]; o[4 * c] = fmaf(p, vv.x, o[4 * c] * al); o[4 * c + 1] = fmaf(p, vv.y, o[4 * c + 1] * al); o[4 * c + 2] = fmaf(p, vv.z, o[4 * c + 2] * al); o[4 * c + 3] = fmaf(p, vv.w, o[4 * c + 3] * al); }
            }
        }
        if (vq) { const float il = 1.0f / l;
#pragma unroll
            for (int c = 0; c < 4; ++c) { v4u w; w.x = cvt_pk_bf16(o[8 * c] * il, o[8 * c + 1] * il); w.y = cvt_pk_bf16(o[8 * c + 2] * il, o[8 * c + 3] * il); w.z = cvt_pk_bf16(o[8 * c + 4] * il, o[8 * c + 5] * il); w.w = cvt_pk_bf16(o[8 * c + 6] * il, o[8 * c + 7] * il);
                *(GAS v4u*)(O + rowq * 1024 + h * 64 + hf * 32 + c * 8) = w; } }
    }
    __syncthreads();
}

__device__ __forceinline__ void gla_simple(Frame& F, bf16* Qb, const bf16* Vb, bf16* KFb, const bf16* KBb, const bf16* SGb, const float* onorm) {
    LAS float* tq = (LAS float*)(F.lds);
    LAS float* tk = (LAS float*)(F.lds + 16384);
    LAS float* tv = (LAS float*)(F.lds + 32768);
    LAS float* pr = (LAS float*)(F.lds + 49152);
    const int j = F.tid & 127, kq = F.tid >> 7;
    for (int it = F.vcu; it < NB * 8; it += F.G) {
        const int b = it >> 3, h = it & 7; const size_t cbase = (size_t)h * 128;
        for (int dir = 0; dir < 2; ++dir) {
            float S[32];
#pragma unroll
            for (int k = 0; k < 32; ++k) S[k] = 0.f;
            const bf16* Kg = dir == 0 ? KFb : KBb;
            for (int tile = 0; tile < (LTOK + 31) / 32; ++tile) {
                __syncthreads();
                { const int i = F.tid >> 4, c8 = (F.tid & 15) * 8; const int tt = tile * 32 + i; const bool vt = tt < LTOK; const int tok = dir == 0 ? tt : LTOK - 1 - tt;
                  const size_t off = ((size_t)b * LP + PADR + (vt ? tok : 0)) * 1024 + cbase + c8;
                  v4u wq = *(const GAS v4u*)(Qb + off), wk = *(const GAS v4u*)(Kg + off), wv = *(const GAS v4u*)(Vb + off);
                  if (!vt) { wq = (v4u){0u, 0u, 0u, 0u}; wk = wq; wv = wq; }
                  LAS float* dq = tq + i * 128 + c8; LAS float* dk = tk + i * 128 + c8; LAS float* dv = tv + i * 128 + c8;
                  dq[0] = bf_lo(wq.x); dq[1] = bf_hi(wq.x); dq[2] = bf_lo(wq.y); dq[3] = bf_hi(wq.y); dq[4] = bf_lo(wq.z); dq[5] = bf_hi(wq.z); dq[6] = bf_lo(wq.w); dq[7] = bf_hi(wq.w);
                  dk[0] = bf_lo(wk.x); dk[1] = bf_hi(wk.x); dk[2] = bf_lo(wk.y); dk[3] = bf_hi(wk.y); dk[4] = bf_lo(wk.z); dk[5] = bf_hi(wk.z); dk[6] = bf_lo(wk.w); dk[7] = bf_hi(wk.w);
                  dv[0] = bf_lo(wv.x); dv[1] = bf_hi(wv.x); dv[2] = bf_lo(wv.y); dv[3] = bf_hi(wv.y); dv[4] = bf_lo(wv.z); dv[5] = bf_hi(wv.z); dv[6] = bf_lo(wv.w); dv[7] = bf_hi(wv.w); }
                __syncthreads();
                for (int i = 0; i < 32; ++i) {
                    const float vj = tv[i * 128 + j]; float part = 0.f;
                    const LAS f32x4* kr = (const LAS f32x4*)(tk + i * 128 + kq * 32); const LAS f32x4* qr = (const LAS f32x4*)(tq + i * 128 + kq * 32);
#pragma unroll
                    for (int c = 0; c < 8; ++c) { const f32x4 kk = kr[c], qq = qr[c];
                        S[4 * c] = fmaf(kk.x, vj - S[4 * c], S[4 * c]); part = fmaf(S[4 * c], qq.x, part);
                        S[4 * c + 1] = fmaf(kk.y, vj - S[4 * c + 1], S[4 * c + 1]); part = fmaf(S[4 * c + 1], qq.y, part);
                        S[4 * c + 2] = fmaf(kk.z, vj - S[4 * c + 2], S[4 * c + 2]); part = fmaf(S[4 * c + 2], qq.z, part);
                        S[4 * c + 3] = fmaf(kk.w, vj - S[4 * c + 3], S[4 * c + 3]); part = fmaf(S[4 * c + 3], qq.w, part); }
                    pr[(i * 4 + kq) * 128 + j] = part;
                }
                __syncthreads();
#pragma unroll
                for (int ii = 0; ii < 4; ++ii) { const int i = F.wave * 4 + ii; const int tt = tile * 32 + i; const bool vt = tt < LTOK; const int tok = dir == 0 ? tt : LTOK - 1 - tt;
                    const int c = 2 * F.lane;
                    float o0 = pr[(i * 4 + 0) * 128 + c] + pr[(i * 4 + 1) * 128 + c] + pr[(i * 4 + 2) * 128 + c] + pr[(i * 4 + 3) * 128 + c];
                    float o1 = pr[(i * 4 + 0) * 128 + c + 1] + pr[(i * 4 + 1) * 128 + c + 1] + pr[(i * 4 + 2) * 128 + c + 1] + pr[(i * 4 + 3) * 128 + c + 1];
                    const size_t off = ((size_t)b * LP + PADR + (vt ? tok : 0)) * 1024 + cbase + c;
                    if (dir == 0) { if (vt) *(GAS unsigned*)(KFb + off) = cvt_pk_bf16(o0, o1); }
                    else { const unsigned wf = *(const GAS unsigned*)(KFb + off); o0 += bf_lo(wf); o1 += bf_hi(wf);
                        const float ss = wave_sum(o0 * o0 + o1 * o1); const float rstd = 1.0f / sqrtf(ss * (1.0f / 128.0f) + EPS);
                        const unsigned wg = *(const GAS unsigned*)(SGb + off); const f32x2 gn = *(const f32x2*)(onorm + cbase + c);
                        if (vt) *(GAS unsigned*)(Qb + off) = cvt_pk_bf16(o0 * rstd * gn.x * bf_lo(wg), o1 * rstd * gn.y * bf_hi(wg)); } }
            }
            __syncthreads();
        }
    }
    __syncthreads();
}
namespace fa {
using bf16x8 = __attribute__((ext_vector_type(8))) short;
using s16x4  = __attribute__((ext_vector_type(4))) short;
using f32x16 = __attribute__((ext_vector_type(16))) float;
using u32x4  = __attribute__((ext_vector_type(4))) unsigned;
constexpr int KROW = 208;
constexpr int SHM_V = 64 * 64 * 2, SHM_K = 64 * KROW;
constexpr int OFF_V = 0, OFF_K = 2 * SHM_V, OFF_WS = OFF_K + 2 * SHM_K, OFF_STG = OFF_WS + 8 * 256, LDS_TOTAL = OFF_STG + 8 * 4096;
constexpr int NT = 65, NQC = 17;
#define FA_SBAR() __builtin_amdgcn_sched_barrier(0)
__device__ __forceinline__ int crow(int r, int hi) { return (r & 3) + 8 * (r >> 2) + 4 * hi; }
constexpr float THRL = 11.5f;
__device__ __forceinline__ void partialSM(f32x16& p0, f32x16& p1, float& mhat, f32x16& negm, float& alpha, bool first) {
  float a = fmaxf(fmaxf(p0[0], p0[1]), p1[0]), b = fmaxf(fmaxf(p0[2], p0[3]), p1[1]); a = fmaxf(fmaxf(a, p1[2]), p1[3]);
#pragma unroll
  for (int r = 4; r < 16; r += 4) { a = fmaxf(fmaxf(a, p0[r]), p0[r + 1]); b = fmaxf(fmaxf(b, p0[r + 2]), p0[r + 3]); a = fmaxf(fmaxf(a, p1[r]), p1[r + 1]); b = fmaxf(fmaxf(b, p1[r + 2]), p1[r + 3]); }
  float rm = fmaxf(a, b);
  { auto rr = __builtin_amdgcn_permlane32_swap(__float_as_uint(rm), __float_as_uint(rm), false, false);
    rm = fmaxf(__uint_as_float(rr[0]), __uint_as_float(rr[1])); }
  alpha = 1.f;
  if (first || __builtin_expect(__any(rm > THRL), 0)) { const float dl = first ? rm : fmaxf(rm, 0.f); mhat += dl;
#pragma unroll
    for (int r = 0; r < 16; ++r) { p0[r] -= dl; p1[r] -= dl; }
#pragma unroll
    for (int r = 0; r < 16; ++r) negm[r] = -mhat;
    asm volatile("" : "+v"(negm));
    alpha = __builtin_amdgcn_exp2f(-dl); }
#pragma unroll
  for (int r = 0; r < 16; ++r) p0[r] = __builtin_amdgcn_exp2f(p0[r]);
}
__device__ __forceinline__ void finishSM(f32x16& p0, f32x16& p1, float alpha, float& l_reg, bf16x8& pa0, bf16x8& pa1, bf16x8& pa2, bf16x8& pa3) {
#pragma unroll
  for (int r = 0; r < 16; ++r) p1[r] = __builtin_amdgcn_exp2f(p1[r]);
  float ps = 0;
#pragma unroll
  for (int r = 0; r < 16; ++r) ps += p0[r];
#pragma unroll
  for (int r = 0; r < 16; ++r) ps += p1[r];
  { auto rr = __builtin_amdgcn_permlane32_swap(__float_as_uint(ps), __float_as_uint(ps), false, false);
    ps = __uint_as_float(rr[0]) + __uint_as_float(rr[1]); }
  l_reg = l_reg * alpha + ps;
#define FA_PK4(P, BASE, OUT) do { unsigned a0 = cvt_pk_bf16(P[BASE + 0], P[BASE + 1]), a1 = cvt_pk_bf16(P[BASE + 2], P[BASE + 3]);   \
    unsigned b0 = cvt_pk_bf16(P[BASE + 4], P[BASE + 5]), b1 = cvt_pk_bf16(P[BASE + 6], P[BASE + 7]);                              \
    auto r0 = __builtin_amdgcn_permlane32_swap(a0, b0, false, false); auto r1 = __builtin_amdgcn_permlane32_swap(a1, b1, false, false); \
    u32x4 w = {r0[0], r1[0], r0[1], r1[1]}; OUT = *reinterpret_cast<bf16x8*>(&w); } while (0)
  FA_PK4(p0, 0, pa0); FA_PK4(p0, 8, pa1); FA_PK4(p1, 0, pa2); FA_PK4(p1, 8, pa3);
#undef FA_PK4
}
__device__ __forceinline__ void qkt(f32x16& p0, f32x16& p1, const char* Ks, const bf16x8* qr, const f32x16& negm, int r32, int hi) {
#pragma unroll
  for (int d0 = 0; d0 < 6; ++d0) { const int cb = (d0 * 16 + hi * 8) * 2;
    const bf16x8 b0 = *reinterpret_cast<const bf16x8*>(Ks + r32 * KROW + cb);
    const bf16x8 b1 = *reinterpret_cast<const bf16x8*>(Ks + (32 + r32) * KROW + cb);
    if (d0 == 0) { p0 = __builtin_amdgcn_mfma_f32_32x32x16_bf16(b0, qr[0], negm, 0, 0, 0); p1 = __builtin_amdgcn_mfma_f32_32x32x16_bf16(b1, qr[0], negm, 0, 0, 0); }
    else { p0 = __builtin_amdgcn_mfma_f32_32x32x16_bf16(b0, qr[d0], p0, 0, 0, 0); p1 = __builtin_amdgcn_mfma_f32_32x32x16_bf16(b1, qr[d0], p1, 0, 0, 0); } }
}
__device__ __forceinline__ int v_st(int k, int c) { const int kk = (k & ~0xC) | ((k & 4) << 1) | ((k & 8) >> 1); return ((kk >> 3) * 2 + (c >> 5)) * 512 + ((kk & 7) * 32 + (c & 31)) * 2; }
__device__ __forceinline__ int v_rd_base(int lane) { return ((lane & 3) << 3) | (((lane >> 2) & 3) << 6) | (((lane >> 4) & 1) << 5) | (((lane >> 5) & 1) << 8); }
constexpr int v_rd_off(int d0, int ks, int half) { return d0 * 512 + ks * 2048 + half * 1024; }
template <int OFF> __device__ __forceinline__ s16x4 tr_read(int vb) {
  s16x4 r; asm volatile("ds_read_b64_tr_b16 %0, %1 offset:%2" : "=&v"(r) : "v"(vb), "i"(OFF) : "memory"); return r;
}
template <int D0> __device__ __forceinline__ void pv_one(f32x16& od, int vb, bf16x8 pa0, bf16x8 pa1, bf16x8 pa2, bf16x8 pa3) {
  const s16x4 l0 = tr_read<v_rd_off(D0, 0, 0)>(vb), h0 = tr_read<v_rd_off(D0, 0, 1)>(vb), l1 = tr_read<v_rd_off(D0, 1, 0)>(vb), h1 = tr_read<v_rd_off(D0, 1, 1)>(vb);
  const s16x4 l2 = tr_read<v_rd_off(D0, 2, 0)>(vb), h2 = tr_read<v_rd_off(D0, 2, 1)>(vb), l3 = tr_read<v_rd_off(D0, 3, 0)>(vb), h3 = tr_read<v_rd_off(D0, 3, 1)>(vb);
  asm volatile("s_waitcnt lgkmcnt(0)" ::: "memory"); FA_SBAR();
#define FA_PK(L, H) (bf16x8){L[0], L[1], L[2], L[3], H[0], H[1], H[2], H[3]}
  od = __builtin_amdgcn_mfma_f32_32x32x16_bf16(pa0, FA_PK(l0, h0), od, 0, 0, 0);
  od = __builtin_amdgcn_mfma_f32_32x32x16_bf16(pa1, FA_PK(l1, h1), od, 0, 0, 0);
  od = __builtin_amdgcn_mfma_f32_32x32x16_bf16(pa2, FA_PK(l2, h2), od, 0, 0, 0);
  od = __builtin_amdgcn_mfma_f32_32x32x16_bf16(pa3, FA_PK(l3, h3), od, 0, 0, 0);
#undef FA_PK
}
__device__ __forceinline__ void pv_d0(f32x16* o, int vb, bf16x8 pa0, bf16x8 pa1, bf16x8 pa2, bf16x8 pa3) {
  pv_one<0>(o[0], vb, pa0, pa1, pa2, pa3); pv_one<1>(o[1], vb, pa0, pa1, pa2, pa3);
}
__device__ __forceinline__ void attn_unit(int b, int h, int q0, const bf16* __restrict__ Q, const bf16* __restrict__ KV, const bf16* __restrict__ KR, bf16* __restrict__ O, char* lds) {
  const int tid = threadIdx.x, wid = tid >> 6, lane = tid & 63, r32 = lane & 31, hi = lane >> 5;
  char* V_lds = lds + OFF_V; char* K_lds = lds + OFF_K;
  float* ws = (float*)(lds + OFF_WS) + wid * 64; float* li_l = ws; float* al_l = ws + 32;
  float mhat = 0.f, l_reg = 0; f32x16 o[2] = {}; bf16x8 qr[6]; f32x16 negm = f32x16{}; asm volatile("" : "+v"(negm));
  const size_t seq0 = (size_t)b * LP;
  { int sq = q0 + wid * 32 + r32; sq = sq < LP ? sq : LP - 1;
    const bf16* Qw = Q + (seq0 + sq) * 1536 + h * 96 + hi * 8;
#pragma unroll
    for (int d0 = 0; d0 < 6; ++d0) qr[d0] = *reinterpret_cast<const bf16x8*>(Qw + d0 * 16); }
  const int sr = tid >> 3, sc = (tid & 7) * 8, rr = (tid >> 2) & 63, rc = (tid & 3) * 8; const bool hasr = tid < 256;
  const int vst = v_st(sr, sc), kst = sr * KROW + sc * 2, rst = rr * KROW + 128 + rc * 2;
  const bf16* Kn = KV + seq0 * 2048 + h * 128 + (size_t)sr * 2048 + sc; const bf16* Vn = Kn + 64; const bf16* Rn = KR + seq0 * 32 + (size_t)rr * 32 + rc;
  const int vb0 = (int)(uintptr_t)V_lds + v_rd_base(lane);
  struct { bf16x8 vs, ks, rs; } sr_[2];
#define FA_SLOAD(i, k0) do { sr_[i].vs = *reinterpret_cast<const bf16x8*>(Vn + (size_t)(k0) * 2048); sr_[i].ks = *reinterpret_cast<const bf16x8*>(Kn + (size_t)(k0) * 2048); \
    if (hasr) sr_[i].rs = *reinterpret_cast<const bf16x8*>(Rn + (size_t)(k0) * 32); } while (0)
#define FA_SWRITE(bf, i) do { *(bf16x8*)(V_lds + (bf) * SHM_V + vst) = sr_[i].vs; *(bf16x8*)(K_lds + (bf) * SHM_K + kst) = sr_[i].ks; \
    if (hasr) *(bf16x8*)(K_lds + (bf) * SHM_K + rst) = sr_[i].rs; } while (0)
#define FA_SWAIT() asm volatile("s_waitcnt vmcnt(3)" ::: "memory")
#define FA_RESC(a) do { if (__any((a) < 1.f)) { if (hi == 0) al_l[r32] = (a); asm volatile("s_waitcnt lgkmcnt(0)" ::: "memory"); \
    _Pragma("unroll") for (int d = 0; d < 2; ++d) _Pragma("unroll") for (int r = 0; r < 16; ++r) o[d][r] *= al_l[crow(r, hi)]; } } while (0)
  f32x16 pA0, pA1, pB0, pB1; float alA, alB; bf16x8 pa0, pa1, pa2, pa3;
  constexpr int SE = 0, SO = 1;
  const bool act = q0 + wid * 32 < LP;
  if (!act) {
    __syncthreads();
    FA_SLOAD(SE, 0); asm volatile("s_waitcnt vmcnt(0)" ::: "memory"); FA_SWRITE(0, SE); __syncthreads();
    FA_SLOAD(SO, 64); FA_SLOAD(SE, 128);
    FA_SWAIT(); FA_SWRITE(1, SO); __syncthreads();
    for (int j = 1; j + 1 < NT; j += 2) {
      if (j + 2 < NT) FA_SLOAD(SO, (j + 2) * 64);
      __syncthreads(); FA_SWAIT(); FA_SWRITE(0, SE); __syncthreads();
      if (j + 3 < NT) FA_SLOAD(SE, (j + 3) * 64);
      __syncthreads(); FA_SWAIT(); if (j + 2 < NT) FA_SWRITE(1, SO); __syncthreads();
    }
    return;
  }
  __syncthreads();
  FA_SLOAD(SE, 0); asm volatile("s_waitcnt vmcnt(0)" ::: "memory"); FA_SWRITE(0, SE); __syncthreads();
  qkt(pA0, pA1, K_lds, qr, negm, r32, hi);
  { const float NEG = -INFINITY;
#pragma unroll
    for (int r = 0; r < 16; ++r) pA0[r] = NEG;
#pragma unroll
    for (int r = 0; r < 8; ++r) pA1[r] = NEG; }
  partialSM(pA0, pA1, mhat, negm, alA, true);
  FA_SLOAD(SO, 64); FA_SLOAD(SE, 128);
  FA_SWAIT(); FA_SWRITE(1, SO); __syncthreads();
  for (int j = 1; j + 1 < NT; j += 2) {
    FA_SBAR(); qkt(pB0, pB1, K_lds + SHM_K, qr, negm, r32, hi);
    finishSM(pA0, pA1, alA, l_reg, pa0, pa1, pa2, pa3); FA_SBAR();
    if (j + 2 < NT) FA_SLOAD(SO, (j + 2) * 64); FA_SBAR();
    pv_d0(o, vb0, pa0, pa1, pa2, pa3); partialSM(pB0, pB1, mhat, negm, alB, false);
    __syncthreads(); FA_SWAIT(); FA_SWRITE(0, SE);
    FA_RESC(alB); __syncthreads();
    FA_SBAR(); qkt(pA0, pA1, K_lds, qr, negm, r32, hi);
    finishSM(pB0, pB1, alB, l_reg, pa0, pa1, pa2, pa3); FA_SBAR();
    if (j + 3 < NT) FA_SLOAD(SE, (j + 3) * 64); FA_SBAR();
    pv_d0(o, vb0 + SHM_V, pa0, pa1, pa2, pa3); partialSM(pA0, pA1, mhat, negm, alA, false);
    __syncthreads(); FA_SWAIT(); if (j + 2 < NT) FA_SWRITE(1, SO);
    FA_RESC(alA); __syncthreads();
  }
  finishSM(pA0, pA1, alA, l_reg, pa0, pa1, pa2, pa3); FA_SBAR();
  pv_d0(o, vb0, pa0, pa1, pa2, pa3);
  if (hi == 0) li_l[r32] = l_reg; asm volatile("s_waitcnt lgkmcnt(0)" ::: "memory");
  float rli[16];
#pragma unroll
  for (int r = 0; r < 16; ++r) rli[r] = __builtin_amdgcn_rcpf(li_l[crow(r, hi)]);
  { unsigned short* stg = (unsigned short*)(lds + OFF_STG) + wid * 2048;
#pragma unroll
    for (int r = 0; r < 16; ++r) { const int orow = crow(r, hi);
#pragma unroll
      for (int d0 = 0; d0 < 2; ++d0) stg[orow * 64 + d0 * 32 + r32] = (unsigned short)(cvt_pk_bf16(o[d0][r] * rli[r], 0.f) & 0xffffu); }
    asm volatile("s_waitcnt lgkmcnt(0)" ::: "memory");
#pragma unroll
    for (int i = 0; i < 4; ++i) { const int row = i * 8 + (lane >> 3), ch = lane & 7; const int sq = q0 + wid * 32 + row; const u32x4 v = *(const u32x4*)(stg + row * 64 + ch * 8);
      if (sq < LP) *(u32x4*)(O + (seq0 + sq) * 1024 + h * 64 + ch * 8) = v; } }
#undef FA_SLOAD
#undef FA_SWRITE
#undef FA_SWAIT
#undef FA_RESC
}
__device__ __forceinline__ void attn_phase(int vcu, int G, const bf16* Q, const bf16* KV, const bf16* KR, bf16* O, char* lds) {
  for (int u = vcu; u < NB * 16 * NQC; u += G) { const int bh = u / NQC, qc = u % NQC; attn_unit(bh >> 4, bh & 15, qc * 256, Q, KV, KR, O, lds); }
  __syncthreads();
}
}
namespace fa2 {
using namespace fa;
constexpr int SLOT = SHM_K + SHM_V;
constexpr int R_WS = 4 * SLOT, R_STG = R_WS + 8 * 256, R_TOTAL = R_STG + 8 * 4096;
static_assert(R_TOTAL <= 131072, "attention LDS");
struct VFr { s16x4 l[2][4], h[2][4]; };
__device__ __forceinline__ void pv_issue(VFr& f, int vb) {
  f.l[0][0] = tr_read<v_rd_off(0, 0, 0)>(vb); f.h[0][0] = tr_read<v_rd_off(0, 0, 1)>(vb); f.l[0][1] = tr_read<v_rd_off(0, 1, 0)>(vb); f.h[0][1] = tr_read<v_rd_off(0, 1, 1)>(vb);
  f.l[0][2] = tr_read<v_rd_off(0, 2, 0)>(vb); f.h[0][2] = tr_read<v_rd_off(0, 2, 1)>(vb); f.l[0][3] = tr_read<v_rd_off(0, 3, 0)>(vb); f.h[0][3] = tr_read<v_rd_off(0, 3, 1)>(vb);
  f.l[1][0] = tr_read<v_rd_off(1, 0, 0)>(vb); f.h[1][0] = tr_read<v_rd_off(1, 0, 1)>(vb); f.l[1][1] = tr_read<v_rd_off(1, 1, 0)>(vb); f.h[1][1] = tr_read<v_rd_off(1, 1, 1)>(vb);
  f.l[1][2] = tr_read<v_rd_off(1, 2, 0)>(vb); f.h[1][2] = tr_read<v_rd_off(1, 2, 1)>(vb); f.l[1][3] = tr_read<v_rd_off(1, 3, 0)>(vb); f.h[1][3] = tr_read<v_rd_off(1, 3, 1)>(vb);
}
__device__ __forceinline__ void pv_mma(f32x16* o, const VFr& f, bf16x8 pa0, bf16x8 pa1, bf16x8 pa2, bf16x8 pa3) {
  asm volatile("s_waitcnt lgkmcnt(0)" ::: "memory"); FA_SBAR();
#define FA2_PK(L, H) (bf16x8){L[0], L[1], L[2], L[3], H[0], H[1], H[2], H[3]}
#pragma unroll
  for (int d = 0; d < 2; ++d) {
    o[d] = __builtin_amdgcn_mfma_f32_32x32x16_bf16(pa0, FA2_PK(f.l[d][0], f.h[d][0]), o[d], 0, 0, 0);
    o[d] = __builtin_amdgcn_mfma_f32_32x32x16_bf16(pa1, FA2_PK(f.l[d][1], f.h[d][1]), o[d], 0, 0, 0);
    o[d] = __builtin_amdgcn_mfma_f32_32x32x16_bf16(pa2, FA2_PK(f.l[d][2], f.h[d][2]), o[d], 0, 0, 0);
    o[d] = __builtin_amdgcn_mfma_f32_32x32x16_bf16(pa3, FA2_PK(f.l[d][3], f.h[d][3]), o[d], 0, 0, 0); }
#undef FA2_PK
}
__device__ __forceinline__ void attn_unit(int b, int h, int q0, const bf16* __restrict__ Q, const bf16* __restrict__ KV, const bf16* __restrict__ KR, bf16* __restrict__ O, char* lds) {
  const int tid = threadIdx.x, wid = __builtin_amdgcn_readfirstlane(tid >> 6), lane = tid & 63, r32 = lane & 31, hi = lane >> 5;
  float* ws = (float*)(lds + R_WS) + wid * 64; float* li_l = ws; float* al_l = ws + 32;
  float mhat = 0.f, l_reg = 0; f32x16 o[2] = {}; bf16x8 qr[6]; f32x16 negm = f32x16{}; asm volatile("" : "+v"(negm));
  const size_t seq0 = (size_t)b * LP;
  const char* sp[3]; unsigned stp[3];
#pragma unroll
  for (int k = 0; k < 3; ++k) { const int c = (wid + 8 * k) * 64 + lane;
    if (c < 832) { const int row = c / 13, cc = c % 13;
      if (cc >= 8 && cc < 12) { sp[k] = (const char*)(KR + (seq0 + row) * 32 + (cc - 8) * 8); stp[k] = 64 * 32 * 2; }
      else { sp[k] = (const char*)(KV + (seq0 + row) * 2048 + h * 128 + (cc < 8 ? cc : 0) * 8); stp[k] = 64 * 2048 * 2; }
    } else { const int p = (c - 832) & 511, kk = ((p >> 6) << 3) | ((p & 31) >> 2), key = (kk & ~0xC) | ((kk & 4) << 1) | ((kk & 8) >> 1), col = ((p >> 5) & 1) * 32 + (p & 3) * 8;
      sp[k] = (const char*)(KV + (seq0 + key) * 2048 + h * 128 + 64 + col); stp[k] = 64 * 2048 * 2; } }
  const bool third = wid < 5;
#define FA2_DMA(t, slot) do { const unsigned t_ = (unsigned)(t); \
    __builtin_amdgcn_global_load_lds((const unsigned*)(sp[0] + (size_t)t_ * stp[0]), (__attribute__((address_space(3))) unsigned*)(lds + (slot) * SLOT + wid * 1024), 16, 0, 0); \
    __builtin_amdgcn_global_load_lds((const unsigned*)(sp[1] + (size_t)t_ * stp[1]), (__attribute__((address_space(3))) unsigned*)(lds + (slot) * SLOT + (wid + 8) * 1024), 16, 0, 0); \
    if (third) __builtin_amdgcn_global_load_lds((const unsigned*)(sp[2] + (size_t)t_ * stp[2]), (__attribute__((address_space(3))) unsigned*)(lds + (slot) * SLOT + (wid + 16) * 1024), 16, 0, 0); } while (0)
#define FA2_RESC(a) do { if (__any((a) < 1.f)) { if (hi == 0) al_l[r32] = (a); asm volatile("s_waitcnt lgkmcnt(0)" ::: "memory"); \
    _Pragma("unroll") for (int d = 0; d < 2; ++d) _Pragma("unroll") for (int r = 0; r < 16; ++r) o[d][r] *= al_l[crow(r, hi)]; } } while (0)
  const bool act = q0 + wid * 32 < LP;
  __syncthreads();
  FA2_DMA(0, 0); FA2_DMA(1, 1);
  { int sq = q0 + wid * 32 + r32; sq = sq < LP ? sq : LP - 1;
    const bf16* Qw = Q + (seq0 + sq) * 1536 + h * 96 + hi * 8;
#pragma unroll
    for (int d0 = 0; d0 < 6; ++d0) qr[d0] = *reinterpret_cast<const bf16x8*>(Qw + d0 * 16); }
  __syncthreads();
  if (!act) {
    FA2_DMA(2, 2); __syncthreads();
    for (int i = 0; i < 16; ++i) { const int j = 4 * i + 1;
      if (j + 2 < NT) FA2_DMA(j + 2, 3); __syncthreads(); if (j + 3 < NT) FA2_DMA(j + 3, 0); __syncthreads(); if (j + 4 < NT) FA2_DMA(j + 4, 1); __syncthreads(); if (j + 5 < NT) FA2_DMA(j + 5, 2); __syncthreads(); }
    return; }
  const int vb0 = (int)(uintptr_t)lds + SHM_K + v_rd_base(lane);
  f32x16 pA0, pA1, pB0, pB1; float alA, alB; bf16x8 pa0, pa1, pa2, pa3;
  FA2_DMA(2, 2);
  qkt(pA0, pA1, lds, qr, negm, r32, hi);
  { const float NEG = -INFINITY;
#pragma unroll
    for (int r = 0; r < 16; ++r) pA0[r] = NEG;
#pragma unroll
    for (int r = 0; r < 8; ++r) pA1[r] = NEG; }
  partialSM(pA0, pA1, mhat, negm, alA, true);
  __syncthreads();
#define FA2_SEG(j, PC0, PC1, ALC, PP0, PP1, ALP, KS, VS, DS) do { if ((j) + 2 < NT) FA2_DMA((j) + 2, DS); \
    FA_SBAR(); qkt(PC0, PC1, lds + (KS) * SLOT, qr, negm, r32, hi); FA_SBAR(); \
    { VFr vf_; pv_issue(vf_, vb0 + (VS) * SLOT); FA_SBAR(); finishSM(PP0, PP1, ALP, l_reg, pa0, pa1, pa2, pa3); FA_SBAR(); \
      pv_mma(o, vf_, pa0, pa1, pa2, pa3); } partialSM(PC0, PC1, mhat, negm, ALC, false); \
    FA2_RESC(ALC); __syncthreads(); } while (0)
  for (int j = 1; j + 1 < NT; j += 2) {
    FA2_SEG(j,     pB0, pB1, alB, pA0, pA1, alA, j & 3, (j - 1) & 3, (j + 2) & 3);
    FA2_SEG(j + 1, pA0, pA1, alA, pB0, pB1, alB, (j + 1) & 3, j & 3, (j + 3) & 3);
  }
  finishSM(pA0, pA1, alA, l_reg, pa0, pa1, pa2, pa3); FA_SBAR();
  pv_d0(o, vb0, pa0, pa1, pa2, pa3);
  if (hi == 0) li_l[r32] = l_reg; asm volatile("s_waitcnt lgkmcnt(0)" ::: "memory");
  float rli[16];
#pragma unroll
  for (int r = 0; r < 16; ++r) rli[r] = __builtin_amdgcn_rcpf(li_l[crow(r, hi)]);
  { unsigned short* stg = (unsigned short*)(lds + R_STG) + wid * 2048;
#pragma unroll
    for (int r = 0; r < 16; ++r) { const int orow = crow(r, hi);
#pragma unroll
      for (int d0 = 0; d0 < 2; ++d0) stg[orow * 64 + d0 * 32 + r32] = (unsigned short)(cvt_pk_bf16(o[d0][r] * rli[r], 0.f) & 0xffffu); }
    asm volatile("s_waitcnt lgkmcnt(0)" ::: "memory");
#pragma unroll
    for (int i = 0; i < 4; ++i) { const int row = i * 8 + (lane >> 3), ch = lane & 7; const int sq = q0 + wid * 32 + row; const u32x4 v = *(const u32x4*)(stg + row * 64 + ch * 8);
      if (sq < LP) *(u32x4*)(O + (seq0 + sq) * 1024 + h * 64 + ch * 8) = v; } }
#undef FA2_DMA
#undef FA2_RESC
#undef FA2_SEG
}
__device__ __forceinline__ void attn_phase(int vcu, int G, const bf16* Q, const bf16* KV, const bf16* KR, bf16* O, char* lds) {
  for (int u = vcu; u < NB * 16 * NQC; u += G) { const int bh = u / NQC, qc = u % NQC; attn_unit(bh >> 4, bh & 15, qc * 256, Q, KV, KR, O, lds); }
  __syncthreads();
}
#undef FA_SBAR
}
namespace gla {
using bf16x8 = __attribute__((ext_vector_type(8))) short;
using s16x4  = __attribute__((ext_vector_type(4))) short;
using f32x16 = __attribute__((ext_vector_type(16))) float;
using u32x4  = __attribute__((ext_vector_type(4))) unsigned;
using u32x2  = __attribute__((ext_vector_type(2))) unsigned;
constexpr int RS = 264;
constexpr int O_QI = 0, O_KI = 64 * RS, O_KD = 2 * 64 * RS, O_VV = O_KD + 16384, O_VEC = O_VV + 16384;
constexpr int V_DEC = O_VEC, V_EREF = O_VEC + 512, V_TOT = O_VEC + 1024, V_F2 = O_VEC + 1024 + 2048;
constexpr int CH_BYTES = O_VEC + 3584;
static_assert(CH_BYTES % 16 == 0 && 2 * CH_BYTES <= 146432, "gla LDS");
#define GLA_SBAR() __builtin_amdgcn_sched_barrier(0)
__device__ __forceinline__ int crow(int r, int hi) { return (r & 3) + 8 * (r >> 2) + 4 * hi; }
__device__ __forceinline__ int v_st4(int k, int c) { const int kk = (k & ~0xC) | ((k & 4) << 1) | ((k & 8) >> 1); return ((kk >> 3) * 4 + (c >> 5)) * 512 + ((kk & 7) * 32 + (c & 31)) * 2; }
__device__ __forceinline__ int v_rd_base(int lane) { return ((lane & 3) << 3) | (((lane >> 2) & 3) << 6) | (((lane >> 4) & 1) << 5) | (((lane >> 5) & 1) << 8); }
template <int OFF> __device__ __forceinline__ s16x4 tr_read(int vb) {
  s16x4 r; asm volatile("ds_read_b64_tr_b16 %0, %1 offset:%2" : "=&v"(r) : "v"(vb), "i"(OFF) : "memory"); return r;
}
__device__ __forceinline__ bf16x8 nat_frag(const char* img, int row, int ks, int hi) {
  const u32x2 a = *(const u32x2*)(img + row * RS + (16 * ks + 4 * hi) * 2), b = *(const u32x2*)(img + row * RS + (16 * ks + 8 + 4 * hi) * 2);
  u32x4 w = {a.x, a.y, b.x, b.y}; return *reinterpret_cast<bf16x8*>(&w);
}
__device__ __forceinline__ bf16x8 pk4(const f32x16& P, int BASE_IS_8) {
  const int B = BASE_IS_8 ? 8 : 0;
  const unsigned a0 = cvt_pk_bf16(P[B + 0], P[B + 1]), a1 = cvt_pk_bf16(P[B + 2], P[B + 3]), b0 = cvt_pk_bf16(P[B + 4], P[B + 5]), b1 = cvt_pk_bf16(P[B + 6], P[B + 7]);
  auto r0 = __builtin_amdgcn_permlane32_swap(a0, b0, false, false); auto r1 = __builtin_amdgcn_permlane32_swap(a1, b1, false, false);
  u32x4 w = {r0[0], r1[0], r0[1], r1[1]}; return *reinterpret_cast<bf16x8*>(&w);
}
#define GLA_PK(L, H) (bf16x8){L[0], L[1], L[2], L[3], H[0], H[1], H[2], H[3]}
__device__ __forceinline__ void gla_phase(int vcu, int G, bf16* Qb, const bf16* Vb, bf16* KFb, bf16* KBb, const bf16* SGb, const float* onorm, char* lds) {
  const int tid = threadIdx.x, wid = __builtin_amdgcn_readfirstlane(tid >> 6), lane = tid & 63, r32 = lane & 31, hi = lane >> 5;
  const int dir = wid >> 2, w4 = wid & 3, ct = tid & 255, kp = ct & 63;
  char* L = lds + dir * CH_BYTES;
  const int lbase = (int)(uintptr_t)L;
  const int vbV = lbase + O_VV + v_rd_base(lane) + w4 * 512, vbK = lbase + O_KD + v_rd_base(lane);
  bf16* Kown = dir ? KBb : KFb; const bf16* Koth = dir ? KFb : KBb;
  for (int it = vcu; it < NB * 8; it += G) {
    const int b = it >> 3, h = it & 7, cb = h * 128; const size_t seq0 = (size_t)b * LP;
    f32x16 S[4];
#pragma unroll
    for (int kb = 0; kb < 4; ++kb) S[kb] = f32x16{};
    unsigned pq[16], pk[16]; bf16x8 pvv[4];
#define GLA_ROW(n, tl) ((n) * 64 + (dir ? 63 - (tl) : (tl)))
#define GLA_LOAD(n) do { _Pragma("unroll") for (int i = 0; i < 16; ++i) { const size_t off = (seq0 + GLA_ROW(n, 16 * w4 + i)) * 1024 + cb + 2 * kp; \
        pq[i] = *(const unsigned*)(Qb + off); pk[i] = *(const unsigned*)(Kown + off); } \
      _Pragma("unroll") for (int i = 0; i < 4; ++i) { const int id = ct + 256 * i; pvv[i] = *(const bf16x8*)(Vb + (seq0 + GLA_ROW(n, id >> 4)) * 1024 + cb + (id & 15) * 8); } } while (0)
#define GLA_PASS1() do { float run0 = 1.f, run1 = 1.f, f20 = 1.f, f21 = 1.f; \
      _Pragma("unroll") for (int i = 0; i < 16; ++i) { run0 *= 1.0f - bf_lo(pk[i]); run1 *= 1.0f - bf_hi(pk[i]); if (i == 0) { f20 = run0; f21 = run1; } } \
      *(f32x2*)(L + V_TOT + (w4 * 128 + 2 * kp) * 4) = (f32x2){run0, run1}; \
      if (w4 == 2) *(f32x2*)(L + V_F2 + (2 * kp) * 4) = (f32x2){f20, f21}; } while (0)
    for (int step = 0; step < 65; ++step) {
      const int n = dir ? 64 - step : step;
      const bool fin = dir ? (step >= 32) : (step >= 33);
      const bool lpath = step >= 32;
      int lane_o = lane; asm volatile("" : "+v"(lane_o));
      const int r32 = lane_o & 31, hi = lane_o >> 5, kp = lane_o, ct = (w4 << 6) | lane_o;
      const int vbV = lbase + O_VV + v_rd_base(lane_o) + w4 * 512, vbK = lbase + O_KD + v_rd_base(lane_o);
      if (step == 0) { GLA_LOAD(n); GLA_PASS1(); __syncthreads(); }
      { const f32x2 t0 = *(const f32x2*)(L + V_TOT + (0 * 128 + 2 * kp) * 4), t1 = *(const f32x2*)(L + V_TOT + (1 * 128 + 2 * kp) * 4), t2 = *(const f32x2*)(L + V_TOT + (2 * 128 + 2 * kp) * 4),
                    t3 = *(const f32x2*)(L + V_TOT + (3 * 128 + 2 * kp) * 4), f2 = *(const f32x2*)(L + V_F2 + (2 * kp) * 4);
        const f32x2 pre = w4 == 0 ? (f32x2){1.f, 1.f} : w4 == 1 ? t0 : w4 == 2 ? t0 * t1 : t0 * t1 * t2;
        const f32x2 pref = t0 * t1 * f2, plast = (t0 * t1) * (t2 * t3);
        const float ir0 = __builtin_amdgcn_rcpf(pref.x), ir1 = __builtin_amdgcn_rcpf(pref.y);
        const float c30 = plast.x * ir0, c31 = plast.y * ir1;
        float run0 = pre.x, run1 = pre.y;
#pragma unroll
        for (int i = 0; i < 16; ++i) { const int t = 16 * w4 + i;
          const float kg0 = bf_lo(pk[i]), kg1 = bf_hi(pk[i]);
          run0 *= 1.0f - kg0; run1 *= 1.0f - kg1;
          const float ki0 = kg0 * pref.x * __builtin_amdgcn_rcpf(run0), ki1 = kg1 * pref.y * __builtin_amdgcn_rcpf(run1);
          *(unsigned*)(L + O_QI + t * RS + 4 * kp) = cvt_pk_bf16(bf_lo(pq[i]) * run0 * ir0, bf_hi(pq[i]) * run1 * ir1);
          *(unsigned*)(L + O_KI + t * RS + 4 * kp) = cvt_pk_bf16(ki0, ki1);
          *(unsigned*)(L + O_KD + v_st4(t, 2 * kp)) = cvt_pk_bf16(ki0 * c30, ki1 * c31); }
        if (w4 == 0) { *(f32x2*)(L + V_DEC + (2 * kp) * 4) = plast; *(f32x2*)(L + V_EREF + (2 * kp) * 4) = pref; }
#pragma unroll
        for (int i = 0; i < 4; ++i) { const int id = ct + 256 * i; *(bf16x8*)(L + O_VV + v_st4(id >> 4, (id & 15) * 8)) = pvv[i]; } }
      __syncthreads();
      f32x16 o[2]; o[0] = f32x16{}; o[1] = f32x16{};
      { bf16x8 Sb[8];
#pragma unroll
        for (int kb = 0; kb < 4; ++kb)
#pragma unroll
          for (int s = 0; s < 2; ++s) { const f32x4 e0 = *(const f32x4*)(L + V_EREF + (32 * kb + 16 * s + 4 * hi) * 4), e1 = *(const f32x4*)(L + V_EREF + (32 * kb + 16 * s + 8 + 4 * hi) * 4);
            u32x4 w; w.x = cvt_pk_bf16(S[kb][8 * s + 0] * e0[0], S[kb][8 * s + 1] * e0[1]); w.y = cvt_pk_bf16(S[kb][8 * s + 2] * e0[2], S[kb][8 * s + 3] * e0[3]);
                     w.z = cvt_pk_bf16(S[kb][8 * s + 4] * e1[0], S[kb][8 * s + 5] * e1[1]); w.w = cvt_pk_bf16(S[kb][8 * s + 6] * e1[2], S[kb][8 * s + 7] * e1[3]);
            Sb[2 * kb + s] = *reinterpret_cast<bf16x8*>(&w); }
#pragma unroll
        for (int tb = 0; tb < 2; ++tb)
#pragma unroll
          for (int ks = 0; ks < 8; ++ks) { o[tb] = __builtin_amdgcn_mfma_f32_32x32x16_bf16(nat_frag(L + O_QI, 32 * tb + r32, ks, hi), Sb[ks], o[tb], 0, 0, 0);
                                           if ((ks & 3) == 3) asm volatile("" ::: "memory"); } }
      { f32x16 a0 = f32x16{};
#pragma unroll
        for (int ks = 0; ks < 8; ++ks) { a0 = __builtin_amdgcn_mfma_f32_32x32x16_bf16(nat_frag(L + O_KI, r32, ks, hi), nat_frag(L + O_QI, r32, ks, hi), a0, 0, 0, 0);
                                         if ((ks & 3) == 3) asm volatile("" ::: "memory"); }
#pragma unroll
        for (int r = 0; r < 16; ++r) a0[r] = crow(r, hi) > r32 ? 0.f : a0[r];
        const bf16x8 pa0 = pk4(a0, 0), pa1 = pk4(a0, 1);
        const s16x4 l0 = tr_read<0 * 4096>(vbV), h0 = tr_read<0 * 4096 + 2048>(vbV), l1 = tr_read<1 * 4096>(vbV), h1 = tr_read<1 * 4096 + 2048>(vbV);
        asm volatile("s_waitcnt lgkmcnt(0)" ::: "memory"); GLA_SBAR();
        o[0] = __builtin_amdgcn_mfma_f32_32x32x16_bf16(pa0, GLA_PK(l0, h0), o[0], 0, 0, 0);
        o[0] = __builtin_amdgcn_mfma_f32_32x32x16_bf16(pa1, GLA_PK(l1, h1), o[0], 0, 0, 0); }
      { f32x16 a0 = f32x16{}, a1 = f32x16{};
#pragma unroll
        for (int ks = 0; ks < 8; ++ks) { const bf16x8 qf = nat_frag(L + O_QI, 32 + r32, ks, hi);
                                         a0 = __builtin_amdgcn_mfma_f32_32x32x16_bf16(nat_frag(L + O_KI, r32, ks, hi), qf, a0, 0, 0, 0);
                                         a1 = __builtin_amdgcn_mfma_f32_32x32x16_bf16(nat_frag(L + O_KI, 32 + r32, ks, hi), qf, a1, 0, 0, 0);
                                         if (ks & 1) asm volatile("" ::: "memory"); }
#pragma unroll
        for (int r = 0; r < 16; ++r) a1[r] = crow(r, hi) > r32 ? 0.f : a1[r];
        const bf16x8 pa0 = pk4(a0, 0), pa1 = pk4(a0, 1), pa2 = pk4(a1, 0), pa3 = pk4(a1, 1);
        const s16x4 l0 = tr_read<0 * 4096>(vbV), h0 = tr_read<0 * 4096 + 2048>(vbV), l1 = tr_read<1 * 4096>(vbV), h1 = tr_read<1 * 4096 + 2048>(vbV);
        const s16x4 l2 = tr_read<2 * 4096>(vbV), h2 = tr_read<2 * 4096 + 2048>(vbV), l3 = tr_read<3 * 4096>(vbV), h3 = tr_read<3 * 4096 + 2048>(vbV);
        asm volatile("s_waitcnt lgkmcnt(0)" ::: "memory"); GLA_SBAR();
        o[1] = __builtin_amdgcn_mfma_f32_32x32x16_bf16(pa0, GLA_PK(l0, h0), o[1], 0, 0, 0);
        o[1] = __builtin_amdgcn_mfma_f32_32x32x16_bf16(pa1, GLA_PK(l1, h1), o[1], 0, 0, 0);
        o[1] = __builtin_amdgcn_mfma_f32_32x32x16_bf16(pa2, GLA_PK(l2, h2), o[1], 0, 0, 0);
        o[1] = __builtin_amdgcn_mfma_f32_32x32x16_bf16(pa3, GLA_PK(l3, h3), o[1], 0, 0, 0); }
      if (lpath) {
      __syncthreads();
      { unsigned short* ot = (unsigned short*)(L + O_KI);
#pragma unroll
        for (int tb = 0; tb < 2; ++tb)
#pragma unroll
          for (int r = 0; r < 16; ++r) ot[(32 * tb + crow(r, hi)) * (RS / 2) + 32 * w4 + r32] = (unsigned short)(cvt_pk_bf16(o[tb][r], 0.f) & 0xffffu); }
      } else {
#pragma unroll
        for (int tb = 0; tb < 2; ++tb)
#pragma unroll
          for (int r = 0; r < 16; ++r) { ((unsigned short*)Kown)[(seq0 + GLA_ROW(n, 32 * tb + crow(r, hi))) * 1024 + cb + 32 * w4 + r32] = (unsigned short)(cvt_pk_bf16(o[tb][r], 0.f) & 0xffffu);
            if ((r & 3) == 3) asm volatile("" ::: "memory"); }
      }
      if (step < 64) { const int nn = dir ? n - 1 : n + 1; GLA_LOAD(nn); }
#pragma unroll
      for (int kb = 0; kb < 4; ++kb)
#pragma unroll
        for (int g4 = 0; g4 < 4; ++g4) { const f32x4 dc = *(const f32x4*)(L + V_DEC + (32 * kb + 8 * g4 + 4 * hi) * 4);
          S[kb][4 * g4 + 0] *= dc[0]; S[kb][4 * g4 + 1] *= dc[1]; S[kb][4 * g4 + 2] *= dc[2]; S[kb][4 * g4 + 3] *= dc[3]; }
      { const s16x4 l0 = tr_read<0 * 4096>(vbV), h0 = tr_read<0 * 4096 + 2048>(vbV), l1 = tr_read<1 * 4096>(vbV), h1 = tr_read<1 * 4096 + 2048>(vbV);
        const s16x4 l2 = tr_read<2 * 4096>(vbV), h2 = tr_read<2 * 4096 + 2048>(vbV), l3 = tr_read<3 * 4096>(vbV), h3 = tr_read<3 * 4096 + 2048>(vbV);
        asm volatile("s_waitcnt lgkmcnt(0)" ::: "memory"); GLA_SBAR();
        const bf16x8 vf0 = GLA_PK(l0, h0), vf1 = GLA_PK(l1, h1), vf2 = GLA_PK(l2, h2), vf3 = GLA_PK(l3, h3);
#define GLA_UPD(kb) do { const s16x4 a0 = tr_read<(kb) * 512 + 0 * 4096>(vbK), b0 = tr_read<(kb) * 512 + 0 * 4096 + 2048>(vbK), a1 = tr_read<(kb) * 512 + 1 * 4096>(vbK), b1 = tr_read<(kb) * 512 + 1 * 4096 + 2048>(vbK); \
          const s16x4 a2 = tr_read<(kb) * 512 + 2 * 4096>(vbK), b2 = tr_read<(kb) * 512 + 2 * 4096 + 2048>(vbK), a3 = tr_read<(kb) * 512 + 3 * 4096>(vbK), b3 = tr_read<(kb) * 512 + 3 * 4096 + 2048>(vbK); \
          asm volatile("s_waitcnt lgkmcnt(0)" ::: "memory"); GLA_SBAR(); \
          S[kb] = __builtin_amdgcn_mfma_f32_32x32x16_bf16(GLA_PK(a0, b0), vf0, S[kb], 0, 0, 0); S[kb] = __builtin_amdgcn_mfma_f32_32x32x16_bf16(GLA_PK(a1, b1), vf1, S[kb], 0, 0, 0); \
          S[kb] = __builtin_amdgcn_mfma_f32_32x32x16_bf16(GLA_PK(a2, b2), vf2, S[kb], 0, 0, 0); S[kb] = __builtin_amdgcn_mfma_f32_32x32x16_bf16(GLA_PK(a3, b3), vf3, S[kb], 0, 0, 0); } while (0)
        GLA_UPD(0); GLA_UPD(1); GLA_UPD(2); GLA_UPD(3);
#undef GLA_UPD
      }
      if (lpath) {
      __syncthreads();
      const int t = ct >> 2, q4 = ct & 3; const size_t goff = (seq0 + GLA_ROW(n, t)) * 1024 + cb + 32 * q4;
      u32x2 ow[8];
#pragma unroll
      for (int i = 0; i < 8; ++i) ow[i] = *(const u32x2*)(L + O_KI + t * RS + q4 * 64 + i * 8);
      if (!fin) {
#pragma unroll
        for (int i = 0; i < 4; ++i) *(u32x4*)(Kown + goff + 8 * i) = (u32x4){ow[2 * i].x, ow[2 * i].y, ow[2 * i + 1].x, ow[2 * i + 1].y};
      }
      if (step == 32) __syncthreads();
      if (fin) {
        float ov[32]; float ss = 0.f;
#pragma unroll
        for (int i = 0; i < 4; ++i) { const u32x4 pw = *(const u32x4*)(Koth + goff + 8 * i);
          ov[8 * i + 0] = bf_lo(ow[2 * i].x) + bf_lo(pw.x); ov[8 * i + 1] = bf_hi(ow[2 * i].x) + bf_hi(pw.x); ov[8 * i + 2] = bf_lo(ow[2 * i].y) + bf_lo(pw.y); ov[8 * i + 3] = bf_hi(ow[2 * i].y) + bf_hi(pw.y);
          ov[8 * i + 4] = bf_lo(ow[2 * i + 1].x) + bf_lo(pw.z); ov[8 * i + 5] = bf_hi(ow[2 * i + 1].x) + bf_hi(pw.z); ov[8 * i + 6] = bf_lo(ow[2 * i + 1].y) + bf_lo(pw.w); ov[8 * i + 7] = bf_hi(ow[2 * i + 1].y) + bf_hi(pw.w); }
#pragma unroll
        for (int i = 0; i < 32; ++i) ss += ov[i] * ov[i];
        ss += __shfl_xor(ss, 1); ss += __shfl_xor(ss, 2);
        const float rstd = 1.0f / sqrtf(ss * (1.0f / 128.0f) + EPS);
#pragma unroll
        for (int i = 0; i < 4; ++i) { const u32x4 gw = *(const u32x4*)(SGb + goff + 8 * i); const f32x4 n0 = *(const f32x4*)(onorm + cb + 32 * q4 + 8 * i), n1 = *(const f32x4*)(onorm + cb + 32 * q4 + 8 * i + 4);
          u32x4 w; w.x = cvt_pk_bf16(ov[8 * i + 0] * rstd * n0[0] * bf_lo(gw.x), ov[8 * i + 1] * rstd * n0[1] * bf_hi(gw.x)); w.y = cvt_pk_bf16(ov[8 * i + 2] * rstd * n0[2] * bf_lo(gw.y), ov[8 * i + 3] * rstd * n0[3] * bf_hi(gw.y));
                   w.z = cvt_pk_bf16(ov[8 * i + 4] * rstd * n1[0] * bf_lo(gw.z), ov[8 * i + 5] * rstd * n1[1] * bf_hi(gw.z)); w.w = cvt_pk_bf16(ov[8 * i + 6] * rstd * n1[2] * bf_lo(gw.w), ov[8 * i + 7] * rstd * n1[3] * bf_hi(gw.w));
          *(u32x4*)(Qb + goff + 8 * i) = w; }
      }
      }
      if (step < 64) GLA_PASS1();
      __syncthreads();
    }
#undef GLA_ROW
#undef GLA_LOAD
#undef GLA_PASS1
  }
  __syncthreads();
}
#undef GLA_PK
#undef GLA_SBAR
}
constexpr int NPHASE = 16;
#ifndef GLA_SIMPLE
#define GLA_SIMPLE 0
#endif
#ifndef ATTN_SIMPLE
#define ATTN_SIMPLE 0
#endif
#ifndef MK_ONE_LAUNCH
#define MK_ONE_LAUNCH 1
#endif
struct Args { const float* in[19]; float* out; unsigned char* ws; int ph_lo, ph_hi; };
__global__ void __launch_bounds__(NWAVES * 64, 2) fwd(Args args) {
    extern __shared__ __attribute__((aligned(16))) unsigned char lds[];
    Frame F;
    F.lds = (LAS unsigned char*)lds;
    F.MISC = (volatile LAS unsigned*)(F.lds + MISC_OFF);
    F.tid = threadIdx.x; F.lane = F.tid & 63; F.wave = __builtin_amdgcn_readfirstlane(F.tid >> 6);
    F.G = gridDim.x; { const int bx = blockIdx.x; F.vcu = (F.G % 8 == 0) ? (bx % 8) * (F.G / 8) + bx / 8 : bx; }
    unsigned char* ws = args.ws;
    for (int u = F.tid; u < (LDS_BYTES - LDSCTL_OFF) / 4; u += NWAVES * 64) ((LAS unsigned*)(F.lds + LDSCTL_OFF))[u] = 0u;
    __syncthreads();
    const int lo = args.ph_lo, hi = args.ph_hi;
    XcdBarrier bar; bar.bar = (unsigned*)(ws + WS_CTL); bar.x = 0; bar.st = nullptr;
    if (hi - lo > 1) bar = xcd_barrier_post((unsigned*)(ws + WS_CTL), F.MISC + 8);
#ifndef ONLY_PHASE
#define ONLY_PHASE -1
#endif
#define IN(k) (lo <= (k) && (k) < hi && (ONLY_PHASE < 0 || ONLY_PHASE == (k)))
#ifndef DUP_MASK
#define DUP_MASK 0
#endif
#ifndef PROBE_NULL_GEMM
#define PROBE_NULL_GEMM 0
#endif
#ifndef DUP_GLA
#define DUP_GLA 0
#endif
#define SEAM(k) do { if (IN(k) && IN((k) + 1)) xcd_barrier(bar); } while (0)
    const float* const* in = args.in;
    bf16* hD = (bf16*)args.out;
    bf16* hB = (bf16*)(ws + WS_B0 + (size_t)SLACK * ROWB);
    const pg8::f32x2* rope = (const pg8::f32x2*)(ws + WS_ROPE);
    using pg8::Gemm; using pg8::StaticOrder;
    const int cid = (int)blockIdx.x;

    if (IN(0)) { p0_prologue(F, in, ws, hD); } SEAM(0);
    if (IN(1)) { Gemm g{hD, (const bf16*)(ws + W_IN), 1024, 1024, 1024}; StaticOrder S; S.init(MT, 5, F.G, cid);
        pg8::EpiProj E{(bf16*)(ws + R_CQKV), (float*)(ws + R_SSQ), (bf16*)(ws + R_KROPE), rope};
        pg8::gemm_phase<pg8::EpiProj, StaticOrder, true, true>(F.lds + RING_OFF, g, S, E); } SEAM(1);
    if (IN(2)) {
        { Gemm g{(const bf16*)(ws + R_CQKV), (const bf16*)(ws + W_UQ), 768, 1024, 768}; StaticOrder S; S.init(MT, 6, F.G, cid);
          pg8::EpiQ E{(bf16*)(ws + R_Q), (const float*)(ws + R_SSQ), rope};
          pg8::gemm_phase<pg8::EpiQ, StaticOrder, true, true>(F.lds + RING_OFF, g, S, E); }
        { Gemm g{(const bf16*)(ws + R_CQKV) + 768, (const bf16*)(ws + W_UKV), 256, 1024, 256}; StaticOrder S; S.init(MT, 8, F.G, cid);
          pg8::EpiKV E{(bf16*)(ws + R_KV), (const float*)(ws + R_SSQ)};
          pg8::gemm_phase<pg8::EpiKV, StaticOrder, true, true>(F.lds + RING_OFF, g, S, E); }
    } SEAM(2);
    if (IN(3)) {
#if ATTN_SIMPLE
        attn_simple(F, (const bf16*)(ws + R_Q), (const bf16*)(ws + R_KV), (const bf16*)(ws + R_KROPE), (bf16*)(ws + R_CQKV));
#else
        fa2::attn_phase(F.vcu, F.G, (const bf16*)(ws + R_Q), (const bf16*)(ws + R_KV), (const bf16*)(ws + R_KROPE), (bf16*)(ws + R_CQKV), (char*)lds);
#endif
        { const int nlast = (NB * 16 * fa::NQC) % F.G; if (F.vcu >= nlast) tail_jobs_0(F, in, ws, F.vcu - nlast, F.G - nlast); }
    } SEAM(3);
    if (IN(4)) { Gemm g{(const bf16*)(ws + R_CQKV), (const bf16*)(ws + W_O), 1024, 1024, 1024}; StaticOrder S; S.init(MT, 4, F.G, cid);
        pg8::EpiResidLN<false, false> E{hD, nullptr, nullptr, nullptr, hB, (pg8::f32x2*)(ws + WS_SUM1) + SLACK, nullptr};
        pg8::gemm_phase<pg8::EpiResidLN<false, false>, StaticOrder, true, true>(F.lds + RING_OFF, g, S, E);
        { const int nfull = (MT * 4) % F.G; if (cid >= nfull) tail_jobs_a(F, in, ws, cid - nfull, F.G - nfull); } } SEAM(4);
#if PROBE_NULL_GEMM
    if (IN(5)) { Gemm g{hD, (const bf16*)(ws + W_HIN), 1024, 1024, 1024}; StaticOrder S; S.init(MT, 20, F.G, cid);
        pg8::EpiNull E{(float*)(ws + WS_CTL + 32768)};
        pg8::gemm_phase<pg8::EpiNull, StaticOrder, true, true>(F.lds + RING_OFF, g, S, E); }
#endif
    if (IN(6)) { Gemm g{hB - 1024, (const bf16*)(ws + W_UP0), 1024, 1024, 1024}; StaticOrder S; S.init(MT_UP, 22, F.G, cid);
        pg8::EpiConvGate E{(bf16*)(ws + R_ACT), in[14], in[15], (const pg8::f32x2*)(ws + WS_SUM1) + SLACK, (const float*)(ws + C1_UP0), (const float*)(ws + C2_UP0)};
        pg8::gemm_phase<pg8::EpiConvGate, StaticOrder, true, true, true>(F.lds + RING_OFF, g, S, E); } SEAM(6);
    if (IN(7)) { Gemm g{(const bf16*)(ws + R_ACT), (const bf16*)(ws + W_DN0), DFF, DFF, DFF}; StaticOrder S; S.init(MT, 4, F.G, cid);
        pg8::EpiResidLN<true, false> E{hB, (const pg8::f32x2*)(ws + WS_SUM1) + SLACK, in[17] + 0 * 1024, in[18] + 0 * 1024, hD, (pg8::f32x2*)(ws + WS_SUM2) + SLACK, nullptr};
        pg8::gemm_phase<pg8::EpiResidLN<true, false>, StaticOrder, true, true>(F.lds + RING_OFF, g, S, E);
        { const int nfull = (MT * 4) % F.G; if (cid >= nfull) tail_jobs_b(F, in, ws, cid - nfull, F.G - nfull); } } SEAM(7);
    if (IN(9)) { Gemm g{hD, (const bf16*)(ws + W_HIN), 1024, 1024, 1024}; StaticOrder S; S.init(MT, 20, F.G, cid);
        pg8::EpiHgIn E{hB, (bf16*)(ws + R_HV), (bf16*)(ws + R_HKF), (bf16*)(ws + R_HKB), (bf16*)(ws + R_HSG), (const float*)(ws + WS_LB), (const pg8::f32x2*)(ws + WS_SUM2) + SLACK, (const float*)(ws + C1_HG), (const float*)(ws + C2_HG)};
        pg8::gemm_phase<pg8::EpiHgIn, StaticOrder, true, true>(F.lds + RING_OFF, g, S, E); } SEAM(9);
    if (IN(10)) {
#if GLA_SIMPLE
        gla_simple(F, hB, (const bf16*)(ws + R_HV), (bf16*)(ws + R_HKF), (const bf16*)(ws + R_HKB), (const bf16*)(ws + R_HSG), in[11]);
#else
        gla::gla_phase((int)blockIdx.x, F.G, hB, (const bf16*)(ws + R_HV), (bf16*)(ws + R_HKF), (bf16*)(ws + R_HKB), (const bf16*)(ws + R_HSG), in[11], (char*)lds);
#endif
    } SEAM(10);
    if (IN(11)) {
        { const int gt = (F.vcu * NWAVES + F.wave) * 64 + F.lane, NGT = F.G * NWAVES * 64; GAS v4u* z0 = (GAS v4u*)(ws + R_HSG); GAS v4u* z1 = (GAS v4u*)(ws + R_XB3 + (size_t)M * ROWB);
          for (int i = gt; i < SLACK * (int)ROWB / 16; i += NGT) { z0[i] = (v4u){0u, 0u, 0u, 0u}; z1[i] = (v4u){0u, 0u, 0u, 0u}; } }
        Gemm g{hB, (const bf16*)(ws + W_HO), 1024, 1024, 1024}; StaticOrder S; S.init(MT, 4, F.G, cid);
        pg8::EpiResidLN<true, false> E{hD, (const pg8::f32x2*)(ws + WS_SUM2) + SLACK, in[17] + 1 * 1024, in[18] + 1 * 1024, (bf16*)(ws + R_XB3), (pg8::f32x2*)(ws + WS_SUM3) + SLACK, nullptr};
        pg8::gemm_phase<pg8::EpiResidLN<true, false>, StaticOrder, true, true>(F.lds + RING_OFF, g, S, E); } SEAM(11);
    if (IN(13)) { Gemm g{(const bf16*)(ws + R_XB3) - 1024, (const bf16*)(ws + W_UP1), 1024, 1024, 1024}; StaticOrder S; S.init(MT_UP, 22, F.G, cid);
        pg8::EpiConvGate E{(bf16*)(ws + R_ACT), in[14] + 3 * NUP, in[15] + NUP, (const pg8::f32x2*)(ws + WS_SUM3) + SLACK, (const float*)(ws + C1_UP1), (const float*)(ws + C2_UP1)};
        pg8::gemm_phase<pg8::EpiConvGate, StaticOrder, true, true, true>(F.lds + RING_OFF, g, S, E); } SEAM(13);
    if (IN(14)) { Gemm g{(const bf16*)(ws + R_ACT), (const bf16*)(ws + W_DN1), DFF, DFF, DFF}; StaticOrder S; S.init(MT, 4, F.G, cid);
        pg8::EpiResidLN<true, false> E{(const bf16*)(ws + R_XB3), (const pg8::f32x2*)(ws + WS_SUM3) + SLACK, in[17] + 2 * 1024, in[18] + 2 * 1024, hB, (pg8::f32x2*)(ws + WS_SUM4) + SLACK, nullptr};
        pg8::gemm_phase<pg8::EpiResidLN<true, false>, StaticOrder, true, true>(F.lds + RING_OFF, g, S, E); } SEAM(14);
    if (IN(15)) { ln_final(F, hB, (const f32x2*)(ws + WS_SUM4) + SLACK, args.out, in[17] + 3 * 1024, in[18] + 3 * 1024); }
#undef IN
#undef SEAM
}

__global__ void nan_fill(float* o, long n) { const float q = __builtin_nanf(""); for (long i = blockIdx.x * 256L + threadIdx.x; i < n; i += gridDim.x * 256L) o[i] = q; }
extern "C" void kernel_launch(void* const* d_in, const int* in_sizes, int n_in, void* d_out, int out_size, void* d_ws, size_t ws_size, hipStream_t stream) {
    static int grid = 0;
    if (grid == 0) {
        bool ok = (n_in == 19) && in_sizes[0] == 16 * SEQ * 1024 && in_sizes[1] == 4 * SEQ * 1024 && out_size == NB * SEQ * 1024 && ws_size >= WS_END;
        int dev = 0, cus = 0;
        if (ok) ok = hipGetDevice(&dev) == hipSuccess && hipDeviceGetAttribute(&cus, hipDeviceAttributeMultiprocessorCount, dev) == hipSuccess;
        if (ok) ok = hipFuncSetAttribute((const void*)fwd, hipFuncAttributeMaxDynamicSharedMemorySize, LDS_BYTES) == hipSuccess;
        if (!ok) { fprintf(stderr, "kernel_launch: unexpected shapes / workspace (%zu) / device\n", ws_size); grid = -1; }
        else grid = cus;
        (void)hipGetLastError();
    }
    if (grid < 0) { hipLaunchKernelGGL(nan_fill, dim3(1024), dim3(256), 0, stream, (float*)d_out, (long)out_size); return; }
    (void)hipMemsetAsync((char*)d_ws + WS_CTL, 0, CTL_ZERO_BYTES, stream);
    Args a{};
    for (int i = 0; i < 19; ++i) a.in[i] = (const float*)d_in[i];
    a.out = (float*)d_out; a.ws = (unsigned char*)d_ws;
#if MK_ONE_LAUNCH
    a.ph_lo = 0; a.ph_hi = NPHASE;
    hipLaunchKernelGGL(fwd, dim3(grid), dim3(NWAVES * 64), LDS_BYTES, stream, a);
#else
    for (int p = 0; p < NPHASE; ++p) { if ((p == 5 && !PROBE_NULL_GEMM) || p == 8 || p == 12) continue;
        for (int r = 0; r < 1 + ((DUP_MASK >> p) & 1); ++r) { a.ph_lo = p; a.ph_hi = p + 1; hipLaunchKernelGGL(fwd, dim3(grid), dim3(NWAVES * 64), LDS_BYTES, stream, a); }
        if (p == 10 && DUP_GLA) for (int q = 9; q <= 10; ++q) { a.ph_lo = q; a.ph_hi = q + 1; hipLaunchKernelGGL(fwd, dim3(grid), dim3(NWAVES * 64), LDS_BYTES, stream, a); } }
#endif
}
```

```cpp
#include <hip/hip_runtime.h>
#include <cstdio>
constexpr int NB = 20;
constexpr int LP = 4160;
constexpr int PADR = 48, LTOK = 4112, SEQ = 4096, DM = 1024;
constexpr int M = NB * LP;
constexpr int MT = M / 256;
constexpr int DFF = 2816, NUP = 2 * DFF;
constexpr int NBLK62 = (M + 61) / 62;
constexpr int MT_UP = (NBLK62 + 3) / 4;
constexpr float EPS = 1e-6f, ALPHA = 1.4142135623730951f;
constexpr float SM_C = 0.10206207261596575f * 1.4426950408889634f;
#include <cstdint>
namespace pg8 {
#define PG8_LAS __attribute__((address_space(3)))
typedef unsigned short bf16_t;
typedef short bf16x8 __attribute__((ext_vector_type(8)));
typedef float f32x4 __attribute__((ext_vector_type(4)));
typedef unsigned u32x4 __attribute__((ext_vector_type(4)));
typedef unsigned u32x2 __attribute__((ext_vector_type(2)));
constexpr int BM = 256, BK = 64, HALF = 128, HTB = HALF * BK * 2  , STAGE_BYTES = 8 * HTB, NXCD = 8, WGM = 8;

__host__ __device__ __forceinline__ int lds_byte(int r, int c) { const int st = (r >> 4) * 2 + (c >> 5), rr = r & 15, cc = c & 31, ob = rr * 64 + cc * 2; return st * 1024 + (ob ^ (((ob >> 9) & 1) << 5)); }
__host__ __device__ __forceinline__ void stage_rc(int b, int& R, int& C) { const int st = b / 1024, sb = b % 1024, swz = sb ^ (((sb >> 9) & 1) << 5); R = (st >> 1) * 16 + swz / 64; C = (st & 1) * 32 + (swz % 64) / 2; }
__host__ __device__ __forceinline__ int perm32(int rho) { const int n = rho >> 4, i = rho & 15; return 8 * (i >> 2) + 4 * n + (i & 3); }

struct Unit { int pm, pn; };
struct Gemm { const bf16_t* A; const bf16_t* Bt; int K, lda, ldb; };

struct StaticOrder {
    int nM, nN, nwg, G, c;
    __host__ __device__ void init(int nM_, int nN_, int G_, int c_) { nM = nM_; nN = nN_; nwg = nM * nN; G = G_; c = c_; }
    __host__ __device__ bool next(int i, Unit& u) const {
        const long L = (long)i * G + c; if (L >= nwg) return false;
        int wgid = (int)L; { const int q = nwg / NXCD, r = nwg % NXCD, xcd = wgid % NXCD, off = wgid / NXCD; wgid = (xcd < r ? xcd * (q + 1) : r * (q + 1) + (xcd - r) * q) + off; }
        const int nig = WGM * nN, gid = wgid / nig, fm = gid * WGM, gsz = (nM - fm) < WGM ? (nM - fm) : WGM;
        u.pm = fm + ((wgid % nig) % gsz); u.pn = (wgid % nig) / gsz; return true;
    }
    __device__ __forceinline__ void a_ready(const Unit&) const {}
    __device__ __forceinline__ void done(const Unit&) const {}
};
__device__ __forceinline__ unsigned cvt_pk_bf16(float lo, float hi) { unsigned r; asm volatile("v_cvt_pk_bf16_f32 %0, %1, %2" : "=v"(r) : "v"(lo), "v"(hi)); return r; }
__device__ __forceinline__ float bf_lo(unsigned w) { return __uint_as_float(w << 16); }
__device__ __forceinline__ float bf_hi(unsigned w) { return __uint_as_float(w & 0xffff0000u); }
typedef float f32x2 __attribute__((ext_vector_type(2)));
__device__ __forceinline__ u32x4 pack8(const f32x4 v0, const f32x4 v1) { u32x4 w; w.x = cvt_pk_bf16(v0[0], v0[1]); w.y = cvt_pk_bf16(v0[2], v0[3]); w.z = cvt_pk_bf16(v1[0], v1[1]); w.w = cvt_pk_bf16(v1[2], v1[3]); return w; }
__device__ __forceinline__ void rope8(f32x4& v0, f32x4& v1, const f32x2* tab, int pos, int i0) {
    const f32x2* t = tab + pos * 16 + i0;
    const f32x2 c0 = t[0], c1 = t[1], c2 = t[2], c3 = t[3];
    f32x4 a, b;
    a[0] = v0[0] * c0.x - v0[1] * c0.y; a[1] = v0[0] * c0.y + v0[1] * c0.x;
    a[2] = v0[2] * c1.x - v0[3] * c1.y; a[3] = v0[2] * c1.y + v0[3] * c1.x;
    b[0] = v1[0] * c2.x - v1[1] * c2.y; b[1] = v1[0] * c2.y + v1[1] * c2.x;
    b[2] = v1[2] * c3.x - v1[3] * c3.y; b[3] = v1[2] * c3.y + v1[3] * c3.x;
    v0 = a; v1 = b;
}
__device__ __forceinline__ void glds16(const void* src, PG8_LAS unsigned char* dst_wave_base) { __builtin_amdgcn_global_load_lds((const unsigned*)src, (PG8_LAS unsigned*)dst_wave_base, 16, 0, 0); }
struct EpiProj {
    static constexpr bool PERM = true, AFTER_DRAIN = false, STAGED = false;
    bf16_t* cqkv; float* ssq; bf16_t* krope; const f32x2* rope;
    __device__ __forceinline__ void operator()(const f32x4 (&acc)[2][2][4][2], const Unit& u, int wr, int wc, int fr, int fq, PG8_LAS unsigned char*) const {
        const int row0 = u.pm * BM + wr * 64 + fr;
        if (u.pn < 4) {
            const int col0 = u.pn * BM + wc * 32 + 8 * fq;
#pragma unroll
            for (int ai = 0; ai < 2; ++ai)
#pragma unroll
                for (int m = 0; m < 4; ++m) { const int row = row0 + ai * HALF + m * 16; float s = 0.f;
#pragma unroll
                    for (int bj = 0; bj < 2; ++bj) { const f32x4 v0 = acc[ai][bj][m][0], v1 = acc[ai][bj][m][1];
                        s += (v0[0] * v0[0] + v0[1] * v0[1]) + (v0[2] * v0[2] + v0[3] * v0[3]) + (v1[0] * v1[0] + v1[1] * v1[1]) + (v1[2] * v1[2] + v1[3] * v1[3]);
                        *(u32x4*)(cqkv + (size_t)row * 1024 + col0 + bj * HALF) = pack8(v0, v1); }
                    s += __shfl_xor(s, 16); s += __shfl_xor(s, 32);
                    if (fq == 0) __hip_atomic_fetch_add((unsigned*)ssq + (size_t)row * 2 + (u.pn == 3 ? 1 : 0), __float2uint_rn(s * 4096.0f), __ATOMIC_RELAXED, __HIP_MEMORY_SCOPE_AGENT); }
        } else if (wc == 0) {
#pragma unroll
            for (int ai = 0; ai < 2; ++ai)
#pragma unroll
                for (int m = 0; m < 4; ++m) { const int row = row0 + ai * HALF + m * 16; int pos = row % LP - PADR; pos = pos < 0 ? 0 : pos;
                    f32x4 v0 = acc[ai][0][m][0], v1 = acc[ai][0][m][1]; rope8(v0, v1, rope, pos, 4 * fq);
                    *(u32x4*)(krope + (size_t)row * 32 + 8 * fq) = pack8(v0, v1); }
        }
    }
};
struct EpiQ {
    static constexpr bool PERM = true, AFTER_DRAIN = false, STAGED = true;
    bf16_t* Q; const float* ssq; const f32x2* rope;
    __device__ __forceinline__ void stage(PG8_LAS unsigned char* slot, const Unit& u, int tid, int wid) const { asm volatile("" : "+v"(tid)); if (tid < 128) glds16(ssq + ((size_t)u.pm * BM + tid * 2) * 2, slot + wid * 1024); }
    __device__ __forceinline__ void operator()(const f32x4 (&acc)[2][2][4][2], const Unit& u, int wr, int wc, int fr, int fq, PG8_LAS unsigned char* slot) const {
        const int col0 = u.pn * BM + wc * 32 + 8 * fq; const PG8_LAS unsigned char* rb = slot + (wr * 64 + fr) * 8;
#pragma unroll
        for (int ai = 0; ai < 2; ++ai)
#pragma unroll
            for (int m = 0; m < 4; ++m) { const int lr = ai * HALF + wr * 64 + m * 16 + fr, row = u.pm * BM + lr; int pos = row % LP - PADR; pos = pos < 0 ? 0 : pos;
                const float ss = (float)*(const PG8_LAS unsigned*)(rb + (ai * HALF + m * 16) * 8) * (1.0f / 4096.0f);
                const float rstd = SM_C / sqrtf(ss * (1.0f / 768.0f) + EPS);
#pragma unroll
                for (int bj = 0; bj < 2; ++bj) { const int c = col0 + bj * HALF, d = c % 96; f32x4 v0 = acc[ai][bj][m][0] * rstd, v1 = acc[ai][bj][m][1] * rstd;
                    if (d >= 64) rope8(v0, v1, rope, pos, (d - 64) >> 1);
                    *(u32x4*)(Q + (size_t)row * 1536 + c) = pack8(v0, v1); }
                asm volatile("" ::: "memory"); }
    }
};
struct EpiKV {
    static constexpr bool PERM = true, AFTER_DRAIN = false, STAGED = true;
    bf16_t* KV; const float* ssq;
    __device__ __forceinline__ void stage(PG8_LAS unsigned char* slot, const Unit& u, int tid, int wid) const { asm volatile("" : "+v"(tid)); if (tid < 128) glds16(ssq + ((size_t)u.pm * BM + tid * 2) * 2, slot + wid * 1024); }
    __device__ __forceinline__ void operator()(const f32x4 (&acc)[2][2][4][2], const Unit& u, int wr, int wc, int fr, int fq, PG8_LAS unsigned char* slot) const {
        const int col0 = u.pn * BM + wc * 32 + 8 * fq; const PG8_LAS unsigned char* rb = slot + (wr * 64 + fr) * 8 + 4;
#pragma unroll
        for (int ai = 0; ai < 2; ++ai)
#pragma unroll
            for (int m = 0; m < 4; ++m) { const int lr = ai * HALF + wr * 64 + m * 16 + fr, row = u.pm * BM + lr;
                const float rstd = 1.0f / sqrtf((float)*(const PG8_LAS unsigned*)(rb + (ai * HALF + m * 16) * 8) * (1.0f / (4096.0f * 256.0f)) + EPS);
#pragma unroll
                for (int bj = 0; bj < 2; ++bj) *(u32x4*)(KV + (size_t)row * 2048 + col0 + bj * HALF) = pack8(acc[ai][bj][m][0] * rstd, acc[ai][bj][m][1] * rstd); }
    }
};
__device__ __forceinline__ void mean_rstd(const u32x2 raw, float& mean, float& rstd) {
    mean = (float)(int)raw.x * (1.0f / (4096.0f * 1024.0f)); rstd = 1.0f / sqrtf(fmaxf((float)raw.y * (1.0f / (32768.0f * 1024.0f)) - mean * mean, 0.f) + EPS);
}
template <bool BASE_LN, bool OUT_F32> struct EpiResidLN {
    static constexpr bool PERM = false, AFTER_DRAIN = false, STAGED = BASE_LN;
    const bf16_t* hb; const f32x2* SUMp; const float* g; const float* b; bf16_t* xo; f32x2* SUMo; float* of32;
    __device__ __forceinline__ void stage(PG8_LAS unsigned char* slot, const Unit& u, int tid, int wid) const {
        asm volatile("" : "+v"(tid));
        const int c = tid; const void* src = c < 64 ? (const void*)(g + u.pn * BM + c * 4) : c < 128 ? (const void*)(b + u.pn * BM + (c - 64) * 4) : (const void*)(SUMp + u.pm * BM + (c - 128) * 2);
        if (c < 256) glds16(src, slot + wid * 1024);
    }
    __device__ __forceinline__ void operator()(const f32x4 (&acc)[2][2][4][2], const Unit& u, int wr, int wc, int fr, int fq, PG8_LAS unsigned char* slot) const {
        const int row0 = u.pm * BM + wr * 64 + fr, col0 = u.pn * BM + wc * 32 + 4 * fq, lc0 = wc * 32 + 4 * fq;
#pragma unroll
        for (int ai = 0; ai < 2; ++ai)
#pragma unroll
            for (int m = 0; m < 4; ++m) { const int lr = ai * HALF + wr * 64 + m * 16 + fr, row = u.pm * BM + lr; const size_t off = (size_t)row * 1024 + col0; const int sq = row % LP;
                float mean = 0.f, rstd = 0.f; if (BASE_LN) mean_rstd(*(const PG8_LAS u32x2*)(slot + (wr * 64 + fr) * 8 + (2048 + (ai * HALF + m * 16) * 8)), mean, rstd);
                const bool pad = sq < PADR; float s = 0.f, q = 0.f; f32x4 x[2][2];
#pragma unroll
                for (int bj = 0; bj < 2; ++bj)
#pragma unroll
                    for (int n = 0; n < 2; ++n) { const u32x2 hw = *(const u32x2*)(hb + off + bj * HALF + n * 16);
                        f32x4 hv; hv[0] = bf_lo(hw.x); hv[1] = bf_hi(hw.x); hv[2] = bf_lo(hw.y); hv[3] = bf_hi(hw.y);
                        if (BASE_LN) { const f32x4 gv = *(const PG8_LAS f32x4*)(slot + (lc0 + bj * HALF + n * 16) * 4), bv = *(const PG8_LAS f32x4*)(slot + 1024 + (lc0 + bj * HALF + n * 16) * 4);
                            hv = (hv - mean) * rstd * gv + bv; if (pad) hv = (f32x4){0.f, 0.f, 0.f, 0.f}; }
                        const f32x4 xv = hv * ALPHA + acc[ai][bj][m][n]; x[bj][n] = xv;
                        s += (xv[0] + xv[1]) + (xv[2] + xv[3]); q += (xv[0] * xv[0] + xv[1] * xv[1]) + (xv[2] * xv[2] + xv[3] * xv[3]); }
                if (OUT_F32) { if (sq >= 64) { float* orow = of32 + ((size_t)(row / LP) * SEQ + (sq - 64)) * 1024 + col0;
#pragma unroll
                        for (int bj = 0; bj < 2; ++bj)
#pragma unroll
                            for (int n = 0; n < 2; ++n) *(f32x4*)(orow + bj * HALF + n * 16) = x[bj][n]; }
                } else {
#pragma unroll
                    for (int bj = 0; bj < 2; ++bj)
#pragma unroll
                        for (int n = 0; n < 2; ++n) { u32x2 w; w.x = cvt_pk_bf16(x[bj][n][0], x[bj][n][1]); w.y = cvt_pk_bf16(x[bj][n][2], x[bj][n][3]); *(u32x2*)(xo + off + bj * HALF + n * 16) = w; }
                    s += __shfl_xor(s, 16); q += __shfl_xor(q, 16); s += __shfl_xor(s, 32); q += __shfl_xor(q, 32);
                    if (fq == 0) { unsigned* sp = (unsigned*)(SUMo + row); __hip_atomic_fetch_add(sp, (unsigned)__float2int_rn(s * 4096.0f), __ATOMIC_RELAXED, __HIP_MEMORY_SCOPE_AGENT); __hip_atomic_fetch_add(sp + 1, __float2uint_rn(q * 32768.0f), __ATOMIC_RELAXED, __HIP_MEMORY_SCOPE_AGENT); } } }
        (void)row0;
    }
};
struct EpiHgIn {
    static constexpr bool PERM = true, AFTER_DRAIN = false, STAGED = true;
    bf16_t* q; bf16_t* v; bf16_t* kf; bf16_t* kb; bf16_t* sg; const float* lb;
    const f32x2* SUM; const float* c1; const float* c2;
    __device__ __forceinline__ void stage(PG8_LAS unsigned char* slot, const Unit& u, int tid, int wid) const {
        asm volatile("" : "+v"(tid));
        const int c = tid, t = u.pn >> 2;
        const void* src = c < 64 ? (const void*)(c1 + u.pn * BM + c * 4) : c < 128 ? (const void*)(c2 + u.pn * BM + (c - 64) * 4)
                        : c < 192 ? (const void*)(lb + ((t == 3) ? 1024 : 0) + (u.pn & 3) * BM + (c - 128) * 4) : (const void*)(SUM + u.pm * BM + (c - 192) * 2);
        if (c < 320) glds16(src, slot + wid * 1024);
    }
    __device__ __forceinline__ void operator()(const f32x4 (&acc)[2][2][4][2], const Unit& u, int wr, int wc, int fr, int fq, PG8_LAS unsigned char* slot) const {
        const int t = u.pn >> 2, col0 = (u.pn & 3) * BM + wc * 32 + 8 * fq, lc0 = wc * 32 + 8 * fq;
        bf16_t* dst = t == 0 ? q : t == 1 ? v : t == 2 ? kf : t == 3 ? kb : sg;
#pragma unroll
        for (int bj = 0; bj < 2; ++bj) { const int c = col0 + bj * HALF, lc = lc0 + bj * HALF;
            f32x4 om0 = {1.f, 1.f, 1.f, 1.f}, om1 = om0;
            if (t == 2 || t == 3) { om0 = 1.0f - *(const PG8_LAS f32x4*)(slot + 2048 + lc * 4); om1 = 1.0f - *(const PG8_LAS f32x4*)(slot + 2048 + lc * 4 + 16); }
            const f32x4 k10 = *(const PG8_LAS f32x4*)(slot + lc * 4), k11 = *(const PG8_LAS f32x4*)(slot + lc * 4 + 16), k20 = *(const PG8_LAS f32x4*)(slot + 1024 + lc * 4), k21 = *(const PG8_LAS f32x4*)(slot + 1024 + lc * 4 + 16);
#pragma unroll
            for (int ai = 0; ai < 2; ++ai)
#pragma unroll
                for (int m = 0; m < 4; ++m) { const int lr = ai * HALF + wr * 64 + m * 16 + fr, row = u.pm * BM + lr; const bool pad = (row % LP) < PADR;
                    float mean, rstd; mean_rstd(*(const PG8_LAS u32x2*)(slot + (wr * 64 + fr) * 8 + (3072 + (ai * HALF + m * 16) * 8)), mean, rstd);
                    f32x4 v0 = (acc[ai][bj][m][0] - k10 * mean) * rstd + k20, v1 = (acc[ai][bj][m][1] - k11 * mean) * rstd + k21;
                    if (pad) { v0 = (f32x4){0.f, 0.f, 0.f, 0.f}; v1 = v0; }
                    if (t == 2 || t == 3) {
#pragma unroll
                        for (int j = 0; j < 4; ++j) { v0[j] = pad ? 0.f : om0[j] * __builtin_amdgcn_rcpf(1.0f + __builtin_amdgcn_exp2f(v0[j] * 1.4426950408889634f));
                                                      v1[j] = pad ? 0.f : om1[j] * __builtin_amdgcn_rcpf(1.0f + __builtin_amdgcn_exp2f(v1[j] * 1.4426950408889634f)); }
                    } else if (t == 4) {
#pragma unroll
                        for (int j = 0; j < 4; ++j) { v0[j] = v0[j] * __builtin_amdgcn_rcpf(1.0f + __builtin_amdgcn_exp2f(v0[j] * -1.4426950408889634f));
                                                      v1[j] = v1[j] * __builtin_amdgcn_rcpf(1.0f + __builtin_amdgcn_exp2f(v1[j] * -1.4426950408889634f)); }
                    }
                    *(u32x4*)(dst + (size_t)row * 1024 + c) = pack8(v0, v1); } }
    }
};
struct EpiConvGate {
    static constexpr bool PERM = true, AFTER_DRAIN = false, STAGED = true;
    bf16_t* act; const float* cw; const float* cb;
    const f32x2* SUM; const float* c1; const float* c2;
    static __device__ __forceinline__ float dpp_mirror(float x) { return __builtin_bit_cast(float, __builtin_amdgcn_update_dpp(0, __builtin_bit_cast(int, x), 0x140, 0xf, 0xf, false)); }
    static __device__ __forceinline__ float dpp_prev(float old, float x) { return __builtin_bit_cast(float, __builtin_amdgcn_update_dpp(__builtin_bit_cast(int, old), __builtin_bit_cast(int, x), 0x111, 0xf, 0xf, false)); }
    static __device__ __forceinline__ float dpp_next(float old, float x) { return __builtin_bit_cast(float, __builtin_amdgcn_update_dpp(__builtin_bit_cast(int, old), __builtin_bit_cast(int, x), 0x101, 0xf, 0xf, false)); }
    __device__ __forceinline__ void stage(PG8_LAS unsigned char* slot, const Unit& u, int tid, int wid) const {
        asm volatile("" : "+v"(tid));
        const int c = tid; const void* src;
        if (c < 384) { const int arr = c >> 5, off = (c & 31) * 4;
            src = arr < 3 ? (const void*)(cw + arr * NUP + 128 * u.pn + off) : arr == 3 ? (const void*)(cb + 128 * u.pn + off) : arr < 7 ? (const void*)(cw + (arr - 4) * NUP + DFF + 128 * u.pn + off)
                : arr == 7 ? (const void*)(cb + DFF + 128 * u.pn + off) : arr == 8 ? (const void*)(c1 + 256 * u.pn + off) : arr == 9 ? (const void*)(c1 + 256 * u.pn + 128 + off)
                : arr == 10 ? (const void*)(c2 + 256 * u.pn + off) : (const void*)(c2 + 256 * u.pn + 128 + off);
        } else { const int i = 2 * (c - 384); src = (const void*)(SUM + (62 * (4 * u.pm + (i >> 6)) - 1 + (i & 63))); }
        glds16(src, slot + wid * 1024);
    }
    __device__ __forceinline__ void operator()(const f32x4 (&acc)[2][2][4][2], const Unit& u, int wr, int wc, int fr, int fq, PG8_LAS unsigned char* slot) const {
        const int cv0 = 128 * u.pn + 32 * wc + 8 * fq;
        float mean[2][4], rstd[2][4];
#pragma unroll
        for (int ai = 0; ai < 2; ++ai)
#pragma unroll
            for (int m = 0; m < 4; ++m) { const int arow = 62 * (4 * u.pm + 2 * ai + wr) - 1 + 16 * m + fr; const bool ok = arow >= 0 && arow < M && (arow % LP) >= PADR;
                mean_rstd(*(const PG8_LAS u32x2*)(slot + (64 * wr + fr) * 8 + (6144 + (128 * ai + 16 * m) * 8)), mean[ai][m], rstd[ai][m]); if (!ok) { rstd[ai][m] = 0.f; mean[ai][m] = 0.f; } }
#pragma unroll
        for (int n = 0; n < 2; ++n) { const int cv = cv0 + 4 * n;
            const int lc = (32 * wc + 8 * fq + 4 * n) * 4;
            const f32x4 k1v = *(const PG8_LAS f32x4*)(slot + 8 * 512 + lc), k1g = *(const PG8_LAS f32x4*)(slot + 9 * 512 + lc), k2v = *(const PG8_LAS f32x4*)(slot + 10 * 512 + lc), k2g = *(const PG8_LAS f32x4*)(slot + 11 * 512 + lc);
            const f32x4 wv0 = *(const PG8_LAS f32x4*)(slot + 0 * 512 + lc), wv1 = *(const PG8_LAS f32x4*)(slot + 1 * 512 + lc), wv2 = *(const PG8_LAS f32x4*)(slot + 2 * 512 + lc), bv = *(const PG8_LAS f32x4*)(slot + 3 * 512 + lc);
            const f32x4 wg0 = *(const PG8_LAS f32x4*)(slot + 4 * 512 + lc), wg1 = *(const PG8_LAS f32x4*)(slot + 5 * 512 + lc), wg2 = *(const PG8_LAS f32x4*)(slot + 6 * 512 + lc), bg = *(const PG8_LAS f32x4*)(slot + 7 * 512 + lc);
#pragma unroll
            for (int ai = 0; ai < 2; ++ai) { const int J = 4 * u.pm + 2 * ai + wr;
                f32x4 o[4];
#pragma unroll
                for (int j = 0; j < 4; ++j) {
                    float uv[4], ug[4], mv[4], mg[4];
#pragma unroll
                    for (int m = 0; m < 4; ++m) { const bool okr = rstd[ai][m] != 0.f; uv[m] = (acc[ai][0][m][n][j] - k1v[j] * mean[ai][m]) * rstd[ai][m] + (okr ? k2v[j] : 0.f); ug[m] = (acc[ai][1][m][n][j] - k1g[j] * mean[ai][m]) * rstd[ai][m] + (okr ? k2g[j] : 0.f);
                                                  mv[m] = dpp_mirror(uv[m]); mg[m] = dpp_mirror(ug[m]); }
#pragma unroll
                    for (int m = 0; m < 4; ++m) {
                        const float pv = dpp_prev(m == 0 ? 0.f : mv[m - 1], uv[m]), nv = dpp_next(m == 3 ? 0.f : mv[m + 1], uv[m]);
                        const float pg = dpp_prev(m == 0 ? 0.f : mg[m - 1], ug[m]), ng = dpp_next(m == 3 ? 0.f : mg[m + 1], ug[m]);
                        const float val = wv0[j] * pv + wv1[j] * uv[m] + wv2[j] * nv + bv[j];
                        const float gat = wg0[j] * pg + wg1[j] * ug[m] + wg2[j] * ng + bg[j];
                        o[m][j] = val * gat * __builtin_amdgcn_rcpf(1.0f + __builtin_amdgcn_exp2f(gat * -1.4426950408889634f)); }
                    asm volatile("" : "+v"(o[0][j]), "+v"(o[1][j]), "+v"(o[2][j]), "+v"(o[3][j])); }
#pragma unroll
                for (int m = 0; m < 4; ++m) { const int R64 = 16 * m + fr; const int rowo = 62 * J - 1 + R64;
                    if (R64 >= 1 && R64 <= 62 && rowo < M) { u32x2 w; w.x = cvt_pk_bf16(o[m][0], o[m][1]); w.y = cvt_pk_bf16(o[m][2], o[m][3]); *(u32x2*)(act + (size_t)rowo * DFF + cv) = w; } }
                asm volatile("" ::: "memory"); } }
    }
};
struct EpiNull {
    static constexpr bool PERM = true, AFTER_DRAIN = false, STAGED = false;
    float* sink;
    __device__ __forceinline__ void operator()(const f32x4 (&acc)[2][2][4][2], const Unit& u, int wr, int wc, int fr, int fq, PG8_LAS unsigned char*) const {
        float s = 0.f;
#pragma unroll
        for (int ai = 0; ai < 2; ++ai)
#pragma unroll
            for (int bj = 0; bj < 2; ++bj)
#pragma unroll
                for (int m = 0; m < 4; ++m)
#pragma unroll
                    for (int n = 0; n < 2; ++n) s += acc[ai][bj][m][n][0] + acc[ai][bj][m][n][1] + acc[ai][bj][m][n][2] + acc[ai][bj][m][n][3];
        if (s == 1.2345e33f) sink[0] = s;
    }
};
template <class Epi, class Sched, bool ALIGN_EPI = false, bool SP2 = false, bool SHIFT = false>
__device__ __forceinline__ void gemm_phase(PG8_LAS unsigned char* lds, const Gemm g, const Sched& S, const Epi& E) {
    const int tid = threadIdx.x, wid = __builtin_amdgcn_readfirstlane(tid >> 6), lane = tid & 63, wr = wid >> 2, wc = wid & 3, fr = lane & 15, fq = lane >> 4;
    const int K = g.K, nt = K / BK;
    unsigned voffA[2], voffB[2];
#pragma unroll
    for (int i = 0; i < 2; ++i) { int R, C; stage_rc(tid * 16 + i * 8192, R, C); const int Rb = Epi::PERM ? ((R & ~31) + perm32(R & 31)) : R;
        const int Ra = SHIFT ? (R - 2 * (R >> 6)) : R; voffA[i] = (unsigned)(Ra * g.lda + C) * 2u; voffB[i] = (unsigned)(Rb * g.ldb + C) * 2u; }
    const size_t kstep = (size_t)(BK * 2);
    const size_t hstepA = (size_t)(SHIFT ? 124 : HALF) * g.lda * 2, hstepB = (size_t)HALF * g.ldb * 2;
    const size_t tstepA = 2 * hstepA, tstepB = 2 * hstepB;
    const unsigned ldsw = (unsigned)wid * 1024u;
    const int aoff = lds_byte(wr * 64 + fr, fq * 8), boff = lds_byte(wc * 32 + fr, fq * 8);
#define PG8_SA(b, h) (((b) * 2 + (h)) * HTB)
#define PG8_SB(b, h) ((4 + (b) * 2 + (h)) * HTB)
#define PG8_STAGE(bufoff, gbase, voff) do { _Pragma("unroll") for (int _i = 0; _i < 2; ++_i) \
        __builtin_amdgcn_global_load_lds((const unsigned*)((const char*)(gbase) + (voff)[_i]), (PG8_LAS unsigned*)(lds + (bufoff) + ldsw + _i * 8192), 16, 0, 0); } while (0)
#define PG8_LDA(dst, b, h) do { _Pragma("unroll") for (int m = 0; m < 4; ++m) _Pragma("unroll") for (int k = 0; k < 2; ++k) dst[m][k] = *(const PG8_LAS bf16x8*)(lds + PG8_SA(b, h) + aoff + m * 2048 + k * 1024); } while (0)
#define PG8_LDB(dst, b, h) do { _Pragma("unroll") for (int n = 0; n < 2; ++n) _Pragma("unroll") for (int k = 0; k < 2; ++k) dst[n][k] = *(const PG8_LAS bf16x8*)(lds + PG8_SB(b, h) + boff + n * 2048 + k * 1024); } while (0)
#define PG8_MMA(ai, bj, At, Bt) do { __builtin_amdgcn_s_setprio(1); _Pragma("unroll") for (int m = 0; m < 4; ++m) _Pragma("unroll") for (int n = 0; n < 2; ++n) _Pragma("unroll") for (int k = 0; k < 2; ++k) \
        acc[ai][bj][m][n] = __builtin_amdgcn_mfma_f32_16x16x32_bf16(Bt[n][k], At[m][k], acc[ai][bj][m][n], 0, 0, 0); __builtin_amdgcn_s_setprio(0); } while (0)
#define PG8_WAIT_V(n) asm volatile("s_waitcnt vmcnt(" #n ")" ::: "memory")
#define PG8_WAIT_L(n) asm volatile("s_waitcnt lgkmcnt(" #n ")" ::: "memory")
#define PG8_BAR __builtin_amdgcn_s_barrier()
#define PG8_SCHED __builtin_amdgcn_sched_barrier(0)
    Unit cur, nxt; int ui = 0;
    if (!S.next(0, cur)) return;
    f32x4 acc[2][2][4][2];
#pragma unroll
    for (int a = 0; a < 2; ++a)
#pragma unroll
        for (int b = 0; b < 2; ++b)
#pragma unroll
            for (int m = 0; m < 4; ++m)
#pragma unroll
                for (int n = 0; n < 2; ++n) acc[a][b][m][n] = (f32x4){0.f, 0.f, 0.f, 0.f};
    bf16x8 At[4][2], B0[2][2], B1[2][2];
    const char* cA = (const char*)g.A + (size_t)cur.pm * tstepA; const char* cB = (const char*)g.Bt + (size_t)cur.pn * tstepB;
    S.a_ready(cur);
    if constexpr (SP2) {
        PG8_STAGE(PG8_SB(0, 0), cB, voffB); PG8_STAGE(PG8_SB(0, 1), cB + hstepB, voffB); PG8_STAGE(PG8_SA(0, 0), cA, voffA); PG8_STAGE(PG8_SA(0, 1), cA + hstepA, voffA);
        if (wr == 1) PG8_BAR;
        PG8_WAIT_V(2); PG8_BAR;
        PG8_STAGE(PG8_SB(1, 0), cB + kstep, voffB); PG8_STAGE(PG8_SA(1, 0), cA + kstep, voffA); PG8_STAGE(PG8_SB(1, 1), cB + hstepB + kstep, voffB);
        PG8_WAIT_V(6); PG8_BAR;
    } else {
        PG8_STAGE(PG8_SB(0, 0), cB, voffB); PG8_STAGE(PG8_SA(0, 0), cA, voffA); PG8_STAGE(PG8_SB(0, 1), cB + hstepB, voffB); PG8_STAGE(PG8_SA(0, 1), cA + hstepA, voffA);
        if (wr == 1) PG8_BAR;
        PG8_WAIT_V(4); PG8_BAR;
        PG8_STAGE(PG8_SB(1, 0), cB + kstep, voffB); PG8_STAGE(PG8_SA(1, 0), cA + kstep, voffA); PG8_STAGE(PG8_SB(1, 1), cB + hstepB + kstep, voffB);
        PG8_WAIT_V(6); PG8_BAR;
    }
    for (;;) {
        if constexpr (Epi::STAGED) E.stage(lds + STAGE_BYTES + (ui & 1) * 8192, cur, tid, wid);
        const bool has_next = S.next(ui + 1, nxt);
        const char* nA = has_next ? (const char*)g.A + (size_t)nxt.pm * tstepA : cA; const char* nB = has_next ? (const char*)g.Bt + (size_t)nxt.pn * tstepB : cB;
        for (int t = 0; t < nt; t += 2) {
            const bool last = (t == nt - 2);
            const char* a1 = cA + (size_t)(t + 1) * kstep;
            const char* a2 = last ? nA : cA + (size_t)(t + 2) * kstep; const char* b2 = last ? nB : cB + (size_t)(t + 2) * kstep;
            const char* a3 = a2 + kstep; const char* b3 = b2 + kstep;
            if (last && has_next) S.a_ready(nxt);
            if constexpr (SP2) {
            PG8_LDB(B0, 0, 0); PG8_LDB(B1, 0, 1); PG8_SCHED; PG8_LDA(At, 0, 0); PG8_STAGE(PG8_SA(1, 1), a1 + hstepA, voffA);
            PG8_WAIT_V(8); PG8_WAIT_L(0); PG8_BAR; PG8_MMA(0, 0, At, B0); PG8_MMA(0, 1, At, B1); PG8_BAR; PG8_SCHED;
            PG8_LDA(At, 0, 1); PG8_STAGE(PG8_SB(0, 0), b2, voffB); PG8_STAGE(PG8_SB(0, 1), b2 + hstepB, voffB); PG8_STAGE(PG8_SA(0, 0), a2, voffA);
            PG8_WAIT_V(8); PG8_WAIT_L(0); PG8_BAR; PG8_MMA(1, 0, At, B0); PG8_MMA(1, 1, At, B1); PG8_BAR; PG8_SCHED;
            PG8_LDB(B0, 1, 0); PG8_LDB(B1, 1, 1); PG8_SCHED; PG8_LDA(At, 1, 0); PG8_STAGE(PG8_SA(0, 1), a2 + hstepA, voffA);
            PG8_WAIT_V(8); PG8_WAIT_L(0); PG8_BAR; PG8_MMA(0, 0, At, B0); PG8_MMA(0, 1, At, B1); PG8_BAR; PG8_SCHED;
            PG8_LDA(At, 1, 1); PG8_STAGE(PG8_SB(1, 0), b3, voffB); PG8_STAGE(PG8_SB(1, 1), b3 + hstepB, voffB); PG8_STAGE(PG8_SA(1, 0), a3, voffA);
            PG8_WAIT_V(8); PG8_WAIT_L(0); PG8_BAR; PG8_MMA(1, 0, At, B0); PG8_MMA(1, 1, At, B1); PG8_BAR; PG8_SCHED;
            } else {
            PG8_LDB(B0, 0, 0); PG8_SCHED; PG8_LDA(At, 0, 0); PG8_STAGE(PG8_SA(1, 1), a1 + hstepA, voffA);
            PG8_WAIT_L(8); PG8_BAR; PG8_WAIT_L(0); PG8_MMA(0, 0, At, B0); PG8_BAR; PG8_SCHED;
            PG8_LDB(B1, 0, 1); PG8_STAGE(PG8_SB(0, 0), b2, voffB);
            PG8_BAR; PG8_WAIT_L(0); PG8_MMA(0, 1, At, B1); PG8_BAR;
            PG8_LDA(At, 0, 1); PG8_STAGE(PG8_SA(0, 0), a2, voffA);
            PG8_BAR; PG8_WAIT_L(0); PG8_MMA(1, 0, At, B0); PG8_BAR; PG8_SCHED;
            PG8_STAGE(PG8_SB(0, 1), b2 + hstepB, voffB);
            PG8_WAIT_V(6); PG8_BAR; PG8_MMA(1, 1, At, B1); PG8_BAR;
            PG8_LDB(B0, 1, 0); PG8_SCHED; PG8_LDA(At, 1, 0); PG8_STAGE(PG8_SA(0, 1), a2 + hstepA, voffA);
            PG8_WAIT_L(8); PG8_BAR; PG8_WAIT_L(0); PG8_MMA(0, 0, At, B0); PG8_BAR; PG8_SCHED;
            PG8_LDB(B1, 1, 1); PG8_STAGE(PG8_SB(1, 0), b3, voffB);
            PG8_BAR; PG8_WAIT_L(0); PG8_MMA(0, 1, At, B1); PG8_BAR;
            PG8_LDA(At, 1, 1); PG8_STAGE(PG8_SA(1, 0), a3, voffA);
            PG8_BAR; PG8_WAIT_L(0); PG8_MMA(1, 0, At, B0); PG8_BAR; PG8_SCHED;
            PG8_STAGE(PG8_SB(1, 1), b3 + hstepB, voffB);
            PG8_WAIT_V(6); PG8_BAR; PG8_MMA(1, 1, At, B1); PG8_BAR;
            }
        }
        if constexpr (ALIGN_EPI) { if (wr == 0) PG8_BAR; }
        if constexpr (!Epi::AFTER_DRAIN) { E(acc, cur, wr, wc, fr, fq, lds + STAGE_BYTES + (ui & 1) * 8192); S.done(cur); }
        if (!has_next) break;
#pragma unroll
        for (int a = 0; a < 2; ++a)
#pragma unroll
            for (int b = 0; b < 2; ++b)
#pragma unroll
                for (int m = 0; m < 4; ++m)
#pragma unroll
                    for (int n = 0; n < 2; ++n) acc[a][b][m][n] = (f32x4){0.f, 0.f, 0.f, 0.f};
        cur = nxt; cA = nA; cB = nB; ++ui;
        if constexpr (ALIGN_EPI) { if (wr == 1) PG8_BAR; }
    }
    PG8_WAIT_V(0);
    if constexpr (!ALIGN_EPI) { if (wr == 0) PG8_BAR; }
    PG8_BAR;
    if constexpr (Epi::AFTER_DRAIN) { E.fused(acc, cur, wr, wc, fr, fq, lds, wid, lane); S.done(cur); }
#undef PG8_SA
#undef PG8_SB
#undef PG8_STAGE
#undef PG8_LDA
#undef PG8_LDB
#undef PG8_MMA
#undef PG8_WAIT_V
#undef PG8_WAIT_L
#undef PG8_BAR
#undef PG8_SCHED
}
}
#define GAS __attribute__((address_space(1)))
#define LAS __attribute__((address_space(3)))
typedef unsigned short bf16;
typedef unsigned v4u __attribute__((ext_vector_type(4)));
typedef unsigned v2u __attribute__((ext_vector_type(2)));
typedef float f32x4 __attribute__((ext_vector_type(4)));
typedef float f32x2 __attribute__((ext_vector_type(2)));
typedef GAS unsigned gu32;
using pg8::cvt_pk_bf16; using pg8::bf_lo; using pg8::bf_hi;

constexpr size_t MiB = 1u << 20;
constexpr size_t WS_CTL = 0, CTL_ZERO_BYTES = 64 * 1024;
constexpr size_t WS_ROPE = 1 * MiB;
constexpr size_t WS_LB = WS_ROPE + 640 * 1024;
constexpr size_t WS_C12 = WS_LB + 16 * 1024;
constexpr size_t C1_UP0 = WS_C12, C2_UP0 = C1_UP0 + 5632 * 4, C1_HG = C2_UP0 + 5632 * 4, C2_HG = C1_HG + 5120 * 4, C1_UP1 = C2_HG + 5120 * 4, C2_UP1 = C1_UP1 + 5632 * 4;
static_assert(C2_UP1 + 5632 * 4 <= 2 * MiB, "small tables");
constexpr size_t WS_W = 2 * MiB;
constexpr size_t W_IN = WS_W, W_UQ = W_IN + 1280ull * 1024 * 2, W_UKV = W_UQ + 1536ull * 768 * 2, W_O = W_UKV + 2048ull * 256 * 2, W_HIN = W_O + 1024ull * 1024 * 2,
                 W_HO = W_HIN + 5120ull * 1024 * 2, W_UP0 = W_HO + 1024ull * 1024 * 2, W_UP1 = W_UP0 + 5632ull * 1024 * 2, W_DN0 = W_UP1 + 5632ull * 1024 * 2, W_DN1 = W_DN0 + 1024ull * 2816 * 2,
                 W_END = W_DN1 + 1024ull * 2816 * 2;
static_assert(W_END <= 55 * MiB, "weights");
constexpr int SLACK = 256;
constexpr size_t ROWB = 2048;
constexpr size_t WS_B0 = 55 * MiB, B0_BYTES = (size_t)(M + 2 * SLACK) * ROWB;
static_assert(B0_BYTES <= 164 * MiB, "B0");
constexpr size_t WS_R = 219 * MiB;
constexpr size_t R_CQKV = WS_R;
constexpr size_t R_Q = R_CQKV + 164 * MiB;
constexpr size_t R_KV = R_Q + 245 * MiB;
constexpr size_t R_KROPE = R_KV + 326 * MiB;
constexpr size_t R_SSQ = R_KROPE + 6 * MiB;
constexpr size_t R_X_L0 = R_Q;
constexpr size_t R_ACT = WS_R;
constexpr size_t R_X_FFN = WS_R + 448 * MiB;
constexpr size_t R_HV = WS_R, R_HKF = WS_R + 163 * MiB, R_HKB = WS_R + 326 * MiB, R_HSG = WS_R + 489 * MiB;
constexpr size_t R_X_HG = WS_R;
constexpr size_t R_XB3 = R_HSG + (size_t)SLACK * ROWB;
constexpr size_t SUM_ROWS = (size_t)M + 2 * SLACK, SUM_BYTES = SUM_ROWS * 8;
constexpr size_t WS_SUM1 = WS_R + 773 * MiB, WS_SUM2 = WS_SUM1 + SUM_BYTES, WS_SUM3 = WS_SUM2 + SUM_BYTES, WS_SUM4 = WS_SUM3 + SUM_BYTES;
constexpr size_t WS_END = 1024 * MiB;
static_assert(SUM_BYTES % 256 == 0 && WS_SUM4 + SUM_BYTES <= WS_END && R_XB3 + (size_t)(M + SLACK) * ROWB <= WS_SUM1 && R_KV + 326 * MiB + 12 * MiB <= WS_SUM1 && R_ACT + 448 * MiB <= R_HSG, "d_ws map 3");
static_assert(R_SSQ + (size_t)M * 16 * 4 <= WS_END && R_X_FFN + (size_t)M * 4096 <= WS_END && R_HSG + (size_t)M * ROWB <= WS_END, "d_ws map");
static_assert((size_t)M * 1536 * 2 + 64 * 3072 <= 245 * MiB && (size_t)M * 4096 + 64 * 4096 <= 326 * MiB && (size_t)M * DFF * 2 <= 448 * MiB && (size_t)M * ROWB <= 163 * MiB, "d_ws map 2");

constexpr int RING_OFF = 0, RING_BYTES = 131072;
constexpr int EPI_OFF = RING_BYTES, EPI_SLOT = 8192;
constexpr int LDSCTL_OFF = 147456, MISC_OFF = LDSCTL_OFF + 320;
constexpr int LDS_BYTES = 148480;
constexpr int NWAVES = 8;

#define RLX_AGENT __ATOMIC_RELAXED, __HIP_MEMORY_SCOPE_AGENT
#define XB_TMO      128
#define XB_XCNT(j)  (256  + 64 * (j))
#define XB_XSUB(j)  (1280 + 64 * (j))
#define XB_XGEN(j)  (2304 + 64 * (j))
#define XB_TOP      3328
#define XB_TOPGEN   3392
#define XCD_BAR_WORDS 3456
#define XB_SPIN_CAP (1u << 18)

__device__ __forceinline__ unsigned xb_ld(unsigned* p)              { return __hip_atomic_load(p, __ATOMIC_RELAXED, __HIP_MEMORY_SCOPE_AGENT); }
__device__ __forceinline__ unsigned xb_add(unsigned* p, unsigned v) { return __hip_atomic_fetch_add(p, v, __ATOMIC_RELAXED, __HIP_MEMORY_SCOPE_AGENT); }
__device__ __forceinline__ unsigned xb_xcc_id() { return (unsigned)__builtin_amdgcn_s_getreg((3 << 11) | 20) & 0xFu; }
#define XB_SPIN(cond, bar) do { unsigned _sp = 0; while (cond) { __builtin_amdgcn_s_sleep(1); \
    if ((++_sp & 255u) == 0u) { if (xb_ld(&(bar)[XB_TMO])) break; if (_sp > XB_SPIN_CAP) { atomicAdd(&(bar)[XB_TMO], 1u); break; } } } } while (0)

struct XcdBarrier {
    unsigned* bar; unsigned x;
    volatile LAS unsigned* st;
};

__device__ __forceinline__ XcdBarrier xcd_barrier_post(unsigned* bar, volatile LAS unsigned* st) {
    XcdBarrier b; b.bar = bar; b.x = xb_xcc_id(); b.st = st;
    if (threadIdx.x == 0) (void)xb_add(&bar[XB_XCNT(b.x)], 1u);
    return b;
}
__device__ __forceinline__ void xcd_barrier_complete(unsigned* bar, unsigned x, unsigned& nloc, unsigned& nx) {
    const unsigned G = gridDim.x * gridDim.y * gridDim.z;
    unsigned sum, cnt, mine, sp = 0u;
    for (;;) {
        sum = 0u; cnt = 0u; mine = 0u;
#pragma unroll
        for (unsigned j = 0; j < 16; ++j) { const unsigned c = xb_ld(&bar[XB_XCNT(j)]); sum += c; cnt += (c > 0u) ? 1u : 0u; mine = (j == x) ? c : mine; }
        if (sum == G) break;
        __builtin_amdgcn_s_sleep(1);
        if ((++sp & 255u) == 0u) { if (xb_ld(&bar[XB_TMO])) break; if (sp > XB_SPIN_CAP) { atomicAdd(&bar[XB_TMO], 1u); break; } }
    }
    nloc = mine > 0u ? mine : 1u; nx = cnt > 0u ? cnt : 1u;
}

__device__ __forceinline__ void xcd_barrier(const XcdBarrier& b) {
    asm volatile("s_waitcnt vmcnt(0)" ::: "memory");
    __syncthreads();
    if (threadIdx.x == 0) {
        unsigned* bar = b.bar;
        __builtin_amdgcn_s_waitcnt(0);
        unsigned nloc = b.st[0], nx = b.st[1];
        if (nloc == 0u) { xcd_barrier_complete(bar, b.x, nloc, nx); b.st[0] = nloc; b.st[1] = nx; }
        const unsigned old = xb_add(&bar[XB_XSUB(b.x)], 1u);
        const unsigned gen = old / nloc;
        if (old + 1u == (gen + 1u) * nloc) {
            __builtin_amdgcn_fence(__ATOMIC_RELEASE, "agent");
            asm volatile("s_waitcnt vmcnt(0)" ::: "memory");
            const unsigned og = xb_add(&bar[XB_TOP], 1u);
            const unsigned tg = og / nx;
            if (og + 1u == (tg + 1u) * nx) xb_add(&bar[XB_TOPGEN], 1u);
            else XB_SPIN(xb_ld(&bar[XB_TOPGEN]) == tg, bar);
            __builtin_amdgcn_fence(__ATOMIC_ACQUIRE, "agent");
            xb_add(&bar[XB_XGEN(b.x)], 1u);
            asm volatile("s_waitcnt vmcnt(0)" ::: "memory");
        } else {
            XB_SPIN(xb_ld(&bar[XB_XGEN(b.x)]) == gen, bar);
            __builtin_amdgcn_fence(__ATOMIC_ACQUIRE, "agent");
            asm volatile("s_waitcnt vmcnt(0)" ::: "memory");
        }
    }
    __syncthreads();
}

struct Frame {
    LAS unsigned char* lds;
    volatile LAS unsigned* MISC;
    int tid, lane, wave;
    int vcu, G;
};
__device__ __forceinline__ float wave_sum(float v) {
#pragma unroll
    for (int o = 1; o < 64; o <<= 1) v += __shfl_xor(v, o);
    return v;
}
__device__ __forceinline__ unsigned f2bf(float f) { unsigned u = __builtin_bit_cast(unsigned, f); return (u + 0x7fffu + ((u >> 16) & 1u)) >> 16; }
__device__ __forceinline__ unsigned pk2(float lo, float hi) { return f2bf(lo) | (f2bf(hi) << 16); }

__device__ __forceinline__ int src_col(int kind, int n) {
    if (kind == 1) { if (n < 1024) return n; if (n >= 1056) return -1; const int e = n - 1024; return 1024 + ((e & 1) ? 16 + (e >> 1) : (e >> 1)); }
    if (kind == 2) { const int hd = n / 96, d = n % 96; if (d < 64) return n; const int e = d - 64; return hd * 96 + 64 + ((e & 1) ? 16 + (e >> 1) : (e >> 1)); }
    if (kind == 3) { const int pn = n >> 8, r = n & 255; return r < 128 ? 128 * pn + r : DFF + 128 * pn + (r - 128); }
    return n;
}
__device__ __forceinline__ void p0_transpose_item(const float* W, int K, int N, bf16* WT, int kind, const float* gain, LAS float* scr, int item, int lane, int NP) {
    const int nblk = NP / 32, kb = item / nblk, nb = item % nblk, k0 = 64 * kb, n0 = 32 * nb;
    const int sc = src_col(kind, n0 + (lane & 31));
#pragma unroll 8
    for (int i = 0; i < 32; ++i) { const int kk = 2 * i + (lane >> 5); float v = sc >= 0 ? W[(size_t)(k0 + kk) * N + sc] : 0.f; if (gain) v *= gain[k0 + kk]; scr[kk * 33 + (lane & 31)] = v; }
    asm volatile("s_waitcnt lgkmcnt(0)" ::: "memory");
    const int c = lane & 7;
#pragma unroll
    for (int j = 0; j < 4; ++j) { const int n = (lane >> 3) + 8 * j; const LAS float* s = scr + (8 * c) * 33 + n;
        v4u o; o.x = pk2(s[0 * 33], s[1 * 33]); o.y = pk2(s[2 * 33], s[3 * 33]); o.z = pk2(s[4 * 33], s[5 * 33]); o.w = pk2(s[6 * 33], s[7 * 33]);
        *(GAS v4u*)(WT + (size_t)(n0 + n) * K + k0 + 8 * c) = o; }
    asm volatile("s_waitcnt lgkmcnt(0)" ::: "memory");
}
__device__ __forceinline__ void wjob(Frame& F, const float* W, bf16* WT, const float* gain, int K, int N, int NP, int kind, int widx, int nwg) {
    LAS float* scr = (LAS float*)(F.lds + RING_OFF + F.wave * 16384);
    const int nitems = (K / 64) * (NP / 32);
    for (int it = widx * NWAVES + F.wave; it < nitems; it += nwg * NWAVES) p0_transpose_item(W, K, N, WT, kind, gain, scr, it, F.lane, NP);
}
__device__ __forceinline__ void c12job(Frame& F, const float* const* in, unsigned char* ws, int which, int widx, int nwg) {
    const float* W = which == 0 ? in[13] : which == 1 ? in[9] : in[13] + (size_t)1024 * NUP; const int N = which == 1 ? 5120 : NUP;
    const float* gn = in[17] + (which == 0 ? 0 : which == 1 ? 1024 : 2048); const float* bs = in[18] + (which == 0 ? 0 : which == 1 ? 1024 : 2048);
    float* c1 = (float*)(ws + (which == 0 ? C1_UP0 : which == 1 ? C1_HG : C1_UP1)); float* c2 = (float*)(ws + (which == 0 ? C2_UP0 : which == 1 ? C2_HG : C2_UP1));
    LAS float* red = (LAS float*)(F.lds + RING_OFF + 12288);
    for (int cb = widx; cb < N / 64; cb += nwg) { const int n = cb * 64 + F.lane; const int sc = which == 1 ? n : src_col(3, n);
        float a1[4] = {0.f, 0.f, 0.f, 0.f}, a2[4] = {0.f, 0.f, 0.f, 0.f};
        for (int k = F.wave * 128; k < F.wave * 128 + 128; k += 4) {
#pragma unroll
            for (int i = 0; i < 4; ++i) { const float w = W[(size_t)(k + i) * N + sc]; a1[i] += __uint_as_float(f2bf(gn[k + i] * w) << 16); a2[i] += bs[k + i] * w; } }
        red[F.wave * 4096 + F.lane * 2] = (a1[0] + a1[1]) + (a1[2] + a1[3]); red[F.wave * 4096 + F.lane * 2 + 1] = (a2[0] + a2[1]) + (a2[2] + a2[3]);
        __syncthreads();
        if (F.wave == 0) { float s1 = 0.f, s2 = 0.f;
#pragma unroll
            for (int w = 0; w < 8; ++w) { s1 += red[w * 4096 + F.lane * 2]; s2 += red[w * 4096 + F.lane * 2 + 1]; }
            c1[n] = s1; c2[n] = s2; }
        __syncthreads(); }
}
__device__ __forceinline__ void tail_jobs_a(Frame& F, const float* const* in, unsigned char* ws, int widx, int nwg) {
    wjob(F, in[9], (bf16*)(ws + W_HIN), in[17] + 1024, 1024, 5120, 5120, 0, widx, nwg);
    wjob(F, in[12], (bf16*)(ws + W_HO), nullptr, 1024, 1024, 1024, 0, widx, nwg);
    c12job(F, in, ws, 1, widx, nwg);
}
__device__ __forceinline__ void tail_jobs_b(Frame& F, const float* const* in, unsigned char* ws, int widx, int nwg) {
    wjob(F, in[13] + (size_t)1024 * NUP, (bf16*)(ws + W_UP1), in[17] + 2048, 1024, NUP, NUP, 3, widx, nwg);
    wjob(F, in[16] + (size_t)DFF * 1024, (bf16*)(ws + W_DN1), nullptr, DFF, 1024, 1024, 0, widx, nwg);
    c12job(F, in, ws, 2, widx, nwg);
}
__device__ __forceinline__ void tail_jobs_0(Frame& F, const float* const* in, unsigned char* ws, int widx, int nwg) {
    wjob(F, in[13], (bf16*)(ws + W_UP0), in[17], 1024, NUP, NUP, 3, widx, nwg);
    wjob(F, in[16], (bf16*)(ws + W_DN0), nullptr, DFF, 1024, 1024, 0, widx, nwg);
    c12job(F, in, ws, 0, widx, nwg);
}
__device__ __forceinline__ void p0_prologue(Frame& F, const float* const* in, unsigned char* ws, bf16* h0) {
    const int gw = F.vcu * NWAVES + F.wave, NGW = F.G * NWAVES;
    wjob(F, in[3], (bf16*)(ws + W_IN), nullptr, 1024, 1056, 1280, 1, F.vcu, F.G);
    wjob(F, in[6], (bf16*)(ws + W_UQ), in[4], 768, 1536, 1536, 2, F.vcu, F.G);
    wjob(F, in[7], (bf16*)(ws + W_UKV), in[5], 256, 2048, 2048, 0, F.vcu, F.G);
    wjob(F, in[8], (bf16*)(ws + W_O), nullptr, 1024, 1024, 1024, 0, F.vcu, F.G);
    for (int row0 = gw; row0 < M; row0 += 4 * NGW) {
        f32x4 v[4][4];
#pragma unroll
        for (int u = 0; u < 4; ++u) { const int row = row0 + u * NGW; const int rc = row < M ? row : M - 1; const int b = rc / LP, s = rc % LP;
            const float* src = s < PADR ? in[2] : s < PADR + 16 ? in[2] + (size_t)(s - PADR) * 1024 : (b < 16 ? in[0] + ((size_t)b * SEQ + (s - 64)) * 1024 : in[1] + ((size_t)(b - 16) * SEQ + (s - 64)) * 1024);
            const GAS f32x4* xr = (const GAS f32x4*)src + F.lane;
#pragma unroll
            for (int j = 0; j < 4; ++j) v[u][j] = xr[64 * j]; }
#pragma unroll
        for (int u = 0; u < 4; ++u) { const int row = row0 + u * NGW; if (row >= M) continue; const int s = row % LP;
            GAS unsigned long long* o8 = (GAS unsigned long long*)(h0 + (size_t)row * 1024) + F.lane;
#pragma unroll
            for (int j = 0; j < 4; ++j) o8[64 * j] = s < PADR ? 0ull : ((unsigned long long)pk2(v[u][j].x, v[u][j].y) | ((unsigned long long)pk2(v[u][j].z, v[u][j].w) << 32)); }
    }
    { const int gt = gw * 64 + F.lane, NGT = NGW * 64; GAS v4u* z0 = (GAS v4u*)(ws + WS_B0); GAS v4u* z1 = (GAS v4u*)(ws + WS_B0 + (size_t)(SLACK + M) * ROWB);
      const int n16 = SLACK * (int)ROWB / 16;
      for (int i = gt; i < n16; i += NGT) { z0[i] = (v4u){0u, 0u, 0u, 0u}; z1[i] = (v4u){0u, 0u, 0u, 0u}; } }
    { const int gt = gw * 64 + F.lane, NGT = NGW * 64; GAS v4u* z = (GAS v4u*)(ws + WS_SUM1);
      for (int i = gt; i < (int)(4 * SUM_BYTES / 16); i += NGT) z[i] = (v4u){0u, 0u, 0u, 0u}; }
    { const int gt = gw * 64 + F.lane, NGT = NGW * 64; GAS v4u* z = (GAS v4u*)(ws + R_SSQ);
      for (int i = gt; i < M * 8 / 16; i += NGT) z[i] = (v4u){0u, 0u, 0u, 0u}; }
    { const int gt = gw * 64 + F.lane, NGT = NGW * 64; f32x2* tab = (f32x2*)(ws + WS_ROPE);
      for (int i = gt; i < LTOK * 16; i += NGT) { const int pos = i >> 4, k = i & 15;
          const float inv = 1.0f / powf(10000.0f, (float)(2 * k) / 32.0f); const float ang = (float)pos * inv;
          f32x2 cs; cs.x = (float)cos((double)ang); cs.y = (float)sin((double)ang); tab[i] = cs; } }
    { const int gt = gw * 64 + F.lane; float* lb = (float*)(ws + WS_LB);
      if (gt < 2048) { const int d = gt >> 10, k = gt & 1023; const float x0 = in[10][(size_t)(d * 2 + 0) * 1024 + k], x1 = in[10][(size_t)(d * 2 + 1) * 1024 + k];
          lb[gt] = 1.0f / (1.0f + expf(x0 - x1)); } }
}

template <bool FINAL> __device__ __forceinline__ void ln_pass(Frame& F, const float* X, const float* gain, const float* bias, bf16* hout, float* out) {
    const int gw = F.vcu * NWAVES + F.wave, NGW = F.G * NWAVES;
    f32x4 g[4], bb[4];
#pragma unroll
    for (int j = 0; j < 4; ++j) { g[j] = ((const f32x4*)gain)[64 * j + F.lane]; bb[j] = ((const f32x4*)bias)[64 * j + F.lane]; }
    for (int row0 = gw; row0 < M; row0 += 4 * NGW) {
        f32x4 v[4][4];
#pragma unroll
        for (int u = 0; u < 4; ++u) { const int row = row0 + u * NGW; const int rc = row < M ? row : M - 1; const GAS f32x4* xr = (const GAS f32x4*)(X + (size_t)rc * 1024) + F.lane;
#pragma unroll
            for (int j = 0; j < 4; ++j) v[u][j] = xr[64 * j]; }
#pragma unroll
        for (int u = 0; u < 4; ++u) { const int row = row0 + u * NGW; if (row >= M) continue;
            const int b = row / LP, s = row % LP;
            if (FINAL) { if (s < 64) continue; }
            else if (s < PADR) { GAS unsigned long long* o8 = (GAS unsigned long long*)(hout + (size_t)row * 1024) + F.lane;
#pragma unroll
                for (int j = 0; j < 4; ++j) o8[64 * j] = 0ull;
                continue; }
            float sm = 0.f;
#pragma unroll
            for (int j = 0; j < 4; ++j) sm += (v[u][j].x + v[u][j].y) + (v[u][j].z + v[u][j].w);
            const float mean = wave_sum(sm) * (1.f / 1024.f); float s2 = 0.f;
#pragma unroll
            for (int j = 0; j < 4; ++j) { v[u][j] = v[u][j] - mean; s2 += (v[u][j].x * v[u][j].x + v[u][j].y * v[u][j].y) + (v[u][j].z * v[u][j].z + v[u][j].w * v[u][j].w); }
            const float rstd = 1.f / sqrtf(wave_sum(s2) * (1.f / 1024.f) + EPS);
            if (FINAL) { GAS f32x4* o = (GAS f32x4*)(out + ((size_t)b * SEQ + (s - 64)) * 1024) + F.lane;
#pragma unroll
                for (int j = 0; j < 4; ++j) o[64 * j] = v[u][j] * rstd * g[j] + bb[j];
            } else { GAS unsigned long long* o8 = (GAS unsigned long long*)(hout + (size_t)row * 1024) + F.lane;
#pragma unroll
                for (int j = 0; j < 4; ++j) { const f32x4 y = v[u][j] * rstd * g[j] + bb[j]; o8[64 * j] = (unsigned long long)cvt_pk_bf16(y.x, y.y) | ((unsigned long long)cvt_pk_bf16(y.z, y.w) << 32); } }
        }
    }
}

__device__ __forceinline__ void ln_final(Frame& F, const bf16* xb, const f32x2* SUM, float* out, const float* gain, const float* bias) {
    const int gw = F.vcu * NWAVES + F.wave, NGW = F.G * NWAVES; constexpr int NR = NB * SEQ;
    f32x4 g[4], bb[4];
#pragma unroll
    for (int j = 0; j < 4; ++j) { g[j] = ((const f32x4*)gain)[64 * j + F.lane]; bb[j] = ((const f32x4*)bias)[64 * j + F.lane]; }
    for (int row0 = gw; row0 < NR; row0 += 4 * NGW) {
        v2u v[4][4]; pg8::u32x2 sq[4];
#pragma unroll
        for (int u = 0; u < 4; ++u) { const int orow = row0 + u * NGW; const int rc = orow < NR ? orow : NR - 1; const size_t row = (size_t)(rc / SEQ) * LP + 64 + rc % SEQ;
            const GAS v2u* xr = (const GAS v2u*)(xb + row * 1024) + F.lane; sq[u] = *(const pg8::u32x2*)(SUM + row);
#pragma unroll
            for (int j = 0; j < 4; ++j) v[u][j] = xr[64 * j]; }
#pragma unroll
        for (int u = 0; u < 4; ++u) { const int orow = row0 + u * NGW; if (orow >= NR) continue;
            float mean, rstd; pg8::mean_rstd(sq[u], mean, rstd);
            GAS f32x4* o = (GAS f32x4*)(out + (size_t)orow * 1024) + F.lane;
#pragma unroll
            for (int j = 0; j < 4; ++j) { f32x4 x; x[0] = bf_lo(v[u][j].x); x[1] = bf_hi(v[u][j].x); x[2] = bf_lo(v[u][j].y); x[3] = bf_hi(v[u][j].y); o[64 * j] = (x - mean) * rstd * g[j] + bb[j]; } }
    }
}
__device__ __forceinline__ void attn_simple(Frame& F, const bf16* Q, const bf16* KV, const bf16* KR, bf16* O) {
    LAS float* Ks = (LAS float*)(F.lds);
    LAS float* Vs = (LAS float*)(F.lds + 64 * 96 * 4);
    constexpr int NQC = 17;
    const int hf = F.tid & 1;
    for (int u = F.vcu; u < NB * 16 * NQC; u += F.G) {
        const int bh = u / NQC, qc = u % NQC, b = bh >> 4, h = bh & 15;
        const int sq = qc * 256 + (F.tid >> 1); const bool vq = sq < LP; const size_t rowq = (size_t)b * LP + (vq ? sq : LP - 1);
        float q[48];
#pragma unroll
        for (int c = 0; c < 6; ++c) { const v4u w = *(const GAS v4u*)(Q + rowq * 1536 + h * 96 + hf * 48 + c * 8);
            q[c * 8 + 0] = bf_lo(w.x); q[c * 8 + 1] = bf_hi(w.x); q[c * 8 + 2] = bf_lo(w.y); q[c * 8 + 3] = bf_hi(w.y);
            q[c * 8 + 4] = bf_lo(w.z); q[c * 8 + 5] = bf_hi(w.z); q[c * 8 + 6] = bf_lo(w.w); q[c * 8 + 7] = bf_hi(w.w); }
        float o[32];
#pragma unroll
        for (int d = 0; d < 32; ++d) o[d] = 0.f;
        float mx = -1e30f, l = 0.f;
        for (int kt = 0; kt < 65; ++kt) {
            __syncthreads();
            for (int idx = F.tid; idx < 64 * 12; idx += 512) { const int j = idx / 12, c = idx % 12; int sk = PADR + kt * 64 + j; sk = sk < LP ? sk : LP - 1; const size_t rk = (size_t)b * LP + sk;
                const v4u w = c < 8 ? *(const GAS v4u*)(KV + rk * 2048 + h * 128 + c * 8) : *(const GAS v4u*)(KR + rk * 32 + (c - 8) * 8);
                LAS float* d = Ks + j * 96 + c * 8; d[0] = bf_lo(w.x); d[1] = bf_hi(w.x); d[2] = bf_lo(w.y); d[3] = bf_hi(w.y); d[4] = bf_lo(w.z); d[5] = bf_hi(w.z); d[6] = bf_lo(w.w); d[7] = bf_hi(w.w); }
            { const int j = F.tid >> 3, c = F.tid & 7; int sk = PADR + kt * 64 + j; sk = sk < LP ? sk : LP - 1; const size_t rk = (size_t)b * LP + sk;
                const v4u w = *(const GAS v4u*)(KV + rk * 2048 + h * 128 + 64 + c * 8);
                LAS float* d = Vs + j * 64 + c * 8; d[0] = bf_lo(w.x); d[1] = bf_hi(w.x); d[2] = bf_lo(w.y); d[3] = bf_hi(w.y); d[4] = bf_lo(w.z); d[5] = bf_hi(w.z); d[6] = bf_lo(w.w); d[7] = bf_hi(w.w); }
            __syncthreads();
            const int nk = (LTOK - kt * 64) < 64 ? (LTOK - kt * 64) : 64;
#pragma unroll 1
            for (int jj = 0; jj < nk; ++jj) {
                const LAS f32x4* kr = (const LAS f32x4*)(Ks + jj * 96 + hf * 48); float a0 = 0.f, a1 = 0.f;
#pragma unroll
                for (int c = 0; c < 12; c += 2) { const f32x4 k0 = kr[c], k1 = kr[c + 1];
                    a0 += q[4 * c] * k0.x + q[4 * c + 1] * k0.y + q[4 * c + 2] * k0.z + q[4 * c + 3] * k0.w;
                    a1 += q[4 * c + 4] * k1.x + q[4 * c + 5] * k1.y + q[4 * c + 6] * k1.z + q[4 * c + 7] * k1.w; }
                float sc = a0 + a1; sc += __shfl_xor(sc, 1);
                const float mn = fmaxf(mx, sc);
                const float al = __builtin_amdgcn_exp2f(mx - mn), p = __builtin_amdgcn_exp2f(sc - mn); mx = mn; l = l * al + p;
                const LAS f32x4* vr = (const LAS f32x4*)(Vs + jj * 64 + hf * 32);
#pragma unroll
                for (int c = 0; c < 8; ++c) { const f32x4 vv = vr[c]; o[4 * c] = fmaf(p, vv.x, o[4 * c] * al); o[4 * c + 1] = fmaf(p, vv.y, o[4 * c + 1] * al); o[4 * c + 2] = fmaf(p, vv.z, o[4 * c + 2] * al); o[4 * c + 3] = fmaf(p, vv.w, o[4 * c + 3] * al); }
            }
        }
        if (vq) { const float il = 1.0f / l;
#pragma unroll
            for (int c = 0; c < 4; ++c) { v4u w; w.x = cvt_pk_bf16(o[8 * c] * il, o[8 * c + 1] * il); w.y = cvt_pk_bf16(o[8 * c + 2] * il, o[8 * c + 3] * il); w.z = cvt_pk_bf16(o[8 * c + 4] * il, o[8 * c + 5] * il); w.w = cvt_pk_bf16(o[8 * c + 6] * il, o[8 * c + 7] * il);
                *(GAS v4u*)(O + rowq * 1024 + h * 64 + hf * 32 + c * 8) = w; } }
    }
    __syncthreads();
}

__device__ __forceinline__ void gla_simple(Frame& F, bf16* Qb, const bf16* Vb, bf16* KFb, const bf16* KBb, const bf16* SGb, const float* onorm) {
    LAS float* tq = (LAS float*)(F.lds);
    LAS float* tk = (LAS float*)(F.lds + 16384);
    LAS float* tv = (LAS float*)(F.lds + 32768);
    LAS float* pr = (LAS float*)(F.lds + 49152);
    const int j = F.tid & 127, kq = F.tid >> 7;
    for (int it = F.vcu; it < NB * 8; it += F.G) {
        const int b = it >> 3, h = it & 7; const size_t cbase = (size_t)h * 128;
        for (int dir = 0; dir < 2; ++dir) {
            float S[32];
#pragma unroll
            for (int k = 0; k < 32; ++k) S[k] = 0.f;
            const bf16* Kg = dir == 0 ? KFb : KBb;
            for (int tile = 0; tile < (LTOK + 31) / 32; ++tile) {
                __syncthreads();
                { const int i = F.tid >> 4, c8 = (F.tid & 15) * 8; const int tt = tile * 32 + i; const bool vt = tt < LTOK; const int tok = dir == 0 ? tt : LTOK - 1 - tt;
                  const size_t off = ((size_t)b * LP + PADR + (vt ? tok : 0)) * 1024 + cbase + c8;
                  v4u wq = *(const GAS v4u*)(Qb + off), wk = *(const GAS v4u*)(Kg + off), wv = *(const GAS v4u*)(Vb + off);
                  if (!vt) { wq = (v4u){0u, 0u, 0u, 0u}; wk = wq; wv = wq; }
                  LAS float* dq = tq + i * 128 + c8; LAS float* dk = tk + i * 128 + c8; LAS float* dv = tv + i * 128 + c8;
                  dq[0] = bf_lo(wq.x); dq[1] = bf_hi(wq.x); dq[2] = bf_lo(wq.y); dq[3] = bf_hi(wq.y); dq[4] = bf_lo(wq.z); dq[5] = bf_hi(wq.z); dq[6] = bf_lo(wq.w); dq[7] = bf_hi(wq.w);
                  dk[0] = bf_lo(wk.x); dk[1] = bf_hi(wk.x); dk[2] = bf_lo(wk.y); dk[3] = bf_hi(wk.y); dk[4] = bf_lo(wk.z); dk[5] = bf_hi(wk.z); dk[6] = bf_lo(wk.w); dk[7] = bf_hi(wk.w);
                  dv[0] = bf_lo(wv.x); dv[1] = bf_hi(wv.x); dv[2] = bf_lo(wv.y); dv[3] = bf_hi(wv.y); dv[4] = bf_lo(wv.z); dv[5] = bf_hi(wv.z); dv[6] = bf_lo(wv.w); dv[7] = bf_hi(wv.w); }
                __syncthreads();
                for (int i = 0; i < 32; ++i) {
                    const float vj = tv[i * 128 + j]; float part = 0.f;
                    const LAS f32x4* kr = (const LAS f32x4*)(tk + i * 128 + kq * 32); const LAS f32x4* qr = (const LAS f32x4*)(tq + i * 128 + kq * 32);
#pragma unroll
                    for (int c = 0; c < 8; ++c) { const f32x4 kk = kr[c], qq = qr[c];
                        S[4 * c] = fmaf(kk.x, vj - S[4 * c], S[4 * c]); part = fmaf(S[4 * c], qq.x, part);
                        S[4 * c + 1] = fmaf(kk.y, vj - S[4 * c + 1], S[4 * c + 1]); part = fmaf(S[4 * c + 1], qq.y, part);
                        S[4 * c + 2] = fmaf(kk.z, vj - S[4 * c + 2], S[4 * c + 2]); part = fmaf(S[4 * c + 2], qq.z, part);
                        S[4 * c + 3] = fmaf(kk.w, vj - S[4 * c + 3], S[4 * c + 3]); part = fmaf(S[4 * c + 3], qq.w, part); }
                    pr[(i * 4 + kq) * 128 + j] = part;
                }
                __syncthreads();
#pragma unroll
                for (int ii = 0; ii < 4; ++ii) { const int i = F.wave * 4 + ii; const int tt = tile * 32 + i; const bool vt = tt < LTOK; const int tok = dir == 0 ? tt : LTOK - 1 - tt;
                    const int c = 2 * F.lane;
                    float o0 = pr[(i * 4 + 0) * 128 + c] + pr[(i * 4 + 1) * 128 + c] + pr[(i * 4 + 2) * 128 + c] + pr[(i * 4 + 3) * 128 + c];
                    float o1 = pr[(i * 4 + 0) * 128 + c + 1] + pr[(i * 4 + 1) * 128 + c + 1] + pr[(i * 4 + 2) * 128 + c + 1] + pr[(i * 4 + 3) * 128 + c + 1];
                    const size_t off = ((size_t)b * LP + PADR + (vt ? tok : 0)) * 1024 + cbase + c;
                    if (dir == 0) { if (vt) *(GAS unsigned*)(KFb + off) = cvt_pk_bf16(o0, o1); }
                    else { const unsigned wf = *(const GAS unsigned*)(KFb + off); o0 += bf_lo(wf); o1 += bf_hi(wf);
                        const float ss = wave_sum(o0 * o0 + o1 * o1); const float rstd = 1.0f / sqrtf(ss * (1.0f / 128.0f) + EPS);
                        const unsigned wg = *(const GAS unsigned*)(SGb + off); const f32x2 gn = *(const f32x2*)(onorm + cbase + c);
                        if (vt) *(GAS unsigned*)(Qb + off) = cvt_pk_bf16(o0 * rstd * gn.x * bf_lo(wg), o1 * rstd * gn.y * bf_hi(wg)); } }
            }
            __syncthreads();
        }
    }
    __syncthreads();
}
namespace fa {
using bf16x8 = __attribute__((ext_vector_type(8))) short;
using s16x4  = __attribute__((ext_vector_type(4))) short;
using f32x16 = __attribute__((ext_vector_type(16))) float;
using u32x4  = __attribute__((ext_vector_type(4))) unsigned;
constexpr int KROW = 208;
constexpr int SHM_V = 64 * 64 * 2, SHM_K = 64 * KROW;
constexpr int OFF_V = 0, OFF_K = 2 * SHM_V, OFF_WS = OFF_K + 2 * SHM_K, OFF_STG = OFF_WS + 8 * 256, LDS_TOTAL = OFF_STG + 8 * 4096;
constexpr int NT = 65, NQC = 17;
#define FA_SBAR() __builtin_amdgcn_sched_barrier(0)
__device__ __forceinline__ int crow(int r, int hi) { return (r & 3) + 8 * (r >> 2) + 4 * hi; }
constexpr float THRL = 11.5f;
__device__ __forceinline__ void partialSM(f32x16& p0, f32x16& p1, float& mhat, f32x16& negm, float& alpha, bool first) {
  float a = fmaxf(fmaxf(p0[0], p0[1]), p1[0]), b = fmaxf(fmaxf(p0[2], p0[3]), p1[1]); a = fmaxf(fmaxf(a, p1[2]), p1[3]);
#pragma unroll
  for (int r = 4; r < 16; r += 4) { a = fmaxf(fmaxf(a, p0[r]), p0[r + 1]); b = fmaxf(fmaxf(b, p0[r + 2]), p0[r + 3]); a = fmaxf(fmaxf(a, p1[r]), p1[r + 1]); b = fmaxf(fmaxf(b, p1[r + 2]), p1[r + 3]); }
  float rm = fmaxf(a, b);
  { auto rr = __builtin_amdgcn_permlane32_swap(__float_as_uint(rm), __float_as_uint(rm), false, false);
    rm = fmaxf(__uint_as_float(rr[0]), __uint_as_float(rr[1])); }
  alpha = 1.f;
  if (first || __builtin_expect(__any(rm > THRL), 0)) { const float dl = first ? rm : fmaxf(rm, 0.f); mhat += dl;
#pragma unroll
    for (int r = 0; r < 16; ++r) { p0[r] -= dl; p1[r] -= dl; }
#pragma unroll
    for (int r = 0; r < 16; ++r) negm[r] = -mhat;
    asm volatile("" : "+v"(negm));
    alpha = __builtin_amdgcn_exp2f(-dl); }
#pragma unroll
  for (int r = 0; r < 16; ++r) p0[r] = __builtin_amdgcn_exp2f(p0[r]);
}
__device__ __forceinline__ void finishSM(f32x16& p0, f32x16& p1, float alpha, float& l_reg, bf16x8& pa0, bf16x8& pa1, bf16x8& pa2, bf16x8& pa3) {
#pragma unroll
  for (int r = 0; r < 16; ++r) p1[r] = __builtin_amdgcn_exp2f(p1[r]);
  float ps = 0;
#pragma unroll
  for (int r = 0; r < 16; ++r) ps += p0[r];
#pragma unroll
  for (int r = 0; r < 16; ++r) ps += p1[r];
  { auto rr = __builtin_amdgcn_permlane32_swap(__float_as_uint(ps), __float_as_uint(ps), false, false);
    ps = __uint_as_float(rr[0]) + __uint_as_float(rr[1]); }
  l_reg = l_reg * alpha + ps;
#define FA_PK4(P, BASE, OUT) do { unsigned a0 = cvt_pk_bf16(P[BASE + 0], P[BASE + 1]), a1 = cvt_pk_bf16(P[BASE + 2], P[BASE + 3]);   \
    unsigned b0 = cvt_pk_bf16(P[BASE + 4], P[BASE + 5]), b1 = cvt_pk_bf16(P[BASE + 6], P[BASE + 7]);                              \
    auto r0 = __builtin_amdgcn_permlane32_swap(a0, b0, false, false); auto r1 = __builtin_amdgcn_permlane32_swap(a1, b1, false, false); \
    u32x4 w = {r0[0], r1[0], r0[1], r1[1]}; OUT = *reinterpret_cast<bf16x8*>(&w); } while (0)
  FA_PK4(p0, 0, pa0); FA_PK4(p0, 8, pa1); FA_PK4(p1, 0, pa2); FA_PK4(p1, 8, pa3);
#undef FA_PK4
}
__device__ __forceinline__ void qkt(f32x16& p0, f32x16& p1, const char* Ks, const bf16x8* qr, const f32x16& negm, int r32, int hi) {
#pragma unroll
  for (int d0 = 0; d0 < 6; ++d0) { const int cb = (d0 * 16 + hi * 8) * 2;
    const bf16x8 b0 = *reinterpret_cast<const bf16x8*>(Ks + r32 * KROW + cb);
    const bf16x8 b1 = *reinterpret_cast<const bf16x8*>(Ks + (32 + r32) * KROW + cb);
    if (d0 == 0) { p0 = __builtin_amdgcn_mfma_f32_32x32x16_bf16(b0, qr[0], negm, 0, 0, 0); p1 = __builtin_amdgcn_mfma_f32_32x32x16_bf16(b1, qr[0], negm, 0, 0, 0); }
    else { p0 = __builtin_amdgcn_mfma_f32_32x32x16_bf16(b0, qr[d0], p0, 0, 0, 0); p1 = __builtin_amdgcn_mfma_f32_32x32x16_bf16(b1, qr[d0], p1, 0, 0, 0); } }
}
__device__ __forceinline__ int v_st(int k, int c) { const int kk = (k & ~0xC) | ((k & 4) << 1) | ((k & 8) >> 1); return ((kk >> 3) * 2 + (c >> 5)) * 512 + ((kk & 7) * 32 + (c & 31)) * 2; }
__device__ __forceinline__ int v_rd_base(int lane) { return ((lane & 3) << 3) | (((lane >> 2) & 3) << 6) | (((lane >> 4) & 1) << 5) | (((lane >> 5) & 1) << 8); }
constexpr int v_rd_off(int d0, int ks, int half) { return d0 * 512 + ks * 2048 + half * 1024; }
template <int OFF> __device__ __forceinline__ s16x4 tr_read(int vb) {
  s16x4 r; asm volatile("ds_read_b64_tr_b16 %0, %1 offset:%2" : "=&v"(r) : "v"(vb), "i"(OFF) : "memory"); return r;
}
template <int D0> __device__ __forceinline__ void pv_one(f32x16& od, int vb, bf16x8 pa0, bf16x8 pa1, bf16x8 pa2, bf16x8 pa3) {
  const s16x4 l0 = tr_read<v_rd_off(D0, 0, 0)>(vb), h0 = tr_read<v_rd_off(D0, 0, 1)>(vb), l1 = tr_read<v_rd_off(D0, 1, 0)>(vb), h1 = tr_read<v_rd_off(D0, 1, 1)>(vb);
  const s16x4 l2 = tr_read<v_rd_off(D0, 2, 0)>(vb), h2 = tr_read<v_rd_off(D0, 2, 1)>(vb), l3 = tr_read<v_rd_off(D0, 3, 0)>(vb), h3 = tr_read<v_rd_off(D0, 3, 1)>(vb);
  asm volatile("s_waitcnt lgkmcnt(0)" ::: "memory"); FA_SBAR();
#define FA_PK(L, H) (bf16x8){L[0], L[1], L[2], L[3], H[0], H[1], H[2], H[3]}
  od = __builtin_amdgcn_mfma_f32_32x32x16_bf16(pa0, FA_PK(l0, h0), od, 0, 0, 0);
  od = __builtin_amdgcn_mfma_f32_32x32x16_bf16(pa1, FA_PK(l1, h1), od, 0, 0, 0);
  od = __builtin_amdgcn_mfma_f32_32x32x16_bf16(pa2, FA_PK(l2, h2), od, 0, 0, 0);
  od = __builtin_amdgcn_mfma_f32_32x32x16_bf16(pa3, FA_PK(l3, h3), od, 0, 0, 0);
#undef FA_PK
}
__device__ __forceinline__ void pv_d0(f32x16* o, int vb, bf16x8 pa0, bf16x8 pa1, bf16x8 pa2, bf16x8 pa3) {
  pv_one<0>(o[0], vb, pa0, pa1, pa2, pa3); pv_one<1>(o[1], vb, pa0, pa1, pa2, pa3);
}
__device__ __forceinline__ void attn_unit(int b, int h, int q0, const bf16* __restrict__ Q, const bf16* __restrict__ KV, const bf16* __restrict__ KR, bf16* __restrict__ O, char* lds) {
  const int tid = threadIdx.x, wid = tid >> 6, lane = tid & 63, r32 = lane & 31, hi = lane >> 5;
  char* V_lds = lds + OFF_V; char* K_lds = lds + OFF_K;
  float* ws = (float*)(lds + OFF_WS) + wid * 64; float* li_l = ws; float* al_l = ws + 32;
  float mhat = 0.f, l_reg = 0; f32x16 o[2] = {}; bf16x8 qr[6]; f32x16 negm = f32x16{}; asm volatile("" : "+v"(negm));
  const size_t seq0 = (size_t)b * LP;
  { int sq = q0 + wid * 32 + r32; sq = sq < LP ? sq : LP - 1;
    const bf16* Qw = Q + (seq0 + sq) * 1536 + h * 96 + hi * 8;
#pragma unroll
    for (int d0 = 0; d0 < 6; ++d0) qr[d0] = *reinterpret_cast<const bf16x8*>(Qw + d0 * 16); }
  const int sr = tid >> 3, sc = (tid & 7) * 8, rr = (tid >> 2) & 63, rc = (tid & 3) * 8; const bool hasr = tid < 256;
  const int vst = v_st(sr, sc), kst = sr * KROW + sc * 2, rst = rr * KROW + 128 + rc * 2;
  const bf16* Kn = KV + seq0 * 2048 + h * 128 + (size_t)sr * 2048 + sc; const bf16* Vn = Kn + 64; const bf16* Rn = KR + seq0 * 32 + (size_t)rr * 32 + rc;
  const int vb0 = (int)(uintptr_t)V_lds + v_rd_base(lane);
  struct { bf16x8 vs, ks, rs; } sr_[2];
#define FA_SLOAD(i, k0) do { sr_[i].vs = *reinterpret_cast<const bf16x8*>(Vn + (size_t)(k0) * 2048); sr_[i].ks = *reinterpret_cast<const bf16x8*>(Kn + (size_t)(k0) * 2048); \
    if (hasr) sr_[i].rs = *reinterpret_cast<const bf16x8*>(Rn + (size_t)(k0) * 32); } while (0)
#define FA_SWRITE(bf, i) do { *(bf16x8*)(V_lds + (bf) * SHM_V + vst) = sr_[i].vs; *(bf16x8*)(K_lds + (bf) * SHM_K + kst) = sr_[i].ks; \
    if (hasr) *(bf16x8*)(K_lds + (bf) * SHM_K + rst) = sr_[i].rs; } while (0)
#define FA_SWAIT() asm volatile("s_waitcnt vmcnt(3)" ::: "memory")
#define FA_RESC(a) do { if (__any((a) < 1.f)) { if (hi == 0) al_l[r32] = (a); asm volatile("s_waitcnt lgkmcnt(0)" ::: "memory"); \
    _Pragma("unroll") for (int d = 0; d < 2; ++d) _Pragma("unroll") for (int r = 0; r < 16; ++r) o[d][r] *= al_l[crow(r, hi)]; } } while (0)
  f32x16 pA0, pA1, pB0, pB1; float alA, alB; bf16x8 pa0, pa1, pa2, pa3;
  constexpr int SE = 0, SO = 1;
  const bool act = q0 + wid * 32 < LP;
  if (!act) {
    __syncthreads();
    FA_SLOAD(SE, 0); asm volatile("s_waitcnt vmcnt(0)" ::: "memory"); FA_SWRITE(0, SE); __syncthreads();
    FA_SLOAD(SO, 64); FA_SLOAD(SE, 128);
    FA_SWAIT(); FA_SWRITE(1, SO); __syncthreads();
    for (int j = 1; j + 1 < NT; j += 2) {
      if (j + 2 < NT) FA_SLOAD(SO, (j + 2) * 64);
      __syncthreads(); FA_SWAIT(); FA_SWRITE(0, SE); __syncthreads();
      if (j + 3 < NT) FA_SLOAD(SE, (j + 3) * 64);
      __syncthreads(); FA_SWAIT(); if (j + 2 < NT) FA_SWRITE(1, SO); __syncthreads();
    }
    return;
  }
  __syncthreads();
  FA_SLOAD(SE, 0); asm volatile("s_waitcnt vmcnt(0)" ::: "memory"); FA_SWRITE(0, SE); __syncthreads();
  qkt(pA0, pA1, K_lds, qr, negm, r32, hi);
  { const float NEG = -INFINITY;
#pragma unroll
    for (int r = 0; r < 16; ++r) pA0[r] = NEG;
#pragma unroll
    for (int r = 0; r < 8; ++r) pA1[r] = NEG; }
  partialSM(pA0, pA1, mhat, negm, alA, true);
  FA_SLOAD(SO, 64); FA_SLOAD(SE, 128);
  FA_SWAIT(); FA_SWRITE(1, SO); __syncthreads();
  for (int j = 1; j + 1 < NT; j += 2) {
    FA_SBAR(); qkt(pB0, pB1, K_lds + SHM_K, qr, negm, r32, hi);
    finishSM(pA0, pA1, alA, l_reg, pa0, pa1, pa2, pa3); FA_SBAR();
    if (j + 2 < NT) FA_SLOAD(SO, (j + 2) * 64); FA_SBAR();
    pv_d0(o, vb0, pa0, pa1, pa2, pa3); partialSM(pB0, pB1, mhat, negm, alB, false);
    __syncthreads(); FA_SWAIT(); FA_SWRITE(0, SE);
    FA_RESC(alB); __syncthreads();
    FA_SBAR(); qkt(pA0, pA1, K_lds, qr, negm, r32, hi);
    finishSM(pB0, pB1, alB, l_reg, pa0, pa1, pa2, pa3); FA_SBAR();
    if (j + 3 < NT) FA_SLOAD(SE, (j + 3) * 64); FA_SBAR();
    pv_d0(o, vb0 + SHM_V, pa0, pa1, pa2, pa3); partialSM(pA0, pA1, mhat, negm, alA, false);
    __syncthreads(); FA_SWAIT(); if (j + 2 < NT) FA_SWRITE(1, SO);
    FA_RESC(alA); __syncthreads();
  }
  finishSM(pA0, pA1, alA, l_reg, pa0, pa1, pa2, pa3); FA_SBAR();
  pv_d0(o, vb0, pa0, pa1, pa2, pa3);
  if (hi == 0) li_l[r32] = l_reg; asm volatile("s_waitcnt lgkmcnt(0)" ::: "memory");
  float rli[16];
#pragma unroll
  for (int r = 0; r < 16; ++r) rli[r] = __builtin_amdgcn_rcpf(li_l[crow(r, hi)]);
  { unsigned short* stg = (unsigned short*)(lds + OFF_STG) + wid * 2048;
#pragma unroll
    for (int r = 0; r < 16; ++r) { const int orow = crow(r, hi);
#pragma unroll
      for (int d0 = 0; d0 < 2; ++d0) stg[orow * 64 + d0 * 32 + r32] = (unsigned short)(cvt_pk_bf16(o[d0][r] * rli[r], 0.f) & 0xffffu); }
    asm volatile("s_waitcnt lgkmcnt(0)" ::: "memory");
#pragma unroll
    for (int i = 0; i < 4; ++i) { const int row = i * 8 + (lane >> 3), ch = lane & 7; const int sq = q0 + wid * 32 + row; const u32x4 v = *(const u32x4*)(stg + row * 64 + ch * 8);
      if (sq < LP) *(u32x4*)(O + (seq0 + sq) * 1024 + h * 64 + ch * 8) = v; } }
#undef FA_SLOAD
#undef FA_SWRITE
#undef FA_SWAIT
#undef FA_RESC
}
__device__ __forceinline__ void attn_phase(int vcu, int G, const bf16* Q, const bf16* KV, const bf16* KR, bf16* O, char* lds) {
  for (int u = vcu; u < NB * 16 * NQC; u += G) { const int bh = u / NQC, qc = u % NQC; attn_unit(bh >> 4, bh & 15, qc * 256, Q, KV, KR, O, lds); }
  __syncthreads();
}
}
namespace fa2 {
using namespace fa;
constexpr int SLOT = SHM_K + SHM_V;
constexpr int R_WS = 4 * SLOT, R_STG = R_WS + 8 * 256, R_TOTAL = R_STG + 8 * 4096;
static_assert(R_TOTAL <= 131072, "attention LDS");
struct VFr { s16x4 l[2][4], h[2][4]; };
__device__ __forceinline__ void pv_issue(VFr& f, int vb) {
  f.l[0][0] = tr_read<v_rd_off(0, 0, 0)>(vb); f.h[0][0] = tr_read<v_rd_off(0, 0, 1)>(vb); f.l[0][1] = tr_read<v_rd_off(0, 1, 0)>(vb); f.h[0][1] = tr_read<v_rd_off(0, 1, 1)>(vb);
  f.l[0][2] = tr_read<v_rd_off(0, 2, 0)>(vb); f.h[0][2] = tr_read<v_rd_off(0, 2, 1)>(vb); f.l[0][3] = tr_read<v_rd_off(0, 3, 0)>(vb); f.h[0][3] = tr_read<v_rd_off(0, 3, 1)>(vb);
  f.l[1][0] = tr_read<v_rd_off(1, 0, 0)>(vb); f.h[1][0] = tr_read<v_rd_off(1, 0, 1)>(vb); f.l[1][1] = tr_read<v_rd_off(1, 1, 0)>(vb); f.h[1][1] = tr_read<v_rd_off(1, 1, 1)>(vb);
  f.l[1][2] = tr_read<v_rd_off(1, 2, 0)>(vb); f.h[1][2] = tr_read<v_rd_off(1, 2, 1)>(vb); f.l[1][3] = tr_read<v_rd_off(1, 3, 0)>(vb); f.h[1][3] = tr_read<v_rd_off(1, 3, 1)>(vb);
}
__device__ __forceinline__ void pv_mma(f32x16* o, const VFr& f, bf16x8 pa0, bf16x8 pa1, bf16x8 pa2, bf16x8 pa3) {
  asm volatile("s_waitcnt lgkmcnt(0)" ::: "memory"); FA_SBAR();
#define FA2_PK(L, H) (bf16x8){L[0], L[1], L[2], L[3], H[0], H[1], H[2], H[3]}
#pragma unroll
  for (int d = 0; d < 2; ++d) {
    o[d] = __builtin_amdgcn_mfma_f32_32x32x16_bf16(pa0, FA2_PK(f.l[d][0], f.h[d][0]), o[d], 0, 0, 0);
    o[d] = __builtin_amdgcn_mfma_f32_32x32x16_bf16(pa1, FA2_PK(f.l[d][1], f.h[d][1]), o[d], 0, 0, 0);
    o[d] = __builtin_amdgcn_mfma_f32_32x32x16_bf16(pa2, FA2_PK(f.l[d][2], f.h[d][2]), o[d], 0, 0, 0);
    o[d] = __builtin_amdgcn_mfma_f32_32x32x16_bf16(pa3, FA2_PK(f.l[d][3], f.h[d][3]), o[d], 0, 0, 0); }
#undef FA2_PK
}
__device__ __forceinline__ void attn_unit(int b, int h, int q0, const bf16* __restrict__ Q, const bf16* __restrict__ KV, const bf16* __restrict__ KR, bf16* __restrict__ O, char* lds) {
  const int tid = threadIdx.x, wid = __builtin_amdgcn_readfirstlane(tid >> 6), lane = tid & 63, r32 = lane & 31, hi = lane >> 5;
  float* ws = (float*)(lds + R_WS) + wid * 64; float* li_l = ws; float* al_l = ws + 32;
  float mhat = 0.f, l_reg = 0; f32x16 o[2] = {}; bf16x8 qr[6]; f32x16 negm = f32x16{}; asm volatile("" : "+v"(negm));
  const size_t seq0 = (size_t)b * LP;
  const char* sp[3]; unsigned stp[3];
#pragma unroll
  for (int k = 0; k < 3; ++k) { const int c = (wid + 8 * k) * 64 + lane;
    if (c < 832) { const int row = c / 13, cc = c % 13;
      if (cc >= 8 && cc < 12) { sp[k] = (const char*)(KR + (seq0 + row) * 32 + (cc - 8) * 8); stp[k] = 64 * 32 * 2; }
      else { sp[k] = (const char*)(KV + (seq0 + row) * 2048 + h * 128 + (cc < 8 ? cc : 0) * 8); stp[k] = 64 * 2048 * 2; }
    } else { const int p = (c - 832) & 511, kk = ((p >> 6) << 3) | ((p & 31) >> 2), key = (kk & ~0xC) | ((kk & 4) << 1) | ((kk & 8) >> 1), col = ((p >> 5) & 1) * 32 + (p & 3) * 8;
      sp[k] = (const char*)(KV + (seq0 + key) * 2048 + h * 128 + 64 + col); stp[k] = 64 * 2048 * 2; } }
  const bool third = wid < 5;
#define FA2_DMA(t, slot) do { const unsigned t_ = (unsigned)(t); \
    __builtin_amdgcn_global_load_lds((const unsigned*)(sp[0] + (size_t)t_ * stp[0]), (__attribute__((address_space(3))) unsigned*)(lds + (slot) * SLOT + wid * 1024), 16, 0, 0); \
    __builtin_amdgcn_global_load_lds((const unsigned*)(sp[1] + (size_t)t_ * stp[1]), (__attribute__((address_space(3))) unsigned*)(lds + (slot) * SLOT + (wid + 8) * 1024), 16, 0, 0); \
    if (third) __builtin_amdgcn_global_load_lds((const unsigned*)(sp[2] + (size_t)t_ * stp[2]), (__attribute__((address_space(3))) unsigned*)(lds + (slot) * SLOT + (wid + 16) * 1024), 16, 0, 0); } while (0)
#define FA2_RESC(a) do { if (__any((a) < 1.f)) { if (hi == 0) al_l[r32] = (a); asm volatile("s_waitcnt lgkmcnt(0)" ::: "memory"); \
    _Pragma("unroll") for (int d = 0; d < 2; ++d) _Pragma("unroll") for (int r = 0; r < 16; ++r) o[d][r] *= al_l[crow(r, hi)]; } } while (0)
  const bool act = q0 + wid * 32 < LP;
  __syncthreads();
  FA2_DMA(0, 0); FA2_DMA(1, 1);
  { int sq = q0 + wid * 32 + r32; sq = sq < LP ? sq : LP - 1;
    const bf16* Qw = Q + (seq0 + sq) * 1536 + h * 96 + hi * 8;
#pragma unroll
    for (int d0 = 0; d0 < 6; ++d0) qr[d0] = *reinterpret_cast<const bf16x8*>(Qw + d0 * 16); }
  __syncthreads();
  if (!act) {
    FA2_DMA(2, 2); __syncthreads();
    for (int i = 0; i < 16; ++i) { const int j = 4 * i + 1;
      if (j + 2 < NT) FA2_DMA(j + 2, 3); __syncthreads(); if (j + 3 < NT) FA2_DMA(j + 3, 0); __syncthreads(); if (j + 4 < NT) FA2_DMA(j + 4, 1); __syncthreads(); if (j + 5 < NT) FA2_DMA(j + 5, 2); __syncthreads(); }
    return; }
  const int vb0 = (int)(uintptr_t)lds + SHM_K + v_rd_base(lane);
  f32x16 pA0, pA1, pB0, pB1; float alA, alB; bf16x8 pa0, pa1, pa2, pa3;
  FA2_DMA(2, 2);
  qkt(pA0, pA1, lds, qr, negm, r32, hi);
  { const float NEG = -INFINITY;
#pragma unroll
    for (int r = 0; r < 16; ++r) pA0[r] = NEG;
#pragma unroll
    for (int r = 0; r < 8; ++r) pA1[r] = NEG; }
  partialSM(pA0, pA1, mhat, negm, alA, true);
  __syncthreads();
#define FA2_SEG(j, PC0, PC1, ALC, PP0, PP1, ALP, KS, VS, DS) do { if ((j) + 2 < NT) FA2_DMA((j) + 2, DS); \
    FA_SBAR(); qkt(PC0, PC1, lds + (KS) * SLOT, qr, negm, r32, hi); FA_SBAR(); \
    { VFr vf_; pv_issue(vf_, vb0 + (VS) * SLOT); FA_SBAR(); finishSM(PP0, PP1, ALP, l_reg, pa0, pa1, pa2, pa3); FA_SBAR(); \
      pv_mma(o, vf_, pa0, pa1, pa2, pa3); } partialSM(PC0, PC1, mhat, negm, ALC, false); \
    FA2_RESC(ALC); __syncthreads(); } while (0)
  for (int j = 1; j + 1 < NT; j += 2) {
    FA2_SEG(j,     pB0, pB1, alB, pA0, pA1, alA, j & 3, (j - 1) & 3, (j + 2) & 3);
    FA2_SEG(j + 1, pA0, pA1, alA, pB0, pB1, alB, (j + 1) & 3, j & 3, (j + 3) & 3);
  }
  finishSM(pA0, pA1, alA, l_reg, pa0, pa1, pa2, pa3); FA_SBAR();
  pv_d0(o, vb0, pa0, pa1, pa2, pa3);
  if (hi == 0) li_l[r32] = l_reg; asm volatile("s_waitcnt lgkmcnt(0)" ::: "memory");
  float rli[16];
#pragma unroll
  for (int r = 0; r < 16; ++r) rli[r] = __builtin_amdgcn_rcpf(li_l[crow(r, hi)]);
  { unsigned short* stg = (unsigned short*)(lds + R_STG) + wid * 2048;
#pragma unroll
    for (int r = 0; r < 16; ++r) { const int orow = crow(r, hi);
#pragma unroll
      for (int d0 = 0; d0 < 2; ++d0) stg[orow * 64 + d0 * 32 + r32] = (unsigned short)(cvt_pk_bf16(o[d0][r] * rli[r], 0.f) & 0xffffu); }
    asm volatile("s_waitcnt lgkmcnt(0)" ::: "memory");
#pragma unroll
    for (int i = 0; i < 4; ++i) { const int row = i * 8 + (lane >> 3), ch = lane & 7; const int sq = q0 + wid * 32 + row; const u32x4 v = *(const u32x4*)(stg + row * 64 + ch * 8);
      if (sq < LP) *(u32x4*)(O + (seq0 + sq) * 1024 + h * 64 + ch * 8) = v; } }
#undef FA2_DMA
#undef FA2_RESC
#undef FA2_SEG
}
__device__ __forceinline__ void attn_phase(int vcu, int G, const bf16* Q, const bf16* KV, const bf16* KR, bf16* O, char* lds) {
  for (int u = vcu; u < NB * 16 * NQC; u += G) { const int bh = u / NQC, qc = u % NQC; attn_unit(bh >> 4, bh & 15, qc * 256, Q, KV, KR, O, lds); }
  __syncthreads();
}
}
namespace fa4 {
using namespace fa;
constexpr int SLOT = fa2::SLOT, R_WS = fa2::R_WS, R_STG = fa2::R_STG;
#define FA4_PIN(x) asm volatile("" : "+v"(x))
__device__ __forceinline__ void attn_unit(int b, int h, int q0, const bf16* __restrict__ Q, const bf16* __restrict__ KV, const bf16* __restrict__ KR, bf16* __restrict__ O, char* lds) {
  const int tid = threadIdx.x, wid = __builtin_amdgcn_readfirstlane(tid >> 6), lane = tid & 63, r32 = lane & 31, hi = lane >> 5;
  float* ws = (float*)(lds + R_WS) + wid * 64; float* li_l = ws; float* al_l = ws + 32;
  float mhat = 0.f, l_reg = 0; f32x16 o[2] = {}; bf16x8 qr[6]; f32x16 negm = f32x16{}; asm volatile("" : "+v"(negm));
  const size_t seq0 = (size_t)b * LP;
  const char* sp[3]; unsigned stp[3];
#pragma unroll
  for (int k = 0; k < 3; ++k) { const int c = (wid + 8 * k) * 64 + lane;
    if (c < 832) { const int row = c / 13, cc = c % 13;
      if (cc >= 8 && cc < 12) { sp[k] = (const char*)(KR + (seq0 + row) * 32 + (cc - 8) * 8); stp[k] = 64 * 32 * 2; }
      else { sp[k] = (const char*)(KV + (seq0 + row) * 2048 + h * 128 + (cc < 8 ? cc : 0) * 8); stp[k] = 64 * 2048 * 2; }
    } else { const int p = (c - 832) & 511, kk = ((p >> 6) << 3) | ((p & 31) >> 2), key = (kk & ~0xC) | ((kk & 4) << 1) | ((kk & 8) >> 1), col = ((p >> 5) & 1) * 32 + (p & 3) * 8;
      sp[k] = (const char*)(KV + (seq0 + key) * 2048 + h * 128 + 64 + col); stp[k] = 64 * 2048 * 2; } }
  const bool third = wid < 5;
#define FA4_DMA(t, slot) do { const unsigned t_ = (unsigned)(t); \
    __builtin_amdgcn_global_load_lds((const unsigned*)(sp[0] + (size_t)t_ * stp[0]), (__attribute__((address_space(3))) unsigned*)(lds + (slot) * SLOT + wid * 1024), 16, 0, 0); \
    __builtin_amdgcn_global_load_lds((const unsigned*)(sp[1] + (size_t)t_ * stp[1]), (__attribute__((address_space(3))) unsigned*)(lds + (slot) * SLOT + (wid + 8) * 1024), 16, 0, 0); \
    if (third) __builtin_amdgcn_global_load_lds((const unsigned*)(sp[2] + (size_t)t_ * stp[2]), (__attribute__((address_space(3))) unsigned*)(lds + (slot) * SLOT + (wid + 16) * 1024), 16, 0, 0); } while (0)
#define FA4_RESC(a) do { if (__any((a) < 1.f)) { if (hi == 0) al_l[r32] = (a); asm volatile("s_waitcnt lgkmcnt(0)" ::: "memory"); \
    _Pragma("unroll") for (int d = 0; d < 2; ++d) _Pragma("unroll") for (int r = 0; r < 16; ++r) o[d][r] *= al_l[crow(r, hi)]; } } while (0)
  const bool act = q0 + wid * 32 < LP;
  __syncthreads();
  FA4_DMA(0, 0); FA4_DMA(1, 1);
  { int sq = q0 + wid * 32 + r32; sq = sq < LP ? sq : LP - 1;
    const bf16* Qw = Q + (seq0 + sq) * 1536 + h * 96 + hi * 8;
#pragma unroll
    for (int d0 = 0; d0 < 6; ++d0) qr[d0] = *reinterpret_cast<const bf16x8*>(Qw + d0 * 16); }
  __syncthreads();
  if (!act) {
    FA4_DMA(2, 2); __syncthreads();
    for (int i = 0; i < 16; ++i) { const int j = 4 * i + 1;
      if (j + 2 < NT) FA4_DMA(j + 2, 3); __syncthreads(); if (j + 3 < NT) FA4_DMA(j + 3, 0); __syncthreads(); if (j + 4 < NT) FA4_DMA(j + 4, 1); __syncthreads(); if (j + 5 < NT) FA4_DMA(j + 5, 2); __syncthreads(); }
    return; }
  const int vb0 = (int)(uintptr_t)lds + SHM_K + v_rd_base(lane);
  f32x16 pA0, pA1, pB0, pB1; float alA, alB; bf16x8 pa0, pa1, pa2, pa3;
  FA4_DMA(2, 2);
  qkt(pA0, pA1, lds, qr, negm, r32, hi);
  { const float NEG = -INFINITY;
#pragma unroll
    for (int r = 0; r < 16; ++r) pA0[r] = NEG;
#pragma unroll
    for (int r = 0; r < 8; ++r) pA1[r] = NEG; }
  partialSM(pA0, pA1, mhat, negm, alA, true);
#pragma unroll
  for (int r = 0; r < 16; ++r) pA1[r] = __builtin_amdgcn_exp2f(pA1[r]);
  __syncthreads();
#define FA4_TR(OFF) tr_read<OFF>(vb_)
#define FA4_PK(L, H) (bf16x8){L[0], L[1], L[2], L[3], H[0], H[1], H[2], H[3]}
#define FA4_KF(row, d0) (*reinterpret_cast<const bf16x8*>(kb_ + (row) * KROW + ((d0) * 16 + hi * 8) * 2))
#define FA4_KX(row, d0) (*reinterpret_cast<const bf16x8*>(kx_ + (row) * KROW + ((d0) * 16 + hi * 8) * 2))
#define FA4_EX4(X, B) do { X[B] = __builtin_amdgcn_exp2f(X[B]); X[B + 1] = __builtin_amdgcn_exp2f(X[B + 1]); X[B + 2] = __builtin_amdgcn_exp2f(X[B + 2]); X[B + 3] = __builtin_amdgcn_exp2f(X[B + 3]); FA4_PIN(X); } while (0)
#define FA4_SEG(j, C0, C1, ALC, P0, P1, KS, VS, DS) do { if ((j) + 2 < NT) FA4_DMA((j) + 2, DS); \
    const char* kb_ = lds + (KS) * SLOT + r32 * KROW; const int vb_ = vb0 + (VS) * SLOT; \
      \
    bf16x8 ka0 = kn0, kb0 = kn1, ka1 = kn2, kb1 = kn3, ka2 = kn4, kb2 = kn5;     \
    const char* kx_ = lds + (((j) + 1) & 3) * SLOT + r32 * KROW;                 \
    float sacc = P0[0] + P0[1]; unsigned w0, w1, w2, w3, w4, w5, w6, w7, w8, w9, w10, w11, w12, w13, w14, w15; \
    FA_SBAR(); \
      \
    C0 = __builtin_amdgcn_mfma_f32_32x32x16_bf16(ka0, qr[0], negm, 0, 0, 0); const s16x4 l00 = FA4_TR(v_rd_off(0, 0, 0)), h00 = FA4_TR(v_rd_off(0, 0, 1)); sacc += P0[2]; sacc += P0[3]; sacc += P0[4]; FA4_PIN(sacc); w0 = cvt_pk_bf16(P0[0], P0[1]); w1 = cvt_pk_bf16(P0[2], P0[3]); FA_SBAR(); \
    C1 = __builtin_amdgcn_mfma_f32_32x32x16_bf16(kb0, qr[0], negm, 0, 0, 0); const s16x4 l01 = FA4_TR(v_rd_off(0, 1, 0)), h01 = FA4_TR(v_rd_off(0, 1, 1)); sacc += P0[5]; sacc += P0[6]; sacc += P0[7]; FA4_PIN(sacc); w2 = cvt_pk_bf16(P0[4], P0[5]); w3 = cvt_pk_bf16(P0[6], P0[7]); FA_SBAR(); \
    C0 = __builtin_amdgcn_mfma_f32_32x32x16_bf16(ka1, qr[1], C0, 0, 0, 0); const s16x4 l02 = FA4_TR(v_rd_off(0, 2, 0)), h02 = FA4_TR(v_rd_off(0, 2, 1)); sacc += P0[8]; sacc += P0[9]; sacc += P0[10]; FA4_PIN(sacc); w4 = cvt_pk_bf16(P0[8], P0[9]); w5 = cvt_pk_bf16(P0[10], P0[11]); FA_SBAR(); \
    C1 = __builtin_amdgcn_mfma_f32_32x32x16_bf16(kb1, qr[1], C1, 0, 0, 0); const s16x4 l03 = FA4_TR(v_rd_off(0, 3, 0)), h03 = FA4_TR(v_rd_off(0, 3, 1)); sacc += P0[11]; sacc += P0[12]; sacc += P0[13]; FA4_PIN(sacc); w6 = cvt_pk_bf16(P0[12], P0[13]); w7 = cvt_pk_bf16(P0[14], P0[15]); FA_SBAR(); \
    ka0 = FA4_KF(0, 3); kb0 = FA4_KF(32, 3); ka1 = FA4_KF(0, 4); kb1 = FA4_KF(32, 4); \
    C0 = __builtin_amdgcn_mfma_f32_32x32x16_bf16(ka2, qr[2], C0, 0, 0, 0); const s16x4 l10 = FA4_TR(v_rd_off(1, 0, 0)), h10 = FA4_TR(v_rd_off(1, 0, 1)); sacc += P0[14]; sacc += P0[15]; sacc += P1[0]; FA4_PIN(sacc); w8 = cvt_pk_bf16(P1[0], P1[1]); w9 = cvt_pk_bf16(P1[2], P1[3]); FA_SBAR(); \
    C1 = __builtin_amdgcn_mfma_f32_32x32x16_bf16(kb2, qr[2], C1, 0, 0, 0); const s16x4 l11 = FA4_TR(v_rd_off(1, 1, 0)), h11 = FA4_TR(v_rd_off(1, 1, 1)); sacc += P1[1]; sacc += P1[2]; sacc += P1[3]; FA4_PIN(sacc); w10 = cvt_pk_bf16(P1[4], P1[5]); w11 = cvt_pk_bf16(P1[6], P1[7]); FA_SBAR(); \
    ka2 = FA4_KF(0, 5); kb2 = FA4_KF(32, 5); \
    C0 = __builtin_amdgcn_mfma_f32_32x32x16_bf16(ka0, qr[3], C0, 0, 0, 0); const s16x4 l12 = FA4_TR(v_rd_off(1, 2, 0)), h12 = FA4_TR(v_rd_off(1, 2, 1)); sacc += P1[4]; sacc += P1[5]; sacc += P1[6]; FA4_PIN(sacc); w12 = cvt_pk_bf16(P1[8], P1[9]); w13 = cvt_pk_bf16(P1[10], P1[11]); FA_SBAR(); \
    C1 = __builtin_amdgcn_mfma_f32_32x32x16_bf16(kb0, qr[3], C1, 0, 0, 0); const s16x4 l13 = FA4_TR(v_rd_off(1, 3, 0)), h13 = FA4_TR(v_rd_off(1, 3, 1)); sacc += P1[7]; sacc += P1[8]; sacc += P1[9]; FA4_PIN(sacc); w14 = cvt_pk_bf16(P1[12], P1[13]); w15 = cvt_pk_bf16(P1[14], P1[15]); FA_SBAR(); \
    C0 = __builtin_amdgcn_mfma_f32_32x32x16_bf16(ka1, qr[4], C0, 0, 0, 0); sacc += P1[10]; sacc += P1[11]; FA4_PIN(sacc); \
      { auto r0_ = __builtin_amdgcn_permlane32_swap(w0, w2, false, false); auto r1_ = __builtin_amdgcn_permlane32_swap(w1, w3, false, false); u32x4 v_ = {r0_[0], r1_[0], r0_[1], r1_[1]}; pa0 = *reinterpret_cast<bf16x8*>(&v_); } FA4_PIN(pa0); FA_SBAR(); \
    C1 = __builtin_amdgcn_mfma_f32_32x32x16_bf16(kb1, qr[4], C1, 0, 0, 0); sacc += P1[12]; sacc += P1[13]; FA4_PIN(sacc); \
      { auto r0_ = __builtin_amdgcn_permlane32_swap(w4, w6, false, false); auto r1_ = __builtin_amdgcn_permlane32_swap(w5, w7, false, false); u32x4 v_ = {r0_[0], r1_[0], r0_[1], r1_[1]}; pa1 = *reinterpret_cast<bf16x8*>(&v_); } FA4_PIN(pa1); FA_SBAR(); \
    C0 = __builtin_amdgcn_mfma_f32_32x32x16_bf16(ka2, qr[5], C0, 0, 0, 0); sacc += P1[14]; sacc += P1[15]; FA4_PIN(sacc); \
      { auto r0_ = __builtin_amdgcn_permlane32_swap(w8, w10, false, false); auto r1_ = __builtin_amdgcn_permlane32_swap(w9, w11, false, false); u32x4 v_ = {r0_[0], r1_[0], r0_[1], r1_[1]}; pa2 = *reinterpret_cast<bf16x8*>(&v_); } FA4_PIN(pa2); FA_SBAR(); \
    C1 = __builtin_amdgcn_mfma_f32_32x32x16_bf16(kb2, qr[5], C1, 0, 0, 0); \
      { auto r0_ = __builtin_amdgcn_permlane32_swap(w12, w14, false, false); auto r1_ = __builtin_amdgcn_permlane32_swap(w13, w15, false, false); u32x4 v_ = {r0_[0], r1_[0], r0_[1], r1_[1]}; pa3 = *reinterpret_cast<bf16x8*>(&v_); } FA4_PIN(pa3); \
      { auto rr_ = __builtin_amdgcn_permlane32_swap(__float_as_uint(sacc), __float_as_uint(sacc), false, false); l_reg += __uint_as_float(rr_[0]) + __uint_as_float(rr_[1]); } FA_SBAR(); \
      \
    { float a_ = fmaxf(fmaxf(C0[0], C0[1]), C1[0]), b_ = fmaxf(fmaxf(C0[2], C0[3]), C1[1]); a_ = fmaxf(fmaxf(a_, C1[2]), C1[3]); \
      _Pragma("unroll") for (int r = 4; r < 16; r += 4) { a_ = fmaxf(fmaxf(a_, C0[r]), C0[r + 1]); b_ = fmaxf(fmaxf(b_, C0[r + 2]), C0[r + 3]); a_ = fmaxf(fmaxf(a_, C1[r]), C1[r + 1]); b_ = fmaxf(fmaxf(b_, C1[r + 2]), C1[r + 3]); } \
      float rm_ = fmaxf(a_, b_); { auto rr_ = __builtin_amdgcn_permlane32_swap(__float_as_uint(rm_), __float_as_uint(rm_), false, false); rm_ = fmaxf(__uint_as_float(rr_[0]), __uint_as_float(rr_[1])); } \
      ALC = 1.f; \
      if (__builtin_expect(__any(rm_ > THRL), 0)) { const float dl_ = fmaxf(rm_, 0.f); mhat += dl_; \
        _Pragma("unroll") for (int r = 0; r < 16; ++r) { C0[r] -= dl_; C1[r] -= dl_; } \
        _Pragma("unroll") for (int r = 0; r < 16; ++r) negm[r] = -mhat; asm volatile("" : "+v"(negm)); \
        ALC = __builtin_amdgcn_exp2f(-dl_); l_reg *= ALC; } } \
    asm volatile("s_waitcnt lgkmcnt(0)" ::: "memory"); FA_SBAR(); \
      \
    o[0] = __builtin_amdgcn_mfma_f32_32x32x16_bf16(pa0, FA4_PK(l00, h00), o[0], 0, 0, 0); FA4_EX4(C0, 0); FA_SBAR(); \
    o[1] = __builtin_amdgcn_mfma_f32_32x32x16_bf16(pa0, FA4_PK(l10, h10), o[1], 0, 0, 0); FA4_EX4(C0, 4); FA_SBAR(); \
    o[0] = __builtin_amdgcn_mfma_f32_32x32x16_bf16(pa1, FA4_PK(l01, h01), o[0], 0, 0, 0); FA4_EX4(C0, 8); FA_SBAR(); \
    o[1] = __builtin_amdgcn_mfma_f32_32x32x16_bf16(pa1, FA4_PK(l11, h11), o[1], 0, 0, 0); FA4_EX4(C0, 12); FA_SBAR(); \
    o[0] = __builtin_amdgcn_mfma_f32_32x32x16_bf16(pa2, FA4_PK(l02, h02), o[0], 0, 0, 0); FA4_EX4(C1, 0); kn0 = FA4_KX(0, 0); kn1 = FA4_KX(32, 0); FA_SBAR(); \
    o[1] = __builtin_amdgcn_mfma_f32_32x32x16_bf16(pa2, FA4_PK(l12, h12), o[1], 0, 0, 0); FA4_EX4(C1, 4); kn2 = FA4_KX(0, 1); kn3 = FA4_KX(32, 1); FA_SBAR(); \
    o[0] = __builtin_amdgcn_mfma_f32_32x32x16_bf16(pa3, FA4_PK(l03, h03), o[0], 0, 0, 0); FA4_EX4(C1, 8); kn4 = FA4_KX(0, 2); kn5 = FA4_KX(32, 2); FA_SBAR(); \
    o[1] = __builtin_amdgcn_mfma_f32_32x32x16_bf16(pa3, FA4_PK(l13, h13), o[1], 0, 0, 0); FA4_EX4(C1, 12); FA_SBAR(); \
    FA4_RESC(ALC); __syncthreads(); } while (0)
  bf16x8 kn0, kn1, kn2, kn3, kn4, kn5;
  { const char* kx_ = lds + 1 * SLOT + r32 * KROW; kn0 = FA4_KX(0, 0); kn1 = FA4_KX(32, 0); kn2 = FA4_KX(0, 1); kn3 = FA4_KX(32, 1); kn4 = FA4_KX(0, 2); kn5 = FA4_KX(32, 2); }
  for (int j = 1; j + 1 < NT; j += 2) {
    FA4_SEG(j,     pB0, pB1, alB, pA0, pA1, j & 3, (j - 1) & 3, (j + 2) & 3);
    FA4_SEG(j + 1, pA0, pA1, alA, pB0, pB1, (j + 1) & 3, j & 3, (j + 3) & 3);
  }
  { float ps = 0.f;
#pragma unroll
    for (int r = 0; r < 16; ++r) ps += pA0[r] + pA1[r];
    { auto rr = __builtin_amdgcn_permlane32_swap(__float_as_uint(ps), __float_as_uint(ps), false, false); l_reg += __uint_as_float(rr[0]) + __uint_as_float(rr[1]); }
#define FA4_PK4(P, BASE, OUT) do { unsigned a0 = cvt_pk_bf16(P[BASE + 0], P[BASE + 1]), a1 = cvt_pk_bf16(P[BASE + 2], P[BASE + 3]);   \
    unsigned b0 = cvt_pk_bf16(P[BASE + 4], P[BASE + 5]), b1 = cvt_pk_bf16(P[BASE + 6], P[BASE + 7]);                              \
    auto r0 = __builtin_amdgcn_permlane32_swap(a0, b0, false, false); auto r1 = __builtin_amdgcn_permlane32_swap(a1, b1, false, false); \
    u32x4 w = {r0[0], r1[0], r0[1], r1[1]}; OUT = *reinterpret_cast<bf16x8*>(&w); } while (0)
    FA4_PK4(pA0, 0, pa0); FA4_PK4(pA0, 8, pa1); FA4_PK4(pA1, 0, pa2); FA4_PK4(pA1, 8, pa3);
#undef FA4_PK4
    FA_SBAR(); pv_d0(o, vb0, pa0, pa1, pa2, pa3); }
  if (hi == 0) li_l[r32] = l_reg; asm volatile("s_waitcnt lgkmcnt(0)" ::: "memory");
  float rli[16];
#pragma unroll
  for (int r = 0; r < 16; ++r) rli[r] = __builtin_amdgcn_rcpf(li_l[crow(r, hi)]);
  { unsigned short* stg = (unsigned short*)(lds + R_STG) + wid * 2048;
#pragma unroll
    for (int r = 0; r < 16; ++r) { const int orow = crow(r, hi);
#pragma unroll
      for (int d0 = 0; d0 < 2; ++d0) stg[orow * 64 + d0 * 32 + r32] = (unsigned short)(cvt_pk_bf16(o[d0][r] * rli[r], 0.f) & 0xffffu); }
    asm volatile("s_waitcnt lgkmcnt(0)" ::: "memory");
#pragma unroll
    for (int i = 0; i < 4; ++i) { const int row = i * 8 + (lane >> 3), ch = lane & 7; const int sq = q0 + wid * 32 + row; const u32x4 v = *(const u32x4*)(stg + row * 64 + ch * 8);
      if (sq < LP) *(u32x4*)(O + (seq0 + sq) * 1024 + h * 64 + ch * 8) = v; } }
#undef FA4_DMA
#undef FA4_RESC
#undef FA4_SEG
#undef FA4_TR
#undef FA4_PK
#undef FA4_KF
#undef FA4_KX
#undef FA4_EX4
}
__device__ __forceinline__ void attn_phase(int vcu, int G, const bf16* Q, const bf16* KV, const bf16* KR, bf16* O, char* lds) {
  for (int u = vcu; u < NB * 16 * NQC; u += G) { const int bh = u / NQC, qc = u % NQC; attn_unit(bh >> 4, bh & 15, qc * 256, Q, KV, KR, O, lds); }
  __syncthreads();
}
#undef FA4_PIN
#undef FA_SBAR
}
namespace gla {
using bf16x8 = __attribute__((ext_vector_type(8))) short;
using s16x4  = __attribute__((ext_vector_type(4))) short;
using f32x16 = __attribute__((ext_vector_type(16))) float;
using u32x4  = __attribute__((ext_vector_type(4))) unsigned;
using u32x2  = __attribute__((ext_vector_type(2))) unsigned;
constexpr int RS = 264;
constexpr int O_QI = 0, O_KI = 64 * RS, O_KD = 2 * 64 * RS, O_VV = O_KD + 16384, O_VEC = O_VV + 16384;
constexpr int V_DEC = O_VEC, V_EREF = O_VEC + 512, V_TOT = O_VEC + 1024, V_F2 = O_VEC + 1024 + 2048;
constexpr int CH_BYTES = O_VEC + 3584;
static_assert(CH_BYTES % 16 == 0 && 2 * CH_BYTES <= 146432, "gla LDS");
#define GLA_SBAR() __builtin_amdgcn_sched_barrier(0)
__device__ __forceinline__ int crow(int r, int hi) { return (r & 3) + 8 * (r >> 2) + 4 * hi; }
__device__ __forceinline__ int v_st4(int k, int c) { const int kk = (k & ~0xC) | ((k & 4) << 1) | ((k & 8) >> 1); return ((kk >> 3) * 4 + (c >> 5)) * 512 + ((kk & 7) * 32 + (c & 31)) * 2; }
__device__ __forceinline__ int v_rd_base(int lane) { return ((lane & 3) << 3) | (((lane >> 2) & 3) << 6) | (((lane >> 4) & 1) << 5) | (((lane >> 5) & 1) << 8); }
template <int OFF> __device__ __forceinline__ s16x4 tr_read(int vb) {
  s16x4 r; asm volatile("ds_read_b64_tr_b16 %0, %1 offset:%2" : "=&v"(r) : "v"(vb), "i"(OFF) : "memory"); return r;
}
__device__ __forceinline__ bf16x8 nat_frag(const char* img, int row, int ks, int hi) {
  const u32x2 a = *(const u32x2*)(img + row * RS + (16 * ks + 4 * hi) * 2), b = *(const u32x2*)(img + row * RS + (16 * ks + 8 + 4 * hi) * 2);
  u32x4 w = {a.x, a.y, b.x, b.y}; return *reinterpret_cast<bf16x8*>(&w);
}
__device__ __forceinline__ bf16x8 pk4(const f32x16& P, int BASE_IS_8) {
  const int B = BASE_IS_8 ? 8 : 0;
  const unsigned a0 = cvt_pk_bf16(P[B + 0], P[B + 1]), a1 = cvt_pk_bf16(P[B + 2], P[B + 3]), b0 = cvt_pk_bf16(P[B + 4], P[B + 5]), b1 = cvt_pk_bf16(P[B + 6], P[B + 7]);
  auto r0 = __builtin_amdgcn_permlane32_swap(a0, b0, false, false); auto r1 = __builtin_amdgcn_permlane32_swap(a1, b1, false, false);
  u32x4 w = {r0[0], r1[0], r0[1], r1[1]}; return *reinterpret_cast<bf16x8*>(&w);
}
#define GLA_PK(L, H) (bf16x8){L[0], L[1], L[2], L[3], H[0], H[1], H[2], H[3]}
__device__ __forceinline__ void gla_phase(int vcu, int G, bf16* Qb, const bf16* Vb, bf16* KFb, bf16* KBb, const bf16* SGb, const float* onorm, char* lds) {
  const int tid = threadIdx.x, wid = __builtin_amdgcn_readfirstlane(tid >> 6), lane = tid & 63, r32 = lane & 31, hi = lane >> 5;
  const int dir = wid >> 2, w4 = wid & 3, ct = tid & 255, kp = ct & 63;
  char* L = lds + dir * CH_BYTES;
  const int lbase = (int)(uintptr_t)L;
  const int vbV = lbase + O_VV + v_rd_base(lane) + w4 * 512, vbK = lbase + O_KD + v_rd_base(lane);
  bf16* Kown = dir ? KBb : KFb; const bf16* Koth = dir ? KFb : KBb;
  for (int it = vcu; it < NB * 8; it += G) {
    const int b = it >> 3, h = it & 7, cb = h * 128; const size_t seq0 = (size_t)b * LP;
    f32x16 S[4];
#pragma unroll
    for (int kb = 0; kb < 4; ++kb) S[kb] = f32x16{};
    unsigned pq[16], pk[16]; bf16x8 pvv[4];
#define GLA_ROW(n, tl) ((n) * 64 + (dir ? 63 - (tl) : (tl)))
#define GLA_LOAD(n) do { _Pragma("unroll") for (int i = 0; i < 16; ++i) { const size_t off = (seq0 + GLA_ROW(n, 16 * w4 + i)) * 1024 + cb + 2 * kp; \
        pq[i] = *(const unsigned*)(Qb + off); pk[i] = *(const unsigned*)(Kown + off); } \
      _Pragma("unroll") for (int i = 0; i < 4; ++i) { const int id = ct + 256 * i; pvv[i] = *(const bf16x8*)(Vb + (seq0 + GLA_ROW(n, id >> 4)) * 1024 + cb + (id & 15) * 8); } } while (0)
#define GLA_PASS1() do { float run0 = 1.f, run1 = 1.f, f20 = 1.f, f21 = 1.f; \
      _Pragma("unroll") for (int i = 0; i < 16; ++i) { run0 *= 1.0f - bf_lo(pk[i]); run1 *= 1.0f - bf_hi(pk[i]); if (i == 0) { f20 = run0; f21 = run1; } } \
      *(f32x2*)(L + V_TOT + (w4 * 128 + 2 * kp) * 4) = (f32x2){run0, run1}; \
      if (w4 == 2) *(f32x2*)(L + V_F2 + (2 * kp) * 4) = (f32x2){f20, f21}; } while (0)
    for (int step = 0; step < 65; ++step) {
      const int n = dir ? 64 - step : step;
      const bool fin = dir ? (step >= 32) : (step >= 33);
      const bool lpath = step >= 32;
      int lane_o = lane; asm volatile("" : "+v"(lane_o));
      const int r32 = lane_o & 31, hi = lane_o >> 5, kp = lane_o, ct = (w4 << 6) | lane_o;
      const int vbV = lbase + O_VV + v_rd_base(lane_o) + w4 * 512, vbK = lbase + O_KD + v_rd_base(lane_o);
      if (step == 0) { GLA_LOAD(n); GLA_PASS1(); __syncthreads(); }
      { const f32x2 t0 = *(const f32x2*)(L + V_TOT + (0 * 128 + 2 * kp) * 4), t1 = *(const f32x2*)(L + V_TOT + (1 * 128 + 2 * kp) * 4), t2 = *(const f32x2*)(L + V_TOT + (2 * 128 + 2 * kp) * 4),
                    t3 = *(const f32x2*)(L + V_TOT + (3 * 128 + 2 * kp) * 4), f2 = *(const f32x2*)(L + V_F2 + (2 * kp) * 4);
        const f32x2 pre = w4 == 0 ? (f32x2){1.f, 1.f} : w4 == 1 ? t0 : w4 == 2 ? t0 * t1 : t0 * t1 * t2;
        const f32x2 pref = t0 * t1 * f2, plast = (t0 * t1) * (t2 * t3);
        const float ir0 = __builtin_amdgcn_rcpf(pref.x), ir1 = __builtin_amdgcn_rcpf(pref.y);
        const float c30 = plast.x * ir0, c31 = plast.y * ir1;
        float run0 = pre.x, run1 = pre.y;
#pragma unroll
        for (int i = 0; i < 16; ++i) { const int t = 16 * w4 + i;
          const float kg0 = bf_lo(pk[i]), kg1 = bf_hi(pk[i]);
          run0 *= 1.0f - kg0; run1 *= 1.0f - kg1;
          const float ki0 = kg0 * pref.x * __builtin_amdgcn_rcpf(run0), ki1 = kg1 * pref.y * __builtin_amdgcn_rcpf(run1);
          *(unsigned*)(L + O_QI + t * RS + 4 * kp) = cvt_pk_bf16(bf_lo(pq[i]) * run0 * ir0, bf_hi(pq[i]) * run1 * ir1);
          *(unsigned*)(L + O_KI + t * RS + 4 * kp) = cvt_pk_bf16(ki0, ki1);
          *(unsigned*)(L + O_KD + v_st4(t, 2 * kp)) = cvt_pk_bf16(ki0 * c30, ki1 * c31); }
        if (w4 == 0) { *(f32x2*)(L + V_DEC + (2 * kp) * 4) = plast; *(f32x2*)(L + V_EREF + (2 * kp) * 4) = pref; }
#pragma unroll
        for (int i = 0; i < 4; ++i) { const int id = ct + 256 * i; *(bf16x8*)(L + O_VV + v_st4(id >> 4, (id & 15) * 8)) = pvv[i]; } }
      __syncthreads();
      f32x16 o[2]; o[0] = f32x16{}; o[1] = f32x16{};
      { bf16x8 Sb[8];
#pragma unroll
        for (int kb = 0; kb < 4; ++kb)
#pragma unroll
          for (int s = 0; s < 2; ++s) { const f32x4 e0 = *(const f32x4*)(L + V_EREF + (32 * kb + 16 * s + 4 * hi) * 4), e1 = *(const f32x4*)(L + V_EREF + (32 * kb + 16 * s + 8 + 4 * hi) * 4);
            u32x4 w; w.x = cvt_pk_bf16(S[kb][8 * s + 0] * e0[0], S[kb][8 * s + 1] * e0[1]); w.y = cvt_pk_bf16(S[kb][8 * s + 2] * e0[2], S[kb][8 * s + 3] * e0[3]);
                     w.z = cvt_pk_bf16(S[kb][8 * s + 4] * e1[0], S[kb][8 * s + 5] * e1[1]); w.w = cvt_pk_bf16(S[kb][8 * s + 6] * e1[2], S[kb][8 * s + 7] * e1[3]);
            Sb[2 * kb + s] = *reinterpret_cast<bf16x8*>(&w); }
#pragma unroll
        for (int tb = 0; tb < 2; ++tb)
#pragma unroll
          for (int ks = 0; ks < 8; ++ks) { o[tb] = __builtin_amdgcn_mfma_f32_32x32x16_bf16(nat_frag(L + O_QI, 32 * tb + r32, ks, hi), Sb[ks], o[tb], 0, 0, 0);
                                           if ((ks & 3) == 3) asm volatile("" ::: "memory"); } }
      { f32x16 a0 = f32x16{};
#pragma unroll
        for (int ks = 0; ks < 8; ++ks) { a0 = __builtin_amdgcn_mfma_f32_32x32x16_bf16(nat_frag(L + O_KI, r32, ks, hi), nat_frag(L + O_QI, r32, ks, hi), a0, 0, 0, 0);
                                         if ((ks & 3) == 3) asm volatile("" ::: "memory"); }
#pragma unroll
        for (int r = 0; r < 16; ++r) a0[r] = crow(r, hi) > r32 ? 0.f : a0[r];
        const bf16x8 pa0 = pk4(a0, 0), pa1 = pk4(a0, 1);
        const s16x4 l0 = tr_read<0 * 4096>(vbV), h0 = tr_read<0 * 4096 + 2048>(vbV), l1 = tr_read<1 * 4096>(vbV), h1 = tr_read<1 * 4096 + 2048>(vbV);
        asm volatile("s_waitcnt lgkmcnt(0)" ::: "memory"); GLA_SBAR();
        o[0] = __builtin_amdgcn_mfma_f32_32x32x16_bf16(pa0, GLA_PK(l0, h0), o[0], 0, 0, 0);
        o[0] = __builtin_amdgcn_mfma_f32_32x32x16_bf16(pa1, GLA_PK(l1, h1), o[0], 0, 0, 0); }
      { f32x16 a0 = f32x16{}, a1 = f32x16{};
#pragma unroll
        for (int ks = 0; ks < 8; ++ks) { const bf16x8 qf = nat_frag(L + O_QI, 32 + r32, ks, hi);
                                         a0 = __builtin_amdgcn_mfma_f32_32x32x16_bf16(nat_frag(L + O_KI, r32, ks, hi), qf, a0, 0, 0, 0);
                                         a1 = __builtin_amdgcn_mfma_f32_32x32x16_bf16(nat_frag(L + O_KI, 32 + r32, ks, hi), qf, a1, 0, 0, 0);
                                         if (ks & 1) asm volatile("" ::: "memory"); }
#pragma unroll
        for (int r = 0; r < 16; ++r) a1[r] = crow(r, hi) > r32 ? 0.f : a1[r];
        const bf16x8 pa0 = pk4(a0, 0), pa1 = pk4(a0, 1), pa2 = pk4(a1, 0), pa3 = pk4(a1, 1);
        const s16x4 l0 = tr_read<0 * 4096>(vbV), h0 = tr_read<0 * 4096 + 2048>(vbV), l1 = tr_read<1 * 4096>(vbV), h1 = tr_read<1 * 4096 + 2048>(vbV);
        const s16x4 l2 = tr_read<2 * 4096>(vbV), h2 = tr_read<2 * 4096 + 2048>(vbV), l3 = tr_read<3 * 4096>(vbV), h3 = tr_read<3 * 4096 + 2048>(vbV);
        asm volatile("s_waitcnt lgkmcnt(0)" ::: "memory"); GLA_SBAR();
        o[1] = __builtin_amdgcn_mfma_f32_32x32x16_bf16(pa0, GLA_PK(l0, h0), o[1], 0, 0, 0);
        o[1] = __builtin_amdgcn_mfma_f32_32x32x16_bf16(pa1, GLA_PK(l1, h1), o[1], 0, 0, 0);
        o[1] = __builtin_amdgcn_mfma_f32_32x32x16_bf16(pa2, GLA_PK(l2, h2), o[1], 0, 0, 0);
        o[1] = __builtin_amdgcn_mfma_f32_32x32x16_bf16(pa3, GLA_PK(l3, h3), o[1], 0, 0, 0); }
      if (lpath) {
      __syncthreads();
      { unsigned short* ot = (unsigned short*)(L + O_KI);
#pragma unroll
        for (int tb = 0; tb < 2; ++tb)
#pragma unroll
          for (int r = 0; r < 16; ++r) ot[(32 * tb + crow(r, hi)) * (RS / 2) + 32 * w4 + r32] = (unsigned short)(cvt_pk_bf16(o[tb][r], 0.f) & 0xffffu); }
      } else {
#pragma unroll
        for (int tb = 0; tb < 2; ++tb)
#pragma unroll
          for (int r = 0; r < 16; ++r) { ((unsigned short*)Kown)[(seq0 + GLA_ROW(n, 32 * tb + crow(r, hi))) * 1024 + cb + 32 * w4 + r32] = (unsigned short)(cvt_pk_bf16(o[tb][r], 0.f) & 0xffffu);
            if ((r & 3) == 3) asm volatile("" ::: "memory"); }
      }
      if (step < 64) { const int nn = dir ? n - 1 : n + 1; GLA_LOAD(nn); }
#pragma unroll
      for (int kb = 0; kb < 4; ++kb)
#pragma unroll
        for (int g4 = 0; g4 < 4; ++g4) { const f32x4 dc = *(const f32x4*)(L + V_DEC + (32 * kb + 8 * g4 + 4 * hi) * 4);
          S[kb][4 * g4 + 0] *= dc[0]; S[kb][4 * g4 + 1] *= dc[1]; S[kb][4 * g4 + 2] *= dc[2]; S[kb][4 * g4 + 3] *= dc[3]; }
      { const s16x4 l0 = tr_read<0 * 4096>(vbV), h0 = tr_read<0 * 4096 + 2048>(vbV), l1 = tr_read<1 * 4096>(vbV), h1 = tr_read<1 * 4096 + 2048>(vbV);
        const s16x4 l2 = tr_read<2 * 4096>(vbV), h2 = tr_read<2 * 4096 + 2048>(vbV), l3 = tr_read<3 * 4096>(vbV), h3 = tr_read<3 * 4096 + 2048>(vbV);
        asm volatile("s_waitcnt lgkmcnt(0)" ::: "memory"); GLA_SBAR();
        const bf16x8 vf0 = GLA_PK(l0, h0), vf1 = GLA_PK(l1, h1), vf2 = GLA_PK(l2, h2), vf3 = GLA_PK(l3, h3);
#define GLA_UPD(kb) do { const s16x4 a0 = tr_read<(kb) * 512 + 0 * 4096>(vbK), b0 = tr_read<(kb) * 512 + 0 * 4096 + 2048>(vbK), a1 = tr_read<(kb) * 512 + 1 * 4096>(vbK), b1 = tr_read<(kb) * 512 + 1 * 4096 + 2048>(vbK); \
          const s16x4 a2 = tr_read<(kb) * 512 + 2 * 4096>(vbK), b2 = tr_read<(kb) * 512 + 2 * 4096 + 2048>(vbK), a3 = tr_read<(kb) * 512 + 3 * 4096>(vbK), b3 = tr_read<(kb) * 512 + 3 * 4096 + 2048>(vbK); \
          asm volatile("s_waitcnt lgkmcnt(0)" ::: "memory"); GLA_SBAR(); \
          S[kb] = __builtin_amdgcn_mfma_f32_32x32x16_bf16(GLA_PK(a0, b0), vf0, S[kb], 0, 0, 0); S[kb] = __builtin_amdgcn_mfma_f32_32x32x16_bf16(GLA_PK(a1, b1), vf1, S[kb], 0, 0, 0); \
          S[kb] = __builtin_amdgcn_mfma_f32_32x32x16_bf16(GLA_PK(a2, b2), vf2, S[kb], 0, 0, 0); S[kb] = __builtin_amdgcn_mfma_f32_32x32x16_bf16(GLA_PK(a3, b3), vf3, S[kb], 0, 0, 0); } while (0)
        GLA_UPD(0); GLA_UPD(1); GLA_UPD(2); GLA_UPD(3);
#undef GLA_UPD
      }
      if (lpath) {
      __syncthreads();
      const int t = ct >> 2, q4 = ct & 3; const size_t goff = (seq0 + GLA_ROW(n, t)) * 1024 + cb + 32 * q4;
      u32x2 ow[8];
#pragma unroll
      for (int i = 0; i < 8; ++i) ow[i] = *(const u32x2*)(L + O_KI + t * RS + q4 * 64 + i * 8);
      if (!fin) {
#pragma unroll
        for (int i = 0; i < 4; ++i) *(u32x4*)(Kown + goff + 8 * i) = (u32x4){ow[2 * i].x, ow[2 * i].y, ow[2 * i + 1].x, ow[2 * i + 1].y};
      }
      if (step == 32) __syncthreads();
      if (fin) {
        float ov[32]; float ss = 0.f;
#pragma unroll
        for (int i = 0; i < 4; ++i) { const u32x4 pw = *(const u32x4*)(Koth + goff + 8 * i);
          ov[8 * i + 0] = bf_lo(ow[2 * i].x) + bf_lo(pw.x); ov[8 * i + 1] = bf_hi(ow[2 * i].x) + bf_hi(pw.x); ov[8 * i + 2] = bf_lo(ow[2 * i].y) + bf_lo(pw.y); ov[8 * i + 3] = bf_hi(ow[2 * i].y) + bf_hi(pw.y);
          ov[8 * i + 4] = bf_lo(ow[2 * i + 1].x) + bf_lo(pw.z); ov[8 * i + 5] = bf_hi(ow[2 * i + 1].x) + bf_hi(pw.z); ov[8 * i + 6] = bf_lo(ow[2 * i + 1].y) + bf_lo(pw.w); ov[8 * i + 7] = bf_hi(ow[2 * i + 1].y) + bf_hi(pw.w); }
#pragma unroll
        for (int i = 0; i < 32; ++i) ss += ov[i] * ov[i];
        ss += __shfl_xor(ss, 1); ss += __shfl_xor(ss, 2);
        const float rstd = 1.0f / sqrtf(ss * (1.0f / 128.0f) + EPS);
#pragma unroll
        for (int i = 0; i < 4; ++i) { const u32x4 gw = *(const u32x4*)(SGb + goff + 8 * i); const f32x4 n0 = *(const f32x4*)(onorm + cb + 32 * q4 + 8 * i), n1 = *(const f32x4*)(onorm + cb + 32 * q4 + 8 * i + 4);
          u32x4 w; w.x = cvt_pk_bf16(ov[8 * i + 0] * rstd * n0[0] * bf_lo(gw.x), ov[8 * i + 1] * rstd * n0[1] * bf_hi(gw.x)); w.y = cvt_pk_bf16(ov[8 * i + 2] * rstd * n0[2] * bf_lo(gw.y), ov[8 * i + 3] * rstd * n0[3] * bf_hi(gw.y));
                   w.z = cvt_pk_bf16(ov[8 * i + 4] * rstd * n1[0] * bf_lo(gw.z), ov[8 * i + 5] * rstd * n1[1] * bf_hi(gw.z)); w.w = cvt_pk_bf16(ov[8 * i + 6] * rstd * n1[2] * bf_lo(gw.w), ov[8 * i + 7] * rstd * n1[3] * bf_hi(gw.w));
          *(u32x4*)(Qb + goff + 8 * i) = w; }
      }
      }
      if (step < 64) GLA_PASS1();
      __syncthreads();
    }
#undef GLA_ROW
#undef GLA_LOAD
#undef GLA_PASS1
  }
  __syncthreads();
}
#undef GLA_PK
#undef GLA_SBAR
}
constexpr int NPHASE = 16;
#ifndef GLA_SIMPLE
#define GLA_SIMPLE 0
#endif
#ifndef ATTN_SIMPLE
#define ATTN_SIMPLE 0
#endif
#ifndef MK_ONE_LAUNCH
#define MK_ONE_LAUNCH 1
#endif
struct Args { const float* in[19]; float* out; unsigned char* ws; int ph_lo, ph_hi; };
__global__ void __launch_bounds__(NWAVES * 64, 2) fwd(Args args) {
    extern __shared__ __attribute__((aligned(16))) unsigned char lds[];
    Frame F;
    F.lds = (LAS unsigned char*)lds;
    F.MISC = (volatile LAS unsigned*)(F.lds + MISC_OFF);
    F.tid = threadIdx.x; F.lane = F.tid & 63; F.wave = __builtin_amdgcn_readfirstlane(F.tid >> 6);
    F.G = gridDim.x; { const int bx = blockIdx.x; F.vcu = (F.G % 8 == 0) ? (bx % 8) * (F.G / 8) + bx / 8 : bx; }
    unsigned char* ws = args.ws;
    for (int u = F.tid; u < (LDS_BYTES - LDSCTL_OFF) / 4; u += NWAVES * 64) ((LAS unsigned*)(F.lds + LDSCTL_OFF))[u] = 0u;
    __syncthreads();
    const int lo = args.ph_lo, hi = args.ph_hi;
    XcdBarrier bar; bar.bar = (unsigned*)(ws + WS_CTL); bar.x = 0; bar.st = nullptr;
    if (hi - lo > 1) bar = xcd_barrier_post((unsigned*)(ws + WS_CTL), F.MISC + 8);
#ifndef ONLY_PHASE
#define ONLY_PHASE -1
#endif
#define IN(k) (lo <= (k) && (k) < hi && (ONLY_PHASE < 0 || ONLY_PHASE == (k)))
#ifndef DUP_MASK
#define DUP_MASK 0
#endif
#ifndef PROBE_NULL_GEMM
#define PROBE_NULL_GEMM 0
#endif
#ifndef DUP_GLA
#define DUP_GLA 0
#endif
#define SEAM(k) do { if (IN(k) && IN((k) + 1)) xcd_barrier(bar); } while (0)
    const float* const* in = args.in;
    bf16* hD = (bf16*)args.out;
    bf16* hB = (bf16*)(ws + WS_B0 + (size_t)SLACK * ROWB);
    const pg8::f32x2* rope = (const pg8::f32x2*)(ws + WS_ROPE);
    using pg8::Gemm; using pg8::StaticOrder;
    const int cid = (int)blockIdx.x;

    if (IN(0)) { p0_prologue(F, in, ws, hD); } SEAM(0);
    if (IN(1)) { Gemm g{hD, (const bf16*)(ws + W_IN), 1024, 1024, 1024}; StaticOrder S; S.init(MT, 5, F.G, cid);
        pg8::EpiProj E{(bf16*)(ws + R_CQKV), (float*)(ws + R_SSQ), (bf16*)(ws + R_KROPE), rope};
        pg8::gemm_phase<pg8::EpiProj, StaticOrder, true, true>(F.lds + RING_OFF, g, S, E); } SEAM(1);
    if (IN(2)) {
        { Gemm g{(const bf16*)(ws + R_CQKV), (const bf16*)(ws + W_UQ), 768, 1024, 768}; StaticOrder S; S.init(MT, 6, F.G, cid);
          pg8::EpiQ E{(bf16*)(ws + R_Q), (const float*)(ws + R_SSQ), rope};
          pg8::gemm_phase<pg8::EpiQ, StaticOrder, true, true>(F.lds + RING_OFF, g, S, E); }
        { Gemm g{(const bf16*)(ws + R_CQKV) + 768, (const bf16*)(ws + W_UKV), 256, 1024, 256}; StaticOrder S; S.init(MT, 8, F.G, cid);
          pg8::EpiKV E{(bf16*)(ws + R_KV), (const float*)(ws + R_SSQ)};
          pg8::gemm_phase<pg8::EpiKV, StaticOrder, true, true>(F.lds + RING_OFF, g, S, E); }
    } SEAM(2);
    if (IN(3)) {
#if ATTN_SIMPLE
        attn_simple(F, (const bf16*)(ws + R_Q), (const bf16*)(ws + R_KV), (const bf16*)(ws + R_KROPE), (bf16*)(ws + R_CQKV));
#else
        fa4::attn_phase(F.vcu, F.G, (const bf16*)(ws + R_Q), (const bf16*)(ws + R_KV), (const bf16*)(ws + R_KROPE), (bf16*)(ws + R_CQKV), (char*)lds);
#endif
        { const int nlast = (NB * 16 * fa::NQC) % F.G; if (F.vcu >= nlast) tail_jobs_0(F, in, ws, F.vcu - nlast, F.G - nlast); }
    } SEAM(3);
    if (IN(4)) { Gemm g{(const bf16*)(ws + R_CQKV), (const bf16*)(ws + W_O), 1024, 1024, 1024}; StaticOrder S; S.init(MT, 4, F.G, cid);
        pg8::EpiResidLN<false, false> E{hD, nullptr, nullptr, nullptr, hB, (pg8::f32x2*)(ws + WS_SUM1) + SLACK, nullptr};
        pg8::gemm_phase<pg8::EpiResidLN<false, false>, StaticOrder, true, true>(F.lds + RING_OFF, g, S, E);
        { const int nfull = (MT * 4) % F.G; if (cid >= nfull) tail_jobs_a(F, in, ws, cid - nfull, F.G - nfull); } } SEAM(4);
#if PROBE_NULL_GEMM
    if (IN(5)) { Gemm g{hD, (const bf16*)(ws + W_HIN), 1024, 1024, 1024}; StaticOrder S; S.init(MT, 20, F.G, cid);
        pg8::EpiNull E{(float*)(ws + WS_CTL + 32768)};
        pg8::gemm_phase<pg8::EpiNull, StaticOrder, true, true>(F.lds + RING_OFF, g, S, E); }
#endif
    if (IN(6)) { Gemm g{hB - 1024, (const bf16*)(ws + W_UP0), 1024, 1024, 1024}; StaticOrder S; S.init(MT_UP, 22, F.G, cid);
        pg8::EpiConvGate E{(bf16*)(ws + R_ACT), in[14], in[15], (const pg8::f32x2*)(ws + WS_SUM1) + SLACK, (const float*)(ws + C1_UP0), (const float*)(ws + C2_UP0)};
        pg8::gemm_phase<pg8::EpiConvGate, StaticOrder, true, true, true>(F.lds + RING_OFF, g, S, E); } SEAM(6);
    if (IN(7)) { Gemm g{(const bf16*)(ws + R_ACT), (const bf16*)(ws + W_DN0), DFF, DFF, DFF}; StaticOrder S; S.init(MT, 4, F.G, cid);
        pg8::EpiResidLN<true, false> E{hB, (const pg8::f32x2*)(ws + WS_SUM1) + SLACK, in[17] + 0 * 1024, in[18] + 0 * 1024, hD, (pg8::f32x2*)(ws + WS_SUM2) + SLACK, nullptr};
        pg8::gemm_phase<pg8::EpiResidLN<true, false>, StaticOrder, true, true>(F.lds + RING_OFF, g, S, E);
        { const int nfull = (MT * 4) % F.G; if (cid >= nfull) tail_jobs_b(F, in, ws, cid - nfull, F.G - nfull); } } SEAM(7);
    if (IN(9)) { Gemm g{hD, (const bf16*)(ws + W_HIN), 1024, 1024, 1024}; StaticOrder S; S.init(MT, 20, F.G, cid);
        pg8::EpiHgIn E{hB, (bf16*)(ws + R_HV), (bf16*)(ws + R_HKF), (bf16*)(ws + R_HKB), (bf16*)(ws + R_HSG), (const float*)(ws + WS_LB), (const pg8::f32x2*)(ws + WS_SUM2) + SLACK, (const float*)(ws + C1_HG), (const float*)(ws + C2_HG)};
        pg8::gemm_phase<pg8::EpiHgIn, StaticOrder, true, true>(F.lds + RING_OFF, g, S, E); } SEAM(9);
    if (IN(10)) {
#if GLA_SIMPLE
        gla_simple(F, hB, (const bf16*)(ws + R_HV), (bf16*)(ws + R_HKF), (const bf16*)(ws + R_HKB), (const bf16*)(ws + R_HSG), in[11]);
#else
        gla::gla_phase((int)blockIdx.x, F.G, hB, (const bf16*)(ws + R_HV), (bf16*)(ws + R_HKF), (bf16*)(ws + R_HKB), (const bf16*)(ws + R_HSG), in[11], (char*)lds);
#endif
    } SEAM(10);
    if (IN(11)) {
        { const int gt = (F.vcu * NWAVES + F.wave) * 64 + F.lane, NGT = F.G * NWAVES * 64; GAS v4u* z0 = (GAS v4u*)(ws + R_HSG); GAS v4u* z1 = (GAS v4u*)(ws + R_XB3 + (size_t)M * ROWB);
          for (int i = gt; i < SLACK * (int)ROWB / 16; i += NGT) { z0[i] = (v4u){0u, 0u, 0u, 0u}; z1[i] = (v4u){0u, 0u, 0u, 0u}; } }
        Gemm g{hB, (const bf16*)(ws + W_HO), 1024, 1024, 1024}; StaticOrder S; S.init(MT, 4, F.G, cid);
        pg8::EpiResidLN<true, false> E{hD, (const pg8::f32x2*)(ws + WS_SUM2) + SLACK, in[17] + 1 * 1024, in[18] + 1 * 1024, (bf16*)(ws + R_XB3), (pg8::f32x2*)(ws + WS_SUM3) + SLACK, nullptr};
        pg8::gemm_phase<pg8::EpiResidLN<true, false>, StaticOrder, true, true>(F.lds + RING_OFF, g, S, E); } SEAM(11);
    if (IN(13)) { Gemm g{(const bf16*)(ws + R_XB3) - 1024, (const bf16*)(ws + W_UP1), 1024, 1024, 1024}; StaticOrder S; S.init(MT_UP, 22, F.G, cid);
        pg8::EpiConvGate E{(bf16*)(ws + R_ACT), in[14] + 3 * NUP, in[15] + NUP, (const pg8::f32x2*)(ws + WS_SUM3) + SLACK, (const float*)(ws + C1_UP1), (const float*)(ws + C2_UP1)};
        pg8::gemm_phase<pg8::EpiConvGate, StaticOrder, true, true, true>(F.lds + RING_OFF, g, S, E); } SEAM(13);
    if (IN(14)) { Gemm g{(const bf16*)(ws + R_ACT), (const bf16*)(ws + W_DN1), DFF, DFF, DFF}; StaticOrder S; S.init(MT, 4, F.G, cid);
        pg8::EpiResidLN<true, false> E{(const bf16*)(ws + R_XB3), (const pg8::f32x2*)(ws + WS_SUM3) + SLACK, in[17] + 2 * 1024, in[18] + 2 * 1024, hB, (pg8::f32x2*)(ws + WS_SUM4) + SLACK, nullptr};
        pg8::gemm_phase<pg8::EpiResidLN<true, false>, StaticOrder, true, true>(F.lds + RING_OFF, g, S, E); } SEAM(14);
    if (IN(15)) { ln_final(F, hB, (const f32x2*)(ws + WS_SUM4) + SLACK, args.out, in[17] + 3 * 1024, in[18] + 3 * 1024); }
#undef IN
#undef SEAM
}

__global__ void nan_fill(float* o, long n) { const float q = __builtin_nanf(""); for (long i = blockIdx.x * 256L + threadIdx.x; i < n; i += gridDim.x * 256L) o[i] = q; }
extern "C" void kernel_launch(void* const* d_in, const int* in_sizes, int n_in, void* d_out, int out_size, void* d_ws, size_t ws_size, hipStream_t stream) {
    static int grid = 0;
    if (grid == 0) {
        bool ok = (n_in == 19) && in_sizes[0] == 16 * SEQ * 1024 && in_sizes[1] == 4 * SEQ * 1024 && out_size == NB * SEQ * 1024 && ws_size >= WS_END;
        int dev = 0, cus = 0;
        if (ok) ok = hipGetDevice(&dev) == hipSuccess && hipDeviceGetAttribute(&cus, hipDeviceAttributeMultiprocessorCount, dev) == hipSuccess;
        if (ok) ok = hipFuncSetAttribute((const void*)fwd, hipFuncAttributeMaxDynamicSharedMemorySize, LDS_BYTES) == hipSuccess;
        if (!ok) { fprintf(stderr, "kernel_launch: unexpected shapes / workspace (%zu) / device\n", ws_size); grid = -1; }
        else grid = cus;
        (void)hipGetLastError();
    }
    if (grid < 0) { hipLaunchKernelGGL(nan_fill, dim3(1024), dim3(256), 0, stream, (float*)d_out, (long)out_size); return; }
    (void)hipMemsetAsync((char*)d_ws + WS_CTL, 0, CTL_ZERO_BYTES, stream);
    Args a{};
    for (int i = 0; i < 19; ++i) a.in[i] = (const float*)d_in[i];
    a.out = (float*)d_out; a.ws = (unsigned char*)d_ws;
#if MK_ONE_LAUNCH
    a.ph_lo = 0; a.ph_hi = NPHASE;
    hipLaunchKernelGGL(fwd, dim3(grid), dim3(NWAVES * 64), LDS_BYTES, stream, a);
#else
    for (int p = 0; p < NPHASE; ++p) { if ((p == 5 && !PROBE_NULL_GEMM) || p == 8 || p == 12) continue;
        for (int r = 0; r < 1 + ((DUP_MASK >> p) & 1); ++r) { a.ph_lo = p; a.ph_hi = p + 1; hipLaunchKernelGGL(fwd, dim3(grid), dim3(NWAVES * 64), LDS_BYTES, stream, a); }
        if (p == 10 && DUP_GLA) for (int q = 9; q <= 10; ++q) { a.ph_lo = q; a.ph_hi = q + 1; hipLaunchKernelGGL(fwd, dim3(grid), dim3(NWAVES * 64), LDS_BYTES, stream, a); } }
#endif
}
```
